# Optimizing an MI355X kernel written in HIP

```python
import math
import jax
import jax.numpy as jnp
from jax import lax
import numpy as np


D_MODEL = 2048
BATCH = 8
SEQ = 2048
DEPTH = 4

N_META = 16
GLA_HEADS = 4
GLA_DK = 64
GLA_DV = 128
GLA_WIDTH = GLA_HEADS * GLA_DV
GLA_RANK = 16
GLA_TAU = 16.0
GLA_CHUNK = 64
GLA_PAD = (-N_META) % GLA_CHUNK
SWA_HEADS = 8
SWA_KV_HEADS = 2
SWA_GROUP = SWA_HEADS // SWA_KV_HEADS
SWA_HEAD_DIM = 128
SWA_WIDTH = SWA_HEADS * SWA_HEAD_DIM
WINDOW = 128
SWA_BLOCK = 128
SWA_PAD = (-N_META) % SWA_BLOCK
HY_WIDTH = 512
HY_SHORT = 3
HY_BANDS = 16
HY_EMB = 2 * HY_BANDS + 1
HY_FFN = 64
HY_FAST_PCT = 0.3
HY_SLOW_PCT = 1.5
HY_TARGET = 1e-2
MIX_WIDTH = GLA_WIDTH + SWA_WIDTH + HY_WIDTH
IN_SIZES = (GLA_HEADS * GLA_DK, GLA_HEADS * GLA_DK, GLA_WIDTH, GLA_RANK, GLA_RANK, GLA_WIDTH,
            SWA_WIDTH, SWA_KV_HEADS * SWA_HEAD_DIM, SWA_KV_HEADS * SWA_HEAD_DIM, 3 * HY_WIDTH)
IN_COLS = sum(IN_SIZES)
IN_OFFSETS = tuple(int(o) for o in np.cumsum(IN_SIZES)[:-1])
N_GROUPS = 4
EXPERTS_PER_GROUP = 4
N_EXPERTS = N_GROUPS * EXPERTS_PER_GROUP
TOP_K = 2
D_EXPERT = 1024
ALPHA = (2.0 * DEPTH) ** 0.25
BETA = (8.0 * DEPTH) ** -0.25
LN_EPS = 1e-5
RMS_EPS = 1e-6
NEG = -1e30

kernel_name = 'hymba_gla_swa_hyena_hmoe_encoder'


def layer_norm(x, g, b):
    xf = x.astype(jnp.float32)
    mu = jnp.mean(xf, axis=-1, keepdims=True)
    var = jnp.mean(jnp.square(xf - mu), axis=-1, keepdims=True)
    y = (xf - mu) * lax.rsqrt(var + LN_EPS) * g.astype(jnp.float32) + b.astype(jnp.float32)
    return y.astype(x.dtype)


def rms_norm(x, g):
    xf = x.astype(jnp.float32)
    return xf * lax.rsqrt(jnp.mean(xf * xf, axis=-1, keepdims=True) + RMS_EPS) * g.astype(jnp.float32)


def gla_chunked(q, k, v, log_a, include_diag):
    bsz, nh, t, dk = q.shape
    dv = v.shape[-1]
    nc = t // GLA_CHUNK
    q, k, log_a = (a.reshape(bsz, nh, nc, GLA_CHUNK, dk) for a in (q, k, log_a))
    v = v.reshape(bsz, nh, nc, GLA_CHUNK, dv)
    cum = jnp.cumsum(log_a, axis=3)
    cum_last = cum[:, :, :, -1:, :]
    q_dec = q * jnp.exp(cum)
    k_inv = k * jnp.exp(-cum)
    lower = jnp.tril(jnp.ones((GLA_CHUNK, GLA_CHUNK), bool), k=0 if include_diag else -1)
    att = jnp.where(lower, jnp.einsum('bhncd,bhnsd->bhncs', q_dec, k_inv), 0.0)
    o_intra = jnp.einsum('bhncs,bhnsv->bhncv', att, v)
    kv_chunk = jnp.einsum('bhnsd,bhnsv->bhndv', k * jnp.exp(cum_last - cum), v)
    decay_chunk = jnp.exp(cum_last[:, :, :, 0, :])

    def step(state, inp):
        dec, kv = inp
        return dec[..., None] * state + kv, state

    s0 = jnp.zeros((bsz, nh, dk, dv), jnp.float32)
    _, s_prev = lax.scan(step, s0, (jnp.moveaxis(decay_chunk, 2, 0), jnp.moveaxis(kv_chunk, 2, 0)))
    s_prev = jnp.moveaxis(s_prev, 0, 2)
    o_inter = jnp.einsum('bhncd,bhndv->bhncv', q_dec, s_prev)
    return (o_intra + o_inter).reshape(bsz, nh, t, dv)


def gla_branch(q, k, v, gl_f, gl_b, r, w2_f, b_f, w2_b, b_b, norm_g):
    bsz, seq_len, _ = q.shape
    dt = q.dtype

    def heads(a, d):
        a = a.astype(jnp.float32).reshape(bsz, seq_len, GLA_HEADS, d)
        a = jnp.pad(a, ((0, 0), (GLA_PAD, 0), (0, 0), (0, 0)))
        return a.transpose(0, 2, 1, 3)

    log_f = jax.nn.log_sigmoid(gl_f.astype(jnp.float32) @ w2_f.astype(jnp.float32) + b_f.astype(jnp.float32)) / GLA_TAU
    log_b = jax.nn.log_sigmoid(gl_b.astype(jnp.float32) @ w2_b.astype(jnp.float32) + b_b.astype(jnp.float32)) / GLA_TAU
    qh = heads(q, GLA_DK) * GLA_DK ** -0.5
    kh = heads(k, GLA_DK)
    vh = heads(v, GLA_DV)
    o_fwd = gla_chunked(qh, kh, vh, heads(log_f, GLA_DK), True)

    def flip(a):
        return jnp.flip(a, axis=2)

    o_bwd = flip(gla_chunked(flip(qh), flip(kh), flip(vh), flip(heads(log_b, GLA_DK)), False))
    o = (o_fwd + o_bwd)[:, :, GLA_PAD:].transpose(0, 2, 1, 3)
    o = rms_norm(o, norm_g.reshape(GLA_HEADS, GLA_DV)).reshape(bsz, seq_len, GLA_WIDTH)
    return (o * jax.nn.silu(r.astype(jnp.float32))).astype(dt)


def swa_branch(q, k, v, sink, norm_g):
    bsz, seq_len, _ = q.shape
    dt = q.dtype
    t_pad = seq_len + SWA_PAD
    nb = t_pad // SWA_BLOCK
    qf = q.astype(jnp.float32).reshape(bsz, seq_len, SWA_KV_HEADS, SWA_GROUP, SWA_HEAD_DIM)
    qf = jnp.pad(qf, ((0, 0), (SWA_PAD, 0), (0, 0), (0, 0), (0, 0)))
    qb = qf.reshape(bsz, nb, SWA_BLOCK, SWA_KV_HEADS, SWA_GROUP, SWA_HEAD_DIM) * SWA_HEAD_DIM ** -0.5
    kf = k.astype(jnp.float32).reshape(bsz, seq_len, SWA_KV_HEADS, SWA_HEAD_DIM)
    vf = v.astype(jnp.float32).reshape(bsz, seq_len, SWA_KV_HEADS, SWA_HEAD_DIM)
    k_meta, v_meta = kf[:, :N_META], vf[:, :N_META]
    ext = ((0, 0), (SWA_PAD + SWA_BLOCK, SWA_BLOCK), (0, 0), (0, 0))

    def band(a):
        a = jnp.pad(a, ext).reshape(bsz, nb + 2, SWA_BLOCK, SWA_KV_HEADS, SWA_HEAD_DIM)
        return jnp.concatenate([a[:, :-2], a[:, 1:-1], a[:, 2:]], axis=2)

    k_band, v_band = band(kf), band(vf)
    pos_q = (jnp.arange(t_pad, dtype=jnp.int32) - SWA_PAD).reshape(nb, SWA_BLOCK)
    pos_e = (jnp.arange(t_pad + 2 * SWA_BLOCK, dtype=jnp.int32) - SWA_PAD - SWA_BLOCK).reshape(nb + 2, SWA_BLOCK)
    pos_band = jnp.concatenate([pos_e[:-2], pos_e[1:-1], pos_e[2:]], axis=1)
    dist_band = jnp.abs(pos_q[:, :, None] - pos_band[:, None, :])
    band_ok = (pos_band[:, None, :] >= N_META) & (pos_band[:, None, :] < seq_len) & (dist_band <= WINDOW)
    dist_meta = jnp.abs(pos_q[:, :, None] - jnp.arange(N_META, dtype=jnp.int32)[None, None, :]).astype(jnp.float32)
    slopes = (2.0 ** (-8.0 * jnp.arange(1, SWA_HEADS + 1, dtype=jnp.float32) / SWA_HEADS)).reshape(SWA_KV_HEADS, SWA_GROUP)
    slopes = slopes[:, :, None, None, None]
    s_meta = jnp.einsum('bnqhgd,bmhd->bhgnqm', qb, k_meta) - slopes * dist_meta
    s_band = jnp.einsum('bnqhgd,bnkhd->bhgnqk', qb, k_band) - slopes * dist_band.astype(jnp.float32)
    s_band = jnp.where(band_ok, s_band, NEG)
    sink_col = jnp.broadcast_to(sink.astype(jnp.float32).reshape(SWA_KV_HEADS, SWA_GROUP)[:, :, None, None, None],
                                (bsz, SWA_KV_HEADS, SWA_GROUP, nb, SWA_BLOCK, 1))
    p = jax.nn.softmax(jnp.concatenate([sink_col, s_meta, s_band], axis=-1), axis=-1)
    out = (jnp.einsum('bhgnqm,bmhd->bnqhgd', p[..., 1:1 + N_META], v_meta)
           + jnp.einsum('bhgnqk,bnkhd->bnqhgd', p[..., 1 + N_META:], v_band))
    out = out.reshape(bsz, t_pad, SWA_WIDTH)[:, SWA_PAD:]
    return rms_norm(out, norm_g).astype(dt)


def short_conv(u, w, b):
    up = jnp.pad(u, ((0, 0), (1, 1), (0, 0)))
    return up[:, :-2] * w[0] + up[:, 1:-1] * w[1] + up[:, 2:] * w[2] + b


def hyena_filters(seq_len, w1, b1, freq, w2, b2, w3):
    f32 = jnp.float32
    t = jnp.linspace(0.0, 1.0, seq_len, dtype=f32)[:, None]
    w = 2.0 * math.pi * jnp.arange(seq_len, dtype=f32)[:, None] / seq_len
    bands = jnp.linspace(1e-4, HY_BANDS - 1, HY_BANDS, dtype=f32)
    z = jnp.concatenate([t, jnp.cos(bands * w), -jnp.sin(bands * w)], axis=-1)
    freq = freq.astype(f32)
    h = jnp.sin(freq[0] * (z @ w1.astype(f32) + b1.astype(f32)))
    h = jnp.sin(freq[1] * (h @ w2.astype(f32) + b2.astype(f32)))
    h = h @ w3.astype(f32)
    max_decay = math.log(HY_TARGET) / HY_FAST_PCT
    min_decay = math.log(HY_TARGET) / HY_SLOW_PCT
    deltas = jnp.linspace(min_decay, max_decay, HY_WIDTH, dtype=f32)
    window = jnp.exp(-t * jnp.abs(deltas))
    h = h.reshape(seq_len, 2, HY_WIDTH) * window[:, None, :]
    return h[:, 0], h[:, 1]


def bidir_fftconv(u, h_fwd, h_bwd, skip):
    seq_len = u.shape[1]
    kern = jnp.concatenate([h_fwd, jnp.zeros((1, HY_WIDTH), jnp.float32), h_bwd[1:][::-1]], axis=0)
    u_hat = jnp.fft.rfft(u, n=2 * seq_len, axis=1)
    k_hat = jnp.fft.rfft(kern, axis=0)
    y = jnp.fft.irfft(u_hat * k_hat[None], n=2 * seq_len, axis=1)[:, :seq_len]
    return y + u * skip.astype(jnp.float32)


def hyena_branch(u, conv_w, conv_b, w1, b1, freq, w2, b2, w3, skip, norm_g):
    dt = u.dtype
    seq_len = u.shape[1]
    uc = short_conv(u.astype(jnp.float32), conv_w.astype(jnp.float32), conv_b.astype(jnp.float32))
    x0, x1, v = jnp.split(uc, 3, axis=-1)
    h_fwd, h_bwd = hyena_filters(seq_len, w1, b1, freq, w2, b2, w3)
    y = x0 * bidir_fftconv(x1 * v, h_fwd, h_bwd, skip)
    return rms_norm(y, norm_g).astype(dt)


def hier_moe(x, wg, bg, we, be, w_gate, w_up, w_down):
    bsz, seq_len, d = x.shape
    xt = x.reshape(-1, d)
    g_prob = jax.nn.softmax((xt @ wg + bg).astype(jnp.float32), axis=-1)
    g_top, g_idx = lax.top_k(g_prob, 1)
    e_logits = (xt @ we + be).astype(jnp.float32).reshape(-1, N_GROUPS, EXPERTS_PER_GROUP)
    e_logits = jnp.take_along_axis(e_logits, g_idx[:, :, None], axis=1)[:, 0]
    e_top, e_idx = lax.top_k(e_logits, TOP_K)
    e_w = jax.nn.softmax(e_top, axis=-1) * g_top
    expert_id = g_idx * EXPERTS_PER_GROUP + e_idx
    gates = jnp.sum(jax.nn.one_hot(expert_id, N_EXPERTS, dtype=jnp.float32) * e_w[..., None], axis=1)
    out = jnp.zeros((xt.shape[0], d), jnp.float32)
    for e in range(N_EXPERTS):
        h = jax.nn.silu(xt @ w_gate[e]) * (xt @ w_up[e])
        out = out + gates[:, e:e + 1] * (h @ w_down[e]).astype(jnp.float32)
    return out.astype(x.dtype).reshape(bsz, seq_len, d)


def setup_inputs(seed: int = 0):
    key = jax.random.key(seed)
    keys = iter(jax.random.split(key, 48))

    def nrm(shape, scale):
        return scale * jax.random.normal(next(keys), shape, jnp.float32)

    def gain(shape):
        return 1.0 + nrm(shape, 0.02)

    segments = ((256, 1.0), (256, 1.0), (GLA_WIDTH, BETA), (GLA_RANK, 1.0), (GLA_RANK, 1.0), (GLA_WIDTH, 1.0),
                (SWA_WIDTH, 1.0), (256, 1.0), (256, BETA), (2 * HY_WIDTH, 1.0), (HY_WIDTH, BETA))
    col_scale = jnp.concatenate([jnp.full((n,), s, jnp.float32) for n, s in segments])
    return {
        'x': nrm((BATCH, SEQ, D_MODEL), 1.0),
        'meta': nrm((N_META, D_MODEL), 1.0),
        'emb_ln_g': gain((D_MODEL,)),
        'emb_ln_b': nrm((D_MODEL,), 0.02),
        'w_in': nrm((DEPTH, D_MODEL, IN_COLS), D_MODEL ** -0.5) * col_scale,
        'b_in': nrm((DEPTH, IN_COLS), 0.02),
        'gla_w2_f': nrm((DEPTH, GLA_RANK, GLA_HEADS * GLA_DK), GLA_RANK ** -0.5),
        'gla_b_f': nrm((DEPTH, GLA_HEADS * GLA_DK), 0.02),
        'gla_w2_b': nrm((DEPTH, GLA_RANK, GLA_HEADS * GLA_DK), GLA_RANK ** -0.5),
        'gla_b_b': nrm((DEPTH, GLA_HEADS * GLA_DK), 0.02),
        'gla_norm_g': gain((DEPTH, GLA_WIDTH)),
        'swa_sink': nrm((DEPTH, SWA_HEADS), 0.5),
        'swa_norm_g': gain((DEPTH, SWA_WIDTH)),
        'hy_conv_w': nrm((DEPTH, HY_SHORT, 3 * HY_WIDTH), HY_SHORT ** -0.5),
        'hy_conv_b': nrm((DEPTH, 3 * HY_WIDTH), 0.02),
        'hy_w1': nrm((DEPTH, HY_EMB, HY_FFN), HY_EMB ** -0.5),
        'hy_b1': nrm((DEPTH, HY_FFN), 0.02),
        'hy_freq': gain((DEPTH, 2, HY_FFN)),
        'hy_w2': nrm((DEPTH, HY_FFN, HY_FFN), HY_FFN ** -0.5),
        'hy_b2': nrm((DEPTH, HY_FFN), 0.02),
        'hy_w3': nrm((DEPTH, HY_FFN, 2 * HY_WIDTH), 0.1 * HY_FFN ** -0.5),
        'hy_skip': nrm((DEPTH, HY_WIDTH), 0.5),
        'hy_norm_g': gain((DEPTH, HY_WIDTH)),
        'w_out': nrm((DEPTH, MIX_WIDTH, D_MODEL), BETA * MIX_WIDTH ** -0.5),
        'b_out': nrm((DEPTH, D_MODEL), 0.02),
        'ln1_g': gain((DEPTH, D_MODEL)),
        'ln1_b': nrm((DEPTH, D_MODEL), 0.02),
        'router_wg': nrm((DEPTH, D_MODEL, N_GROUPS), D_MODEL ** -0.5),
        'router_bg': nrm((DEPTH, N_GROUPS), 0.01),
        'router_we': nrm((DEPTH, D_MODEL, N_EXPERTS), D_MODEL ** -0.5),
        'router_be': nrm((DEPTH, N_EXPERTS), 0.01),
        'exp_w_gate': nrm((DEPTH, N_EXPERTS, D_MODEL, D_EXPERT), BETA * D_MODEL ** -0.5),
        'exp_w_up': nrm((DEPTH, N_EXPERTS, D_MODEL, D_EXPERT), BETA * D_MODEL ** -0.5),
        'exp_w_down': nrm((DEPTH, N_EXPERTS, D_EXPERT, D_MODEL), BETA * D_EXPERT ** -0.5),
        'ln2_g': gain((DEPTH, D_MODEL)),
        'ln2_b': nrm((DEPTH, D_MODEL), 0.02),
    }


def reference(x, meta, emb_ln_g, emb_ln_b, w_in, b_in, gla_w2_f, gla_b_f, gla_w2_b, gla_b_b, gla_norm_g,
              swa_sink, swa_norm_g, hy_conv_w, hy_conv_b, hy_w1, hy_b1, hy_freq, hy_w2, hy_b2, hy_w3, hy_skip,
              hy_norm_g, w_out, b_out, ln1_g, ln1_b, router_wg, router_bg, router_we, router_be,
              exp_w_gate, exp_w_up, exp_w_down, ln2_g, ln2_b):
    bsz = x.shape[0]
    dt = x.dtype
    meta_b = jnp.broadcast_to(meta.astype(dt)[None], (bsz, N_META, D_MODEL))
    h = layer_norm(jnp.concatenate([meta_b, x], axis=1), emb_ln_g, emb_ln_b)
    for l in range(DEPTH):
        u = h @ w_in[l] + b_in[l]
        a_q, a_k, a_v, a_gf, a_gb, a_r, b_q, b_k, b_v, c_u = jnp.split(u, list(IN_OFFSETS), axis=-1)
        y_a = gla_branch(a_q, a_k, a_v, a_gf, a_gb, a_r, gla_w2_f[l], gla_b_f[l], gla_w2_b[l], gla_b_b[l], gla_norm_g[l])
        y_b = swa_branch(b_q, b_k, b_v, swa_sink[l], swa_norm_g[l])
        y_c = hyena_branch(c_u, hy_conv_w[l], hy_conv_b[l], hy_w1[l], hy_b1[l], hy_freq[l], hy_w2[l], hy_b2[l],
                           hy_w3[l], hy_skip[l], hy_norm_g[l])
        mix = jnp.concatenate([y_a, y_b, y_c], axis=-1) @ w_out[l] + b_out[l]
        h = layer_norm(ALPHA * h + mix, ln1_g[l], ln1_b[l])
        moe = hier_moe(h, router_wg[l], router_bg[l], router_we[l], router_be[l],
                       exp_w_gate[l], exp_w_up[l], exp_w_down[l])
        h = layer_norm(ALPHA * h + moe, ln2_g[l], ln2_b[l])
    return h[:, N_META:]
```

```cpp
#include <hip/hip_runtime.h>
#include <stdint.h>

namespace nv {
constexpr int D = 2048, NB = 8, SEQ = 2048, NMETA = 16, L = SEQ + NMETA, T = NB * L, DEPTH = 4;
constexpr int INC = 4640;
constexpr int O_AQ = 0, O_AK = 256, O_AV = 512, O_GF = 1024, O_GB = 1040, O_AR = 1056, O_BQ = 1568, O_BK = 2592, O_BV = 2848, O_CU = 3104;
constexpr int NEXP = 16, DEXP = 1024;
constexpr float ALPHA = 1.681792830507429f;

__device__ __forceinline__ float wave_sum(float v) {
#pragma unroll
    for (int o = 32; o >= 1; o >>= 1) v += __shfl_xor(v, o);
    return v;
}
__device__ __forceinline__ float wave_max(float v) {
#pragma unroll
    for (int o = 32; o >= 1; o >>= 1) v = fmaxf(v, __shfl_xor(v, o));
    return v;
}
__device__ __forceinline__ float block_sum256(float v, float* sh  ) {
    v = wave_sum(v);
    __syncthreads();
    if ((threadIdx.x & 63) == 0) sh[threadIdx.x >> 6] = v;
    __syncthreads();
    return sh[0] + sh[1] + sh[2] + sh[3];
}

__device__ __forceinline__ void ln_row_store(float (&v)[8], const float* g, const float* b, float* out, float* sh) {
    float s = 0.f;
#pragma unroll
    for (int j = 0; j < 8; ++j) s += v[j];
    const float mean = block_sum256(s, sh) * (1.0f / D);
    float q = 0.f;
#pragma unroll
    for (int j = 0; j < 8; ++j) { const float d = v[j] - mean; q += d * d; }
    const float var = block_sum256(q, sh) * (1.0f / D);
    const float rstd = rsqrtf(var + 1e-5f);
#pragma unroll
    for (int j = 0; j < 8; ++j) { const int i = threadIdx.x + 256 * j; out[i] = (v[j] - mean) * rstd * g[i] + b[i]; }
}

__global__ __launch_bounds__(256) void k_embed_ln(const float* x, const float* meta, const float* g, const float* b, float* h) {
    __shared__ float sh[4];
    const int row = blockIdx.x, bb = row / L, p = row % L;
    const float* src = p < NMETA ? meta + (size_t)p * D : x + ((size_t)bb * SEQ + (p - NMETA)) * D;
    float v[8];
#pragma unroll
    for (int j = 0; j < 8; ++j) v[j] = src[threadIdx.x + 256 * j];
    ln_row_store(v, g, b, h + (size_t)row * D, sh);
}

struct GemmArgs { const float* A; const int* list; const float* W; const float* bias; float* C; const int* cnt; size_t w_estride; int lda, ldw, ldc, M, N, K, gather; };
__global__ __launch_bounds__(256) void k_gemm(GemmArgs g) {
    const int e = blockIdx.z;
    int M = g.M, rowoff = 0;
    if (g.cnt) { M = g.cnt[e]; for (int j = 0; j < e; ++j) rowoff += g.cnt[j]; }
    const int m0 = blockIdx.y * 64, n0 = blockIdx.x * 64;
    if (m0 >= M) return;
    const float* W = g.W + (size_t)e * g.w_estride;
    __shared__ __attribute__((aligned(16))) float As[16][68];
    __shared__ __attribute__((aligned(16))) float Ws[16][68];
    const int t = threadIdx.x;
    const int ar = t >> 2, ak = (t & 3) * 4;
    const int arow = m0 + ar; const bool av = arow < M;
    size_t asrc = 0;
    if (av) asrc = g.gather ? (size_t)g.list[(size_t)e * T + arow] : (size_t)(rowoff + arow);
    const float* Ap = g.A + asrc * g.lda + ak;
    const int wk = t >> 4, wn = (t & 15) * 4; const bool wv = (n0 + wn) < g.N;
    const float* Wp = W + (size_t)wk * g.ldw + n0 + wn;
    float acc[4][4];
#pragma unroll
    for (int i = 0; i < 4; ++i)
#pragma unroll
        for (int j = 0; j < 4; ++j) acc[i][j] = 0.f;
    const int ty = t >> 4, tx = t & 15;
    for (int k0 = 0; k0 < g.K; k0 += 16) {
        float4 a = make_float4(0.f, 0.f, 0.f, 0.f), w = make_float4(0.f, 0.f, 0.f, 0.f);
        if (av) a = *(const float4*)(Ap + k0);
        if (wv) w = *(const float4*)(Wp + (size_t)k0 * g.ldw);
        As[ak + 0][ar] = a.x; As[ak + 1][ar] = a.y; As[ak + 2][ar] = a.z; As[ak + 3][ar] = a.w;
        *(float4*)&Ws[wk][wn] = w;
        __syncthreads();
#pragma unroll
        for (int kk = 0; kk < 16; ++kk) {
            const float4 a4 = *(const float4*)&As[kk][ty * 4];
            const float4 w4 = *(const float4*)&Ws[kk][tx * 4];
            const float aa[4] = {a4.x, a4.y, a4.z, a4.w}, ww[4] = {w4.x, w4.y, w4.z, w4.w};
#pragma unroll
            for (int i = 0; i < 4; ++i)
#pragma unroll
                for (int j = 0; j < 4; ++j) acc[i][j] += aa[i] * ww[j];
        }
        __syncthreads();
    }
#pragma unroll
    for (int i = 0; i < 4; ++i) {
        const int row = m0 + ty * 4 + i; if (row >= M) continue;
        float* cp = g.C + (size_t)(rowoff + row) * g.ldc;
#pragma unroll
        for (int j = 0; j < 4; ++j) { const int col = n0 + tx * 4 + j; if (col < g.N) cp[col] = acc[i][j] + (g.bias ? g.bias[col] : 0.f); }
    }
}

__device__ __forceinline__ float logsigmoidf(float x) { return fminf(x, 0.f) - log1pf(expf(-fabsf(x))); }

__global__ __launch_bounds__(256) void k_gla_gates(const float* U, const float* w2f, const float* bf, const float* w2b, const float* bb, float* LF, float* LB) {
    const int row = blockIdx.x, j = threadIdx.x;
    const float* u = U + (size_t)row * INC;
    float xf = bf[j], xb = bb[j];
#pragma unroll
    for (int r = 0; r < 16; ++r) { xf += u[O_GF + r] * w2f[r * 256 + j]; xb += u[O_GB + r] * w2b[r * 256 + j]; }
    LF[(size_t)row * 256 + j] = logsigmoidf(xf) * (1.0f / 16.0f);
    LB[(size_t)row * 256 + j] = logsigmoidf(xb) * (1.0f / 16.0f);
}

__global__ __launch_bounds__(256) void k_gla_scan(const float* U, const float* LF, const float* LB, float* OF, float* OB) {
    const int bh = blockIdx.x, b = bh >> 2, hh = bh & 3, dir = blockIdx.y;
    const float* LG = dir ? LB : LF; float* O = dir ? OB : OF;
    const int tid = threadIdx.x, c = tid & 127, half = tid >> 7;
    __shared__ float qs[64], ks[64], as[64], vs[128], red[2][128];
    float S[32];
#pragma unroll
    for (int i = 0; i < 32; ++i) S[i] = 0.f;
    for (int step = 0; step < L; ++step) {
        const int p = dir ? (L - 1 - step) : step;
        const size_t row = (size_t)b * L + p;
        const float* u = U + row * INC;
        if (tid < 64) qs[tid] = u[O_AQ + hh * 64 + tid];
        else if (tid < 128) ks[tid - 64] = u[O_AK + hh * 64 + tid - 64];
        else if (tid < 192) as[tid - 128] = expf(LG[row * 256 + hh * 64 + tid - 128]);
        if (tid < 128) vs[tid] = u[O_AV + hh * 128 + tid];
        __syncthreads();
        float acc = 0.f; const float vc = vs[c];
        if (!dir) {
#pragma unroll
            for (int i = 0; i < 32; ++i) { const int d = half * 32 + i; S[i] = as[d] * S[i] + ks[d] * vc; acc += qs[d] * S[i]; }
        } else {
#pragma unroll
            for (int i = 0; i < 32; ++i) { const int d = half * 32 + i; const float tmp = as[d] * S[i]; acc += qs[d] * tmp; S[i] = tmp + ks[d] * vc; }
        }
        red[half][c] = acc;
        __syncthreads();
        if (half == 0) O[row * 512 + hh * 128 + c] = (red[0][c] + red[1][c]) * 0.125f;
    }
}

__global__ __launch_bounds__(256) void k_gla_finish(const float* OF, const float* OB, const float* U, const float* g, float* Y) {
    const int row = blockIdx.x, w = threadIdx.x >> 6, lane = threadIdx.x & 63;
    const size_t o = (size_t)row * 512 + w * 128;
    const float a0 = OF[o + lane] + OB[o + lane], a1 = OF[o + lane + 64] + OB[o + lane + 64];
    const float ss = wave_sum(a0 * a0 + a1 * a1);
    const float rs = rsqrtf(ss * (1.0f / 128.0f) + 1e-6f);
    const float* u = U + (size_t)row * INC + O_AR + w * 128;
    const float r0 = u[lane], r1 = u[lane + 64];
    float* y = Y + (size_t)row * D + w * 128;
    y[lane] = a0 * rs * g[w * 128 + lane] * (r0 / (1.0f + expf(-r0)));
    y[lane + 64] = a1 * rs * g[w * 128 + lane + 64] * (r1 / (1.0f + expf(-r1)));
}

__global__ __launch_bounds__(64) void k_swa(const float* U, const float* sink, float* SW) {
    const int p = blockIdx.x, hd = blockIdx.y, b = blockIdx.z, lane = threadIdx.x, kv = hd >> 2;
    __shared__ float qs[128]; __shared__ float ps[288];
    const size_t row = (size_t)b * L + p;
    qs[lane] = U[row * INC + O_BQ + hd * 128 + lane]; qs[lane + 64] = U[row * INC + O_BQ + hd * 128 + lane + 64];
    __syncthreads();
    const int lo = max(NMETA, p - 128), hi = min(L - 1, p + 128); const int nk = 16 + (hi - lo + 1);
    const float slope = exp2f(-(float)(hd + 1));
    const float sk = sink[hd];
    float mx = sk;
    for (int i = lane; i < nk; i += 64) {
        const int pos = i < 16 ? i : lo + i - 16;
        const float* kp = U + ((size_t)b * L + pos) * INC + O_BK + kv * 128;
        float dot = 0.f;
        for (int d = 0; d < 128; ++d) dot += qs[d] * kp[d];
        const float s = dot * 0.08838834764831845f - slope * fabsf((float)(p - pos));
        ps[i] = s; mx = fmaxf(mx, s);
    }
    mx = wave_max(mx);
    float sum = 0.f;
    for (int i = lane; i < nk; i += 64) { const float e = expf(ps[i] - mx); ps[i] = e; sum += e; }
    sum = wave_sum(sum) + expf(sk - mx);
    __syncthreads();
    const float inv = 1.0f / sum;
    float a0 = 0.f, a1 = 0.f;
    for (int i = 0; i < nk; ++i) {
        const int pos = i < 16 ? i : lo + i - 16;
        const float* vp = U + ((size_t)b * L + pos) * INC + O_BV + kv * 128;
        const float pi = ps[i];
        a0 += pi * vp[lane]; a1 += pi * vp[lane + 64];
    }
    SW[row * 1024 + hd * 128 + lane] = a0 * inv; SW[row * 1024 + hd * 128 + lane + 64] = a1 * inv;
}

__global__ __launch_bounds__(256) void k_rms(const float* in, int n, const float* g, float* Y, int off) {
    __shared__ float sh[4];
    const int row = blockIdx.x; const float* r = in + (size_t)row * n;
    float s = 0.f;
    for (int i = threadIdx.x; i < n; i += 256) s += r[i] * r[i];
    const float rs = rsqrtf(block_sum256(s, sh) / (float)n + 1e-6f);
    for (int i = threadIdx.x; i < n; i += 256) Y[(size_t)row * D + off + i] = r[i] * rs * g[i];
}

__global__ __launch_bounds__(256) void k_hy_filter(const float* w1, const float* b1, const float* freq, const float* w2, const float* b2, const float* w3, float* HF, float* HB) {
    const int i = blockIdx.x, t = threadIdx.x;
    __shared__ float z[33], h1[64], h2[64];
    const float tt = (float)i / (float)(L - 1);
    if (t == 0) z[0] = tt;
    if (t >= 1 && t < 33) {
        const int j = (t - 1) & 15;
        const double band = 1e-4 + (double)j * ((15.0 - 1e-4) / 15.0);
        const double ang = band * (2.0 * 3.14159265358979323846 * (double)i / (double)L);
        z[t] = t < 17 ? (float)cos(ang) : (float)(-sin(ang));
    }
    __syncthreads();
    if (t < 64) { float a = b1[t]; for (int k = 0; k < 33; ++k) a += z[k] * w1[k * 64 + t]; h1[t] = sinf(freq[t] * a); }
    __syncthreads();
    if (t < 64) { float a = b2[t]; for (int k = 0; k < 64; ++k) a += h1[k] * w2[k * 64 + t]; h2[t] = sinf(freq[64 + t] * a); }
    __syncthreads();
    const float mind = logf(1e-2f) / 1.5f, maxd = logf(1e-2f) / 0.3f;
    for (int c = t; c < 1024; c += 256) {
        float a = 0.f; for (int k = 0; k < 64; ++k) a += h2[k] * w3[k * 1024 + c];
        const int cc = c & 511;
        const float delta = mind + (float)cc * ((maxd - mind) / 511.0f);
        const float win = expf(-tt * fabsf(delta));
        (c < 512 ? HF : HB)[(size_t)i * 512 + cc] = a * win;
    }
}

__global__ __launch_bounds__(256) void k_hy_short(const float* U, const float* cw, const float* cb, float* X0, float* Z) {
    const int row = blockIdx.x, p = row % L;
    for (int c = threadIdx.x; c < 512; c += 256) {
        float uc[3];
#pragma unroll
        for (int gI = 0; gI < 3; ++gI) {
            const int col = gI * 512 + c;
            const float* u = U + (size_t)row * INC + O_CU + col;
            float a = cb[col] + u[0] * cw[1536 + col];
            if (p > 0) a += u[-INC] * cw[col];
            if (p < L - 1) a += u[INC] * cw[3072 + col];
            uc[gI] = a;
        }
        X0[(size_t)row * 512 + c] = uc[0]; Z[(size_t)row * 512 + c] = uc[1] * uc[2];
    }
}

__global__ __launch_bounds__(256) void k_hy_conv(const float* Z, const float* HF, const float* HB, const float* X0, const float* skip, float* YC) {
    const int c = blockIdx.x * 256 + threadIdx.x, p = blockIdx.y, b = blockIdx.z;
    const float* zb = Z + (size_t)b * L * 512 + c;
    float acc = 0.f;
    for (int s = 0; s <= p; ++s) acc += HF[(size_t)(p - s) * 512 + c] * zb[(size_t)s * 512];
    for (int s = p + 1; s < L; ++s) acc += HB[(size_t)(s - p) * 512 + c] * zb[(size_t)s * 512];
    const size_t o = ((size_t)b * L + p) * 512 + c;
    YC[o] = X0[o] * (acc + skip[c] * zb[(size_t)p * 512]);
}

__global__ __launch_bounds__(256) void k_add_ln(float* h, const float* add, const float* O, const int* tok_e, const int* tok_pos, const float* tok_w, const int* cnt, const float* g, const float* bt) {
    __shared__ float sh[4];
    const int row = blockIdx.x;
    float v[8];
    float* hr = h + (size_t)row * D;
    if (add) {
#pragma unroll
        for (int j = 0; j < 8; ++j) { const int i = threadIdx.x + 256 * j; v[j] = ALPHA * hr[i] + add[(size_t)row * D + i]; }
    } else {
        const int e0 = tok_e[2 * row], e1 = tok_e[2 * row + 1];
        int off0 = 0, off1 = 0;
        for (int j = 0; j < e0; ++j) off0 += cnt[j];
        for (int j = 0; j < e1; ++j) off1 += cnt[j];
        const float* o0 = O + (size_t)(off0 + tok_pos[2 * row]) * D; const float* o1 = O + (size_t)(off1 + tok_pos[2 * row + 1]) * D;
        const float w0 = tok_w[2 * row], w1 = tok_w[2 * row + 1];
#pragma unroll
        for (int j = 0; j < 8; ++j) { const int i = threadIdx.x + 256 * j; v[j] = ALPHA * hr[i] + (w0 * o0[i] + w1 * o1[i]); }
    }
    __syncthreads();
    ln_row_store(v, g, bt, hr, sh);
}

__global__ __launch_bounds__(256) void k_router(const float* h, const float* wg, const float* bg, const float* we, const float* be, int* cnt, int* list, int* tok_e, int* tok_pos, float* tok_w) {
    const int row = blockIdx.x, t = threadIdx.x;
    __shared__ float red[4][20]; __shared__ float lg[20];
    float acc[20];
#pragma unroll
    for (int j = 0; j < 20; ++j) acc[j] = 0.f;
    const float* hr = h + (size_t)row * D;
    for (int i = t; i < D; i += 256) {
        const float x = hr[i];
#pragma unroll
        for (int j = 0; j < 4; ++j) acc[j] += x * wg[i * 4 + j];
#pragma unroll
        for (int j = 0; j < 16; ++j) acc[4 + j] += x * we[i * 16 + j];
    }
#pragma unroll
    for (int j = 0; j < 20; ++j) { const float s = wave_sum(acc[j]); if ((t & 63) == 0) red[t >> 6][j] = s; }
    __syncthreads();
    if (t < 20) lg[t] = red[0][t] + red[1][t] + red[2][t] + red[3][t] + (t < 4 ? bg[t] : be[t - 4]);
    __syncthreads();
    if (t == 0) {
        int gi = 0; float gm = lg[0];
        for (int j = 1; j < 4; ++j) if (lg[j] > gm) { gm = lg[j]; gi = j; }
        float den = 0.f; for (int j = 0; j < 4; ++j) den += expf(lg[j] - gm);
        const float gtop = 1.0f / den;
        const float* el = lg + 4 + gi * 4;
        int i1 = 0; for (int j = 1; j < 4; ++j) if (el[j] > el[i1]) i1 = j;
        int i2 = -1; for (int j = 0; j < 4; ++j) if (j != i1 && (i2 < 0 || el[j] > el[i2])) i2 = j;
        const float ex = expf(el[i2] - el[i1]);
        const float w1 = gtop / (1.0f + ex), w2 = gtop * ex / (1.0f + ex);
        const int e1 = gi * 4 + i1, e2 = gi * 4 + i2;
        const int p1 = atomicAdd(&cnt[e1], 1), p2 = atomicAdd(&cnt[e2], 1);
        list[(size_t)e1 * T + p1] = row; list[(size_t)e2 * T + p2] = row;
        tok_e[2 * row] = e1; tok_e[2 * row + 1] = e2; tok_pos[2 * row] = p1; tok_pos[2 * row + 1] = p2; tok_w[2 * row] = w1; tok_w[2 * row + 1] = w2;
    }
}

__global__ __launch_bounds__(256) void k_silu_mul(const float* G, const float* Uu, float* Hm, size_t n) {
    for (size_t i = (size_t)blockIdx.x * 256 + threadIdx.x; i < n; i += (size_t)gridDim.x * 256) { const float gv = G[i]; Hm[i] = gv / (1.0f + expf(-gv)) * Uu[i]; }
}

__global__ __launch_bounds__(256) void k_out(const float* h, float* out) {
    const int r = blockIdx.x, b = r / SEQ, s = r % SEQ;
    const float4* src = (const float4*)(h + ((size_t)b * L + NMETA + s) * D); float4* dst = (float4*)(out + (size_t)r * D);
    for (int i = threadIdx.x; i < D / 4; i += 256) dst[i] = src[i];
}
}

extern "C" void kernel_launch(void* const* d_in, const int* in_sizes, int n_in, void* d_out, int out_size, void* d_ws, size_t ws_size, hipStream_t stream) {
    using namespace nv;
    const float* x = (const float*)d_in[0]; const float* meta = (const float*)d_in[1];
    const float* emb_g = (const float*)d_in[2]; const float* emb_b = (const float*)d_in[3];
    const float* w_in = (const float*)d_in[4]; const float* b_in = (const float*)d_in[5];
    const float* w2f = (const float*)d_in[6]; const float* bf = (const float*)d_in[7]; const float* w2b = (const float*)d_in[8]; const float* bb = (const float*)d_in[9];
    const float* gla_g = (const float*)d_in[10]; const float* sink = (const float*)d_in[11]; const float* swa_g = (const float*)d_in[12];
    const float* hcw = (const float*)d_in[13]; const float* hcb = (const float*)d_in[14]; const float* hw1 = (const float*)d_in[15]; const float* hb1 = (const float*)d_in[16];
    const float* hfreq = (const float*)d_in[17]; const float* hw2 = (const float*)d_in[18]; const float* hb2 = (const float*)d_in[19]; const float* hw3 = (const float*)d_in[20];
    const float* hskip = (const float*)d_in[21]; const float* hy_g = (const float*)d_in[22];
    const float* w_out = (const float*)d_in[23]; const float* b_out = (const float*)d_in[24]; const float* ln1g = (const float*)d_in[25]; const float* ln1b = (const float*)d_in[26];
    const float* rwg = (const float*)d_in[27]; const float* rbg = (const float*)d_in[28]; const float* rwe = (const float*)d_in[29]; const float* rbe = (const float*)d_in[30];
    const float* ewg = (const float*)d_in[31]; const float* ewu = (const float*)d_in[32]; const float* ewd = (const float*)d_in[33];
    const float* ln2g = (const float*)d_in[34]; const float* ln2b = (const float*)d_in[35];

    char* ws = (char*)d_ws; size_t off = 0;
    auto alloc = [&](size_t bytes) { void* p = ws + off; off += (bytes + 255) & ~(size_t)255; return p; };
    float* h = (float*)alloc((size_t)T * D * 4);
    int* cnt = (int*)alloc(DEPTH * 64 * 4);
    int* list = (int*)alloc((size_t)NEXP * T * 4);
    int* tok_e = (int*)alloc((size_t)2 * T * 4); int* tok_pos = (int*)alloc((size_t)2 * T * 4); float* tok_w = (float*)alloc((size_t)2 * T * 4);
    float* HF = (float*)alloc((size_t)L * 512 * 4); float* HB = (float*)alloc((size_t)L * 512 * 4);
    const size_t region = off;
    float* U = (float*)alloc((size_t)T * INC * 4);
    float* LF = (float*)alloc((size_t)T * 256 * 4); float* LB = (float*)alloc((size_t)T * 256 * 4);
    float* OF = (float*)alloc((size_t)T * 512 * 4); float* OB = (float*)alloc((size_t)T * 512 * 4);
    float* SW = (float*)alloc((size_t)T * 1024 * 4);
    float* X0 = (float*)alloc((size_t)T * 512 * 4); float* Z = (float*)alloc((size_t)T * 512 * 4); float* YC = (float*)alloc((size_t)T * 512 * 4);
    float* Y = (float*)alloc((size_t)T * D * 4);
    float* MIX = (float*)alloc((size_t)T * D * 4);
    off = region;
    float* G = (float*)alloc((size_t)2 * T * DEXP * 4); float* Uu = (float*)alloc((size_t)2 * T * DEXP * 4); float* Hm = (float*)alloc((size_t)2 * T * DEXP * 4);
    float* O = (float*)alloc((size_t)2 * T * D * 4);

    hipMemsetAsync(cnt, 0, DEPTH * 64 * 4, stream);
    k_embed_ln<<<T, 256, 0, stream>>>(x, meta, emb_g, emb_b, h);
    for (int l = 0; l < DEPTH; ++l) {
        { GemmArgs g{}; g.A = h; g.lda = D; g.W = w_in + (size_t)l * D * INC; g.ldw = INC; g.bias = b_in + (size_t)l * INC; g.C = U; g.ldc = INC; g.M = T; g.N = INC; g.K = D;
          k_gemm<<<dim3((INC + 63) / 64, (T + 63) / 64, 1), 256, 0, stream>>>(g); }
        k_gla_gates<<<T, 256, 0, stream>>>(U, w2f + (size_t)l * 16 * 256, bf + l * 256, w2b + (size_t)l * 16 * 256, bb + l * 256, LF, LB);
        k_gla_scan<<<dim3(NB * 4, 2), 256, 0, stream>>>(U, LF, LB, OF, OB);
        k_gla_finish<<<T, 256, 0, stream>>>(OF, OB, U, gla_g + l * 512, Y);
        k_swa<<<dim3(L, 8, NB), 64, 0, stream>>>(U, sink + l * 8, SW);
        k_rms<<<T, 256, 0, stream>>>(SW, 1024, swa_g + l * 1024, Y, 512);
        k_hy_filter<<<L, 256, 0, stream>>>(hw1 + (size_t)l * 33 * 64, hb1 + l * 64, hfreq + l * 128, hw2 + (size_t)l * 64 * 64, hb2 + l * 64, hw3 + (size_t)l * 64 * 1024, HF, HB);
        k_hy_short<<<T, 256, 0, stream>>>(U, hcw + (size_t)l * 3 * 1536, hcb + l * 1536, X0, Z);
        k_hy_conv<<<dim3(2, L, NB), 256, 0, stream>>>(Z, HF, HB, X0, hskip + l * 512, YC);
        k_rms<<<T, 256, 0, stream>>>(YC, 512, hy_g + l * 512, Y, 1536);
        { GemmArgs g{}; g.A = Y; g.lda = D; g.W = w_out + (size_t)l * D * D; g.ldw = D; g.bias = b_out + (size_t)l * D; g.C = MIX; g.ldc = D; g.M = T; g.N = D; g.K = D;
          k_gemm<<<dim3(D / 64, (T + 63) / 64, 1), 256, 0, stream>>>(g); }
        k_add_ln<<<T, 256, 0, stream>>>(h, MIX, nullptr, nullptr, nullptr, nullptr, nullptr, ln1g + l * D, ln1b + l * D);
        int* cl = cnt + l * 64;
        k_router<<<T, 256, 0, stream>>>(h, rwg + (size_t)l * D * 4, rbg + l * 4, rwe + (size_t)l * D * 16, rbe + l * 16, cl, list, tok_e, tok_pos, tok_w);
        { GemmArgs g{}; g.A = h; g.lda = D; g.list = list; g.gather = 1; g.W = ewg + (size_t)l * NEXP * D * DEXP; g.w_estride = (size_t)D * DEXP; g.ldw = DEXP; g.C = G; g.ldc = DEXP; g.cnt = cl; g.N = DEXP; g.K = D;
          k_gemm<<<dim3(DEXP / 64, (T + 63) / 64, NEXP), 256, 0, stream>>>(g);
          g.W = ewu + (size_t)l * NEXP * D * DEXP; g.C = Uu;
          k_gemm<<<dim3(DEXP / 64, (T + 63) / 64, NEXP), 256, 0, stream>>>(g); }
        k_silu_mul<<<4096, 256, 0, stream>>>(G, Uu, Hm, (size_t)2 * T * DEXP);
        { GemmArgs g{}; g.A = Hm; g.lda = DEXP; g.gather = 0; g.W = ewd + (size_t)l * NEXP * DEXP * D; g.w_estride = (size_t)DEXP * D; g.ldw = D; g.C = O; g.ldc = D; g.cnt = cl; g.N = D; g.K = DEXP;
          k_gemm<<<dim3(D / 64, (T + 63) / 64, NEXP), 256, 0, stream>>>(g); }
        k_add_ln<<<T, 256, 0, stream>>>(h, nullptr, O, tok_e, tok_pos, tok_w, cl, ln2g + l * D, ln2b + l * D);
    }
    k_out<<<NB * SEQ, 256, 0, stream>>>(h, (float*)d_out);
}
```

```cpp
#include <hip/hip_runtime.h>
#include <stdint.h>

#define LAS __attribute__((address_space(3)))
#define GAS __attribute__((address_space(1)))
typedef unsigned short bf16_t;
typedef short bf16x8 __attribute__((ext_vector_type(8)));
typedef float f32x4 __attribute__((ext_vector_type(4)));
typedef float f32x2 __attribute__((ext_vector_type(2)));
typedef unsigned u32x4 __attribute__((ext_vector_type(4)));
typedef unsigned u32x2 __attribute__((ext_vector_type(2)));

constexpr int D = 2048, NB = 8, SEQ = 2048, NMETA = 16, L = SEQ + NMETA, T = NB * L, DEPTH = 4;
constexpr int MPAD = 16640;
constexpr int INC = 4640, INCP = 4864;
constexpr int O_AQ = 0, O_AK = 256, O_AV = 512, O_GF = 1024, O_GB = 1040, O_AR = 1056, O_BQ = 1568, O_BK = 2592, O_BV = 2848, O_CU = 3104;
constexpr int NEXP = 16, DEXP = 1024;
constexpr float ALPHA = 1.681792830507429f;
constexpr int NPH = 9;
constexpr int HMROWS = 2 * T + 4096;

constexpr size_t al256(size_t x) { return (x + 255) & ~(size_t)255; }
constexpr size_t WS_CTL = 0, CTL_BYTES = 1u << 20;
constexpr size_t WS_WIN = WS_CTL + CTL_BYTES;
constexpr size_t WS_WOUT = WS_WIN + (size_t)DEPTH * INCP * D * 2;
constexpr size_t WS_WGU = WS_WOUT + (size_t)DEPTH * D * D * 2;
constexpr size_t WS_WD = WS_WGU + (size_t)DEPTH * NEXP * 2048 * D * 2;
constexpr size_t WS_HB8 = WS_WD + (size_t)DEPTH * NEXP * D * DEXP * 2;
constexpr size_t WS_H = WS_HB8 + (size_t)MPAD * D;
constexpr size_t WS_HB = WS_H + (size_t)T * D * 4;
constexpr size_t WS_Y = WS_HB + (size_t)MPAD * D * 2;
constexpr size_t WS_LIST = WS_Y + (size_t)MPAD * D * 2;
constexpr size_t WS_TOKE = WS_LIST + (size_t)NEXP * T * 4;
constexpr size_t WS_TOKP = WS_TOKE + (size_t)2 * T * 4;
constexpr size_t WS_TOKW = WS_TOKP + (size_t)2 * T * 4;
constexpr size_t WS_HF = WS_TOKW + (size_t)2 * T * 4;
constexpr size_t WS_HBW = WS_HF + (size_t)L * 512 * 4;
constexpr int GLEN = 4736, GCEN = 2336, ZL = 2112;
constexpr int ZROW = 3520, ZOFF = 576;
constexpr size_t WS_FG = al256(WS_HBW + (size_t)L * 512 * 4);
constexpr size_t WS_WR = al256(WS_FG + (size_t)DEPTH * 512 * 2 * GLEN * 2);
constexpr size_t WS_REG = al256(WS_WR + (size_t)DEPTH * 64 * 2 * 2 * 512 * 2);
constexpr size_t WS_U = WS_REG;
constexpr int GNC = 33;
constexpr size_t WS_KVT = al256(WS_U + (size_t)T * INC * 2);
constexpr size_t WS_DEC = WS_KVT + (size_t)64 * GNC * 128 * 64 * 4;
constexpr size_t WS_SPT = WS_DEC + (size_t)64 * GNC * 64 * 4;
constexpr size_t WS_GQK = WS_SPT + (size_t)64 * GNC * 128 * 64 * 2;
constexpr size_t WS_GVT = WS_GQK + (size_t)NB * 4 * GNC * 4 * 64 * 64 * 2;
constexpr size_t WS_SW = WS_GVT + (size_t)NB * 4 * GNC * 128 * 64 * 2;
constexpr size_t WS_X0T = WS_SW + (size_t)T * 1024 * 4;
constexpr size_t WS_ZT = WS_X0T + (size_t)512 * NB * ZL * 2;
constexpr size_t WS_YT = WS_ZT + (size_t)512 * NB * ZL * 2;
constexpr size_t WS_END1 = WS_YT + (size_t)512 * NB * ZL * 2;
constexpr size_t WS_R1 = WS_REG;
constexpr size_t WS_HM = WS_R1 + (size_t)T * D * 4;
constexpr size_t WS_O = WS_HM + (size_t)HMROWS * DEXP * 2;
constexpr size_t WS_END2 = WS_O + (size_t)HMROWS * D * 2;
constexpr size_t WS_DUM = al256(WS_END2);
static_assert(WS_END1 < 2100000000ull && WS_DUM + (size_t)T * D * 6 + (size_t)NEXP * T * 4 + (size_t)T * 32 < 2100000000ull, "d_ws budget");
constexpr int CW_BAR = 4096;
constexpr int CW_Q = 12288;
constexpr int CW_CNT = 16384;

constexpr int RING_BYTES = 131072;
constexpr int LDSCTL_OFF = RING_BYTES;
constexpr int MISC_OFF = LDSCTL_OFF + 1024;
constexpr int LDS_BYTES = 147456;

#define LDS_WAIT() asm volatile("s_waitcnt lgkmcnt(0)" ::: "memory")
#define VM_WAIT() asm volatile("s_waitcnt vmcnt(0)" ::: "memory")
__device__ __forceinline__ unsigned f2bf(float f) { unsigned u = __builtin_bit_cast(unsigned, f); return (u + 0x7fffu + ((u >> 16) & 1u)) >> 16; }
__device__ __forceinline__ unsigned pk2i(float lo, float hi) { return f2bf(lo) | (f2bf(hi) << 16); }
__device__ __forceinline__ unsigned pk2(float lo, float hi) { unsigned r; asm("v_cvt_pk_bf16_f32 %0, %1, %2" : "=v"(r) : "v"(lo), "v"(hi)); return r; }
__device__ __forceinline__ float bf2f(unsigned short b) { return __builtin_bit_cast(float, (unsigned)b << 16); }
template <int N> __device__ __forceinline__ float dpp_row_shr_add(float v) { const int t = __builtin_amdgcn_update_dpp(0, __builtin_bit_cast(int, v), 0x110 + N, 0xf, 0xf, true); return v + __builtin_bit_cast(float, t); }
__device__ __forceinline__ float wave_sum(float v) {
    v = dpp_row_shr_add<1>(v); v = dpp_row_shr_add<2>(v); v = dpp_row_shr_add<4>(v); v = dpp_row_shr_add<8>(v);
    const int vi = __builtin_bit_cast(int, v);
    return (__builtin_bit_cast(float, __builtin_amdgcn_readlane(vi, 15)) + __builtin_bit_cast(float, __builtin_amdgcn_readlane(vi, 31))) + (__builtin_bit_cast(float, __builtin_amdgcn_readlane(vi, 47)) + __builtin_bit_cast(float, __builtin_amdgcn_readlane(vi, 63)));
}
__device__ __forceinline__ float xor32(float v) {
    const int vi = __builtin_bit_cast(int, v);
    auto r = __builtin_amdgcn_permlane32_swap(vi, vi, false, false);
    return __builtin_bit_cast(float, (threadIdx.x & 32) ? r[0] : r[1]);
}
__device__ __forceinline__ float wave_max(float v) {
#pragma unroll
    for (int o = 1; o < 64; o <<= 1) v = fmaxf(v, __shfl_xor(v, o));
    return v;
}

#define XB_TMO      128
#define XB_XCNT(j)  (256  + 64 * (j))
#define XB_XSUB(j)  (1280 + 64 * (j))
#define XB_XGEN(j)  (2304 + 64 * (j))
#define XB_TOP      3328
#define XB_TOPGEN   3392
#define XCD_BAR_WORDS 3456
#define XB_SPIN_CAP (1u << 18)
__device__ __forceinline__ unsigned xb_ld(unsigned* p)              { return __hip_atomic_load(p, __ATOMIC_RELAXED, __HIP_MEMORY_SCOPE_AGENT); }
__device__ __forceinline__ unsigned xb_add(unsigned* p, unsigned v) { return __hip_atomic_fetch_add(p, v, __ATOMIC_RELAXED, __HIP_MEMORY_SCOPE_AGENT); }
__device__ __forceinline__ unsigned xb_xcc_id() { return (unsigned)__builtin_amdgcn_s_getreg((3 << 11) | 20) & 0xFu; }
#define XB_SPIN(cond, bar) do { unsigned _sp = 0; while (cond) { __builtin_amdgcn_s_sleep(1); \
    if ((++_sp & 255u) == 0u) { if (xb_ld(&(bar)[XB_TMO])) break; if (_sp > XB_SPIN_CAP) { atomicAdd(&(bar)[XB_TMO], 1u); break; } } } } while (0)
struct XcdBarrier { unsigned* bar; unsigned x; volatile LAS unsigned* st; };
__device__ __forceinline__ XcdBarrier xcd_barrier_post(unsigned* bar, volatile LAS unsigned* st) {
    XcdBarrier b; b.bar = bar; b.x = xb_xcc_id(); b.st = st;
    if (threadIdx.x == 0) (void)xb_add(&bar[XB_XCNT(b.x)], 1u);
    return b;
}
__device__ __forceinline__ void xcd_barrier_complete(unsigned* bar, unsigned x, unsigned& nloc, unsigned& nx) {
    const unsigned G = gridDim.x * gridDim.y * gridDim.z;
    unsigned sum, cnt, mine, sp = 0u;
    for (;;) {
        sum = 0u; cnt = 0u; mine = 0u;
#pragma unroll
        for (unsigned j = 0; j < 16; ++j) { const unsigned c = xb_ld(&bar[XB_XCNT(j)]); sum += c; cnt += (c > 0u) ? 1u : 0u; mine = (j == x) ? c : mine; }
        if (sum == G) break;
        __builtin_amdgcn_s_sleep(1);
        if ((++sp & 255u) == 0u) { if (xb_ld(&bar[XB_TMO])) break; if (sp > XB_SPIN_CAP) { atomicAdd(&bar[XB_TMO], 1u); break; } }
    }
    nloc = mine > 0u ? mine : 1u; nx = cnt > 0u ? cnt : 1u;
}
__device__ __forceinline__ void xcd_barrier(const XcdBarrier& b) {
    asm volatile("s_waitcnt vmcnt(0)" ::: "memory");
    __syncthreads();
    if (threadIdx.x == 0) {
        unsigned* bar = b.bar;
        __builtin_amdgcn_s_waitcnt(0);
        unsigned nloc = b.st[0], nx = b.st[1];
        if (nloc == 0u) { xcd_barrier_complete(bar, b.x, nloc, nx); b.st[0] = nloc; b.st[1] = nx; }
        const unsigned old = xb_add(&bar[XB_XSUB(b.x)], 1u);
        const unsigned gen = old / nloc;
        if (old + 1u == (gen + 1u) * nloc) {
            __builtin_amdgcn_fence(__ATOMIC_RELEASE, "agent");
            asm volatile("s_waitcnt vmcnt(0)" ::: "memory");
            const unsigned og = xb_add(&bar[XB_TOP], 1u);
            const unsigned tg = og / nx;
            if (og + 1u == (tg + 1u) * nx) xb_add(&bar[XB_TOPGEN], 1u);
            else XB_SPIN(xb_ld(&bar[XB_TOPGEN]) == tg, bar);
            __builtin_amdgcn_fence(__ATOMIC_ACQUIRE, "agent");
            xb_add(&bar[XB_XGEN(b.x)], 1u);
            asm volatile("s_waitcnt vmcnt(0)" ::: "memory");
        } else {
            XB_SPIN(xb_ld(&bar[XB_XGEN(b.x)]) == gen, bar);
            __builtin_amdgcn_fence(__ATOMIC_ACQUIRE, "agent");
            asm volatile("s_waitcnt vmcnt(0)" ::: "memory");
        }
    }
    __syncthreads();
}

namespace pg {
constexpr int BM = 256, BK = 64, HALF = 128, HTB = HALF * BK * 2, STAGE_BYTES = 8 * HTB, NXCD = 8, WGM = 8;
__host__ __device__ __forceinline__ int lds_byte(int r, int c) { const int st = (r >> 4) * 2 + (c >> 5), rr = r & 15, cc = c & 31, ob = rr * 64 + cc * 2; return st * 1024 + (ob ^ (((ob >> 9) & 1) << 5)); }
__host__ __device__ __forceinline__ void stage_rc(int b, int& R, int& C) { const int st = b / 1024, sb = b % 1024, swz = sb ^ (((sb >> 9) & 1) << 5); R = (st >> 1) * 16 + swz / 64; C = (st & 1) * 32 + (swz % 64) / 2; }

__host__ __device__ __forceinline__ int perm32(int rho) { const int n = rho >> 4, i = rho & 15; return 8 * (i >> 2) + 4 * n + (i & 3); }
struct Unit { int e, pm, pn, mvalid, crow0; };

struct PlainSched {
    int nM, nN, nwg, G, c;
    __device__ void init(int nM_, int nN_, int G_, int c_) { nM = nM_; nN = nN_; nwg = nM * nN; G = G_; c = c_; }
    __device__ bool next(int i, Unit& u) const {
        const long Lx = (long)i * G + c; if (Lx >= nwg) return false;
        int wgid = (int)Lx; { const int q = nwg / NXCD, r = nwg % NXCD, xcd = wgid % NXCD, off = wgid / NXCD; wgid = (xcd < r ? xcd * (q + 1) : r * (q + 1) + (xcd - r) * q) + off; }
        const int nig = WGM * nN, gid = wgid / nig, fm = gid * WGM, gsz = (nM - fm) < WGM ? (nM - fm) : WGM;
        u.pm = fm + ((wgid % nig) % gsz); u.pn = (wgid % nig) / gsz; u.e = 0; u.crow0 = u.pm * BM; u.mvalid = min(BM, T - u.pm * BM); return true;
    }
    __device__ __forceinline__ int arow(const Unit& u, int r) const { return min(u.pm * BM + r, T - 1); }
    __device__ __forceinline__ int brow0(const Unit& u) const { return u.pn * BM; }
};
struct MoeSched {
    const LAS int* tab; const int* list; int nN, G, c, gather, nrowsB;
    __device__ bool next(int i, Unit& u) const {
        const int Lx = i * G + c; const int panel = Lx / nN;
        if (panel >= __builtin_amdgcn_readfirstlane(tab[32])) return false;
        int e = 0;
#pragma unroll 1
        for (int j = 1; j < 16; ++j) if (panel >= __builtin_amdgcn_readfirstlane(tab[16 + j])) e = j;
        u.e = e; u.pm = panel - __builtin_amdgcn_readfirstlane(tab[16 + e]); u.pn = Lx % nN; u.crow0 = __builtin_amdgcn_readfirstlane(tab[33 + e]) + u.pm * BM;
        u.mvalid = min(BM, __builtin_amdgcn_readfirstlane(tab[e]) - u.pm * BM); return true;
    }
    __device__ __forceinline__ int arow(const Unit& u, int r) const {
        const int rr = min(r, u.mvalid - 1);
        return gather ? list[(size_t)u.e * T + u.pm * BM + rr] : (u.crow0 + rr);
    }
    __device__ __forceinline__ int brow0(const Unit& u) const { return u.e * nrowsB + u.pn * BM; }
};

typedef int i32x8 __attribute__((ext_vector_type(8)));
typedef int i32x4_ __attribute__((ext_vector_type(4)));
__host__ __device__ __forceinline__ int lds_byte8(int r, int kb) { const int st = (r >> 4) * 2 + (kb >> 1), rr = r & 15; return st * 1024 + rr * 64 + 32 * ((kb & 1) ^ (rr >> 3)); }
template <bool FP8, class Epi, class Sched>
__device__ __forceinline__ void gemm_phase(LAS unsigned char* lds, const void* A, const void* Bt, const int K  , const Sched& S, const Epi& E) {
    const int tid = threadIdx.x, wid = __builtin_amdgcn_readfirstlane(tid >> 6), lane = tid & 63, wr = wid >> 2, wc = wid & 3, fr = lane & 15, fq = lane >> 4;
    const int nt = K / BK;
    unsigned voffB[2];
#pragma unroll
    for (int i = 0; i < 2; ++i) { int R, C; stage_rc(tid * 16 + i * 8192, R, C); const int Rb = Epi::PERM ? ((R & ~31) + perm32(R & 31)) : R; voffB[i] = (unsigned)(Rb * K + C) * 2u; }
    const size_t kstep = (size_t)(BK * 2);
    const size_t hstep = (size_t)HALF * K * 2;
    const unsigned rowb = (unsigned)K * 2u;
    const unsigned ldsw = (unsigned)wid * 1024u;
    const int aoff = FP8 ? lds_byte8(wr * 64 + fr, fq) : lds_byte(wr * 64 + fr, fq * 8), boff = FP8 ? lds_byte8(wc * 32 + fr, fq) : lds_byte(wc * 32 + fr, fq * 8);
#define PG_SA(b, h) (((b) * 2 + (h)) * HTB)
#define PG_SB(b, h) ((4 + (b) * 2 + (h)) * HTB)
#define PG_STAGE_B(bufoff, gbase) do { _Pragma("unroll") for (int _i = 0; _i < 2; ++_i) \
        __builtin_amdgcn_global_load_lds((const unsigned*)((const char*)(gbase) + voffB[_i]), (LAS unsigned*)(lds + (bufoff) + ldsw + _i * 8192), 16, 0, 0); } while (0)
#define PG_STAGE_A(bufoff, gbase, v0, v1) do { \
        __builtin_amdgcn_global_load_lds((const unsigned*)((const char*)(gbase) + (v0)), (LAS unsigned*)(lds + (bufoff) + ldsw), 16, 0, 0); \
        __builtin_amdgcn_global_load_lds((const unsigned*)((const char*)(gbase) + (v1)), (LAS unsigned*)(lds + (bufoff) + ldsw + 8192), 16, 0, 0); } while (0)
#define PG_LDA(dst, b, h) do { _Pragma("unroll") for (int m = 0; m < 4; ++m) _Pragma("unroll") for (int k = 0; k < 2; ++k) dst[m][k] = *(const LAS bf16x8*)(lds + PG_SA(b, h) + aoff + m * 2048 + (FP8 ? k * 16 : k * 1024)); } while (0)
#define PG_LDB(dst, b, h) do { _Pragma("unroll") for (int n = 0; n < 2; ++n) _Pragma("unroll") for (int k = 0; k < 2; ++k) dst[n][k] = *(const LAS bf16x8*)(lds + PG_SB(b, h) + boff + n * 2048 + (FP8 ? k * 16 : k * 1024)); } while (0)
#define PG_MMA(ai, bj, At, Bt_) do { __builtin_amdgcn_s_setprio(1); if constexpr (FP8) { _Pragma("unroll") for (int m = 0; m < 4; ++m) _Pragma("unroll") for (int n = 0; n < 2; ++n) { \
            const i32x8 bq_ = __builtin_shufflevector(__builtin_bit_cast(i32x4_, Bt_[n][0]), __builtin_bit_cast(i32x4_, Bt_[n][1]), 0, 1, 2, 3, 4, 5, 6, 7), aq_ = __builtin_shufflevector(__builtin_bit_cast(i32x4_, At[m][0]), __builtin_bit_cast(i32x4_, At[m][1]), 0, 1, 2, 3, 4, 5, 6, 7); \
            acc[ai][bj][m][n] = __builtin_amdgcn_mfma_scale_f32_16x16x128_f8f6f4(bq_, aq_, acc[ai][bj][m][n], 0, 0, 0, 0x7f7f7f7f, 0, 0x7f7f7f7f); } } \
        else { _Pragma("unroll") for (int m = 0; m < 4; ++m) _Pragma("unroll") for (int n = 0; n < 2; ++n) _Pragma("unroll") for (int k = 0; k < 2; ++k) \
        acc[ai][bj][m][n] = __builtin_amdgcn_mfma_f32_16x16x32_bf16(Bt_[n][k], At[m][k], acc[ai][bj][m][n], 0, 0, 0); } __builtin_amdgcn_s_setprio(0); } while (0)
#define PG_WAIT_V(n) asm volatile("s_waitcnt vmcnt(" #n ")" ::: "memory")
#define PG_WAIT_L(n) asm volatile("s_waitcnt lgkmcnt(" #n ")" ::: "memory")
#define PG_BAR __builtin_amdgcn_s_barrier()
#define PG_SCHED __builtin_amdgcn_sched_barrier(0)
#define PG_SETA(v, u) do { int R0_, C0_, R1_, C1_; stage_rc(tid * 16, R0_, C0_); stage_rc(tid * 16 + 8192, R1_, C1_); \
        v##00 = (unsigned)S.arow(u, R0_) * rowb + (unsigned)C0_ * 2u; v##01 = (unsigned)S.arow(u, R1_) * rowb + (unsigned)C1_ * 2u; \
        v##10 = (unsigned)S.arow(u, HALF + R0_) * rowb + (unsigned)C0_ * 2u; v##11 = (unsigned)S.arow(u, HALF + R1_) * rowb + (unsigned)C1_ * 2u; } while (0)
    Unit cur, nxt; int ui = 0;
    if (!S.next(0, cur)) return;
    f32x4 acc[2][2][4][2];
#pragma unroll
    for (int a = 0; a < 2; ++a)
#pragma unroll
        for (int b = 0; b < 2; ++b)
#pragma unroll
            for (int m = 0; m < 4; ++m)
#pragma unroll
                for (int n = 0; n < 2; ++n) acc[a][b][m][n] = (f32x4){0.f, 0.f, 0.f, 0.f};
    bf16x8 At[4][2], B0[2][2], B1[2][2];
    unsigned vc00, vc01, vc10, vc11;
    PG_SETA(vc, cur);
    const char* Ab = (const char*)A;
    const char* cB = (const char*)Bt + (size_t)S.brow0(cur) * rowb;
    PG_STAGE_B(PG_SB(0, 0), cB); PG_STAGE_B(PG_SB(0, 1), cB + hstep); PG_STAGE_A(PG_SA(0, 0), Ab, vc00, vc01); PG_STAGE_A(PG_SA(0, 1), Ab, vc10, vc11);
    if (wr == 1) PG_BAR;
    PG_WAIT_V(2); PG_BAR;
    PG_STAGE_B(PG_SB(1, 0), cB + kstep); PG_STAGE_A(PG_SA(1, 0), Ab + kstep, vc00, vc01); PG_STAGE_B(PG_SB(1, 1), cB + hstep + kstep);
    PG_WAIT_V(6); PG_BAR;
    for (;;) {
        const bool has_next = S.next(ui + 1, nxt);
        const char* nB = has_next ? (const char*)Bt + (size_t)S.brow0(nxt) * rowb : cB;
        for (int t = 0; t < nt; t += 2) {
            const bool last = (t == nt - 2);
            const char* a1 = Ab + (size_t)(t + 1) * kstep;
            const char* a2 = last ? Ab : Ab + (size_t)(t + 2) * kstep; const char* b2 = last ? nB : cB + (size_t)(t + 2) * kstep;
            const char* a3 = a2 + kstep; const char* b3 = b2 + kstep;
            PG_LDB(B0, 0, 0); PG_LDB(B1, 0, 1); PG_SCHED; PG_LDA(At, 0, 0); PG_STAGE_A(PG_SA(1, 1), a1, vc10, vc11);
            if (last && has_next) { PG_SETA(vc, nxt); }
            PG_WAIT_V(8); PG_WAIT_L(0); PG_BAR; PG_MMA(0, 0, At, B0); PG_MMA(0, 1, At, B1); PG_BAR; PG_SCHED;
            PG_LDA(At, 0, 1); PG_STAGE_B(PG_SB(0, 0), b2); PG_STAGE_B(PG_SB(0, 1), b2 + hstep); PG_STAGE_A(PG_SA(0, 0), a2, vc00, vc01);
            PG_WAIT_V(8); PG_WAIT_L(0); PG_BAR; PG_MMA(1, 0, At, B0); PG_MMA(1, 1, At, B1); PG_BAR; PG_SCHED;
            PG_LDB(B0, 1, 0); PG_LDB(B1, 1, 1); PG_SCHED; PG_LDA(At, 1, 0); PG_STAGE_A(PG_SA(0, 1), a2, vc10, vc11);
            PG_WAIT_V(8); PG_WAIT_L(0); PG_BAR; PG_MMA(0, 0, At, B0); PG_MMA(0, 1, At, B1); PG_BAR; PG_SCHED;
            PG_LDA(At, 1, 1); PG_STAGE_B(PG_SB(1, 0), b3); PG_STAGE_B(PG_SB(1, 1), b3 + hstep); PG_STAGE_A(PG_SA(1, 0), a3, vc00, vc01);
            PG_WAIT_V(8); PG_WAIT_L(0); PG_BAR; PG_MMA(1, 0, At, B0); PG_MMA(1, 1, At, B1); PG_BAR; PG_SCHED;
        }
        if (wr == 0) PG_BAR;
        E(acc, cur, wr, wc, fr, fq);
        if (!has_next) break;
#pragma unroll
        for (int a = 0; a < 2; ++a)
#pragma unroll
            for (int b = 0; b < 2; ++b)
#pragma unroll
                for (int m = 0; m < 4; ++m)
#pragma unroll
                    for (int n = 0; n < 2; ++n) acc[a][b][m][n] = (f32x4){0.f, 0.f, 0.f, 0.f};
        cur = nxt; cB = nB; ++ui;
        if (wr == 1) PG_BAR;
    }
    PG_WAIT_V(0);
    PG_BAR;
#undef PG_SA
#undef PG_SB
#undef PG_STAGE_A
#undef PG_STAGE_B
#undef PG_LDA
#undef PG_LDB
#undef PG_MMA
#undef PG_WAIT_V
#undef PG_WAIT_L
#undef PG_BAR
#undef PG_SCHED
#undef PG_SETA
}

struct EpiInProj {
    static constexpr bool PERM = true;
    bf16_t* U; const float* bias;
    __device__ __forceinline__ void operator()(const f32x4 (&acc)[2][2][4][2], const Unit& u, int wr, int wc, int fr, int fq) const {
        const int col0 = u.pn * BM + wc * 32 + 8 * fq;
        f32x4 bv[2][2]; bool cv[2];
#pragma unroll
        for (int bj = 0; bj < 2; ++bj) { const int c = col0 + bj * HALF; cv[bj] = c < INC;
#pragma unroll
            for (int n = 0; n < 2; ++n) bv[bj][n] = cv[bj] ? *(const f32x4*)(bias + c + 4 * n) : (f32x4){0.f, 0.f, 0.f, 0.f}; }
#pragma unroll
        for (int ai = 0; ai < 2; ++ai)
#pragma unroll
            for (int m = 0; m < 4; ++m) { const int r = ai * HALF + wr * 64 + m * 16 + fr;
                if (r < u.mvalid) { bf16_t* rowp = U + (size_t)(u.crow0 + r) * INC + col0;
#pragma unroll
                    for (int bj = 0; bj < 2; ++bj) if (cv[bj]) { const f32x4 v0 = acc[ai][bj][m][0] + bv[bj][0], v1 = acc[ai][bj][m][1] + bv[bj][1];
                        u32x4 w; w.x = pk2(v0[0], v0[1]); w.y = pk2(v0[2], v0[3]); w.z = pk2(v1[0], v1[1]); w.w = pk2(v1[2], v1[3]); *(u32x4*)(rowp + bj * HALF) = w; } } }
    }
};
struct EpiOutProj {
    static constexpr bool PERM = true;
    bf16_t* MX; const float* bias;
    __device__ __forceinline__ void operator()(const f32x4 (&acc)[2][2][4][2], const Unit& u, int wr, int wc, int fr, int fq) const {
        const int col0 = u.pn * BM + wc * 32 + 8 * fq;
        f32x4 bv[2][2];
#pragma unroll
        for (int bj = 0; bj < 2; ++bj)
#pragma unroll
            for (int n = 0; n < 2; ++n) bv[bj][n] = *(const f32x4*)(bias + col0 + bj * HALF + 4 * n);
#pragma unroll
        for (int ai = 0; ai < 2; ++ai)
#pragma unroll
            for (int m = 0; m < 4; ++m) { const int r = ai * HALF + wr * 64 + m * 16 + fr;
                if (r < u.mvalid) { bf16_t* rowp = MX + (size_t)(u.crow0 + r) * D + col0;
#pragma unroll
                    for (int bj = 0; bj < 2; ++bj) { const f32x4 v0 = acc[ai][bj][m][0] + bv[bj][0], v1 = acc[ai][bj][m][1] + bv[bj][1];
                        u32x4 w; w.x = pk2(v0[0], v0[1]); w.y = pk2(v0[2], v0[3]); w.z = pk2(v1[0], v1[1]); w.w = pk2(v1[2], v1[3]); *(u32x4*)(rowp + bj * HALF) = w; } } }
    }
};
struct EpiGateUp {
    static constexpr bool PERM = false;
    bf16_t* Hm;
    __device__ __forceinline__ void operator()(const f32x4 (&acc)[2][2][4][2], const Unit& u, int wr, int wc, int fr, int fq) const {
        const int col0 = u.pn * 128 + wc * 16 + 4 * fq;
#pragma unroll
        for (int ai = 0; ai < 2; ++ai)
#pragma unroll
            for (int m = 0; m < 4; ++m) { const int r = ai * HALF + wr * 64 + m * 16 + fr;
                if (r < u.mvalid) { bf16_t* rowp = Hm + (size_t)(u.crow0 + r) * DEXP + col0;
#pragma unroll
                    for (int bj = 0; bj < 2; ++bj) { const f32x4 g = acc[ai][bj][m][0], up = acc[ai][bj][m][1]; float o[4];
#pragma unroll
                        for (int j = 0; j < 4; ++j) o[j] = g[j] / (1.0f + __expf(-g[j])) * up[j];
                        u32x2 w; w.x = pk2(o[0], o[1]); w.y = pk2(o[2], o[3]); *(u32x2*)(rowp + bj * 64) = w; } } }
    }
};
struct EpiGateUp8 {
    static constexpr bool PERM = false;
    unsigned char* Hm;
    __device__ __forceinline__ void operator()(const f32x4 (&acc)[2][2][4][2], const Unit& u, int wr, int wc, int fr, int fq) const {
        const int col0 = u.pn * 128 + wc * 32 + 8 * fq;
#pragma unroll
        for (int ai = 0; ai < 2; ++ai)
#pragma unroll
            for (int m = 0; m < 4; ++m) { const int r = ai * HALF + wr * 64 + m * 16 + fr;
                if (r < u.mvalid) { int pk[2];
#pragma unroll
                    for (int bj = 0; bj < 2; ++bj) { const f32x4 g = acc[ai][bj][m][0] * (1.0f / 64.0f), up = acc[ai][bj][m][1] * (16.0f / 64.0f); float o[4];
#pragma unroll
                        for (int j = 0; j < 4; ++j) o[j] = g[j] / (1.0f + __expf(-g[j])) * up[j];
                        int q = __builtin_amdgcn_cvt_pk_fp8_f32(o[0], o[1], 0, false); pk[bj] = __builtin_amdgcn_cvt_pk_fp8_f32(o[2], o[3], q, true); }
                    *(u32x2*)(Hm + (size_t)(u.crow0 + r) * DEXP + col0) = (u32x2){(unsigned)pk[0], (unsigned)pk[1]}; } }
    }
};
struct EpiDown8 {
    static constexpr bool PERM = true;
    unsigned char* O;
    __device__ __forceinline__ void operator()(const f32x4 (&acc)[2][2][4][2], const Unit& u, int wr, int wc, int fr, int fq) const {
        const int col0 = u.pn * BM + wc * 32 + 8 * fq;
#pragma unroll
        for (int ai = 0; ai < 2; ++ai)
#pragma unroll
            for (int m = 0; m < 4; ++m) { const int r = ai * HALF + wr * 64 + m * 16 + fr;
                if (r < u.mvalid) { unsigned char* rowp = O + (size_t)(u.crow0 + r) * D + col0;
#pragma unroll
                    for (int bj = 0; bj < 2; ++bj) { const f32x4 v0 = acc[ai][bj][m][0] * (1.0f / 16.0f), v1 = acc[ai][bj][m][1] * (1.0f / 16.0f);
                        int p0 = __builtin_amdgcn_cvt_pk_fp8_f32(v0[0], v0[1], 0, false); p0 = __builtin_amdgcn_cvt_pk_fp8_f32(v0[2], v0[3], p0, true);
                        int p1 = __builtin_amdgcn_cvt_pk_fp8_f32(v1[0], v1[1], 0, false); p1 = __builtin_amdgcn_cvt_pk_fp8_f32(v1[2], v1[3], p1, true);
                        *(u32x2*)(rowp + bj * HALF) = (u32x2){(unsigned)p0, (unsigned)p1}; } } }
    }
};
struct EpiDown {
    static constexpr bool PERM = false;
    bf16_t* O;
    __device__ __forceinline__ void operator()(const f32x4 (&acc)[2][2][4][2], const Unit& u, int wr, int wc, int fr, int fq) const {
        const int col0 = u.pn * BM + wc * 32 + 4 * fq;
#pragma unroll
        for (int ai = 0; ai < 2; ++ai)
#pragma unroll
            for (int m = 0; m < 4; ++m) { const int r = ai * HALF + wr * 64 + m * 16 + fr;
                if (r < u.mvalid) { bf16_t* rowp = O + (size_t)(u.crow0 + r) * D + col0;
#pragma unroll
                    for (int bj = 0; bj < 2; ++bj)
#pragma unroll
                        for (int n = 0; n < 2; ++n) { const f32x4 v = acc[ai][bj][m][n]; u32x2 w; w.x = pk2i(v[0], v[1]); w.y = pk2i(v[2], v[3]); *(u32x2*)(rowp + bj * HALF + n * 16) = w; } } }
    }
};
}

struct Frame {
    LAS unsigned char* lds; volatile LAS unsigned* MISC; unsigned* ctl; unsigned char* ws;
    int tid, lane, wave, vcu, G;
};
__device__ __forceinline__ int opaque_v(int v) { asm volatile("" : "+v"(v)); return v; }
__device__ __forceinline__ unsigned char* launder_ws(unsigned char* p) { GAS unsigned char* q = (GAS unsigned char*)p; asm volatile("" : "+s"(q)); return (unsigned char*)q; }
struct Args { const float* in[36]; float* out; unsigned char* ws; int ph_lo, ph_hi; };
struct ArgsG { const GAS float* in_[36]; GAS float* out_; GAS unsigned char* ws_; int ph_lo, ph_hi;
 };
#define CAS __attribute__((address_space(4)))
__device__ __forceinline__ const CAS ArgsG* kargp() { const CAS ArgsG* p = (const CAS ArgsG*)__builtin_amdgcn_kernarg_segment_ptr(); asm volatile("" : "+s"(p)); return p; }
__device__ __forceinline__ const float* kin(int k) { return (const float*)kargp()->in_[k]; }
__device__ __forceinline__ float* kout() { return (float*)kargp()->out_; }

__device__ __forceinline__ void transpose64(const float* colp4, int ldw, int K, bf16_t* WT, int k0, int j0, LAS float* scr, int lane) {
    const int kr = lane >> 4, c4 = lane & 15;
    f32x4 t[16];
#pragma unroll
    for (int i = 0; i < 16; ++i) t[i] = colp4 ? *(const f32x4*)(colp4 + (size_t)(k0 + kr + 4 * i) * ldw) : (f32x4){0.f, 0.f, 0.f, 0.f};
    const int ch = lane >> 4, nr = lane & 15;
#pragma unroll
    for (int hf = 0; hf < 2; ++hf) {
#pragma unroll
        for (int i = 0; i < 8; ++i) { LAS float* d = scr + (kr + 4 * i) * 66 + 4 * c4; const f32x4 x = t[hf * 8 + i]; *(LAS f32x2*)d = (f32x2){x[0], x[1]}; *(LAS f32x2*)(d + 2) = (f32x2){x[2], x[3]}; }
        LDS_WAIT();
#pragma unroll
        for (int it = 0; it < 4; ++it) { const int n = nr + 16 * it; const LAS float* sp = scr + (8 * ch) * 66 + n;
            u32x4 o; o.x = pk2(sp[0], sp[66]); o.y = pk2(sp[2 * 66], sp[3 * 66]); o.z = pk2(sp[4 * 66], sp[5 * 66]); o.w = pk2(sp[6 * 66], sp[7 * 66]);
            *(u32x4*)(WT + (size_t)(j0 + n) * K + k0 + 32 * hf + 8 * ch) = o; }
        LDS_WAIT();
    }
}
__device__ __forceinline__ void transpose64_fp8(const float* colp4, int ldw, int K, unsigned char* WT, int k0, int j0, LAS float* scr, int lane) {
    const int kr = lane >> 4, c4 = lane & 15;
    f32x4 t[16];
#pragma unroll
    for (int i = 0; i < 16; ++i) t[i] = *(const f32x4*)(colp4 + (size_t)(k0 + kr + 4 * i) * ldw);
    const int ch = lane >> 5, nr = lane & 31;
#pragma unroll
    for (int hf = 0; hf < 2; ++hf) {
#pragma unroll
        for (int i = 0; i < 8; ++i) { LAS float* d = scr + (kr + 4 * i) * 66 + 4 * c4; const f32x4 x = t[hf * 8 + i]; *(LAS f32x2*)d = (f32x2){x[0], x[1]}; *(LAS f32x2*)(d + 2) = (f32x2){x[2], x[3]}; }
        LDS_WAIT();
#pragma unroll
        for (int it = 0; it < 2; ++it) { const int n = nr + 32 * it; const LAS float* sp = scr + (16 * ch) * 66 + n; int q[4];
#pragma unroll
            for (int g = 0; g < 4; ++g) { int pk = __builtin_amdgcn_cvt_pk_fp8_f32(sp[(4 * g) * 66] * 64.0f, sp[(4 * g + 1) * 66] * 64.0f, 0, false); q[g] = __builtin_amdgcn_cvt_pk_fp8_f32(sp[(4 * g + 2) * 66] * 64.0f, sp[(4 * g + 3) * 66] * 64.0f, pk, true); }
            *(u32x4*)(WT + (size_t)(j0 + n) * K + k0 + 32 * hf + 16 * ch) = (u32x4){(unsigned)q[0], (unsigned)q[1], (unsigned)q[2], (unsigned)q[3]}; }
        LDS_WAIT();
    }
}
__device__ __forceinline__ f32x4 ldg4(const float* p) { return *(const f32x4*)p; }
__device__ __forceinline__ f32x4 ldg4(const LAS float* p) { return *(const LAS f32x4*)p; }
template <bool HB8 = false, bool OUT_ONLY = false, class GP = const float*>
__device__ __forceinline__ void ln_wave_store(f32x4 (&v)[8], GP g, GP b, bf16_t* resrow, unsigned char* f8row, float* orow, int lane) {
    float s = 0.f;
#pragma unroll
    for (int j = 0; j < 8; ++j) s += (v[j][0] + v[j][1]) + (v[j][2] + v[j][3]);
    const float mean = wave_sum(s) * (1.0f / D);
    float q = 0.f;
#pragma unroll
    for (int j = 0; j < 8; ++j) { v[j] = v[j] - mean; q += (v[j][0] * v[j][0] + v[j][1] * v[j][1]) + (v[j][2] * v[j][2] + v[j][3] * v[j][3]); }
    const float rstd = rsqrtf(wave_sum(q) * (1.0f / D) + 1e-5f);
#pragma unroll
    for (int j = 0; j < 8; ++j) {
        const int i4 = lane + 64 * j;
        const f32x4 gv = ldg4(g + 4 * i4), bv = ldg4(b + 4 * i4);
        if (HB8 && (j & 1) == 0) __builtin_amdgcn_sched_barrier(0);
        const f32x4 o = v[j] * rstd * gv + bv;
        v[j] = o;
        if (OUT_ONLY) { if (orow) ((f32x4*)orow)[i4] = o; continue; }
        { u32x2 w; w.x = pk2(o[0], o[1]); w.y = pk2(o[2], o[3]); ((u32x2*)resrow)[i4] = w; }
        if (HB8) { int pk = __builtin_amdgcn_cvt_pk_fp8_f32(o[0], o[1], 0, false); pk = __builtin_amdgcn_cvt_pk_fp8_f32(o[2], o[3], pk, true); ((int*)f8row)[i4] = pk; }
        if (orow) ((f32x4*)orow)[i4] = o;
    }
}

__device__ __forceinline__ void hy_filter_item(Frame& F, int item, unsigned char* wsl);
__device__ __forceinline__ void hy_filter_tails(Frame& F, unsigned char* wsl);
__device__ __forceinline__ void p_prologue(Frame& F) {
    unsigned char* const wsl = launder_ws(F.ws); unsigned* const ctl = (unsigned*)(wsl + WS_CTL);
    LAS float* scr = (LAS float*)(F.lds + F.wave * 16384);
    const int gw = F.vcu * 8 + F.wave, NGW = F.G * 8, lane = F.lane;
    bf16_t* WIN = (bf16_t*)(wsl + WS_WIN); bf16_t* WOUT = (bf16_t*)(wsl + WS_WOUT); bf16_t* WGU = (bf16_t*)(wsl + WS_WGU); bf16_t* WD = (bf16_t*)(wsl + WS_WD);
    constexpr int I_IN = 32 * (INCP / 64), I_OUT = 32 * 32, I_GU = 32 * 32, I_D = 16 * 32;
    constexpr int N_IN = DEPTH * I_IN, N_OUT = DEPTH * I_OUT, N_GU = DEPTH * NEXP * I_GU, N_D = DEPTH * NEXP * I_D, N_TR = N_IN + N_OUT + N_GU + N_D;
    const int c4 = lane & 15, kr4 = lane >> 4;
    struct TrItem { const float* colp; unsigned char* wt; int ldw, K, k0, j0, f8; };
#define TR_DECODE(itv, d) do { int r_ = (itv); \
        if (r_ < N_IN) { const int ll = r_ / I_IN, q = r_ % I_IN, nb = q % (INCP / 64), kb = q / (INCP / 64); const int n = nb * 64 + 4 * c4; \
            d.colp = n < INC ? kin(4) + (size_t)ll * D * INC + n : nullptr; d.ldw = INC; d.K = D; d.wt = (unsigned char*)(WIN + (size_t)ll * INCP * D); d.k0 = kb * 64; d.j0 = nb * 64; d.f8 = 0; } \
        else if (r_ < N_IN + N_OUT) { r_ -= N_IN; const int ll = r_ / I_OUT, q = r_ % I_OUT, nb = q % 32, kb = q / 32; const int n = nb * 64 + 4 * c4; \
            d.colp = kin(23) + (size_t)ll * D * D + n; d.ldw = D; d.K = D; d.wt = (unsigned char*)(WOUT + (size_t)ll * D * D); d.k0 = kb * 64; d.j0 = nb * 64; d.f8 = 0; } \
        else if (r_ < N_IN + N_OUT + N_GU) { r_ -= N_IN + N_OUT; const int le = r_ / I_GU, q = r_ % I_GU, nb = q % 32, kb = q / 32; const int j = nb * 64 + 4 * c4; \
            const int pn = j >> 8, cp = j & 255, bj = cp >> 7, wc = (cp >> 5) & 3, nn = (cp >> 4) & 1, fq = (cp >> 2) & 3; const int hid = pn * 128 + wc * 32 + fq * 8 + bj * 4; \
            d.colp = (nn ? kin(32) : kin(31)) + (size_t)le * D * DEXP + hid; d.ldw = DEXP; d.K = D; d.wt = (unsigned char*)WGU + (size_t)le * 2048 * D; d.k0 = kb * 64; d.j0 = nb * 64; d.f8 = 1; } \
        else { r_ -= N_IN + N_OUT + N_GU; const int le = r_ / I_D, q = r_ % I_D, nb = q % 32, kb = q / 32; const int n = nb * 64 + 4 * c4; \
            d.colp = kin(33) + (size_t)le * DEXP * D + n; d.ldw = D; d.K = DEXP; d.wt = (unsigned char*)WD + (size_t)le * D * DEXP; d.k0 = kb * 64; d.j0 = nb * 64; d.f8 = 1; } } while (0)
#define TR_LOAD(d, t) do { _Pragma("unroll") for (int i = 0; i < 16; ++i) t[i] = d.colp ? *(const f32x4*)(d.colp + (size_t)(d.k0 + kr4 + 4 * i) * d.ldw) : (f32x4){0.f, 0.f, 0.f, 0.f}; } while (0)
    { int it = gw; TrItem dc, dn; f32x4 tc[16], tn[16];
      if (it < N_TR) { TR_DECODE(it, dc); TR_LOAD(dc, tc); }
      for (; it < N_TR; it += NGW) {
          const int itn = it + NGW;
          if (itn < N_TR) { TR_DECODE(itn, dn); TR_LOAD(dn, tn); }
#pragma unroll
          for (int hf = 0; hf < 2; ++hf) {
#pragma unroll
              for (int i = 0; i < 8; ++i) { LAS float* dd = scr + (kr4 + 4 * i) * 66 + 4 * c4; const f32x4 x = tc[hf * 8 + i]; *(LAS f32x2*)dd = (f32x2){x[0], x[1]}; *(LAS f32x2*)(dd + 2) = (f32x2){x[2], x[3]}; }
              LDS_WAIT();
              if (dc.f8) { const int ch = lane >> 5, nr = lane & 31;
#pragma unroll
                  for (int i2 = 0; i2 < 2; ++i2) { const int n = nr + 32 * i2; const LAS float* sp = scr + (16 * ch) * 66 + n; int q[4];
#pragma unroll
                      for (int g = 0; g < 4; ++g) { int pk = __builtin_amdgcn_cvt_pk_fp8_f32(sp[(4 * g) * 66] * 64.0f, sp[(4 * g + 1) * 66] * 64.0f, 0, false); q[g] = __builtin_amdgcn_cvt_pk_fp8_f32(sp[(4 * g + 2) * 66] * 64.0f, sp[(4 * g + 3) * 66] * 64.0f, pk, true); }
                      *(u32x4*)(dc.wt + (size_t)(dc.j0 + n) * dc.K + dc.k0 + 32 * hf + 16 * ch) = (u32x4){(unsigned)q[0], (unsigned)q[1], (unsigned)q[2], (unsigned)q[3]}; }
              } else { const int ch = lane >> 4, nr = lane & 15;
#pragma unroll
                  for (int i2 = 0; i2 < 4; ++i2) { const int n = nr + 16 * i2; const LAS float* sp = scr + (8 * ch) * 66 + n;
                      u32x4 o; o.x = pk2(sp[0], sp[66]); o.y = pk2(sp[2 * 66], sp[3 * 66]); o.z = pk2(sp[4 * 66], sp[5 * 66]); o.w = pk2(sp[6 * 66], sp[7 * 66]);
                      *(u32x4*)((bf16_t*)dc.wt + (size_t)(dc.j0 + n) * dc.K + dc.k0 + 32 * hf + 8 * ch) = o; } }
              LDS_WAIT();
          }
          dc = dn;
#pragma unroll
          for (int i = 0; i < 16; ++i) tc[i] = tn[i];
      } }
#undef TR_DECODE
#undef TR_LOAD
    { bf16_t* WR = (bf16_t*)(wsl + WS_WR);
      for (int idx = blockIdx.x * 512 + F.tid; idx < DEPTH * 64 * 2 * 64; idx += F.G * 512) {
          const int ln = idx & 63, t = (idx >> 6) & 1, sst = (idx >> 7) & 63, ll = idx >> 13, n = ln & 15, kg = ln >> 4, c = 16 * t + n;
          unsigned hi[8], lo[8];
#pragma unroll
          for (int j = 0; j < 8; ++j) { const int k = 32 * sst + 8 * kg + j;
              const float wv = c < 4 ? kin(27)[((size_t)ll * D + k) * 4 + c] : (c < 20 ? kin(29)[((size_t)ll * D + k) * 16 + c - 4] : 0.f);
              hi[j] = f2bf(wv); lo[j] = f2bf(wv - __builtin_bit_cast(float, hi[j] << 16)); }
          bf16_t* o = WR + ((size_t)ll * 256 + (sst * 2 + t) * 2) * 512 + ln * 8;
          *(u32x4*)o = (u32x4){hi[0] | (hi[1] << 16), hi[2] | (hi[3] << 16), hi[4] | (hi[5] << 16), hi[6] | (hi[7] << 16)};
          *(u32x4*)(o + 512) = (u32x4){lo[0] | (lo[1] << 16), lo[2] | (lo[3] << 16), lo[4] | (lo[5] << 16), lo[6] | (lo[7] << 16)}; } }
    hy_filter_tails(F, wsl);
    for (int it = blockIdx.x; it < DEPTH * 66; it += F.G) hy_filter_item(F, it, wsl);
    __syncthreads();
    bf16_t* hb = (bf16_t*)(wsl + WS_HB);
    for (int row = gw; row < T; row += NGW) {
        const int bb = row / L, p = row % L;
        const float* src = p < NMETA ? kin(1) + (size_t)p * D : kin(0) + ((size_t)bb * SEQ + (p - NMETA)) * D;
        f32x4 v[8];
#pragma unroll
        for (int j = 0; j < 8; ++j) v[j] = ((const f32x4*)src)[lane + 64 * j];
        ln_wave_store(v, kin(2), kin(3), hb + (size_t)row * D, nullptr, nullptr, lane);
    }
}


__device__ __forceinline__ void hy_filter_item(Frame& F, int item, unsigned char* wsl) {
    const int half = item & 1, blk = (item >> 1) % 33, l = item / 66, tid = F.tid;
    const float* w1 = kin(15) + (size_t)l * 33 * 64; const float* b1 = kin(16) + l * 64; const float* freq = kin(17) + l * 128;
    const float* w2 = kin(18) + (size_t)l * 64 * 64; const float* b2 = kin(19) + l * 64; const float* w3 = kin(20) + (size_t)l * 64 * 1024;
    LAS float* z = (LAS float*)F.lds;
    LAS float* h1 = z + 64 * 33;
    LAS float* h2 = h1 + 64 * 64;
    LAS bf16_t* ot = (LAS bf16_t*)(h2 + 64 * 64);
    const int d0 = blk * 64;
    __syncthreads();
    for (int e = tid; e < 64 * 33; e += 512) { const int pl = e / 33, k = e % 33, i = d0 + pl; float v;
        if (k == 0) v = (float)i / (float)(L - 1);
        else { const int j = (k - 1) & 15; const double band = 1e-4 + (double)j * ((15.0 - 1e-4) / 15.0); double turns = band * (double)i / (double)L; turns -= (double)(long long)turns;
               const float ang = (float)(turns * 6.283185307179586476925); v = k < 17 ? __cosf(ang) : -__sinf(ang); }
        z[e] = v; }
    __syncthreads();
    { const int j = tid & 63, pg = tid >> 6; const float fq = freq[j], bb = b1[j];
      float a[8];
#pragma unroll
      for (int r = 0; r < 8; ++r) a[r] = bb;
      for (int k = 0; k < 33; ++k) { const float w = w1[k * 64 + j];
#pragma unroll
          for (int r = 0; r < 8; ++r) a[r] += z[(pg * 8 + r) * 33 + k] * w; }
#pragma unroll
      for (int r = 0; r < 8; ++r) h1[(pg * 8 + r) * 64 + j] = __sinf(fq * a[r]); }
    __syncthreads();
    { const int j = tid & 63, pg = tid >> 6; const float fq = freq[64 + j], bb = b2[j];
      float a[8];
#pragma unroll
      for (int r = 0; r < 8; ++r) a[r] = bb;
      for (int k = 0; k < 64; ++k) { const float w = w2[k * 64 + j];
#pragma unroll
          for (int r = 0; r < 8; ++r) a[r] += h1[(pg * 8 + r) * 64 + k] * w; }
#pragma unroll
      for (int r = 0; r < 8; ++r) h2[(pg * 8 + r) * 64 + j] = __sinf(fq * a[r]); }
    __syncthreads();
    { const int c = tid;
      const float mind = logf(1e-2f) / 1.5f, maxd = logf(1e-2f) / 0.3f;
      const float adel = fabsf(mind + (float)c * ((maxd - mind) / 511.0f));
      for (int pq = 0; pq < 64; pq += 8) {
          float a[8];
#pragma unroll
          for (int r = 0; r < 8; ++r) a[r] = 0.f;
          for (int k = 0; k < 64; ++k) { const float w = w3[k * 1024 + half * 512 + c];
#pragma unroll
              for (int r = 0; r < 8; ++r) a[r] += h2[(pq + r) * 64 + k] * w; }
#pragma unroll
          for (int r = 0; r < 8; ++r) { const int i = d0 + pq + r; const float tt = (float)i / (float)(L - 1); ot[c * 66 + pq + r] = (bf16_t)f2bf(a[r] * __expf(-tt * adel)); } } }
    __syncthreads();
    { bf16_t* FG = (bf16_t*)(wsl + WS_FG) + (size_t)l * 512 * 2 * GLEN;
      const int dl = tid & 63, cg = tid >> 6, d = d0 + dl;
      if (d < L && !(half == 1 && d == 0)) {
          const int m = half ? GCEN + d : GCEN - d;
          for (int c = cg; c < 512; c += 8) { const bf16_t v = ot[c * 66 + dl]; bf16_t* row = FG + (size_t)c * 2 * GLEN; row[m] = v; row[GLEN + m - 1] = v; } } }
}
__device__ __forceinline__ void hy_filter_tails(Frame& F, unsigned char* wsl) {
    bf16_t* FG = (bf16_t*)(wsl + WS_FG);
    constexpr int LO0 = GCEN - (L - 1), HI0 = GCEN + (L - 1) + 1;
    constexpr int NT0 = LO0 + (GLEN - HI0), NT1 = (LO0 - 1) + (GLEN - (HI0 - 1));
    for (size_t idx = (size_t)blockIdx.x * 512 + F.tid; idx < (size_t)DEPTH * 512 * (NT0 + NT1); idx += (size_t)F.G * 512) {
        const int rowi = (int)(idx / (NT0 + NT1)); int k = (int)(idx % (NT0 + NT1));
        bf16_t* row = FG + (size_t)rowi * 2 * GLEN;
        if (k < NT0) { const int m = k < LO0 ? k : HI0 + (k - LO0); row[m] = 0; }
        else { k -= NT0; const int m = k < LO0 - 1 ? k : (HI0 - 1) + (k - (LO0 - 1)); row[GLEN + m] = 0; } }
}

constexpr int MIXC_SG = 98304, MIXC_CW = 102400, MIXC_CB = 120832, MIXC_HG = 98304;
__device__ __forceinline__ void hy_pre_item(Frame& F, int item, int l, unsigned char* wsl) {
    const bf16_t* U = (const bf16_t*)(wsl + WS_U);
    bf16_t* X0T = (bf16_t*)(wsl + WS_X0T); bf16_t* ZT = (bf16_t*)(wsl + WS_ZT);
    const LAS float* cw = (const LAS float*)(F.lds + MIXC_CW); const LAS float* cb = (const LAS float*)(F.lds + MIXC_CB);
    const int cc = item & 3, pt = (item >> 2) % 33, b = item / (4 * 33), tid = opaque_v(F.tid);
    const int c8 = tid & 15, pl = tid >> 4, c0 = cc * 128 + 8 * c8;
    LAS bf16_t* zt = (LAS bf16_t*)F.lds; LAS bf16_t* xt = zt + 128 * 72;
    __syncthreads();
    u32x4 raw[2][3][3];
#pragma unroll
    for (int ps = 0; ps < 2; ++ps) { const int p = pt * 64 + pl + 32 * ps; const bool pv = p < L;
#pragma unroll
        for (int g = 0; g < 3; ++g) { const bf16_t* ub = U + ((size_t)b * L + (pv ? p : 0)) * INC + O_CU + g * 512 + c0; const u32x4 z4 = (u32x4){0u, 0u, 0u, 0u};
            raw[ps][g][0] = (pv && p > 0) ? *(const u32x4*)(ub - INC) : z4; raw[ps][g][1] = pv ? *(const u32x4*)ub : z4; raw[ps][g][2] = (p + 1 < L) ? *(const u32x4*)(ub + INC) : z4; } }
#pragma unroll
    for (int ps = 0; ps < 2; ++ps) { const int p = pt * 64 + pl + 32 * ps; const bool pv = p < L;
        float uc[3][8];
#pragma unroll
        for (int g = 0; g < 3; ++g) { const int col = g * 512 + c0;
            const f32x4 wa0 = *(const LAS f32x4*)(cw + col), wa1 = *(const LAS f32x4*)(cw + col + 4), wb0 = *(const LAS f32x4*)(cw + 1536 + col), wb1 = *(const LAS f32x4*)(cw + 1536 + col + 4),
                        wc0 = *(const LAS f32x4*)(cw + 3072 + col), wc1 = *(const LAS f32x4*)(cw + 3072 + col + 4), bb0 = *(const LAS f32x4*)(cb + col), bb1 = *(const LAS f32x4*)(cb + col + 4);
            const u32x4 rm = raw[ps][g][0], r0 = raw[ps][g][1], rp = raw[ps][g][2];
#pragma unroll
            for (int j = 0; j < 4; ++j) {
                const float m0 = __builtin_bit_cast(float, rm[j] << 16), m1 = __builtin_bit_cast(float, rm[j] & 0xffff0000u), x0 = __builtin_bit_cast(float, r0[j] << 16), x1 = __builtin_bit_cast(float, r0[j] & 0xffff0000u),
                            q0 = __builtin_bit_cast(float, rp[j] << 16), q1 = __builtin_bit_cast(float, rp[j] & 0xffff0000u);
                const int e = 2 * j; const float w0a = e < 4 ? wa0[e & 3] : wa1[e & 3], w0b = e < 4 ? wb0[e & 3] : wb1[e & 3], w0c = e < 4 ? wc0[e & 3] : wc1[e & 3], b0_ = e < 4 ? bb0[e & 3] : bb1[e & 3];
                const float w1a = e < 4 ? wa0[(e + 1) & 3] : wa1[(e + 1) & 3], w1b = e < 4 ? wb0[(e + 1) & 3] : wb1[(e + 1) & 3], w1c = e < 4 ? wc0[(e + 1) & 3] : wc1[(e + 1) & 3], b1_ = e < 4 ? bb0[(e + 1) & 3] : bb1[(e + 1) & 3];
                uc[g][e] = pv ? (b0_ + m0 * w0a + x0 * w0b + q0 * w0c) : 0.f; uc[g][e + 1] = pv ? (b1_ + m1 * w1a + x1 * w1b + q1 * w1c) : 0.f; } }
#pragma unroll
        for (int j = 0; j < 8; ++j) { zt[(8 * c8 + j) * 72 + pl + 32 * ps] = (bf16_t)f2bf(uc[1][j] * uc[2][j]); xt[(8 * c8 + j) * 72 + pl + 32 * ps] = (bf16_t)f2bf(uc[0][j]); } }
    __syncthreads();
#pragma unroll
    for (int it = 0; it < 2; ++it) { const int cr = (tid >> 3) + 64 * it, pc = tid & 7;
      const size_t o = ((size_t)(cc * 128 + cr) * NB + b) * ZL + pt * 64 + pc * 8;
      *(u32x4*)(ZT + o) = *(const LAS u32x4*)(zt + cr * 72 + pc * 8);
      *(u32x4*)(X0T + o) = *(const LAS u32x4*)(xt + cr * 72 + pc * 8); }
}

__device__ __forceinline__ void hy_conv_phase(Frame& F, int l, unsigned char* wsl) {
    const bf16_t* ZT = (const bf16_t*)(wsl + WS_ZT); const bf16_t* X0T = (const bf16_t*)(wsl + WS_X0T); bf16_t* YT = (bf16_t*)(wsl + WS_YT);
    const bf16_t* FG = (const bf16_t*)(wsl + WS_FG) + (size_t)l * 512 * 2 * GLEN;
    const float* skip = kin(21) + l * 512;
    LAS unsigned char* Zs = F.lds;
    LAS unsigned char* Gs = F.lds + 8 * ZROW * 2;
    const int tid = F.tid, lane = F.lane, wave = F.wave;
    __syncthreads();
    for (int e = tid; e < 8 * ZROW * 2 / 16; e += 512) *(LAS u32x4*)(Zs + e * 16) = (u32x4){0u, 0u, 0u, 0u};
    const int pp = wave & 1, q = wave >> 1;
    const int T0 = 576 * q + 16 * pp, D0 = -(576 * q + 544 + 32 * pp), S0 = T0 + D0;
    const int n = lane & 15, kg = lane >> 4, bb = n & 7, u = n >> 3;
    const unsigned zb = (unsigned)(bb * ZROW * 2 + 2 * (ZOFF + S0 + 32 * u + 8 * kg));
    const int par = n & 1, e0 = GCEN + D0 + 8 * kg - n;
    const unsigned ab = (unsigned)(8 * ZROW * 2 + par * GLEN * 2 + 2 * (e0 - par));
    for (int c = F.vcu; c < 512; c += F.G) {
        __syncthreads();
        for (int e = tid; e < 8 * (ZL / 8); e += 512) { const int b = e / (ZL / 8), pc = e % (ZL / 8);
            *(LAS u32x4*)(Zs + (b * ZROW + ZOFF + pc * 8) * 2) = *(const u32x4*)(ZT + ((size_t)c * NB + b) * ZL + pc * 8); }
        for (int e = tid; e < 2 * GLEN / 8; e += 512) *(LAS u32x4*)(Gs + e * 16) = *(const u32x4*)(FG + (size_t)c * 2 * GLEN + e * 8);
        __syncthreads();
        f32x4 acc[9];
#pragma unroll
        for (int k = 0; k < 9; ++k) acc[k] = (f32x4){0.f, 0.f, 0.f, 0.f};
        bf16x8 ring[18];
#pragma unroll
        for (int s2 = 0; s2 < 17; ++s2) ring[s2] = *(const LAS bf16x8*)(F.lds + zb + 64 * s2);
        u32x4 an;
#pragma unroll
        for (int d = 0; d < 4; ++d) an[d] = *(const LAS unsigned*)(F.lds + ab + 4 * d);
        for (int jo = 0; jo < 5; ++jo) {
            const unsigned zo = zb + (unsigned)jo * 18u * 64u, ao = ab + (unsigned)jo * 18u * 64u;
#pragma unroll
            for (int jj = 0; jj < 18; ++jj) {
                const bf16x8 acur = __builtin_bit_cast(bf16x8, an);
                ring[(jj + 17) % 18] = *(const LAS bf16x8*)(F.lds + zo + 64 * (jj + 17));
#pragma unroll
                for (int d = 0; d < 4; ++d) an[d] = *(const LAS unsigned*)(F.lds + ao + 64 * (jj + 1) + 4 * d);
#pragma unroll
                for (int k = 0; k < 9; ++k) acc[k] = __builtin_amdgcn_mfma_f32_16x16x32_bf16(acur, ring[(jj + 2 * k) % 18], acc[k], 0, 0, 0);
            }
        }
        const float sk = skip[c];
#pragma unroll
        for (int k = 0; k < 9; ++k) { const int t = T0 + 64 * k + 32 * u + 4 * kg;
            if (t < L) { const size_t o = ((size_t)c * NB + bb) * ZL + t;
                const u32x2 xv = *(const u32x2*)(X0T + o); const u32x2 zv = *(const LAS u32x2*)(Zs + (bb * ZROW + ZOFF + t) * 2);
                float y[4];
                y[0] = __builtin_bit_cast(float, xv.x << 16) * (acc[k][0] + sk * __builtin_bit_cast(float, zv.x << 16));
                y[1] = __builtin_bit_cast(float, xv.x & 0xffff0000u) * (acc[k][1] + sk * __builtin_bit_cast(float, zv.x & 0xffff0000u));
                y[2] = __builtin_bit_cast(float, xv.y << 16) * (acc[k][2] + sk * __builtin_bit_cast(float, zv.y << 16));
                y[3] = __builtin_bit_cast(float, xv.y & 0xffff0000u) * (acc[k][3] + sk * __builtin_bit_cast(float, zv.y & 0xffff0000u));
                u32x2 w; w.x = pk2(y[0], y[1]); w.y = pk2(y[2], y[3]); *(u32x2*)(YT + o) = w; } }
    }
    __syncthreads();
}

__device__ __forceinline__ void hy_norm_item(Frame& F, int item, int l, unsigned char* wsl) {
    const bf16_t* YT = (const bf16_t*)(wsl + WS_YT); bf16_t* Y = (bf16_t*)(wsl + WS_Y); const LAS float* hg = (const LAS float*)(F.lds + MIXC_HG);
    const int pt = item % 33, b = item / 33, p0 = pt * 64, tid = opaque_v(F.tid);
    LAS bf16_t* tl = (LAS bf16_t*)F.lds;
    LAS float* part = (LAS float*)(F.lds + 512 * 72 * 2);
    LAS float* rsv = part + 512;
    __syncthreads();
#pragma unroll
    for (int it = 0; it < 8; ++it) { const int c = (tid >> 3) + 64 * it, pc = tid & 7;
        *(LAS u32x4*)(tl + c * 72 + pc * 8) = *(const u32x4*)(YT + ((size_t)c * NB + b) * ZL + p0 + pc * 8); }
    __syncthreads();
    { const int pos = tid & 63, cg = tid >> 6; float sacc = 0.f;
      for (int c = cg * 64; c < cg * 64 + 64; ++c) { const float v = bf2f(tl[c * 72 + pos]); sacc += v * v; }
      part[cg * 64 + pos] = sacc; }
    __syncthreads();
    if (tid < 64) { float sacc = 0.f;
#pragma unroll
        for (int g = 0; g < 8; ++g) sacc += part[g * 64 + tid];
        rsv[tid] = rsqrtf(sacc * (1.0f / 512.0f) + 1e-6f); }
    __syncthreads();
    { const int pos = tid >> 3, pc = tid & 7, p = p0 + pos;
      if (p < L) { const float rs = rsv[pos]; bf16_t* yrow = Y + ((size_t)b * L + p) * D + 1536;
#pragma unroll
          for (int it = 0; it < 8; ++it) { const int c = it * 64 + pc * 8; float v[8];
#pragma unroll
              for (int j = 0; j < 8; ++j) v[j] = bf2f(tl[(c + j) * 72 + pos]) * rs * hg[c + j];
              u32x4 w; w.x = pk2(v[0], v[1]); w.y = pk2(v[2], v[3]); w.z = pk2(v[4], v[5]); w.w = pk2(v[6], v[7]);
              *(u32x4*)(yrow + c) = w; } } }
}


constexpr int GS = 72;
constexpr int G_OP0 = 0, G_OP1 = 9216, G_VT = 18432, G_DEC = 36864, G_PART = 37376, G_W = 38400, G_ST = 49152;
typedef float f32x16 __attribute__((ext_vector_type(16)));
typedef short s16x4 __attribute__((ext_vector_type(4)));
__device__ __forceinline__ float logsigmoid_fast(float x) { return fminf(x, 0.f) - log1pf(__expf(-fabsf(x))); }
template <int N> __device__ __forceinline__ float row_shr_add(float v) { const int t = __builtin_amdgcn_update_dpp(0, __builtin_bit_cast(int, v), 0x110 + N, 0xf, 0xf, true); return v + __builtin_bit_cast(float, t); }
__device__ __forceinline__ float wave_incl_scan(float v, int lane) {
    v = row_shr_add<1>(v); v = row_shr_add<2>(v); v = row_shr_add<4>(v); v = row_shr_add<8>(v);
    const int vi = __builtin_bit_cast(int, v);
    const float r0 = __builtin_bit_cast(float, __builtin_amdgcn_readlane(vi, 15)), r1 = __builtin_bit_cast(float, __builtin_amdgcn_readlane(vi, 31)), r2 = __builtin_bit_cast(float, __builtin_amdgcn_readlane(vi, 47));
    return v + (lane >= 16 ? r0 : 0.f) + (lane >= 32 ? r1 : 0.f) + (lane >= 48 ? r2 : 0.f);
}
__device__ __forceinline__ float lane_bcast63(float v) { return __builtin_bit_cast(float, __builtin_amdgcn_readlane(__builtin_bit_cast(int, v), 63)); }
__device__ __forceinline__ int crow16(int i, int hh) { return (i & 3) + 8 * (i >> 2) + 4 * hh; }
#define MFMA32(a, b, c) __builtin_amdgcn_mfma_f32_32x32x16_bf16((a), (b), (c), 0, 0, 0)
__device__ __forceinline__ void gla_passA_item(Frame& F, int item, int l, unsigned char* wsl) {
    const int n = item % GNC, bh = item / GNC, b = bh >> 2, h = bh & 3, tid = opaque_v(F.tid), w = F.wave, lane = tid & 63;
    LAS float* gw = (LAS float*)(F.lds + G_W);
    const bf16_t* U = (const bf16_t*)(wsl + WS_U);
    const int d0 = 8 * w, p = 64 * n - 48 + lane; const bool valid = p >= 0;
    const bf16_t* urow = U + ((size_t)b * L + (valid ? p : 0)) * INC;
    const u32x4 g0 = *(const u32x4*)(urow + O_GF), g1 = *(const u32x4*)(urow + O_GF + 8), g2 = *(const u32x4*)(urow + O_GB), g3 = *(const u32x4*)(urow + O_GB + 8);
    const u32x4 qraw = *(const u32x4*)(urow + O_AQ + h * 64 + d0), kraw = *(const u32x4*)(urow + O_AK + h * 64 + d0);
    const u32x4 v0 = *(const u32x4*)(urow + O_AV + h * 128 + 16 * w), v1 = *(const u32x4*)(urow + O_AV + h * 128 + 16 * w + 8);
    __syncthreads();
    for (int e = tid; e < 2176; e += 512) { float v;
        if (e < 2048) { const int dirw = e >> 10, rr = (e >> 6) & 15, d = e & 63; v = (dirw ? kin(8) : kin(6))[(size_t)l * 16 * 256 + rr * 256 + h * 64 + d]; }
        else { const int dirw = (e - 2048) >> 6, d = e & 63; v = (dirw ? kin(9) : kin(7))[l * 256 + h * 64 + d]; }
        gw[e] = v; }
    __syncthreads();
    float glf[16], glb[16];
    {
#pragma unroll
      for (int r = 0; r < 4; ++r) { glf[2 * r] = __builtin_bit_cast(float, g0[r] << 16); glf[2 * r + 1] = __builtin_bit_cast(float, g0[r] & 0xffff0000u); glf[8 + 2 * r] = __builtin_bit_cast(float, g1[r] << 16); glf[9 + 2 * r] = __builtin_bit_cast(float, g1[r] & 0xffff0000u);
          glb[2 * r] = __builtin_bit_cast(float, g2[r] << 16); glb[2 * r + 1] = __builtin_bit_cast(float, g2[r] & 0xffff0000u); glb[8 + 2 * r] = __builtin_bit_cast(float, g3[r] << 16); glb[9 + 2 * r] = __builtin_bit_cast(float, g3[r] & 0xffff0000u); } }
    float cF[8], cB[8], tF[8], tB[8];
#pragma unroll
    for (int dirw = 0; dirw < 2; ++dirw) {
        float x[8];
        { const f32x4 b0 = *(const LAS f32x4*)(gw + 2048 + dirw * 64 + d0), b1 = *(const LAS f32x4*)(gw + 2048 + dirw * 64 + d0 + 4);
#pragma unroll
          for (int j = 0; j < 4; ++j) { x[j] = b0[j]; x[4 + j] = b1[j]; } }
#pragma unroll
        for (int r = 0; r < 16; ++r) {
            const f32x4 a0 = *(const LAS f32x4*)(gw + dirw * 1024 + r * 64 + d0), a1 = *(const LAS f32x4*)(gw + dirw * 1024 + r * 64 + d0 + 4);
            const float g = dirw ? glb[r] : glf[r];
#pragma unroll
            for (int j = 0; j < 4; ++j) { x[j] += g * a0[j]; x[4 + j] += g * a1[j]; }
            if ((r & 3) == 3) asm volatile("" : "+v"(x[0]), "+v"(x[1]), "+v"(x[2]), "+v"(x[3]), "+v"(x[4]), "+v"(x[5]), "+v"(x[6]), "+v"(x[7]));
        }
#pragma unroll
        for (int dd = 0; dd < 8; ++dd) {
            const float lg = valid ? logsigmoid_fast(x[dd]) * (1.0f / 16.0f) : 0.f;
            const float ps = wave_incl_scan(lg, lane), tot = lane_bcast63(ps);
            if (dirw == 0) { cF[dd] = ps; tF[dd] = tot; } else { cB[dd] = tot - ps + lg; tB[dd] = tot; }
            if ((dd & 1) == 1) { if (dirw == 0) asm volatile("" : "+v"(cF[dd]), "+v"(cF[dd - 1])); else asm volatile("" : "+v"(cB[dd]), "+v"(cB[dd - 1])); }
        }
    }
    LAS bf16_t* op0 = (LAS bf16_t*)(F.lds + G_OP0); LAS bf16_t* op1 = (LAS bf16_t*)(F.lds + G_OP1); LAS float* dec = (LAS float*)(F.lds + G_DEC);
    unsigned pq0[4], pq1[4], pq2[4], pq3[4];
#pragma unroll
    for (int dd = 0; dd < 8; ++dd) {
        const float qv = valid ? ((dd & 1) ? __builtin_bit_cast(float, qraw[dd >> 1] & 0xffff0000u) : __builtin_bit_cast(float, qraw[dd >> 1] << 16)) : 0.f;
        const float kv = valid ? ((dd & 1) ? __builtin_bit_cast(float, kraw[dd >> 1] & 0xffff0000u) : __builtin_bit_cast(float, kraw[dd >> 1] << 16)) : 0.f;
        op0[(d0 + dd) * GS + lane] = (bf16_t)f2bf(kv * __expf(tF[dd] - cF[dd]));
        op1[(d0 + dd) * GS + lane] = (bf16_t)f2bf(kv * __expf(tB[dd] - cB[dd]));
        if (lane == 0) { dec[d0 + dd] = __expf(tF[dd]); dec[64 + d0 + dd] = __expf(tB[dd]); }
        const unsigned a0 = f2bf(qv * 0.125f * __expf(cF[dd])), a1 = f2bf(kv * __expf(-cF[dd])), a2 = f2bf(qv * 0.125f * __expf(cB[dd])), a3 = f2bf(kv * __expf(-cB[dd]));
        if (dd & 1) { pq0[dd >> 1] |= a0 << 16; pq1[dd >> 1] |= a1 << 16; pq2[dd >> 1] |= a2 << 16; pq3[dd >> 1] |= a3 << 16; }
        else { pq0[dd >> 1] = a0; pq1[dd >> 1] = a1; pq2[dd >> 1] = a2; pq3[dd >> 1] = a3; }
    }
    { LAS bf16_t* st = (LAS bf16_t*)(F.lds + G_ST) + lane * GS + d0;
      *(LAS u32x4*)(st) = (u32x4){pq0[0], pq0[1], pq0[2], pq0[3]}; *(LAS u32x4*)(st + 64 * GS) = (u32x4){pq1[0], pq1[1], pq1[2], pq1[3]};
      *(LAS u32x4*)(st + 128 * GS) = (u32x4){pq2[0], pq2[1], pq2[2], pq2[3]}; *(LAS u32x4*)(st + 192 * GS) = (u32x4){pq3[0], pq3[1], pq3[2], pq3[3]}; }
    LAS bf16_t* vt = (LAS bf16_t*)(F.lds + G_VT);
    {
#pragma unroll
      for (int j = 0; j < 4; ++j) { const int dv = 16 * w + 2 * j;
          vt[dv * GS + lane] = valid ? (bf16_t)(v0[j] & 0xffffu) : (bf16_t)0; vt[(dv + 1) * GS + lane] = valid ? (bf16_t)(v0[j] >> 16) : (bf16_t)0;
          vt[(dv + 8) * GS + lane] = valid ? (bf16_t)(v1[j] & 0xffffu) : (bf16_t)0; vt[(dv + 9) * GS + lane] = valid ? (bf16_t)(v1[j] >> 16) : (bf16_t)0; } }
    __syncthreads();
    { bf16_t* gvt = (bf16_t*)(wsl + WS_GVT) + (size_t)item * 8192;
#pragma unroll
      for (int it = 0; it < 2; ++it) { const int e = it * 512 + tid, dv = e >> 3, pc = e & 7; *(u32x4*)(gvt + dv * 64 + pc * 8) = *(const LAS u32x4*)(vt + dv * GS + pc * 8); } }
    { bf16_t* gqk = (bf16_t*)(wsl + WS_GQK) + (size_t)item * 4 * 4096; const LAS bf16_t* st = (const LAS bf16_t*)(F.lds + G_ST);
#pragma unroll
      for (int it = 0; it < 4; ++it) { const int pos = tid >> 3, pc = tid & 7; *(u32x4*)(gqk + it * 4096 + pos * 64 + pc * 8) = *(const LAS u32x4*)(st + (it * 64 + pos) * GS + pc * 8); } }
    const int dir = w >> 2, dvb = w & 3, r = lane & 31, hh = lane >> 5;
    const LAS bf16_t* KL = (const LAS bf16_t*)(F.lds + (dir ? G_OP1 : G_OP0));
    f32x16 acc0, acc1;
#pragma unroll
    for (int i = 0; i < 16; ++i) { acc0[i] = 0.f; acc1[i] = 0.f; }
#pragma unroll
    for (int ks = 0; ks < 4; ++ks) {
        const bf16x8 a = *(const LAS bf16x8*)(vt + (32 * dvb + r) * GS + 16 * ks + 8 * hh);
        const bf16x8 b0 = *(const LAS bf16x8*)(KL + r * GS + 16 * ks + 8 * hh);
        const bf16x8 b1 = *(const LAS bf16x8*)(KL + (32 + r) * GS + 16 * ks + 8 * hh);
        acc0 = MFMA32(a, b0, acc0); acc1 = MFMA32(a, b1, acc1);
    }
    const int chain = (bh << 1) | dir;
    bf16_t* kvt = (bf16_t*)(wsl + WS_KVT) + ((size_t)chain * GNC + n) * 128 * 64;
#pragma unroll
    for (int i = 0; i < 16; ++i) { const int dv = 32 * dvb + crow16(i, hh); kvt[dv * 64 + r] = (bf16_t)f2bf(acc0[i]); kvt[dv * 64 + 32 + r] = (bf16_t)f2bf(acc1[i]); }
    if (tid < 128) { const int d = tid & 63, dd = tid >> 6; ((float*)(wsl + WS_DEC))[((size_t)((bh << 1) | dd) * GNC + n) * 64 + d] = ((const LAS float*)(F.lds + G_DEC))[dd * 64 + d]; }
}
__device__ __forceinline__ void gla_passB(Frame& F, unsigned char* wsl) {
    const bf16_t* KVT = (const bf16_t*)(wsl + WS_KVT); const float* DEC = (const float*)(wsl + WS_DEC); bf16_t* SPT = (bf16_t*)(wsl + WS_SPT);
    const int t0 = blockIdx.x * 512 + F.tid, tstride = F.G * 512;
    for (int t = t0; t < 64 * 4096; t += 2 * tstride) {
        const int tb = t + tstride; const bool hasb = tb < 64 * 4096; const int t2 = hasb ? tb : t;
        const int chA = t >> 12, remA = t & 4095, dvA = remA >> 5, dkA = (remA & 31) * 2, dirA = chA & 1;
        const int chB = t2 >> 12, remB = t2 & 4095, dvB = remB >> 5, dkB = (remB & 31) * 2, dirB = chB & 1;
        float a0 = 0.f, a1 = 0.f, b0 = 0.f, b1 = 0.f;
#pragma unroll 11
        for (int st = 0; st < GNC; ++st) { const int nA = dirA ? GNC - 1 - st : st, nB = dirB ? GNC - 1 - st : st;
            const size_t oA = (((size_t)chA * GNC + nA) * 128 + dvA) * 64 + dkA, oB = (((size_t)chB * GNC + nB) * 128 + dvB) * 64 + dkB;
            *(unsigned*)(SPT + oA) = pk2(a0, a1); if (hasb) *(unsigned*)(SPT + oB) = pk2(b0, b1);
            const unsigned kva_ = *(const unsigned*)(KVT + oA); const f32x2 kvA = (f32x2){__builtin_bit_cast(float, kva_ << 16), __builtin_bit_cast(float, kva_ & 0xffff0000u)}, dcA = *(const f32x2*)(DEC + ((size_t)chA * GNC + nA) * 64 + dkA);
            const unsigned kvb_ = *(const unsigned*)(KVT + oB); const f32x2 kvB = (f32x2){__builtin_bit_cast(float, kvb_ << 16), __builtin_bit_cast(float, kvb_ & 0xffff0000u)}, dcB = *(const f32x2*)(DEC + ((size_t)chB * GNC + nB) * 64 + dkB);
            a0 = dcA[0] * a0 + kvA[0]; a1 = dcA[1] * a1 + kvA[1]; b0 = dcB[0] * b0 + kvB[0]; b1 = dcB[1] * b1 + kvB[1]; }
    }
}
__device__ __forceinline__ void gla_passC_item(Frame& F, int item, int l, unsigned char* wsl) {
    const int n = item % GNC, bh = item / GNC, b = bh >> 2, h = bh & 3;
    const int w = F.wave, lane = opaque_v(F.lane), cb = w >> 2, dvb = w & 3, r = lane & 31, hh = lane >> 5;
    const bf16_t* gqk = (const bf16_t*)(wsl + WS_GQK) + (size_t)item * 4 * 4096;
    const bf16_t* gvt = (const bf16_t*)(wsl + WS_GVT) + (size_t)item * 8192 + (32 * dvb + r) * 64 + 4 * hh;
    const bf16_t* U = (const bf16_t*)(wsl + WS_U); bf16_t* Y = (bf16_t*)(wsl + WS_Y);
    bf16x8 qf[2][4], kf[2][2][4], sf[2][4]; s16x4 vlo[2][2], vhi[2][2]; unsigned short rgv[16];
#pragma unroll
    for (int dir = 0; dir < 2; ++dir) {
        const bf16_t* QD = gqk + dir * 8192; const bf16_t* KI = QD + 4096;
        const bf16_t* spt = (const bf16_t*)(wsl + WS_SPT) + ((size_t)((bh << 1) | dir) * GNC + n) * 128 * 64;
#pragma unroll
        for (int ks = 0; ks < 4; ++ks) { qf[dir][ks] = *(const bf16x8*)(QD + (32 * cb + r) * 64 + 16 * ks + 8 * hh); sf[dir][ks] = *(const bf16x8*)(spt + (32 * dvb + r) * 64 + 16 * ks + 8 * hh);
#pragma unroll
            for (int sb = 0; sb < 2; ++sb) kf[dir][sb][ks] = *(const bf16x8*)(KI + (32 * sb + r) * 64 + 16 * ks + 8 * hh); } }
#pragma unroll
    for (int sb = 0; sb < 2; ++sb)
#pragma unroll
        for (int ks2 = 0; ks2 < 2; ++ks2) { vlo[sb][ks2] = *(const s16x4*)(gvt + 32 * sb + 16 * ks2); vhi[sb][ks2] = *(const s16x4*)(gvt + 32 * sb + 16 * ks2 + 8); }
#pragma unroll
    for (int i = 0; i < 16; ++i) { const int p = 64 * n - 48 + 32 * cb + crow16(i, hh); rgv[i] = U[((size_t)b * L + max(p, 0)) * INC + O_AR + h * 128 + 32 * dvb + r]; }
    const float gv = (kin(10) + l * 512 + h * 128 + 32 * dvb)[r];
    asm volatile("s_waitcnt vmcnt(0)" ::: "memory");
    f32x16 o;
#pragma unroll
    for (int i = 0; i < 16; ++i) o[i] = 0.f;
#pragma unroll
    for (int dir = 0; dir < 2; ++dir) {
#pragma unroll
        for (int sb = 0; sb < 2; ++sb) {
            f32x16 X;
#pragma unroll
            for (int i = 0; i < 16; ++i) X[i] = 0.f;
#pragma unroll
            for (int ks = 0; ks < 4; ++ks) X = MFMA32(kf[dir][sb][ks], qf[dir][ks], X);
            const int cidx = 32 * cb + r;
#pragma unroll
            for (int i = 0; i < 16; ++i) { const int sidx = 32 * sb + crow16(i, hh); const bool keep = dir ? (sidx > cidx) : (sidx <= cidx); X[i] = keep ? X[i] : 0.f; }
#pragma unroll
            for (int ks2 = 0; ks2 < 2; ++ks2) {
                u32x4 xp; xp.x = pk2(X[8 * ks2 + 0], X[8 * ks2 + 1]); xp.y = pk2(X[8 * ks2 + 2], X[8 * ks2 + 3]); xp.z = pk2(X[8 * ks2 + 4], X[8 * ks2 + 5]); xp.w = pk2(X[8 * ks2 + 6], X[8 * ks2 + 7]);
                o = MFMA32(__builtin_bit_cast(bf16x8, xp), __builtin_shufflevector(vlo[sb][ks2], vhi[sb][ks2], 0, 1, 2, 3, 4, 5, 6, 7), o);
            }
        }
#pragma unroll
        for (int ks = 0; ks < 4; ++ks) o = MFMA32(qf[dir][ks], sf[dir][ks], o);
    }
    LAS float* part = (LAS float*)(F.lds + G_PART);
    __syncthreads();
#pragma unroll
    for (int i = 0; i < 16; ++i) { float q = o[i] * o[i];
        q = row_shr_add<1>(q); q = row_shr_add<2>(q); q = row_shr_add<4>(q); q = row_shr_add<8>(q);
        const int qi = __builtin_bit_cast(int, q);
        const float s0 = __builtin_bit_cast(float, __builtin_amdgcn_readlane(qi, 15)) + __builtin_bit_cast(float, __builtin_amdgcn_readlane(qi, 31));
        const float s1 = __builtin_bit_cast(float, __builtin_amdgcn_readlane(qi, 47)) + __builtin_bit_cast(float, __builtin_amdgcn_readlane(qi, 63));
        if (r == 0) part[(cb * 4 + dvb) * 32 + crow16(i, hh)] = hh ? s1 : s0; }
    __syncthreads();
#pragma unroll
    for (int i = 0; i < 16; ++i) { const int rw = crow16(i, hh), p = 64 * n - 48 + 32 * cb + rw;
        if (p >= 0) { const float ss = (part[(cb * 4 + 0) * 32 + rw] + part[(cb * 4 + 1) * 32 + rw]) + (part[(cb * 4 + 2) * 32 + rw] + part[(cb * 4 + 3) * 32 + rw]);
            const float rs = rsqrtf(ss * (1.0f / 128.0f) + 1e-6f); const float rg = bf2f(rgv[i]);
            Y[((size_t)b * L + p) * D + h * 128 + 32 * dvb + r] = (bf16_t)f2bf(o[i] * rs * gv * (rg / (1.0f + __expf(-rg)))); } }
}

constexpr int SW_KS = 136, SW_VS = 40;
constexpr int SW_K = 0, SW_V = 2 * 2 * 32 * SW_KS * 2;
constexpr int SW_PART = SW_V + 2 * 2 * 128 * SW_VS * 2;
constexpr int SW_OS = 1032;
__device__ __forceinline__ void swa_item(Frame& F, int item, int l, unsigned char* wsl) {
    const bf16_t* U = (const bf16_t*)(wsl + WS_U); bf16_t* Y = (bf16_t*)(wsl + WS_Y);
    const int qb = item % 65, b = item / 65, q0 = 32 * qb, tid = opaque_v(F.tid), lane = tid & 63, w = F.wave, r = lane & 31, hh = lane >> 5;
    const int head = w, kvh = w >> 2, qp = q0 + r;
    const float slope = exp2f(-(float)(head + 1));
    const float sk = (kin(11) + l * 8)[head];
    bf16x8 Qf[8];
    { const bf16_t* qrow = U + ((size_t)b * L + min(qp, L - 1)) * INC + O_BQ + head * 128;
#pragma unroll
      for (int ks = 0; ks < 8; ++ks) Qf[ks] = *(const bf16x8*)(qrow + 16 * ks + 8 * hh); }
    f32x16 O[4];
#pragma unroll
    for (int db = 0; db < 4; ++db)
#pragma unroll
        for (int i = 0; i < 16; ++i) O[db][i] = 0.f;
    const float sc2 = 0.08838834764831845f * 1.4426950408889634f, slope2 = slope * 1.4426950408889634f;
    float m = sk * 1.4426950408889634f, lsum = hh == 0 ? 1.0f : 0.0f;
    const int tlo = max(1, qb - 4), thi = min(64, qb + 4), ntile = 1 + (thi - tlo + 1), nch = (ntile + 1) >> 1;
    LAS bf16_t* Ks = (LAS bf16_t*)(F.lds + SW_K); LAS bf16_t* Vs = (LAS bf16_t*)(F.lds + SW_V);
    u32x4 kx[2][4], vx[2][4];
#define SWA_FETCH(chn, par_) do { _Pragma("unroll") for (int it = 0; it < 4; ++it) { const int e = it * 512 + tid; const int key = e & 31, d8 = (e >> 5) & 15, kv2 = (e >> 9) & 1, sl_ = e >> 10; \
            const int ti_ = (chn) * 2 + sl_; const int tl_ = ti_ == 0 ? 0 : tlo + ti_ - 1; const int kp_ = min(32 * tl_ + key, L - 1); const bf16_t* krow = U + ((size_t)b * L + kp_) * INC; \
            const int kkey_ = (e >> 4) & 31, kd8_ = e & 15; const bf16_t* krow2 = U + ((size_t)b * L + min(32 * tl_ + kkey_, L - 1)) * INC;        \
            kx[par_][it] = *(const u32x4*)(krow2 + O_BK + kv2 * 128 + 8 * kd8_); vx[par_][it] = *(const u32x4*)(krow + O_BV + kv2 * 128 + 8 * d8); } } while (0)
    SWA_FETCH(0, 0);
    if (nch > 1) SWA_FETCH(1, 1);
    for (int c2 = 0; c2 < nch; c2 += 2) {
#pragma unroll
      for (int par = 0; par < 2; ++par) {
        const int ch = c2 + par; if (ch >= nch) break;
        __syncthreads();
#pragma unroll
        for (int it = 0; it < 4; ++it) { const int e = it * 512 + tid; const int key = e & 31, d8 = (e >> 5) & 15, kv2 = (e >> 9) & 1, sl = e >> 10;
            *(LAS u32x4*)(Ks + ((sl * 2 + kv2) * 32 + ((e >> 4) & 31)) * SW_KS + 8 * (e & 15)) = kx[par][it];
            LAS bf16_t* vb = Vs + ((sl * 2 + kv2) * 128 + 8 * d8) * SW_VS + key;
#pragma unroll
            for (int j = 0; j < 4; ++j) { vb[(2 * j) * SW_VS] = (bf16_t)(vx[par][it][j] & 0xffffu); vb[(2 * j + 1) * SW_VS] = (bf16_t)(vx[par][it][j] >> 16); } }
        if (ch + 2 < nch) SWA_FETCH(ch + 2, par);
        __syncthreads();
#pragma unroll 1
        for (int sl = 0; sl < 2; ++sl) {
            const int ti = ch * 2 + sl; if (ti >= ntile) break;
            const int tl = ti == 0 ? 0 : tlo + ti - 1, kp0 = 32 * tl;
            f32x16 S;
#pragma unroll
            for (int i = 0; i < 16; ++i) S[i] = 0.f;
            const LAS bf16_t* kt = Ks + ((sl * 2 + kvh) * 32 + r) * SW_KS + 8 * hh;
#pragma unroll
            for (int ks = 0; ks < 8; ++ks) { const bf16x8 a = *(const LAS bf16x8*)(kt + 16 * ks); S = MFMA32(a, Qf[ks], S); }
            float mx = -1e30f;
            const float fb = (float)(qp - kp0 - 4 * hh);
            if (tl != 0 && abs(qb - tl) <= 3 && tl < 64) {
#pragma unroll
                for (int i = 0; i < 16; ++i) { const float dist = fabsf(fb - (float)((i & 3) + 8 * (i >> 2))); const float sv = S[i] * sc2 - slope2 * dist; S[i] = sv; mx = fmaxf(mx, sv); }
            } else {
#pragma unroll
                for (int i = 0; i < 16; ++i) { const int kp = kp0 + crow16(i, hh); const float dist = fabsf(fb - (float)((i & 3) + 8 * (i >> 2)));
                    const bool ok = (tl == 0) ? (kp < NMETA || dist <= 128.f) : (kp < L && dist <= 128.f);
                    const float sv = ok ? S[i] * sc2 - slope2 * dist : -1e30f; S[i] = sv; mx = fmaxf(mx, sv); }
            }
            mx = fmaxf(mx, xor32(mx));
            float mn = m, alpha = 1.0f;
            if (__builtin_amdgcn_ballot_w64(mx - m > 8.0f) != 0ull) { mn = fmaxf(m, mx); alpha = __builtin_amdgcn_exp2f(m - mn); m = mn; }
            float ps = 0.f;
#pragma unroll
            for (int i = 0; i < 16; ++i) { const float pv = __builtin_amdgcn_exp2f(S[i] - mn); S[i] = pv; ps += pv; }
            lsum = lsum * alpha + ps;
            if (__builtin_amdgcn_ballot_w64(alpha != 1.0f) != 0ull) {
#pragma unroll
                for (int db = 0; db < 4; ++db)
#pragma unroll
                    for (int i = 0; i < 16; ++i) O[db][i] *= alpha; }
            const LAS bf16_t* vt = Vs + ((sl * 2 + kvh) * 128 + r) * SW_VS + 4 * hh;
#pragma unroll
            for (int ks2 = 0; ks2 < 2; ++ks2) {
                u32x4 xp; xp.x = pk2(S[8 * ks2 + 0], S[8 * ks2 + 1]); xp.y = pk2(S[8 * ks2 + 2], S[8 * ks2 + 3]); xp.z = pk2(S[8 * ks2 + 4], S[8 * ks2 + 5]); xp.w = pk2(S[8 * ks2 + 6], S[8 * ks2 + 7]);
                const bf16x8 pb = __builtin_bit_cast(bf16x8, xp);
#pragma unroll
                for (int db = 0; db < 4; ++db) {
                    const s16x4 lo = *(const LAS s16x4*)(vt + (32 * db) * SW_VS + 16 * ks2), hi = *(const LAS s16x4*)(vt + (32 * db) * SW_VS + 16 * ks2 + 8);
                    O[db] = MFMA32(__builtin_shufflevector(lo, hi, 0, 1, 2, 3, 4, 5, 6, 7), pb, O[db]); }
            }
        }
      }
    }
#undef SWA_FETCH
    const float lt = lsum + xor32(lsum), inv = 1.0f / lt;
    float ss = 0.f;
#pragma unroll
    for (int db = 0; db < 4; ++db)
#pragma unroll
        for (int i = 0; i < 16; ++i) { O[db][i] *= inv; ss += O[db][i] * O[db][i]; }
    ss += xor32(ss);
    __syncthreads();
    LAS float* part = (LAS float*)(F.lds + SW_PART); LAS bf16_t* os = (LAS bf16_t*)F.lds;
    if (hh == 0) part[w * 32 + r] = ss;
#pragma unroll
    for (int db = 0; db < 4; ++db)
#pragma unroll
        for (int g = 0; g < 4; ++g) { u32x2 pk; pk.x = pk2(O[db][4 * g], O[db][4 * g + 1]); pk.y = pk2(O[db][4 * g + 2], O[db][4 * g + 3]);
            *(LAS u32x2*)(os + r * SW_OS + w * 128 + 32 * db + 8 * g + 4 * hh) = pk; }
    __syncthreads();
    { const int q = tid >> 4, pc = tid & 15, p = q0 + q;
      if (p < L) { float tot = 0.f;
#pragma unroll
          for (int ww = 0; ww < 8; ++ww) tot += part[ww * 32 + q];
          const float rs = rsqrtf(tot * (1.0f / 1024.0f) + 1e-6f); const LAS float* sg = (const LAS float*)(F.lds + MIXC_SG); bf16_t* yrow = Y + ((size_t)b * L + p) * D + 512;
#pragma unroll
          for (int k = 0; k < 8; ++k) { const int c = 8 * pc + 128 * k; const u32x4 v = *(const LAS u32x4*)(os + q * SW_OS + c);
              const f32x4 g0 = *(const LAS f32x4*)(sg + c), g1 = *(const LAS f32x4*)(sg + c + 4); u32x4 o;
              o.x = pk2(__builtin_bit_cast(float, v.x << 16) * rs * g0[0], __builtin_bit_cast(float, v.x & 0xffff0000u) * rs * g0[1]);
              o.y = pk2(__builtin_bit_cast(float, v.y << 16) * rs * g0[2], __builtin_bit_cast(float, v.y & 0xffff0000u) * rs * g0[3]);
              o.z = pk2(__builtin_bit_cast(float, v.z << 16) * rs * g1[0], __builtin_bit_cast(float, v.z & 0xffff0000u) * rs * g1[1]);
              o.w = pk2(__builtin_bit_cast(float, v.w << 16) * rs * g1[2], __builtin_bit_cast(float, v.w & 0xffff0000u) * rs * g1[3]);
              *(u32x4*)(yrow + c) = o; } } }
}

__device__ __forceinline__ float logsigmoidf_(float x) { return fminf(x, 0.f) - log1pf(expf(-fabsf(x))); }

__device__ __forceinline__ int q_publish(Frame& F, int fetched) {
    LAS int* slot = (LAS int*)(F.lds + LDSCTL_OFF + 512);
    __syncthreads();
    if (F.tid == 0) *slot = fetched;
    __syncthreads();
    return *slot;
}
__device__ __forceinline__ void p_mix1(Frame& F, int l) {
    unsigned char* const wsl = launder_ws(F.ws);
    unsigned* const qw = (unsigned*)(wsl + WS_CTL) + CW_Q + (l * 4 + 0) * 64;
    constexpr int N_SWA = NB * 65, N_GLA = NB * 4 * GNC, N_HP = NB * 33 * 4, N_ALL = N_SWA + N_GLA + N_HP;
    int fetched = 0;
    if (F.tid == 0) fetched = (int)atomicAdd(qw, 1u);
    { const float* sgg = kin(12) + l * 1024; const float* cwg = kin(13) + (size_t)l * 3 * 1536; const float* cbg = kin(14) + l * 1536;
      if (F.tid < 256) *(LAS f32x4*)(F.lds + MIXC_SG + 16 * F.tid) = ((const f32x4*)sgg)[F.tid];
      for (int e = F.tid; e < 1152; e += 512) *(LAS f32x4*)(F.lds + MIXC_CW + 16 * e) = ((const f32x4*)cwg)[e];
      if (F.tid < 384) *(LAS f32x4*)(F.lds + MIXC_CB + 16 * F.tid) = ((const f32x4*)cbg)[F.tid]; }
    int u = q_publish(F, fetched);
    while (u < N_ALL) {
        if (F.tid == 0) fetched = (int)atomicAdd(qw, 1u);
        if (u < N_SWA) swa_item(F, u, l, wsl);
        else if (u < N_SWA + N_GLA) gla_passA_item(F, u - N_SWA, l, wsl);
        else hy_pre_item(F, u - N_SWA - N_GLA, l, wsl);
        u = q_publish(F, fetched);
    }
    __syncthreads();
}

__device__ __forceinline__ void p_mix2(Frame& F, int l) {
    unsigned char* const wsl = launder_ws(F.ws);
    gla_passB(F, wsl);
    hy_conv_phase(F, l, wsl);
}

__device__ __forceinline__ void p_mix3(Frame& F, int l) {
    unsigned char* const wsl = launder_ws(F.ws);
    unsigned* const qw = (unsigned*)(wsl + WS_CTL) + CW_Q + (l * 4 + 2) * 64;
    constexpr int N_GC = NB * 4 * GNC, N_HN = NB * 33, N_ALL = N_GC + N_HN;
    int fetched = 0;
    if (F.tid == 0) fetched = (int)atomicAdd(qw, 1u);
    if (F.tid < 128) *(LAS f32x4*)(F.lds + MIXC_HG + 16 * F.tid) = ((const f32x4*)(kin(22) + l * 512))[F.tid];
    int u = q_publish(F, fetched);
    while (u < N_ALL) {
        if (F.tid == 0) fetched = (int)atomicAdd(qw, 1u);
        if (u < N_HN) hy_norm_item(F, u, l, wsl);
        else gla_passC_item(F, u - N_HN, l, wsl);
        u = q_publish(F, fetched);
    }
    __syncthreads();
}

constexpr int R_RS = 2056;
constexpr int R_AH = 0, R_AL = 8 * R_RS * 2, R_PART = 2 * 8 * R_RS * 2, R_LG = R_PART + 8 * 8 * 32 * 4, R_LCNT = R_LG + 1024, R_REC = R_LCNT + 128;
template <bool DUMMY>
__device__ __forceinline__ void p_ln1_router(Frame& F, int l) {
    unsigned char* const wsl = launder_ws(F.ws); unsigned* const ctl = (unsigned*)(wsl + WS_CTL);
    const bf16_t* MX = (const bf16_t*)(wsl + WS_R1); const bf16_t* hin = (const bf16_t*)(wsl + WS_HB); bf16_t* h = (bf16_t*)(wsl + (DUMMY ? WS_DUM : WS_HB)); unsigned char* hb = wsl + (DUMMY ? WS_DUM + (size_t)T * D * 4 : WS_HB8);
    int* cnt = (int*)(ctl + CW_CNT + l * 512 + (DUMMY ? 256 : 0)); int* list = (int*)(wsl + (DUMMY ? WS_DUM + (size_t)T * D * 6 : WS_LIST));
    int* tok_e = (int*)(wsl + (DUMMY ? WS_DUM + (size_t)T * D * 6 + (size_t)NEXP * T * 4 : WS_TOKE)); int* tok_p = tok_e + (DUMMY ? 2 * T : (WS_TOKP - WS_TOKE) / 4); float* tok_w = (float*)(tok_e + (DUMMY ? 4 * T : (WS_TOKW - WS_TOKE) / 4));
    const LAS float* g = (const LAS float*)(F.lds + 81920); const LAS float* bt = g + D;
    { const float* gg = kin(25) + (size_t)l * D; const float* gb = kin(26) + (size_t)l * D; *(LAS f32x4*)(F.lds + 81920 + 16 * F.tid) = ((const f32x4*)gg)[F.tid]; *(LAS f32x4*)(F.lds + 81920 + 8192 + 16 * F.tid) = ((const f32x4*)gb)[F.tid]; }
    const LAS float* be = (const LAS float*)(F.lds + 81920 + 16384); const LAS float* bg = be + 16;
    if (F.tid < 16) ((LAS float*)(F.lds + 81920 + 16384))[F.tid] = (kin(30) + l * 16)[F.tid]; else if (F.tid < 20) ((LAS float*)(F.lds + 81920 + 16384))[F.tid] = (kin(28) + l * 4)[F.tid - 16];
    const bf16_t* wr = (const bf16_t*)(wsl + WS_WR) + (size_t)l * 256 * 512;
    const int lane = opaque_v(F.lane), w = F.wave, n = lane & 15, kg = lane >> 4;
    LAS bf16_t* AH = (LAS bf16_t*)(F.lds + R_AH); LAS bf16_t* AL = (LAS bf16_t*)(F.lds + R_AL); LAS float* PART = (LAS float*)(F.lds + R_PART); LAS float* LG = (LAS float*)(F.lds + R_LG);
    constexpr int NGRP = T / 8;
    bf16x8 wfr[8][4];
#pragma unroll
    for (int si = 0; si < 8; ++si) { const bf16_t* wp = wr + ((size_t)(8 * w + si) * 4 * 64 + lane) * 8;
#pragma unroll
        for (int q = 0; q < 4; ++q) wfr[si][q] = *(const bf16x8*)(wp + 512 * q); }
    LAS int* lcnt = (LAS int*)(F.lds + R_LCNT); LAS int* rec = (LAS int*)(F.lds + R_REC);
    if (F.tid < 32) lcnt[F.tid] = 0;
    int nloc = 0;
    f32x4 v[8];
    u32x2 hxr[8], mxr[8];
    int gi = F.vcu;
    if (gi < NGRP) {
#pragma unroll
        for (int j = 0; j < 8; ++j) { hxr[j] = ((const u32x2*)(hin + (size_t)(8 * gi + w) * D))[lane + 64 * j]; mxr[j] = ((const u32x2*)(MX + (size_t)(8 * gi + w) * D))[lane + 64 * j]; } }
    __syncthreads();
    for (; gi < NGRP; gi += F.G) {
        const int row = 8 * gi + w;
#pragma unroll
        for (int j = 0; j < 8; ++j) { const u32x2 hx = hxr[j], mx = j < 4 ? mxr[j] : ((const u32x2*)(MX + (size_t)row * D))[lane + 64 * j];
            v[j] = (f32x4){__builtin_bit_cast(float, hx.x << 16), __builtin_bit_cast(float, hx.x & 0xffff0000u), __builtin_bit_cast(float, hx.y << 16), __builtin_bit_cast(float, hx.y & 0xffff0000u)} * ALPHA
                 + (f32x4){__builtin_bit_cast(float, mx.x << 16), __builtin_bit_cast(float, mx.x & 0xffff0000u), __builtin_bit_cast(float, mx.y << 16), __builtin_bit_cast(float, mx.y & 0xffff0000u)}; }
        ln_wave_store<true>(v, g, bt, h + (size_t)row * D, hb + (size_t)row * D, nullptr, lane);
#pragma unroll
        for (int j = 0; j < 8; ++j) { const unsigned h01 = pk2(v[j][0], v[j][1]), h23 = pk2(v[j][2], v[j][3]);
            const unsigned l01 = pk2(v[j][0] - __builtin_bit_cast(float, h01 << 16), v[j][1] - __builtin_bit_cast(float, h01 & 0xffff0000u)), l23 = pk2(v[j][2] - __builtin_bit_cast(float, h23 << 16), v[j][3] - __builtin_bit_cast(float, h23 & 0xffff0000u));
            *(LAS u32x2*)(AH + w * R_RS + (lane + 64 * j) * 4) = (u32x2){h01, h23};
            *(LAS u32x2*)(AL + w * R_RS + (lane + 64 * j) * 4) = (u32x2){l01, l23}; }
        asm volatile("" ::: "memory");
        { const int gn = gi + F.G;
          if (gn < NGRP) {
#pragma unroll
            for (int j = 0; j < 8; ++j) { hxr[j] = ((const u32x2*)(hin + (size_t)(8 * gn + w) * D))[lane + 64 * j]; if (j < 4) mxr[j] = ((const u32x2*)(MX + (size_t)(8 * gn + w) * D))[lane + 64 * j]; } } }
        __syncthreads();
        f32x4 a0 = (f32x4){0.f, 0.f, 0.f, 0.f}, a1 = (f32x4){0.f, 0.f, 0.f, 0.f};
        { const LAS bf16_t* ah = AH + (n & 7) * R_RS + 8 * kg; const LAS bf16_t* al = AL + (n & 7) * R_RS + 8 * kg;
#pragma unroll
          for (int si = 0; si < 8; ++si) { const int st = 8 * w + si;
              const bf16x8 xh = *(const LAS bf16x8*)(ah + 32 * st), xl = *(const LAS bf16x8*)(al + 32 * st);
              const bf16x8 bh0 = wfr[si][0], bl0 = wfr[si][1], bh1 = wfr[si][2], bl1 = wfr[si][3];
              a0 = __builtin_amdgcn_mfma_f32_16x16x32_bf16(xh, bh0, a0, 0, 0, 0); a0 = __builtin_amdgcn_mfma_f32_16x16x32_bf16(xh, bl0, a0, 0, 0, 0); a0 = __builtin_amdgcn_mfma_f32_16x16x32_bf16(xl, bh0, a0, 0, 0, 0);
              a1 = __builtin_amdgcn_mfma_f32_16x16x32_bf16(xh, bh1, a1, 0, 0, 0); a1 = __builtin_amdgcn_mfma_f32_16x16x32_bf16(xh, bl1, a1, 0, 0, 0); a1 = __builtin_amdgcn_mfma_f32_16x16x32_bf16(xl, bh1, a1, 0, 0, 0);
              if (si == 3) __builtin_amdgcn_sched_barrier(0); } }
        if (kg < 2) {
#pragma unroll
            for (int r = 0; r < 4; ++r) { PART[(w * 8 + 4 * kg + r) * 32 + n] = a0[r]; PART[(w * 8 + 4 * kg + r) * 32 + 16 + n] = a1[r]; } }
        __syncthreads();
        if (lane < 32) { float sacc = 0.f;
#pragma unroll
            for (int ww = 0; ww < 8; ++ww) sacc += PART[(ww * 8 + w) * 32 + lane];
            LG[w * 32 + lane] = sacc; }
        LDS_WAIT();
        if (lane == 0) {
            const f32x4 l0 = *(const LAS f32x4*)(LG + w * 32), l1 = *(const LAS f32x4*)(LG + w * 32 + 4), l2 = *(const LAS f32x4*)(LG + w * 32 + 8), l3 = *(const LAS f32x4*)(LG + w * 32 + 12), l4 = *(const LAS f32x4*)(LG + w * 32 + 16);
            float gl[4];
#pragma unroll
            for (int j = 0; j < 4; ++j) gl[j] = l0[j] + bg[j];
            int gsel = 0; float gm = gl[0];
#pragma unroll
            for (int j = 1; j < 4; ++j) if (gl[j] > gm) { gm = gl[j]; gsel = j; }
            float den = 0.f;
#pragma unroll
            for (int j = 0; j < 4; ++j) den += expf(gl[j] - gm);
            const float gtop = 1.0f / den;
            float el[4];
            const float k0 = gsel == 0 ? 1.f : 0.f, k1 = gsel == 1 ? 1.f : 0.f, k2 = gsel == 2 ? 1.f : 0.f, k3 = gsel == 3 ? 1.f : 0.f;
#pragma unroll
            for (int j = 0; j < 4; ++j) el[j] = (k0 * l1[j] + k1 * l2[j]) + (k2 * l3[j] + k3 * l4[j]) + be[gsel * 4 + j];
            int i1 = 0; float m1 = el[0];
#pragma unroll
            for (int j = 1; j < 4; ++j) if (el[j] > m1) { m1 = el[j]; i1 = j; }
            int i2 = -1; float m2 = -3.0e38f;
#pragma unroll
            for (int j = 0; j < 4; ++j) if (j != i1 && el[j] > m2) { m2 = el[j]; i2 = j; }
            const float ex = expf(m2 - m1); const float w1 = gtop / (1.0f + ex), w2 = gtop * ex / (1.0f + ex);
            const int e1 = gsel * 4 + i1, e2 = gsel * 4 + i2;
            const int li1 = __hip_atomic_fetch_add(lcnt + e1, 1, __ATOMIC_RELAXED, __HIP_MEMORY_SCOPE_WORKGROUP), li2 = __hip_atomic_fetch_add(lcnt + e2, 1, __ATOMIC_RELAXED, __HIP_MEMORY_SCOPE_WORKGROUP);
            const int k = nloc * 8 + w; rec[4 * k] = row; rec[4 * k + 1] = e1 | (e2 << 8); rec[4 * k + 2] = li1; rec[4 * k + 3] = li2;
            tok_e[2 * row] = e1; tok_e[2 * row + 1] = e2; tok_w[2 * row] = w1; tok_w[2 * row + 1] = w2;
        }
        ++nloc;
    }
    __syncthreads();
    if (F.tid < 16) { const int c = lcnt[F.tid]; lcnt[16 + F.tid] = c ? atomicAdd(&cnt[16 * F.tid], c) : 0; }
    __syncthreads();
    if (F.tid < nloc * 8) { const int row = rec[4 * F.tid], ee = rec[4 * F.tid + 1], e1 = ee & 255, e2 = ee >> 8;
        const int p1 = lcnt[16 + e1] + rec[4 * F.tid + 2], p2 = lcnt[16 + e2] + rec[4 * F.tid + 3];
        list[(size_t)e1 * T + p1] = row; list[(size_t)e2 * T + p2] = row; tok_p[2 * row] = p1; tok_p[2 * row + 1] = p2; }
    __syncthreads();
}

__device__ __forceinline__ void moe_table(Frame& F, int l) {
    LAS int* tab = (LAS int*)(F.lds + LDSCTL_OFF + 256);
    unsigned* const ctl = (unsigned*)(launder_ws(F.ws) + WS_CTL);
    const int* cnt = (const int*)(ctl + CW_CNT + l * 512);
    __syncthreads();
    if (F.tid < 16) tab[F.tid] = __hip_atomic_load(cnt + 16 * F.tid, __ATOMIC_RELAXED, __HIP_MEMORY_SCOPE_AGENT);
    __syncthreads();
    if (F.tid == 0) { int pp = 0;
        for (int e = 0; e < 16; ++e) { const int c = tab[e]; tab[16 + e] = pp; tab[33 + e] = pp * 256; pp += (c + 255) >> 8; }
        tab[32] = pp; }
    __syncthreads();
}

template <bool DUMMY>
__device__ __forceinline__ void p_ln2(Frame& F, int l) {
    unsigned char* const wsl = launder_ws(F.ws);
    bf16_t* hb = (bf16_t*)(wsl + WS_HB); const unsigned char* O = (const unsigned char*)(wsl + WS_O);
    const int* tok_e = (const int*)(wsl + WS_TOKE); const int* tok_p = (const int*)(wsl + WS_TOKP); const float* tok_w = (const float*)(wsl + WS_TOKW);
    const LAS int* tab = (const LAS int*)(F.lds + LDSCTL_OFF + 256);
    const LAS float* g = (const LAS float*)(F.lds + 65536); const LAS float* bt = g + D;
    { const float* gg = kin(34) + (size_t)l * D; const float* gb = kin(35) + (size_t)l * D; *(LAS f32x4*)(F.lds + 65536 + 16 * F.tid) = ((const f32x4*)gg)[F.tid]; *(LAS f32x4*)(F.lds + 65536 + 8192 + 16 * F.tid) = ((const f32x4*)gb)[F.tid]; }
    __syncthreads();
    const int gw = F.vcu * 8 + F.wave, NGW = F.G * 8, lane = opaque_v(F.lane);
    u32x2 hv[8]; int oa[8], ob[8]; float w0 = 0.f, w1 = 0.f;
    int te0 = 0, te1 = 0, tp0 = 0, tp1 = 0; float tw0 = 0.f, tw1 = 0.f;
    { const int rk = gw + lane * NGW; if (lane < 16 && rk < T) { te0 = tok_e[2 * rk]; te1 = tok_e[2 * rk + 1]; tp0 = tok_p[2 * rk]; tp1 = tok_p[2 * rk + 1]; tw0 = tok_w[2 * rk]; tw1 = tok_w[2 * rk + 1]; } }
    int kk = 0;
#define LN2_ISSUE(rw) do { const int e0_ = __builtin_amdgcn_readlane(te0, kk), e1_ = __builtin_amdgcn_readlane(te1, kk); \
        const size_t r0_ = (size_t)(tab[33 + e0_] + __builtin_amdgcn_readlane(tp0, kk)), r1_ = (size_t)(tab[33 + e1_] + __builtin_amdgcn_readlane(tp1, kk)); \
        w0 = __builtin_bit_cast(float, __builtin_amdgcn_readlane(__builtin_bit_cast(int, tw0), kk)) * (1.0f / 64.0f); w1 = __builtin_bit_cast(float, __builtin_amdgcn_readlane(__builtin_bit_cast(int, tw1), kk)) * (1.0f / 64.0f); ++kk; \
        _Pragma("unroll") for (int j = 0; j < 8; ++j) { const int i4 = lane + 64 * j; hv[j] = ((const u32x2*)(hb + (size_t)(rw) * D))[i4]; oa[j] = ((const int*)(O + r0_ * D))[i4]; ob[j] = ((const int*)(O + r1_ * D))[i4]; } } while (0)
    int row = gw;
    if (row < T) LN2_ISSUE(row);
    for (; row < T; row += NGW) {
        f32x4 v[8];
#pragma unroll
        for (int j = 0; j < 8; ++j) { f32x4 m;
            const f32x2 a01 = __builtin_amdgcn_cvt_pk_f32_fp8(oa[j], false), a23 = __builtin_amdgcn_cvt_pk_f32_fp8(oa[j], true), b01 = __builtin_amdgcn_cvt_pk_f32_fp8(ob[j], false), b23 = __builtin_amdgcn_cvt_pk_f32_fp8(ob[j], true);
            m[0] = w0 * a01[0] + w1 * b01[0]; m[1] = w0 * a01[1] + w1 * b01[1]; m[2] = w0 * a23[0] + w1 * b23[0]; m[3] = w0 * a23[1] + w1 * b23[1];
            v[j] = (f32x4){__builtin_bit_cast(float, hv[j].x << 16), __builtin_bit_cast(float, hv[j].x & 0xffff0000u), __builtin_bit_cast(float, hv[j].y << 16), __builtin_bit_cast(float, hv[j].y & 0xffff0000u)} * ALPHA + m; }
        const int nrow = row + NGW;
        if (nrow < T) LN2_ISSUE(nrow);
        float* orow = nullptr;
        if (l == DEPTH - 1) { const int bb = row / L, pp = row % L; if (pp >= NMETA) orow = kout() + ((size_t)bb * SEQ + (pp - NMETA)) * D; }
        if (DUMMY) ln_wave_store(v, g, bt, (bf16_t*)(wsl + WS_DUM) + (size_t)row * D, nullptr, nullptr, lane);
        else if (l == DEPTH - 1) ln_wave_store<false, true>(v, g, bt, nullptr, nullptr, orow, lane);
        else ln_wave_store(v, g, bt, hb + (size_t)row * D, nullptr, orow, lane);
    }
#undef LN2_ISSUE
}


__device__ __forceinline__ void outproj_tail(Frame& F, int l, unsigned char* wsl) {
    if (F.vcu >= 128) return;
    const bf16_t* Yb = (const bf16_t*)(wsl + WS_Y) + (size_t)16384 * D; const bf16_t* Wt = (const bf16_t*)(wsl + WS_WOUT) + (size_t)l * D * D + (size_t)(16 * F.vcu) * D;
    const int lane = opaque_v(F.lane), w = F.wave, n = lane & 15, kg = lane >> 4;
    f32x4 acc[8];
#pragma unroll
    for (int mb = 0; mb < 8; ++mb) acc[mb] = (f32x4){0.f, 0.f, 0.f, 0.f};
    const bf16_t* ap = Yb + (size_t)n * D + 256 * w + 8 * kg; const bf16_t* bp = Wt + (size_t)n * D + 256 * w + 8 * kg;
#pragma unroll 2
    for (int ks = 0; ks < 8; ++ks) {
        const bf16x8 bfr = *(const bf16x8*)(bp + 32 * ks);
        bf16x8 af[8];
#pragma unroll
        for (int mb = 0; mb < 8; ++mb) af[mb] = *(const bf16x8*)(ap + (size_t)(16 * mb) * D + 32 * ks);
#pragma unroll
        for (int mb = 0; mb < 8; ++mb) acc[mb] = __builtin_amdgcn_mfma_f32_16x16x32_bf16(af[mb], bfr, acc[mb], 0, 0, 0);
    }
    LAS f32x4* red = (LAS f32x4*)F.lds;
    __syncthreads();
#pragma unroll
    for (int mb = 0; mb < 8; ++mb) red[(w * 8 + mb) * 64 + lane] = acc[mb];
    __syncthreads();
    { const int mb = F.tid >> 6;
      f32x4 sacc = red[(0 * 8 + mb) * 64 + lane];
#pragma unroll
      for (int ww = 1; ww < 8; ++ww) sacc += red[(ww * 8 + mb) * 64 + lane];
      const int col = 16 * F.vcu + n; const float bias = (kin(24) + (size_t)l * D)[col];
      bf16_t* MX = (bf16_t*)(wsl + WS_R1);
#pragma unroll
      for (int r = 0; r < 4; ++r) { const size_t o = (size_t)(16384 + 16 * mb + 4 * kg + r) * D + col; MX[o] = (bf16_t)f2bf(sacc[r] + bias); } }
    __syncthreads();
}

#ifndef REP_LN
#define REP_LN 1
#endif
#ifndef REP_PRO
#define REP_PRO 1
#endif
#ifndef REP_MIX
#define REP_MIX 1
#endif
#ifndef REP_GEMM
#define REP_GEMM 1
#endif
#define IN(k) (lo <= (k) && (k) < hi)
#define SEAM(k) do { if (IN(k) && IN((k) + 1)) xcd_barrier(bar); } while (0)
template <int l>
__device__ __forceinline__ void run_layer(Frame& F, const int lo, const int hi, const XcdBarrier& bar) {
        const int P = 1 + l * NPH;
        if (IN(P + 0)) {
            unsigned char* const wsl = launder_ws(F.ws);
            pg::PlainSched S; S.init(MPAD / 256, INCP / 256, F.G, (int)blockIdx.x);
            pg::EpiInProj E{(bf16_t*)(wsl + WS_U), kin(5) + (size_t)l * INC};
            for (int rep = 0; rep < REP_GEMM; ++rep) pg::gemm_phase<false>(F.lds, wsl + WS_HB, (const bf16_t*)(wsl + WS_WIN) + (size_t)l * INCP * D, D, S, E);
        }
        SEAM(P + 0);
        if (IN(P + 1)) for (int rep = 0; rep < REP_MIX; ++rep) p_mix1(F, l);
        SEAM(P + 1);
        if (IN(P + 2)) for (int rep = 0; rep < REP_MIX; ++rep) p_mix2(F, l);
        SEAM(P + 2);
        if (IN(P + 3)) for (int rep = 0; rep < REP_MIX; ++rep) p_mix3(F, l);
        SEAM(P + 3);
        if (IN(P + 4)) {
            unsigned char* const wsl = launder_ws(F.ws);
            pg::PlainSched S; S.init(64, D / 256, F.G, (int)blockIdx.x);
            pg::EpiOutProj E{(bf16_t*)(wsl + WS_R1), kin(24) + (size_t)l * D};
            for (int rep = 0; rep < REP_GEMM; ++rep) pg::gemm_phase<false>(F.lds, wsl + WS_Y, (const bf16_t*)(wsl + WS_WOUT) + (size_t)l * D * D, D, S, E);
            outproj_tail(F, l, wsl);
        }
        SEAM(P + 4);
        if (IN(P + 5)) { if (REP_LN > 1) p_ln1_router<true>(F, l); p_ln1_router<false>(F, l); }
        SEAM(P + 5);
        if (IN(P + 6)) {
            moe_table(F, l);
            unsigned char* const wsl = launder_ws(F.ws);
            pg::MoeSched S; S.tab = (const LAS int*)(F.lds + LDSCTL_OFF + 256); S.list = (const int*)(wsl + WS_LIST); S.nN = 8; S.G = F.G; S.c = F.vcu; S.gather = 1; S.nrowsB = 2048;
            pg::EpiGateUp8 E{(unsigned char*)(wsl + WS_HM)};
            for (int rep = 0; rep < REP_GEMM; ++rep) pg::gemm_phase<true>(F.lds, wsl + WS_HB8, wsl + WS_WGU + (size_t)l * NEXP * 2048 * D, D / 2, S, E);
        }
        SEAM(P + 6);
        if (IN(P + 7)) {
            moe_table(F, l);
            unsigned char* const wsl = launder_ws(F.ws);
            pg::MoeSched S; S.tab = (const LAS int*)(F.lds + LDSCTL_OFF + 256); S.list = nullptr; S.nN = 8; S.G = F.G; S.c = F.vcu; S.gather = 0; S.nrowsB = 2048;
            pg::EpiDown8 E{(unsigned char*)(wsl + WS_O)};
            for (int rep = 0; rep < REP_GEMM; ++rep) pg::gemm_phase<true>(F.lds, wsl + WS_HM, wsl + WS_WD + (size_t)l * NEXP * D * DEXP, DEXP / 2, S, E);
        }
        SEAM(P + 7);
        if (IN(P + 8)) { moe_table(F, l); if (REP_LN > 1) p_ln2<true>(F, l); p_ln2<false>(F, l); }
        SEAM(P + 8);
}

__global__ void __launch_bounds__(512, 2) mk_fwd(Args args) {
    extern __shared__ __attribute__((aligned(16))) unsigned char lds_raw[];
    Frame F;
    F.lds = (LAS unsigned char*)lds_raw;
    F.MISC = (volatile LAS unsigned*)(F.lds + MISC_OFF);
    F.tid = threadIdx.x; F.lane = F.tid & 63; F.wave = __builtin_amdgcn_readfirstlane(F.tid >> 6);
    F.G = gridDim.x; { const int bx = blockIdx.x; F.vcu = (F.G % 8 == 0) ? (bx % 8) * (F.G / 8) + bx / 8 : bx; }
    F.ws = args.ws; F.ctl = (unsigned*)(args.ws + WS_CTL);
    for (int u = F.tid; u < (LDS_BYTES - LDSCTL_OFF) / 4; u += 512) ((LAS unsigned*)(F.lds + LDSCTL_OFF))[u] = 0u;
    __syncthreads();
    const int lo = args.ph_lo, hi = args.ph_hi;
    const bool multi = (hi - lo) > 1;
    XcdBarrier bar; bar.bar = F.ctl + CW_BAR; bar.x = 0; bar.st = nullptr;
    if (multi) bar = xcd_barrier_post(F.ctl + CW_BAR, F.MISC + 8);

    if (IN(0)) { for (int rep = 0; rep < REP_PRO; ++rep) p_prologue(F); }
    SEAM(0);
    run_layer<0>(F, lo, hi, bar); run_layer<1>(F, lo, hi, bar); run_layer<2>(F, lo, hi, bar); run_layer<3>(F, lo, hi, bar);
}

#ifndef MK_CUT
#define MK_CUT 0
#endif
extern "C" void kernel_launch(void* const* d_in, const int* in_sizes, int n_in, void* d_out, int out_size, void* d_ws, size_t ws_size, hipStream_t stream) {
    static bool attr = false;
    if (!attr) { (void)hipFuncSetAttribute((const void*)mk_fwd, hipFuncAttributeMaxDynamicSharedMemorySize, LDS_BYTES); attr = true; }
    (void)hipMemsetAsync(d_ws, 0, CTL_BYTES, stream);
    Args a{};
    for (int i = 0; i < 36; ++i) a.in[i] = (const float*)d_in[i];
    a.out = (float*)d_out; a.ws = (unsigned char*)d_ws;
    const int NP = 1 + DEPTH * NPH;
#if MK_CUT
    for (int p = 0; p < NP; ++p) { a.ph_lo = p; a.ph_hi = p + 1; hipLaunchKernelGGL(mk_fwd, dim3(256), dim3(512), LDS_BYTES, stream, a); }
#else
    a.ph_lo = 0; a.ph_hi = NP; hipLaunchKernelGGL(mk_fwd, dim3(256), dim3(512), LDS_BYTES, stream, a);
#endif
}
```

```cpp
#include <hip/hip_runtime.h>
#include <stdint.h>

#define LAS __attribute__((address_space(3)))
#define GAS __attribute__((address_space(1)))
typedef unsigned short bf16_t;
typedef short bf16x8 __attribute__((ext_vector_type(8)));
typedef float f32x4 __attribute__((ext_vector_type(4)));
typedef float f32x2 __attribute__((ext_vector_type(2)));
typedef unsigned u32x4 __attribute__((ext_vector_type(4)));
typedef unsigned u32x2 __attribute__((ext_vector_type(2)));

constexpr int D = 2048, NB = 8, SEQ = 2048, NMETA = 16, L = SEQ + NMETA, T = NB * L, DEPTH = 4;
constexpr int MPAD = 16640;
constexpr int INC = 4640, INCP = 4864;
constexpr int O_AQ = 0, O_AK = 256, O_AV = 512, O_GF = 1024, O_GB = 1040, O_AR = 1056, O_BQ = 1568, O_BK = 2592, O_BV = 2848, O_CU = 3104;
constexpr int NEXP = 16, DEXP = 1024;
constexpr float ALPHA = 1.681792830507429f;
constexpr int NPH = 9;
constexpr int HMROWS = 2 * T + 4096;

constexpr size_t al256(size_t x) { return (x + 255) & ~(size_t)255; }
constexpr size_t WS_CTL = 0, CTL_BYTES = 1u << 20;
constexpr size_t WS_WIN = WS_CTL + CTL_BYTES;
constexpr size_t WS_WOUT = WS_WIN + (size_t)DEPTH * INCP * D * 2;
constexpr size_t WS_WGU = WS_WOUT + (size_t)DEPTH * D * D * 2;
constexpr size_t WS_WD = WS_WGU + (size_t)DEPTH * NEXP * 2048 * D * 2;
constexpr size_t WS_HB8 = WS_WD + (size_t)DEPTH * NEXP * D * DEXP * 2;
constexpr size_t WS_H = WS_HB8 + (size_t)MPAD * D;
constexpr size_t WS_HB = WS_H + (size_t)T * D * 4;
constexpr size_t WS_Y = WS_HB + (size_t)MPAD * D * 2;
constexpr size_t WS_LIST = WS_Y + (size_t)MPAD * D * 2;
constexpr size_t WS_TOKE = WS_LIST + (size_t)NEXP * T * 4;
constexpr size_t WS_TOKP = WS_TOKE + (size_t)2 * T * 4;
constexpr size_t WS_TOKW = WS_TOKP + (size_t)2 * T * 4;
constexpr size_t WS_HF = WS_TOKW + (size_t)2 * T * 4;
constexpr size_t WS_HBW = WS_HF + (size_t)L * 512 * 4;
constexpr int GLEN = 4736, GCEN = 2336, ZL = 2112;
constexpr int ZROW = 3520, ZOFF = 576;
constexpr size_t WS_FG = al256(WS_HBW + (size_t)L * 512 * 4);
constexpr size_t WS_WR = al256(WS_FG + (size_t)DEPTH * 512 * 2 * GLEN * 2);
constexpr size_t WS_REG = al256(WS_WR + (size_t)DEPTH * 64 * 2 * 2 * 512 * 2);
constexpr size_t WS_U = WS_REG;
constexpr int GNC = 33;
constexpr size_t WS_KVT = al256(WS_U + (size_t)T * INC * 2);
constexpr size_t WS_DEC = WS_KVT + (size_t)64 * GNC * 128 * 64 * 4;
constexpr size_t WS_SPT = WS_DEC + (size_t)64 * GNC * 64 * 4;
constexpr size_t WS_GQK = WS_SPT + (size_t)64 * GNC * 128 * 64 * 2;
constexpr size_t WS_GVT = WS_GQK + (size_t)NB * 4 * GNC * 4 * 64 * 64 * 2;
constexpr size_t WS_SW = WS_GVT + (size_t)NB * 4 * GNC * 128 * 64 * 2;
constexpr size_t WS_X0T = WS_SW + (size_t)T * 1024 * 4;
constexpr size_t WS_ZT = WS_X0T + (size_t)512 * NB * ZL * 2;
constexpr size_t WS_YT = WS_ZT + (size_t)512 * NB * ZL * 2;
constexpr size_t WS_END1 = WS_YT + (size_t)512 * NB * ZL * 2;
constexpr size_t WS_R1 = WS_REG;
constexpr size_t WS_HM = WS_R1 + (size_t)T * D * 4;
constexpr size_t WS_O = WS_HM + (size_t)HMROWS * DEXP * 2;
constexpr size_t WS_END2 = WS_O + (size_t)HMROWS * D * 2;
constexpr size_t WS_DUM = al256(WS_END2);
static_assert(WS_END1 < 2100000000ull && WS_DUM + (size_t)T * D * 6 + (size_t)NEXP * T * 4 + (size_t)T * 32 < 2100000000ull, "d_ws budget");
constexpr int CW_BAR = 4096;
constexpr int CW_Q = 12288;
constexpr int CW_CNT = 16384;

constexpr int RING_BYTES = 131072;
constexpr int LDSCTL_OFF = RING_BYTES;
constexpr int MISC_OFF = LDSCTL_OFF + 1024;
constexpr int LDS_BYTES = 147456;

#define LDS_WAIT() asm volatile("s_waitcnt lgkmcnt(0)" ::: "memory")
#define VM_WAIT() asm volatile("s_waitcnt vmcnt(0)" ::: "memory")
__device__ __forceinline__ unsigned f2bf(float f) { unsigned u = __builtin_bit_cast(unsigned, f); return (u + 0x7fffu + ((u >> 16) & 1u)) >> 16; }
__device__ __forceinline__ unsigned pk2i(float lo, float hi) { return f2bf(lo) | (f2bf(hi) << 16); }
__device__ __forceinline__ unsigned pk2(float lo, float hi) { unsigned r; asm("v_cvt_pk_bf16_f32 %0, %1, %2" : "=v"(r) : "v"(lo), "v"(hi)); return r; }
__device__ __forceinline__ float bf2f(unsigned short b) { return __builtin_bit_cast(float, (unsigned)b << 16); }
template <int N> __device__ __forceinline__ float dpp_row_shr_add(float v) { const int t = __builtin_amdgcn_update_dpp(0, __builtin_bit_cast(int, v), 0x110 + N, 0xf, 0xf, true); return v + __builtin_bit_cast(float, t); }
__device__ __forceinline__ float wave_sum(float v) {
    v = dpp_row_shr_add<1>(v); v = dpp_row_shr_add<2>(v); v = dpp_row_shr_add<4>(v); v = dpp_row_shr_add<8>(v);
    const int vi = __builtin_bit_cast(int, v);
    return (__builtin_bit_cast(float, __builtin_amdgcn_readlane(vi, 15)) + __builtin_bit_cast(float, __builtin_amdgcn_readlane(vi, 31))) + (__builtin_bit_cast(float, __builtin_amdgcn_readlane(vi, 47)) + __builtin_bit_cast(float, __builtin_amdgcn_readlane(vi, 63)));
}
__device__ __forceinline__ float xor32(float v) {
    const int vi = __builtin_bit_cast(int, v);
    auto r = __builtin_amdgcn_permlane32_swap(vi, vi, false, false);
    return __builtin_bit_cast(float, (threadIdx.x & 32) ? r[0] : r[1]);
}
__device__ __forceinline__ float wave_max(float v) {
#pragma unroll
    for (int o = 1; o < 64; o <<= 1) v = fmaxf(v, __shfl_xor(v, o));
    return v;
}

#define XB_TMO      128
#define XB_XCNT(j)  (256  + 64 * (j))
#define XB_XSUB(j)  (1280 + 64 * (j))
#define XB_XGEN(j)  (2304 + 64 * (j))
#define XB_TOP      3328
#define XB_TOPGEN   3392
#define XCD_BAR_WORDS 3456
#define XB_SPIN_CAP (1u << 18)
__device__ __forceinline__ unsigned xb_ld(unsigned* p)              { return __hip_atomic_load(p, __ATOMIC_RELAXED, __HIP_MEMORY_SCOPE_AGENT); }
__device__ __forceinline__ unsigned xb_add(unsigned* p, unsigned v) { return __hip_atomic_fetch_add(p, v, __ATOMIC_RELAXED, __HIP_MEMORY_SCOPE_AGENT); }
__device__ __forceinline__ unsigned xb_xcc_id() { return (unsigned)__builtin_amdgcn_s_getreg((3 << 11) | 20) & 0xFu; }
#define XB_SPIN(cond, bar) do { unsigned _sp = 0; while (cond) { __builtin_amdgcn_s_sleep(1); \
    if ((++_sp & 255u) == 0u) { if (xb_ld(&(bar)[XB_TMO])) break; if (_sp > XB_SPIN_CAP) { atomicAdd(&(bar)[XB_TMO], 1u); break; } } } } while (0)
struct XcdBarrier { unsigned* bar; unsigned x; volatile LAS unsigned* st; };
__device__ __forceinline__ XcdBarrier xcd_barrier_post(unsigned* bar, volatile LAS unsigned* st) {
    XcdBarrier b; b.bar = bar; b.x = xb_xcc_id(); b.st = st;
    if (threadIdx.x == 0) (void)xb_add(&bar[XB_XCNT(b.x)], 1u);
    return b;
}
__device__ __forceinline__ void xcd_barrier_complete(unsigned* bar, unsigned x, unsigned& nloc, unsigned& nx) {
    const unsigned G = gridDim.x * gridDim.y * gridDim.z;
    unsigned sum, cnt, mine, sp = 0u;
    for (;;) {
        sum = 0u; cnt = 0u; mine = 0u;
#pragma unroll
        for (unsigned j = 0; j < 16; ++j) { const unsigned c = xb_ld(&bar[XB_XCNT(j)]); sum += c; cnt += (c > 0u) ? 1u : 0u; mine = (j == x) ? c : mine; }
        if (sum == G) break;
        __builtin_amdgcn_s_sleep(1);
        if ((++sp & 255u) == 0u) { if (xb_ld(&bar[XB_TMO])) break; if (sp > XB_SPIN_CAP) { atomicAdd(&bar[XB_TMO], 1u); break; } }
    }
    nloc = mine > 0u ? mine : 1u; nx = cnt > 0u ? cnt : 1u;
}
__device__ __forceinline__ void xcd_barrier(const XcdBarrier& b) {
    asm volatile("s_waitcnt vmcnt(0)" ::: "memory");
    __syncthreads();
    if (threadIdx.x == 0) {
        unsigned* bar = b.bar;
        __builtin_amdgcn_s_waitcnt(0);
        unsigned nloc = b.st[0], nx = b.st[1];
        if (nloc == 0u) { xcd_barrier_complete(bar, b.x, nloc, nx); b.st[0] = nloc; b.st[1] = nx; }
        const unsigned old = xb_add(&bar[XB_XSUB(b.x)], 1u);
        const unsigned gen = old / nloc;
        if (old + 1u == (gen + 1u) * nloc) {
            __builtin_amdgcn_fence(__ATOMIC_RELEASE, "agent");
            asm volatile("s_waitcnt vmcnt(0)" ::: "memory");
            const unsigned og = xb_add(&bar[XB_TOP], 1u);
            const unsigned tg = og / nx;
            if (og + 1u == (tg + 1u) * nx) xb_add(&bar[XB_TOPGEN], 1u);
            else XB_SPIN(xb_ld(&bar[XB_TOPGEN]) == tg, bar);
            __builtin_amdgcn_fence(__ATOMIC_ACQUIRE, "agent");
            xb_add(&bar[XB_XGEN(b.x)], 1u);
            asm volatile("s_waitcnt vmcnt(0)" ::: "memory");
        } else {
            XB_SPIN(xb_ld(&bar[XB_XGEN(b.x)]) == gen, bar);
            __builtin_amdgcn_fence(__ATOMIC_ACQUIRE, "agent");
            asm volatile("s_waitcnt vmcnt(0)" ::: "memory");
        }
    }
    __syncthreads();
}

namespace pg {
constexpr int BM = 256, BK = 64, HALF = 128, HTB = HALF * BK * 2, STAGE_BYTES = 8 * HTB, NXCD = 8, WGM = 8;
__host__ __device__ __forceinline__ int lds_byte(int r, int c) { const int st = (r >> 4) * 2 + (c >> 5), rr = r & 15, cc = c & 31, ob = rr * 64 + cc * 2; return st * 1024 + (ob ^ (((ob >> 9) & 1) << 5)); }
__host__ __device__ __forceinline__ void stage_rc(int b, int& R, int& C) { const int st = b / 1024, sb = b % 1024, swz = sb ^ (((sb >> 9) & 1) << 5); R = (st >> 1) * 16 + swz / 64; C = (st & 1) * 32 + (swz % 64) / 2; }

__host__ __device__ __forceinline__ int perm32(int rho) { const int n = rho >> 4, i = rho & 15; return 8 * (i >> 2) + 4 * n + (i & 3); }
struct Unit { int e, pm, pn, mvalid, crow0; };

struct PlainSched {
    int nM, nN, nwg, G, c;
    __device__ void init(int nM_, int nN_, int G_, int c_) { nM = nM_; nN = nN_; nwg = nM * nN; G = G_; c = c_; }
    __device__ bool next(int i, Unit& u) const {
        const long Lx = (long)i * G + c; if (Lx >= nwg) return false;
        int wgid = (int)Lx; { const int q = nwg / NXCD, r = nwg % NXCD, xcd = wgid % NXCD, off = wgid / NXCD; wgid = (xcd < r ? xcd * (q + 1) : r * (q + 1) + (xcd - r) * q) + off; }
        const int nig = WGM * nN, gid = wgid / nig, fm = gid * WGM, gsz = (nM - fm) < WGM ? (nM - fm) : WGM;
        u.pm = fm + ((wgid % nig) % gsz); u.pn = (wgid % nig) / gsz; u.e = 0; u.crow0 = u.pm * BM; u.mvalid = min(BM, T - u.pm * BM); return true;
    }
    __device__ __forceinline__ int arow(const Unit& u, int r) const { return min(u.pm * BM + r, T - 1); }
    __device__ __forceinline__ int brow0(const Unit& u) const { return u.pn * BM; }
};
struct MoeSched {
    const LAS int* tab; const int* list; int nN, G, c, gather, nrowsB;
    __device__ bool next(int i, Unit& u) const {
        const int Lx = i * G + c; const int panel = Lx / nN;
        if (panel >= __builtin_amdgcn_readfirstlane(tab[32])) return false;
        int e = 0;
#pragma unroll 1
        for (int j = 1; j < 16; ++j) if (panel >= __builtin_amdgcn_readfirstlane(tab[16 + j])) e = j;
        u.e = e; u.pm = panel - __builtin_amdgcn_readfirstlane(tab[16 + e]); u.pn = Lx % nN; u.crow0 = __builtin_amdgcn_readfirstlane(tab[33 + e]) + u.pm * BM;
        u.mvalid = min(BM, __builtin_amdgcn_readfirstlane(tab[e]) - u.pm * BM); return true;
    }
    __device__ __forceinline__ int arow(const Unit& u, int r) const {
        const int rr = min(r, u.mvalid - 1);
        return gather ? list[(size_t)u.e * T + u.pm * BM + rr] : (u.crow0 + rr);
    }
    __device__ __forceinline__ int brow0(const Unit& u) const { return u.e * nrowsB + u.pn * BM; }
};

typedef int i32x8 __attribute__((ext_vector_type(8)));
typedef int i32x4_ __attribute__((ext_vector_type(4)));
__host__ __device__ __forceinline__ int lds_byte8(int r, int kb) { const int st = (r >> 4) * 2 + (kb >> 1), rr = r & 15; return st * 1024 + rr * 64 + 32 * ((kb & 1) ^ (rr >> 3)); }
template <bool FP8, class Epi, class Sched>
__device__ __forceinline__ void gemm_phase(LAS unsigned char* lds, const void* A, const void* Bt, const int K  , const Sched& S, const Epi& E) {
    const int tid = threadIdx.x, wid = __builtin_amdgcn_readfirstlane(tid >> 6), lane = tid & 63, wr = wid >> 2, wc = wid & 3, fr = lane & 15, fq = lane >> 4;
    const int nt = K / BK;
    unsigned voffB[2];
#pragma unroll
    for (int i = 0; i < 2; ++i) { int R, C; stage_rc(tid * 16 + i * 8192, R, C); const int Rb = Epi::PERM ? ((R & ~31) + perm32(R & 31)) : R; voffB[i] = (unsigned)(Rb * K + C) * 2u; }
    const size_t kstep = (size_t)(BK * 2);
    const size_t hstep = (size_t)HALF * K * 2;
    const unsigned rowb = (unsigned)K * 2u;
    const unsigned ldsw = (unsigned)wid * 1024u;
    const int aoff = FP8 ? lds_byte8(wr * 64 + fr, fq) : lds_byte(wr * 64 + fr, fq * 8), boff = FP8 ? lds_byte8(wc * 32 + fr, fq) : lds_byte(wc * 32 + fr, fq * 8);
#define PG_SA(b, h) (((b) * 2 + (h)) * HTB)
#define PG_SB(b, h) ((4 + (b) * 2 + (h)) * HTB)
#define PG_STAGE_B(bufoff, gbase) do { _Pragma("unroll") for (int _i = 0; _i < 2; ++_i) \
        __builtin_amdgcn_global_load_lds((const unsigned*)((const char*)(gbase) + voffB[_i]), (LAS unsigned*)(lds + (bufoff) + ldsw + _i * 8192), 16, 0, 0); } while (0)
#define PG_STAGE_A(bufoff, gbase, v0, v1) do { \
        __builtin_amdgcn_global_load_lds((const unsigned*)((const char*)(gbase) + (v0)), (LAS unsigned*)(lds + (bufoff) + ldsw), 16, 0, 0); \
        __builtin_amdgcn_global_load_lds((const unsigned*)((const char*)(gbase) + (v1)), (LAS unsigned*)(lds + (bufoff) + ldsw + 8192), 16, 0, 0); } while (0)
#define PG_LDA(dst, b, h) do { _Pragma("unroll") for (int m = 0; m < 4; ++m) _Pragma("unroll") for (int k = 0; k < 2; ++k) dst[m][k] = *(const LAS bf16x8*)(lds + PG_SA(b, h) + aoff + m * 2048 + (FP8 ? k * 16 : k * 1024)); } while (0)
#define PG_LDB(dst, b, h) do { _Pragma("unroll") for (int n = 0; n < 2; ++n) _Pragma("unroll") for (int k = 0; k < 2; ++k) dst[n][k] = *(const LAS bf16x8*)(lds + PG_SB(b, h) + boff + n * 2048 + (FP8 ? k * 16 : k * 1024)); } while (0)
#define PG_MMA(ai, bj, At, Bt_) do { __builtin_amdgcn_s_setprio(1); if constexpr (FP8) { _Pragma("unroll") for (int m = 0; m < 4; ++m) _Pragma("unroll") for (int n = 0; n < 2; ++n) { \
            const i32x8 bq_ = __builtin_shufflevector(__builtin_bit_cast(i32x4_, Bt_[n][0]), __builtin_bit_cast(i32x4_, Bt_[n][1]), 0, 1, 2, 3, 4, 5, 6, 7), aq_ = __builtin_shufflevector(__builtin_bit_cast(i32x4_, At[m][0]), __builtin_bit_cast(i32x4_, At[m][1]), 0, 1, 2, 3, 4, 5, 6, 7); \
            acc[ai][bj][m][n] = __builtin_amdgcn_mfma_scale_f32_16x16x128_f8f6f4(bq_, aq_, acc[ai][bj][m][n], 0, 0, 0, 0x7f7f7f7f, 0, 0x7f7f7f7f); } } \
        else { _Pragma("unroll") for (int m = 0; m < 4; ++m) _Pragma("unroll") for (int n = 0; n < 2; ++n) _Pragma("unroll") for (int k = 0; k < 2; ++k) \
        acc[ai][bj][m][n] = __builtin_amdgcn_mfma_f32_16x16x32_bf16(Bt_[n][k], At[m][k], acc[ai][bj][m][n], 0, 0, 0); } __builtin_amdgcn_s_setprio(0); } while (0)
#define PG_WAIT_V(n) asm volatile("s_waitcnt vmcnt(" #n ")" ::: "memory")
#define PG_WAIT_L(n) asm volatile("s_waitcnt lgkmcnt(" #n ")" ::: "memory")
#define PG_BAR __builtin_amdgcn_s_barrier()
#define PG_SCHED __builtin_amdgcn_sched_barrier(0)
#define PG_SETA(v, u) do { int R0_, C0_, R1_, C1_; stage_rc(tid * 16, R0_, C0_); stage_rc(tid * 16 + 8192, R1_, C1_); \
        v##00 = (unsigned)S.arow(u, R0_) * rowb + (unsigned)C0_ * 2u; v##01 = (unsigned)S.arow(u, R1_) * rowb + (unsigned)C1_ * 2u; \
        v##10 = (unsigned)S.arow(u, HALF + R0_) * rowb + (unsigned)C0_ * 2u; v##11 = (unsigned)S.arow(u, HALF + R1_) * rowb + (unsigned)C1_ * 2u; } while (0)
    Unit cur, nxt; int ui = 0;
    if (!S.next(0, cur)) return;
    f32x4 acc[2][2][4][2];
#pragma unroll
    for (int a = 0; a < 2; ++a)
#pragma unroll
        for (int b = 0; b < 2; ++b)
#pragma unroll
            for (int m = 0; m < 4; ++m)
#pragma unroll
                for (int n = 0; n < 2; ++n) acc[a][b][m][n] = (f32x4){0.f, 0.f, 0.f, 0.f};
    bf16x8 At[4][2], B0[2][2], B1[2][2];
    unsigned vc00, vc01, vc10, vc11;
    PG_SETA(vc, cur);
    const char* Ab = (const char*)A;
    const char* cB = (const char*)Bt + (size_t)S.brow0(cur) * rowb;
    PG_STAGE_B(PG_SB(0, 0), cB); PG_STAGE_B(PG_SB(0, 1), cB + hstep); PG_STAGE_A(PG_SA(0, 0), Ab, vc00, vc01); PG_STAGE_A(PG_SA(0, 1), Ab, vc10, vc11);
    if (wr == 1) PG_BAR;
    PG_WAIT_V(2); PG_BAR;
    PG_STAGE_B(PG_SB(1, 0), cB + kstep); PG_STAGE_A(PG_SA(1, 0), Ab + kstep, vc00, vc01); PG_STAGE_B(PG_SB(1, 1), cB + hstep + kstep);
    PG_WAIT_V(6); PG_BAR;
    for (;;) {
        const bool has_next = S.next(ui + 1, nxt);
        const char* nB = has_next ? (const char*)Bt + (size_t)S.brow0(nxt) * rowb : cB;
        for (int t = 0; t < nt; t += 2) {
            const bool last = (t == nt - 2);
            const char* a1 = Ab + (size_t)(t + 1) * kstep;
            const char* a2 = last ? Ab : Ab + (size_t)(t + 2) * kstep; const char* b2 = last ? nB : cB + (size_t)(t + 2) * kstep;
            const char* a3 = a2 + kstep; const char* b3 = b2 + kstep;
            PG_LDB(B0, 0, 0); PG_LDB(B1, 0, 1); PG_SCHED; PG_LDA(At, 0, 0); PG_STAGE_A(PG_SA(1, 1), a1, vc10, vc11);
            if (last && has_next) { PG_SETA(vc, nxt); }
            PG_WAIT_V(8); PG_WAIT_L(0); PG_BAR; PG_MMA(0, 0, At, B0); PG_MMA(0, 1, At, B1); PG_BAR; PG_SCHED;
            PG_LDA(At, 0, 1); PG_STAGE_B(PG_SB(0, 0), b2); PG_STAGE_B(PG_SB(0, 1), b2 + hstep); PG_STAGE_A(PG_SA(0, 0), a2, vc00, vc01);
            PG_WAIT_V(8); PG_WAIT_L(0); PG_BAR; PG_MMA(1, 0, At, B0); PG_MMA(1, 1, At, B1); PG_BAR; PG_SCHED;
            PG_LDB(B0, 1, 0); PG_LDB(B1, 1, 1); PG_SCHED; PG_LDA(At, 1, 0); PG_STAGE_A(PG_SA(0, 1), a2, vc10, vc11);
            PG_WAIT_V(8); PG_WAIT_L(0); PG_BAR; PG_MMA(0, 0, At, B0); PG_MMA(0, 1, At, B1); PG_BAR; PG_SCHED;
            PG_LDA(At, 1, 1); PG_STAGE_B(PG_SB(1, 0), b3); PG_STAGE_B(PG_SB(1, 1), b3 + hstep); PG_STAGE_A(PG_SA(1, 0), a3, vc00, vc01);
            PG_WAIT_V(8); PG_WAIT_L(0); PG_BAR; PG_MMA(1, 0, At, B0); PG_MMA(1, 1, At, B1); PG_BAR; PG_SCHED;
        }
        if (wr == 0) PG_BAR;
        E(acc, cur, wr, wc, fr, fq);
        if (!has_next) break;
#pragma unroll
        for (int a = 0; a < 2; ++a)
#pragma unroll
            for (int b = 0; b < 2; ++b)
#pragma unroll
                for (int m = 0; m < 4; ++m)
#pragma unroll
                    for (int n = 0; n < 2; ++n) acc[a][b][m][n] = (f32x4){0.f, 0.f, 0.f, 0.f};
        cur = nxt; cB = nB; ++ui;
        if (wr == 1) PG_BAR;
    }
    PG_WAIT_V(0);
    PG_BAR;
#undef PG_SA
#undef PG_SB
#undef PG_STAGE_A
#undef PG_STAGE_B
#undef PG_LDA
#undef PG_LDB
#undef PG_MMA
#undef PG_WAIT_V
#undef PG_WAIT_L
#undef PG_BAR
#undef PG_SCHED
#undef PG_SETA
}

struct EpiInProj {
    static constexpr bool PERM = true;
    bf16_t* U; const float* bias;
    __device__ __forceinline__ void operator()(const f32x4 (&acc)[2][2][4][2], const Unit& u, int wr, int wc, int fr, int fq) const {
        const int col0 = u.pn * BM + wc * 32 + 8 * fq;
        f32x4 bv[2][2]; bool cv[2];
#pragma unroll
        for (int bj = 0; bj < 2; ++bj) { const int c = col0 + bj * HALF; cv[bj] = c < INC;
#pragma unroll
            for (int n = 0; n < 2; ++n) bv[bj][n] = cv[bj] ? *(const f32x4*)(bias + c + 4 * n) : (f32x4){0.f, 0.f, 0.f, 0.f}; }
#pragma unroll
        for (int ai = 0; ai < 2; ++ai)
#pragma unroll
            for (int m = 0; m < 4; ++m) { const int r = ai * HALF + wr * 64 + m * 16 + fr;
                if (r < u.mvalid) { bf16_t* rowp = U + (size_t)(u.crow0 + r) * INC + col0;
#pragma unroll
                    for (int bj = 0; bj < 2; ++bj) if (cv[bj]) { const f32x4 v0 = acc[ai][bj][m][0] + bv[bj][0], v1 = acc[ai][bj][m][1] + bv[bj][1];
                        u32x4 w; w.x = pk2(v0[0], v0[1]); w.y = pk2(v0[2], v0[3]); w.z = pk2(v1[0], v1[1]); w.w = pk2(v1[2], v1[3]); *(u32x4*)(rowp + bj * HALF) = w; } } }
    }
};
struct EpiOutProj {
    static constexpr bool PERM = true;
    bf16_t* MX; const float* bias;
    __device__ __forceinline__ void operator()(const f32x4 (&acc)[2][2][4][2], const Unit& u, int wr, int wc, int fr, int fq) const {
        const int col0 = u.pn * BM + wc * 32 + 8 * fq;
        f32x4 bv[2][2];
#pragma unroll
        for (int bj = 0; bj < 2; ++bj)
#pragma unroll
            for (int n = 0; n < 2; ++n) bv[bj][n] = *(const f32x4*)(bias + col0 + bj * HALF + 4 * n);
#pragma unroll
        for (int ai = 0; ai < 2; ++ai)
#pragma unroll
            for (int m = 0; m < 4; ++m) { const int r = ai * HALF + wr * 64 + m * 16 + fr;
                if (r < u.mvalid) { bf16_t* rowp = MX + (size_t)(u.crow0 + r) * D + col0;
#pragma unroll
                    for (int bj = 0; bj < 2; ++bj) { const f32x4 v0 = acc[ai][bj][m][0] + bv[bj][0], v1 = acc[ai][bj][m][1] + bv[bj][1];
                        u32x4 w; w.x = pk2(v0[0], v0[1]); w.y = pk2(v0[2], v0[3]); w.z = pk2(v1[0], v1[1]); w.w = pk2(v1[2], v1[3]); *(u32x4*)(rowp + bj * HALF) = w; } } }
    }
};
struct EpiGateUp {
    static constexpr bool PERM = false;
    bf16_t* Hm;
    __device__ __forceinline__ void operator()(const f32x4 (&acc)[2][2][4][2], const Unit& u, int wr, int wc, int fr, int fq) const {
        const int col0 = u.pn * 128 + wc * 16 + 4 * fq;
#pragma unroll
        for (int ai = 0; ai < 2; ++ai)
#pragma unroll
            for (int m = 0; m < 4; ++m) { const int r = ai * HALF + wr * 64 + m * 16 + fr;
                if (r < u.mvalid) { bf16_t* rowp = Hm + (size_t)(u.crow0 + r) * DEXP + col0;
#pragma unroll
                    for (int bj = 0; bj < 2; ++bj) { const f32x4 g = acc[ai][bj][m][0], up = acc[ai][bj][m][1]; float o[4];
#pragma unroll
                        for (int j = 0; j < 4; ++j) o[j] = g[j] / (1.0f + __expf(-g[j])) * up[j];
                        u32x2 w; w.x = pk2(o[0], o[1]); w.y = pk2(o[2], o[3]); *(u32x2*)(rowp + bj * 64) = w; } } }
    }
};
struct EpiGateUp8 {
    static constexpr bool PERM = false;
    unsigned char* Hm;
    __device__ __forceinline__ void operator()(const f32x4 (&acc)[2][2][4][2], const Unit& u, int wr, int wc, int fr, int fq) const {
        const int col0 = u.pn * 128 + wc * 32 + 8 * fq;
#pragma unroll
        for (int ai = 0; ai < 2; ++ai)
#pragma unroll
            for (int m = 0; m < 4; ++m) { const int r = ai * HALF + wr * 64 + m * 16 + fr;
                if (r < u.mvalid) { int pk[2];
#pragma unroll
                    for (int bj = 0; bj < 2; ++bj) { const f32x4 g = acc[ai][bj][m][0] * (1.0f / 64.0f), up = acc[ai][bj][m][1] * (16.0f / 64.0f); float o[4];
#pragma unroll
                        for (int j = 0; j < 4; ++j) o[j] = g[j] / (1.0f + __expf(-g[j])) * up[j];
                        int q = __builtin_amdgcn_cvt_pk_fp8_f32(o[0], o[1], 0, false); pk[bj] = __builtin_amdgcn_cvt_pk_fp8_f32(o[2], o[3], q, true); }
                    *(u32x2*)(Hm + (size_t)(u.crow0 + r) * DEXP + col0) = (u32x2){(unsigned)pk[0], (unsigned)pk[1]}; } }
    }
};
struct EpiDown8 {
    static constexpr bool PERM = true;
    unsigned char* O;
    __device__ __forceinline__ void operator()(const f32x4 (&acc)[2][2][4][2], const Unit& u, int wr, int wc, int fr, int fq) const {
        const int col0 = u.pn * BM + wc * 32 + 8 * fq;
#pragma unroll
        for (int ai = 0; ai < 2; ++ai)
#pragma unroll
            for (int m = 0; m < 4; ++m) { const int r = ai * HALF + wr * 64 + m * 16 + fr;
                if (r < u.mvalid) { unsigned char* rowp = O + (size_t)(u.crow0 + r) * D + col0;
#pragma unroll
                    for (int bj = 0; bj < 2; ++bj) { const f32x4 v0 = acc[ai][bj][m][0] * (1.0f / 16.0f), v1 = acc[ai][bj][m][1] * (1.0f / 16.0f);
                        int p0 = __builtin_amdgcn_cvt_pk_fp8_f32(v0[0], v0[1], 0, false); p0 = __builtin_amdgcn_cvt_pk_fp8_f32(v0[2], v0[3], p0, true);
                        int p1 = __builtin_amdgcn_cvt_pk_fp8_f32(v1[0], v1[1], 0, false); p1 = __builtin_amdgcn_cvt_pk_fp8_f32(v1[2], v1[3], p1, true);
                        *(u32x2*)(rowp + bj * HALF) = (u32x2){(unsigned)p0, (unsigned)p1}; } } }
    }
};
struct EpiDown {
    static constexpr bool PERM = false;
    bf16_t* O;
    __device__ __forceinline__ void operator()(const f32x4 (&acc)[2][2][4][2], const Unit& u, int wr, int wc, int fr, int fq) const {
        const int col0 = u.pn * BM + wc * 32 + 4 * fq;
#pragma unroll
        for (int ai = 0; ai < 2; ++ai)
#pragma unroll
            for (int m = 0; m < 4; ++m) { const int r = ai * HALF + wr * 64 + m * 16 + fr;
                if (r < u.mvalid) { bf16_t* rowp = O + (size_t)(u.crow0 + r) * D + col0;
#pragma unroll
                    for (int bj = 0; bj < 2; ++bj)
#pragma unroll
                        for (int n = 0; n < 2; ++n) { const f32x4 v = acc[ai][bj][m][n]; u32x2 w; w.x = pk2i(v[0], v[1]); w.y = pk2i(v[2], v[3]); *(u32x2*)(rowp + bj * HALF + n * 16) = w; } } }
    }
};
}

struct Frame {
    LAS unsigned char* lds; volatile LAS unsigned* MISC; unsigned* ctl; unsigned char* ws;
    int tid, lane, wave, vcu, G;
};
__device__ __forceinline__ int opaque_v(int v) { asm volatile("" : "+v"(v)); return v; }
__device__ __forceinline__ unsigned char* launder_ws(unsigned char* p) { GAS unsigned char* q = (GAS unsigned char*)p; asm volatile("" : "+s"(q)); return (unsigned char*)q; }
struct Args { const float* in[36]; float* out; unsigned char* ws; int ph_lo, ph_hi; };
struct ArgsG { const GAS float* in_[36]; GAS float* out_; GAS unsigned char* ws_; int ph_lo, ph_hi;
 };
#define CAS __attribute__((address_space(4)))
__device__ __forceinline__ const CAS ArgsG* kargp() { const CAS ArgsG* p = (const CAS ArgsG*)__builtin_amdgcn_kernarg_segment_ptr(); asm volatile("" : "+s"(p)); return p; }
__device__ __forceinline__ const float* kin(int k) { return (const float*)kargp()->in_[k]; }
__device__ __forceinline__ float* kout() { return (float*)kargp()->out_; }

__device__ __forceinline__ void transpose64(const float* colp4, int ldw, int K, bf16_t* WT, int k0, int j0, LAS float* scr, int lane) {
    const int kr = lane >> 4, c4 = lane & 15;
    f32x4 t[16];
#pragma unroll
    for (int i = 0; i < 16; ++i) t[i] = colp4 ? *(const f32x4*)(colp4 + (size_t)(k0 + kr + 4 * i) * ldw) : (f32x4){0.f, 0.f, 0.f, 0.f};
    const int ch = lane >> 4, nr = lane & 15;
#pragma unroll
    for (int hf = 0; hf < 2; ++hf) {
#pragma unroll
        for (int i = 0; i < 8; ++i) { LAS float* d = scr + (kr + 4 * i) * 66 + 4 * c4; const f32x4 x = t[hf * 8 + i]; *(LAS f32x2*)d = (f32x2){x[0], x[1]}; *(LAS f32x2*)(d + 2) = (f32x2){x[2], x[3]}; }
        LDS_WAIT();
#pragma unroll
        for (int it = 0; it < 4; ++it) { const int n = nr + 16 * it; const LAS float* sp = scr + (8 * ch) * 66 + n;
            u32x4 o; o.x = pk2(sp[0], sp[66]); o.y = pk2(sp[2 * 66], sp[3 * 66]); o.z = pk2(sp[4 * 66], sp[5 * 66]); o.w = pk2(sp[6 * 66], sp[7 * 66]);
            *(u32x4*)(WT + (size_t)(j0 + n) * K + k0 + 32 * hf + 8 * ch) = o; }
        LDS_WAIT();
    }
}
__device__ __forceinline__ void transpose64_fp8(const float* colp4, int ldw, int K, unsigned char* WT, int k0, int j0, LAS float* scr, int lane) {
    const int kr = lane >> 4, c4 = lane & 15;
    f32x4 t[16];
#pragma unroll
    for (int i = 0; i < 16; ++i) t[i] = *(const f32x4*)(colp4 + (size_t)(k0 + kr + 4 * i) * ldw);
    const int ch = lane >> 5, nr = lane & 31;
#pragma unroll
    for (int hf = 0; hf < 2; ++hf) {
#pragma unroll
        for (int i = 0; i < 8; ++i) { LAS float* d = scr + (kr + 4 * i) * 66 + 4 * c4; const f32x4 x = t[hf * 8 + i]; *(LAS f32x2*)d = (f32x2){x[0], x[1]}; *(LAS f32x2*)(d + 2) = (f32x2){x[2], x[3]}; }
        LDS_WAIT();
#pragma unroll
        for (int it = 0; it < 2; ++it) { const int n = nr + 32 * it; const LAS float* sp = scr + (16 * ch) * 66 + n; int q[4];
#pragma unroll
            for (int g = 0; g < 4; ++g) { int pk = __builtin_amdgcn_cvt_pk_fp8_f32(sp[(4 * g) * 66] * 64.0f, sp[(4 * g + 1) * 66] * 64.0f, 0, false); q[g] = __builtin_amdgcn_cvt_pk_fp8_f32(sp[(4 * g + 2) * 66] * 64.0f, sp[(4 * g + 3) * 66] * 64.0f, pk, true); }
            *(u32x4*)(WT + (size_t)(j0 + n) * K + k0 + 32 * hf + 16 * ch) = (u32x4){(unsigned)q[0], (unsigned)q[1], (unsigned)q[2], (unsigned)q[3]}; }
        LDS_WAIT();
    }
}
__device__ __forceinline__ f32x4 ldg4(const float* p) { return *(const f32x4*)p; }
__device__ __forceinline__ f32x4 ldg4(const LAS float* p) { return *(const LAS f32x4*)p; }
template <bool HB8 = false, bool OUT_ONLY = false, class GP = const float*>
__device__ __forceinline__ void ln_wave_store(f32x4 (&v)[8], GP g, GP b, bf16_t* resrow, unsigned char* f8row, float* orow, int lane) {
    float s = 0.f;
#pragma unroll
    for (int j = 0; j < 8; ++j) s += (v[j][0] + v[j][1]) + (v[j][2] + v[j][3]);
    const float mean = wave_sum(s) * (1.0f / D);
    float q = 0.f;
#pragma unroll
    for (int j = 0; j < 8; ++j) { v[j] = v[j] - mean; q += (v[j][0] * v[j][0] + v[j][1] * v[j][1]) + (v[j][2] * v[j][2] + v[j][3] * v[j][3]); }
    const float rstd = rsqrtf(wave_sum(q) * (1.0f / D) + 1e-5f);
#pragma unroll
    for (int j = 0; j < 8; ++j) {
        const int i4 = lane + 64 * j;
        const f32x4 gv = ldg4(g + 4 * i4), bv = ldg4(b + 4 * i4);
        if (HB8 && (j & 1) == 0) __builtin_amdgcn_sched_barrier(0);
        const f32x4 o = v[j] * rstd * gv + bv;
        v[j] = o;
        if (OUT_ONLY) { if (orow) ((f32x4*)orow)[i4] = o; continue; }
        { u32x2 w; w.x = pk2(o[0], o[1]); w.y = pk2(o[2], o[3]); ((u32x2*)resrow)[i4] = w; }
        if (HB8) { int pk = __builtin_amdgcn_cvt_pk_fp8_f32(o[0], o[1], 0, false); pk = __builtin_amdgcn_cvt_pk_fp8_f32(o[2], o[3], pk, true); ((int*)f8row)[i4] = pk; }
        if (orow) ((f32x4*)orow)[i4] = o;
    }
}

__device__ __forceinline__ void hy_filter_item(Frame& F, int item, unsigned char* wsl);
__device__ __forceinline__ void hy_filter_tails(Frame& F, unsigned char* wsl);
__device__ __forceinline__ void p_prologue(Frame& F) {
    unsigned char* const wsl = launder_ws(F.ws); unsigned* const ctl = (unsigned*)(wsl + WS_CTL);
    LAS float* scr = (LAS float*)(F.lds + F.wave * 16384);
    const int gw = F.vcu * 8 + F.wave, NGW = F.G * 8, lane = F.lane;
    bf16_t* WIN = (bf16_t*)(wsl + WS_WIN); bf16_t* WOUT = (bf16_t*)(wsl + WS_WOUT); bf16_t* WGU = (bf16_t*)(wsl + WS_WGU); bf16_t* WD = (bf16_t*)(wsl + WS_WD);
    constexpr int I_IN = 32 * (INCP / 64), I_OUT = 32 * 32, I_GU = 32 * 32, I_D = 16 * 32;
    constexpr int N_IN = DEPTH * I_IN, N_OUT = DEPTH * I_OUT, N_GU = DEPTH * NEXP * I_GU, N_D = DEPTH * NEXP * I_D, N_TR = N_IN + N_OUT + N_GU + N_D;
    const int c4 = lane & 15, kr4 = lane >> 4;
    struct TrItem { const float* colp; unsigned char* wt; int ldw, K, k0, j0, f8; };
#define TR_DECODE(itv, d) do { int r_ = (itv); \
        if (r_ < N_IN) { const int ll = r_ / I_IN, q = r_ % I_IN, nb = q % (INCP / 64), kb = q / (INCP / 64); const int n = nb * 64 + 4 * c4; \
            d.colp = n < INC ? kin(4) + (size_t)ll * D * INC + n : nullptr; d.ldw = INC; d.K = D; d.wt = (unsigned char*)(WIN + (size_t)ll * INCP * D); d.k0 = kb * 64; d.j0 = nb * 64; d.f8 = 0; } \
        else if (r_ < N_IN + N_OUT) { r_ -= N_IN; const int ll = r_ / I_OUT, q = r_ % I_OUT, nb = q % 32, kb = q / 32; const int n = nb * 64 + 4 * c4; \
            d.colp = kin(23) + (size_t)ll * D * D + n; d.ldw = D; d.K = D; d.wt = (unsigned char*)(WOUT + (size_t)ll * D * D); d.k0 = kb * 64; d.j0 = nb * 64; d.f8 = 0; } \
        else if (r_ < N_IN + N_OUT + N_GU) { r_ -= N_IN + N_OUT; const int le = r_ / I_GU, q = r_ % I_GU, nb = q % 32, kb = q / 32; const int j = nb * 64 + 4 * c4; \
            const int pn = j >> 8, cp = j & 255, bj = cp >> 7, wc = (cp >> 5) & 3, nn = (cp >> 4) & 1, fq = (cp >> 2) & 3; const int hid = pn * 128 + wc * 32 + fq * 8 + bj * 4; \
            d.colp = (nn ? kin(32) : kin(31)) + (size_t)le * D * DEXP + hid; d.ldw = DEXP; d.K = D; d.wt = (unsigned char*)WGU + (size_t)le * 2048 * D; d.k0 = kb * 64; d.j0 = nb * 64; d.f8 = 1; } \
        else { r_ -= N_IN + N_OUT + N_GU; const int le = r_ / I_D, q = r_ % I_D, nb = q % 32, kb = q / 32; const int n = nb * 64 + 4 * c4; \
            d.colp = kin(33) + (size_t)le * DEXP * D + n; d.ldw = D; d.K = DEXP; d.wt = (unsigned char*)WD + (size_t)le * D * DEXP; d.k0 = kb * 64; d.j0 = nb * 64; d.f8 = 1; } } while (0)
#define TR_LOAD(d, t) do { _Pragma("unroll") for (int i = 0; i < 16; ++i) t[i] = d.colp ? *(const f32x4*)(d.colp + (size_t)(d.k0 + kr4 + 4 * i) * d.ldw) : (f32x4){0.f, 0.f, 0.f, 0.f}; } while (0)
    { int it = gw; TrItem dc, dn; f32x4 tc[16], tn[16];
      if (it < N_TR) { TR_DECODE(it, dc); TR_LOAD(dc, tc); }
      for (; it < N_TR; it += NGW) {
          const int itn = it + NGW;
          if (itn < N_TR) { TR_DECODE(itn, dn); TR_LOAD(dn, tn); }
#pragma unroll
          for (int hf = 0; hf < 2; ++hf) {
#pragma unroll
              for (int i = 0; i < 8; ++i) { LAS float* dd = scr + (kr4 + 4 * i) * 66 + 4 * c4; const f32x4 x = tc[hf * 8 + i]; *(LAS f32x2*)dd = (f32x2){x[0], x[1]}; *(LAS f32x2*)(dd + 2) = (f32x2){x[2], x[3]}; }
              LDS_WAIT();
              if (dc.f8) { const int ch = lane >> 5, nr = lane & 31;
#pragma unroll
                  for (int i2 = 0; i2 < 2; ++i2) { const int n = nr + 32 * i2; const LAS float* sp = scr + (16 * ch) * 66 + n; int q[4];
#pragma unroll
                      for (int g = 0; g < 4; ++g) { int pk = __builtin_amdgcn_cvt_pk_fp8_f32(sp[(4 * g) * 66] * 64.0f, sp[(4 * g + 1) * 66] * 64.0f, 0, false); q[g] = __builtin_amdgcn_cvt_pk_fp8_f32(sp[(4 * g + 2) * 66] * 64.0f, sp[(4 * g + 3) * 66] * 64.0f, pk, true); }
                      *(u32x4*)(dc.wt + (size_t)(dc.j0 + n) * dc.K + dc.k0 + 32 * hf + 16 * ch) = (u32x4){(unsigned)q[0], (unsigned)q[1], (unsigned)q[2], (unsigned)q[3]}; }
              } else { const int ch = lane >> 4, nr = lane & 15;
#pragma unroll
                  for (int i2 = 0; i2 < 4; ++i2) { const int n = nr + 16 * i2; const LAS float* sp = scr + (8 * ch) * 66 + n;
                      u32x4 o; o.x = pk2(sp[0], sp[66]); o.y = pk2(sp[2 * 66], sp[3 * 66]); o.z = pk2(sp[4 * 66], sp[5 * 66]); o.w = pk2(sp[6 * 66], sp[7 * 66]);
                      *(u32x4*)((bf16_t*)dc.wt + (size_t)(dc.j0 + n) * dc.K + dc.k0 + 32 * hf + 8 * ch) = o; } }
              LDS_WAIT();
          }
          dc = dn;
#pragma unroll
          for (int i = 0; i < 16; ++i) tc[i] = tn[i];
      } }
#undef TR_DECODE
#undef TR_LOAD
    { bf16_t* WR = (bf16_t*)(wsl + WS_WR);
      for (int idx = blockIdx.x * 512 + F.tid; idx < DEPTH * 64 * 2 * 64; idx += F.G * 512) {
          const int ln = idx & 63, t = (idx >> 6) & 1, sst = (idx >> 7) & 63, ll = idx >> 13, n = ln & 15, kg = ln >> 4, c = 16 * t + n;
          unsigned hi[8], lo[8];
#pragma unroll
          for (int j = 0; j < 8; ++j) { const int k = 32 * sst + 8 * kg + j;
              const float wv = c < 4 ? kin(27)[((size_t)ll * D + k) * 4 + c] : (c < 20 ? kin(29)[((size_t)ll * D + k) * 16 + c - 4] : 0.f);
              hi[j] = f2bf(wv); lo[j] = f2bf(wv - __builtin_bit_cast(float, hi[j] << 16)); }
          bf16_t* o = WR + ((size_t)ll * 256 + (sst * 2 + t) * 2) * 512 + ln * 8;
          *(u32x4*)o = (u32x4){hi[0] | (hi[1] << 16), hi[2] | (hi[3] << 16), hi[4] | (hi[5] << 16), hi[6] | (hi[7] << 16)};
          *(u32x4*)(o + 512) = (u32x4){lo[0] | (lo[1] << 16), lo[2] | (lo[3] << 16), lo[4] | (lo[5] << 16), lo[6] | (lo[7] << 16)}; } }
    hy_filter_tails(F, wsl);
    for (int it = blockIdx.x; it < DEPTH * 66; it += F.G) hy_filter_item(F, it, wsl);
    __syncthreads();
    bf16_t* hb = (bf16_t*)(wsl + WS_HB);
    for (int row = gw; row < T; row += NGW) {
        const int bb = row / L, p = row % L;
        const float* src = p < NMETA ? kin(1) + (size_t)p * D : kin(0) + ((size_t)bb * SEQ + (p - NMETA)) * D;
        f32x4 v[8];
#pragma unroll
        for (int j = 0; j < 8; ++j) v[j] = ((const f32x4*)src)[lane + 64 * j];
        ln_wave_store(v, kin(2), kin(3), hb + (size_t)row * D, nullptr, nullptr, lane);
    }
}


__device__ __forceinline__ void hy_filter_item(Frame& F, int item, unsigned char* wsl) {
    const int half = item & 1, blk = (item >> 1) % 33, l = item / 66, tid = F.tid;
    const float* w1 = kin(15) + (size_t)l * 33 * 64; const float* b1 = kin(16) + l * 64; const float* freq = kin(17) + l * 128;
    const float* w2 = kin(18) + (size_t)l * 64 * 64; const float* b2 = kin(19) + l * 64; const float* w3 = kin(20) + (size_t)l * 64 * 1024;
    LAS float* z = (LAS float*)F.lds;
    LAS float* h1 = z + 64 * 33;
    LAS float* h2 = h1 + 64 * 64;
    LAS bf16_t* ot = (LAS bf16_t*)(h2 + 64 * 64);
    const int d0 = blk * 64;
    __syncthreads();
    for (int e = tid; e < 64 * 33; e += 512) { const int pl = e / 33, k = e % 33, i = d0 + pl; float v;
        if (k == 0) v = (float)i / (float)(L - 1);
        else { const int j = (k - 1) & 15; const double band = 1e-4 + (double)j * ((15.0 - 1e-4) / 15.0); double turns = band * (double)i / (double)L; turns -= (double)(long long)turns;
               const float ang = (float)(turns * 6.283185307179586476925); v = k < 17 ? __cosf(ang) : -__sinf(ang); }
        z[e] = v; }
    __syncthreads();
    { const int j = tid & 63, pg = tid >> 6; const float fq = freq[j], bb = b1[j];
      float a[8];
#pragma unroll
      for (int r = 0; r < 8; ++r) a[r] = bb;
      for (int k = 0; k < 33; ++k) { const float w = w1[k * 64 + j];
#pragma unroll
          for (int r = 0; r < 8; ++r) a[r] += z[(pg * 8 + r) * 33 + k] * w; }
#pragma unroll
      for (int r = 0; r < 8; ++r) h1[(pg * 8 + r) * 64 + j] = __sinf(fq * a[r]); }
    __syncthreads();
    { const int j = tid & 63, pg = tid >> 6; const float fq = freq[64 + j], bb = b2[j];
      float a[8];
#pragma unroll
      for (int r = 0; r < 8; ++r) a[r] = bb;
      for (int k = 0; k < 64; ++k) { const float w = w2[k * 64 + j];
#pragma unroll
          for (int r = 0; r < 8; ++r) a[r] += h1[(pg * 8 + r) * 64 + k] * w; }
#pragma unroll
      for (int r = 0; r < 8; ++r) h2[(pg * 8 + r) * 64 + j] = __sinf(fq * a[r]); }
    __syncthreads();
    { const int c = tid;
      const float mind = logf(1e-2f) / 1.5f, maxd = logf(1e-2f) / 0.3f;
      const float adel = fabsf(mind + (float)c * ((maxd - mind) / 511.0f));
      for (int pq = 0; pq < 64; pq += 8) {
          float a[8];
#pragma unroll
          for (int r = 0; r < 8; ++r) a[r] = 0.f;
          for (int k = 0; k < 64; ++k) { const float w = w3[k * 1024 + half * 512 + c];
#pragma unroll
              for (int r = 0; r < 8; ++r) a[r] += h2[(pq + r) * 64 + k] * w; }
#pragma unroll
          for (int r = 0; r < 8; ++r) { const int i = d0 + pq + r; const float tt = (float)i / (float)(L - 1); ot[c * 66 + pq + r] = (bf16_t)f2bf(a[r] * __expf(-tt * adel)); } } }
    __syncthreads();
    { bf16_t* FG = (bf16_t*)(wsl + WS_FG) + (size_t)l * 512 * 2 * GLEN;
      const int dl = tid & 63, cg = tid >> 6, d = d0 + dl;
      if (d < L && !(half == 1 && d == 0)) {
          const int m = half ? GCEN + d : GCEN - d;
          for (int c = cg; c < 512; c += 8) { const bf16_t v = ot[c * 66 + dl]; bf16_t* row = FG + (size_t)c * 2 * GLEN; row[m] = v; row[GLEN + m - 1] = v; } } }
}
__device__ __forceinline__ void hy_filter_tails(Frame& F, unsigned char* wsl) {
    bf16_t* FG = (bf16_t*)(wsl + WS_FG);
    constexpr int LO0 = GCEN - (L - 1), HI0 = GCEN + (L - 1) + 1;
    constexpr int NT0 = LO0 + (GLEN - HI0), NT1 = (LO0 - 1) + (GLEN - (HI0 - 1));
    for (size_t idx = (size_t)blockIdx.x * 512 + F.tid; idx < (size_t)DEPTH * 512 * (NT0 + NT1); idx += (size_t)F.G * 512) {
        const int rowi = (int)(idx / (NT0 + NT1)); int k = (int)(idx % (NT0 + NT1));
        bf16_t* row = FG + (size_t)rowi * 2 * GLEN;
        if (k < NT0) { const int m = k < LO0 ? k : HI0 + (k - LO0); row[m] = 0; }
        else { k -= NT0; const int m = k < LO0 - 1 ? k : (HI0 - 1) + (k - (LO0 - 1)); row[GLEN + m] = 0; } }
}

constexpr int MIXC_SG = 98304, MIXC_CW = 102400, MIXC_CB = 120832, MIXC_HG = 98304;
__device__ __forceinline__ void hy_pre_item(Frame& F, int item, int l, unsigned char* wsl) {
    const bf16_t* U = (const bf16_t*)(wsl + WS_U);
    bf16_t* X0T = (bf16_t*)(wsl + WS_X0T); bf16_t* ZT = (bf16_t*)(wsl + WS_ZT);
    const LAS float* cw = (const LAS float*)(F.lds + MIXC_CW); const LAS float* cb = (const LAS float*)(F.lds + MIXC_CB);
    const int cc = item & 3, pt = (item >> 2) % 33, b = item / (4 * 33), tid = opaque_v(F.tid);
    const int c8 = tid & 15, pl = tid >> 4, c0 = cc * 128 + 8 * c8;
    LAS bf16_t* zt = (LAS bf16_t*)F.lds; LAS bf16_t* xt = zt + 128 * 72;
    __syncthreads();
    u32x4 raw[2][3][3];
#pragma unroll
    for (int ps = 0; ps < 2; ++ps) { const int p = pt * 64 + pl + 32 * ps; const bool pv = p < L;
#pragma unroll
        for (int g = 0; g < 3; ++g) { const bf16_t* ub = U + ((size_t)b * L + (pv ? p : 0)) * INC + O_CU + g * 512 + c0; const u32x4 z4 = (u32x4){0u, 0u, 0u, 0u};
            raw[ps][g][0] = (pv && p > 0) ? *(const u32x4*)(ub - INC) : z4; raw[ps][g][1] = pv ? *(const u32x4*)ub : z4; raw[ps][g][2] = (p + 1 < L) ? *(const u32x4*)(ub + INC) : z4; } }
#pragma unroll
    for (int ps = 0; ps < 2; ++ps) { const int p = pt * 64 + pl + 32 * ps; const bool pv = p < L;
        float uc[3][8];
#pragma unroll
        for (int g = 0; g < 3; ++g) { const int col = g * 512 + c0;
            const f32x4 wa0 = *(const LAS f32x4*)(cw + col), wa1 = *(const LAS f32x4*)(cw + col + 4), wb0 = *(const LAS f32x4*)(cw + 1536 + col), wb1 = *(const LAS f32x4*)(cw + 1536 + col + 4),
                        wc0 = *(const LAS f32x4*)(cw + 3072 + col), wc1 = *(const LAS f32x4*)(cw + 3072 + col + 4), bb0 = *(const LAS f32x4*)(cb + col), bb1 = *(const LAS f32x4*)(cb + col + 4);
            const u32x4 rm = raw[ps][g][0], r0 = raw[ps][g][1], rp = raw[ps][g][2];
#pragma unroll
            for (int j = 0; j < 4; ++j) {
                const float m0 = __builtin_bit_cast(float, rm[j] << 16), m1 = __builtin_bit_cast(float, rm[j] & 0xffff0000u), x0 = __builtin_bit_cast(float, r0[j] << 16), x1 = __builtin_bit_cast(float, r0[j] & 0xffff0000u),
                            q0 = __builtin_bit_cast(float, rp[j] << 16), q1 = __builtin_bit_cast(float, rp[j] & 0xffff0000u);
                const int e = 2 * j; const float w0a = e < 4 ? wa0[e & 3] : wa1[e & 3], w0b = e < 4 ? wb0[e & 3] : wb1[e & 3], w0c = e < 4 ? wc0[e & 3] : wc1[e & 3], b0_ = e < 4 ? bb0[e & 3] : bb1[e & 3];
                const float w1a = e < 4 ? wa0[(e + 1) & 3] : wa1[(e + 1) & 3], w1b = e < 4 ? wb0[(e + 1) & 3] : wb1[(e + 1) & 3], w1c = e < 4 ? wc0[(e + 1) & 3] : wc1[(e + 1) & 3], b1_ = e < 4 ? bb0[(e + 1) & 3] : bb1[(e + 1) & 3];
                uc[g][e] = pv ? (b0_ + m0 * w0a + x0 * w0b + q0 * w0c) : 0.f; uc[g][e + 1] = pv ? (b1_ + m1 * w1a + x1 * w1b + q1 * w1c) : 0.f; } }
#pragma unroll
        for (int j = 0; j < 8; ++j) { zt[(8 * c8 + j) * 72 + pl + 32 * ps] = (bf16_t)f2bf(uc[1][j] * uc[2][j]); xt[(8 * c8 + j) * 72 + pl + 32 * ps] = (bf16_t)f2bf(uc[0][j]); } }
    __syncthreads();
#pragma unroll
    for (int it = 0; it < 2; ++it) { const int cr = (tid >> 3) + 64 * it, pc = tid & 7;
      const size_t o = ((size_t)(cc * 128 + cr) * NB + b) * ZL + pt * 64 + pc * 8;
      *(u32x4*)(ZT + o) = *(const LAS u32x4*)(zt + cr * 72 + pc * 8);
      *(u32x4*)(X0T + o) = *(const LAS u32x4*)(xt + cr * 72 + pc * 8); }
}

__device__ __forceinline__ void hy_conv_phase(Frame& F, int l, unsigned char* wsl) {
    const bf16_t* ZT = (const bf16_t*)(wsl + WS_ZT); const bf16_t* X0T = (const bf16_t*)(wsl + WS_X0T); bf16_t* YT = (bf16_t*)(wsl + WS_YT);
    const bf16_t* FG = (const bf16_t*)(wsl + WS_FG) + (size_t)l * 512 * 2 * GLEN;
    const float* skip = kin(21) + l * 512;
    LAS unsigned char* Zs = F.lds;
    LAS unsigned char* Gs = F.lds + 8 * ZROW * 2;
    const int tid = F.tid, lane = F.lane, wave = F.wave;
    __syncthreads();
    for (int e = tid; e < 8 * ZROW * 2 / 16; e += 512) *(LAS u32x4*)(Zs + e * 16) = (u32x4){0u, 0u, 0u, 0u};
    const int pp = wave & 1, q = wave >> 1;
    const int T0 = 576 * q + 16 * pp, D0 = -(576 * q + 544 + 32 * pp), S0 = T0 + D0;
    const int n = lane & 15, kg = lane >> 4, bb = n & 7, u = n >> 3;
    const unsigned zb = (unsigned)(bb * ZROW * 2 + 2 * (ZOFF + S0 + 32 * u + 8 * kg));
    const int par = n & 1, e0 = GCEN + D0 + 8 * kg - n;
    const unsigned ab = (unsigned)(8 * ZROW * 2 + par * GLEN * 2 + 2 * (e0 - par));
    for (int c = F.vcu; c < 512; c += F.G) {
        __syncthreads();
        for (int e = tid; e < 8 * (ZL / 8); e += 512) { const int b = e / (ZL / 8), pc = e % (ZL / 8);
            *(LAS u32x4*)(Zs + (b * ZROW + ZOFF + pc * 8) * 2) = *(const u32x4*)(ZT + ((size_t)c * NB + b) * ZL + pc * 8); }
        for (int e = tid; e < 2 * GLEN / 8; e += 512) *(LAS u32x4*)(Gs + e * 16) = *(const u32x4*)(FG + (size_t)c * 2 * GLEN + e * 8);
        __syncthreads();
        f32x4 acc[9];
#pragma unroll
        for (int k = 0; k < 9; ++k) acc[k] = (f32x4){0.f, 0.f, 0.f, 0.f};
        bf16x8 ring[18];
#pragma unroll
        for (int s2 = 0; s2 < 17; ++s2) ring[s2] = *(const LAS bf16x8*)(F.lds + zb + 64 * s2);
        u32x4 an;
#pragma unroll
        for (int d = 0; d < 4; ++d) an[d] = *(const LAS unsigned*)(F.lds + ab + 4 * d);
        for (int jo = 0; jo < 5; ++jo) {
            const unsigned zo = zb + (unsigned)jo * 18u * 64u, ao = ab + (unsigned)jo * 18u * 64u;
#pragma unroll
            for (int jj = 0; jj < 18; ++jj) {
                const bf16x8 acur = __builtin_bit_cast(bf16x8, an);
                ring[(jj + 17) % 18] = *(const LAS bf16x8*)(F.lds + zo + 64 * (jj + 17));
#pragma unroll
                for (int d = 0; d < 4; ++d) an[d] = *(const LAS unsigned*)(F.lds + ao + 64 * (jj + 1) + 4 * d);
#pragma unroll
                for (int k = 0; k < 9; ++k) acc[k] = __builtin_amdgcn_mfma_f32_16x16x32_bf16(acur, ring[(jj + 2 * k) % 18], acc[k], 0, 0, 0);
            }
        }
        const float sk = skip[c];
#pragma unroll
        for (int k = 0; k < 9; ++k) { const int t = T0 + 64 * k + 32 * u + 4 * kg;
            if (t < L) { const size_t o = ((size_t)c * NB + bb) * ZL + t;
                const u32x2 xv = *(const u32x2*)(X0T + o); const u32x2 zv = *(const LAS u32x2*)(Zs + (bb * ZROW + ZOFF + t) * 2);
                float y[4];
                y[0] = __builtin_bit_cast(float, xv.x << 16) * (acc[k][0] + sk * __builtin_bit_cast(float, zv.x << 16));
                y[1] = __builtin_bit_cast(float, xv.x & 0xffff0000u) * (acc[k][1] + sk * __builtin_bit_cast(float, zv.x & 0xffff0000u));
                y[2] = __builtin_bit_cast(float, xv.y << 16) * (acc[k][2] + sk * __builtin_bit_cast(float, zv.y << 16));
                y[3] = __builtin_bit_cast(float, xv.y & 0xffff0000u) * (acc[k][3] + sk * __builtin_bit_cast(float, zv.y & 0xffff0000u));
                u32x2 w; w.x = pk2(y[0], y[1]); w.y = pk2(y[2], y[3]); *(u32x2*)(YT + o) = w; } }
    }
    __syncthreads();
}

__device__ __forceinline__ void hy_norm_item(Frame& F, int item, int l, unsigned char* wsl) {
    const bf16_t* YT = (const bf16_t*)(wsl + WS_YT); bf16_t* Y = (bf16_t*)(wsl + WS_Y); const LAS float* hg = (const LAS float*)(F.lds + MIXC_HG);
    const int pt = item % 33, b = item / 33, p0 = pt * 64, tid = opaque_v(F.tid);
    LAS bf16_t* tl = (LAS bf16_t*)F.lds;
    LAS float* part = (LAS float*)(F.lds + 512 * 72 * 2);
    LAS float* rsv = part + 512;
    __syncthreads();
#pragma unroll
    for (int it = 0; it < 8; ++it) { const int c = (tid >> 3) + 64 * it, pc = tid & 7;
        *(LAS u32x4*)(tl + c * 72 + pc * 8) = *(const u32x4*)(YT + ((size_t)c * NB + b) * ZL + p0 + pc * 8); }
    __syncthreads();
    { const int pos = tid & 63, cg = tid >> 6; float sacc = 0.f;
      for (int c = cg * 64; c < cg * 64 + 64; ++c) { const float v = bf2f(tl[c * 72 + pos]); sacc += v * v; }
      part[cg * 64 + pos] = sacc; }
    __syncthreads();
    if (tid < 64) { float sacc = 0.f;
#pragma unroll
        for (int g = 0; g < 8; ++g) sacc += part[g * 64 + tid];
        rsv[tid] = rsqrtf(sacc * (1.0f / 512.0f) + 1e-6f); }
    __syncthreads();
    { const int pos = tid >> 3, pc = tid & 7, p = p0 + pos;
      if (p < L) { const float rs = rsv[pos]; bf16_t* yrow = Y + ((size_t)b * L + p) * D + 1536;
#pragma unroll
          for (int it = 0; it < 8; ++it) { const int c = it * 64 + pc * 8; float v[8];
#pragma unroll
              for (int j = 0; j < 8; ++j) v[j] = bf2f(tl[(c + j) * 72 + pos]) * rs * hg[c + j];
              u32x4 w; w.x = pk2(v[0], v[1]); w.y = pk2(v[2], v[3]); w.z = pk2(v[4], v[5]); w.w = pk2(v[6], v[7]);
              *(u32x4*)(yrow + c) = w; } } }
}


constexpr int GS = 72;
constexpr int G_OP0 = 0, G_OP1 = 9216, G_VT = 18432, G_DEC = 36864, G_PART = 37376, G_W = 38400, G_ST = 49152;
typedef float f32x16 __attribute__((ext_vector_type(16)));
typedef short s16x4 __attribute__((ext_vector_type(4)));
__device__ __forceinline__ float logsigmoid_fast(float x) { return fminf(x, 0.f) - log1pf(__expf(-fabsf(x))); }
template <int N> __device__ __forceinline__ float row_shr_add(float v) { const int t = __builtin_amdgcn_update_dpp(0, __builtin_bit_cast(int, v), 0x110 + N, 0xf, 0xf, true); return v + __builtin_bit_cast(float, t); }
__device__ __forceinline__ float wave_incl_scan(float v, int lane) {
    v = row_shr_add<1>(v); v = row_shr_add<2>(v); v = row_shr_add<4>(v); v = row_shr_add<8>(v);
    const int vi = __builtin_bit_cast(int, v);
    const float r0 = __builtin_bit_cast(float, __builtin_amdgcn_readlane(vi, 15)), r1 = __builtin_bit_cast(float, __builtin_amdgcn_readlane(vi, 31)), r2 = __builtin_bit_cast(float, __builtin_amdgcn_readlane(vi, 47));
    return v + (lane >= 16 ? r0 : 0.f) + (lane >= 32 ? r1 : 0.f) + (lane >= 48 ? r2 : 0.f);
}
__device__ __forceinline__ float lane_bcast63(float v) { return __builtin_bit_cast(float, __builtin_amdgcn_readlane(__builtin_bit_cast(int, v), 63)); }
__device__ __forceinline__ int crow16(int i, int hh) { return (i & 3) + 8 * (i >> 2) + 4 * hh; }
#define MFMA32(a, b, c) __builtin_amdgcn_mfma_f32_32x32x16_bf16((a), (b), (c), 0, 0, 0)
__device__ __forceinline__ void gla_passA_item(Frame& F, int item, int l, unsigned char* wsl) {
    const int n = item % GNC, bh = item / GNC, b = bh >> 2, h = bh & 3, tid = opaque_v(F.tid), w = F.wave, lane = tid & 63;
    LAS float* gw = (LAS float*)(F.lds + G_W);
    const bf16_t* U = (const bf16_t*)(wsl + WS_U);
    const int d0 = 8 * w, p = 64 * n - 48 + lane; const bool valid = p >= 0;
    const bf16_t* urow = U + ((size_t)b * L + (valid ? p : 0)) * INC;
    const u32x4 g0 = *(const u32x4*)(urow + O_GF), g1 = *(const u32x4*)(urow + O_GF + 8), g2 = *(const u32x4*)(urow + O_GB), g3 = *(const u32x4*)(urow + O_GB + 8);
    const u32x4 qraw = *(const u32x4*)(urow + O_AQ + h * 64 + d0), kraw = *(const u32x4*)(urow + O_AK + h * 64 + d0);
    const u32x4 v0 = *(const u32x4*)(urow + O_AV + h * 128 + 16 * w), v1 = *(const u32x4*)(urow + O_AV + h * 128 + 16 * w + 8);
    __syncthreads();
    for (int e = tid; e < 2176; e += 512) { float v;
        if (e < 2048) { const int dirw = e >> 10, rr = (e >> 6) & 15, d = e & 63; v = (dirw ? kin(8) : kin(6))[(size_t)l * 16 * 256 + rr * 256 + h * 64 + d]; }
        else { const int dirw = (e - 2048) >> 6, d = e & 63; v = (dirw ? kin(9) : kin(7))[l * 256 + h * 64 + d]; }
        gw[e] = v; }
    __syncthreads();
    float glf[16], glb[16];
    {
#pragma unroll
      for (int r = 0; r < 4; ++r) { glf[2 * r] = __builtin_bit_cast(float, g0[r] << 16); glf[2 * r + 1] = __builtin_bit_cast(float, g0[r] & 0xffff0000u); glf[8 + 2 * r] = __builtin_bit_cast(float, g1[r] << 16); glf[9 + 2 * r] = __builtin_bit_cast(float, g1[r] & 0xffff0000u);
          glb[2 * r] = __builtin_bit_cast(float, g2[r] << 16); glb[2 * r + 1] = __builtin_bit_cast(float, g2[r] & 0xffff0000u); glb[8 + 2 * r] = __builtin_bit_cast(float, g3[r] << 16); glb[9 + 2 * r] = __builtin_bit_cast(float, g3[r] & 0xffff0000u); } }
    float cF[8], cB[8], tF[8], tB[8];
#pragma unroll
    for (int dirw = 0; dirw < 2; ++dirw) {
        float x[8];
        { const f32x4 b0 = *(const LAS f32x4*)(gw + 2048 + dirw * 64 + d0), b1 = *(const LAS f32x4*)(gw + 2048 + dirw * 64 + d0 + 4);
#pragma unroll
          for (int j = 0; j < 4; ++j) { x[j] = b0[j]; x[4 + j] = b1[j]; } }
#pragma unroll
        for (int r = 0; r < 16; ++r) {
            const f32x4 a0 = *(const LAS f32x4*)(gw + dirw * 1024 + r * 64 + d0), a1 = *(const LAS f32x4*)(gw + dirw * 1024 + r * 64 + d0 + 4);
            const float g = dirw ? glb[r] : glf[r];
#pragma unroll
            for (int j = 0; j < 4; ++j) { x[j] += g * a0[j]; x[4 + j] += g * a1[j]; }
            if ((r & 3) == 3) asm volatile("" : "+v"(x[0]), "+v"(x[1]), "+v"(x[2]), "+v"(x[3]), "+v"(x[4]), "+v"(x[5]), "+v"(x[6]), "+v"(x[7]));
        }
#pragma unroll
        for (int dd = 0; dd < 8; ++dd) {
            const float lg = valid ? logsigmoid_fast(x[dd]) * (1.0f / 16.0f) : 0.f;
            const float ps = wave_incl_scan(lg, lane), tot = lane_bcast63(ps);
            if (dirw == 0) { cF[dd] = ps; tF[dd] = tot; } else { cB[dd] = tot - ps + lg; tB[dd] = tot; }
            if ((dd & 1) == 1) { if (dirw == 0) asm volatile("" : "+v"(cF[dd]), "+v"(cF[dd - 1])); else asm volatile("" : "+v"(cB[dd]), "+v"(cB[dd - 1])); }
        }
    }
    LAS bf16_t* op0 = (LAS bf16_t*)(F.lds + G_OP0); LAS bf16_t* op1 = (LAS bf16_t*)(F.lds + G_OP1); LAS float* dec = (LAS float*)(F.lds + G_DEC);
    unsigned pq0[4], pq1[4], pq2[4], pq3[4];
#pragma unroll
    for (int dd = 0; dd < 8; ++dd) {
        const float qv = valid ? ((dd & 1) ? __builtin_bit_cast(float, qraw[dd >> 1] & 0xffff0000u) : __builtin_bit_cast(float, qraw[dd >> 1] << 16)) : 0.f;
        const float kv = valid ? ((dd & 1) ? __builtin_bit_cast(float, kraw[dd >> 1] & 0xffff0000u) : __builtin_bit_cast(float, kraw[dd >> 1] << 16)) : 0.f;
        op0[(d0 + dd) * GS + lane] = (bf16_t)f2bf(kv * __expf(tF[dd] - cF[dd]));
        op1[(d0 + dd) * GS + lane] = (bf16_t)f2bf(kv * __expf(tB[dd] - cB[dd]));
        if (lane == 0) { dec[d0 + dd] = __expf(tF[dd]); dec[64 + d0 + dd] = __expf(tB[dd]); }
        const unsigned a0 = f2bf(qv * 0.125f * __expf(cF[dd])), a1 = f2bf(kv * __expf(-cF[dd])), a2 = f2bf(qv * 0.125f * __expf(cB[dd])), a3 = f2bf(kv * __expf(-cB[dd]));
        if (dd & 1) { pq0[dd >> 1] |= a0 << 16; pq1[dd >> 1] |= a1 << 16; pq2[dd >> 1] |= a2 << 16; pq3[dd >> 1] |= a3 << 16; }
        else { pq0[dd >> 1] = a0; pq1[dd >> 1] = a1; pq2[dd >> 1] = a2; pq3[dd >> 1] = a3; }
    }
    { LAS bf16_t* st = (LAS bf16_t*)(F.lds + G_ST) + lane * GS + d0;
      *(LAS u32x4*)(st) = (u32x4){pq0[0], pq0[1], pq0[2], pq0[3]}; *(LAS u32x4*)(st + 64 * GS) = (u32x4){pq1[0], pq1[1], pq1[2], pq1[3]};
      *(LAS u32x4*)(st + 128 * GS) = (u32x4){pq2[0], pq2[1], pq2[2], pq2[3]}; *(LAS u32x4*)(st + 192 * GS) = (u32x4){pq3[0], pq3[1], pq3[2], pq3[3]}; }
    LAS bf16_t* vt = (LAS bf16_t*)(F.lds + G_VT);
    {
#pragma unroll
      for (int j = 0; j < 4; ++j) { const int dv = 16 * w + 2 * j;
          vt[dv * GS + lane] = valid ? (bf16_t)(v0[j] & 0xffffu) : (bf16_t)0; vt[(dv + 1) * GS + lane] = valid ? (bf16_t)(v0[j] >> 16) : (bf16_t)0;
          vt[(dv + 8) * GS + lane] = valid ? (bf16_t)(v1[j] & 0xffffu) : (bf16_t)0; vt[(dv + 9) * GS + lane] = valid ? (bf16_t)(v1[j] >> 16) : (bf16_t)0; } }
    __syncthreads();
    { bf16_t* gvt = (bf16_t*)(wsl + WS_GVT) + (size_t)item * 8192;
#pragma unroll
      for (int it = 0; it < 2; ++it) { const int e = it * 512 + tid, dv = e >> 3, pc = e & 7; *(u32x4*)(gvt + dv * 64 + pc * 8) = *(const LAS u32x4*)(vt + dv * GS + pc * 8); } }
    { bf16_t* gqk = (bf16_t*)(wsl + WS_GQK) + (size_t)item * 4 * 4096; const LAS bf16_t* st = (const LAS bf16_t*)(F.lds + G_ST);
#pragma unroll
      for (int it = 0; it < 4; ++it) { const int pos = tid >> 3, pc = tid & 7; *(u32x4*)(gqk + it * 4096 + pos * 64 + pc * 8) = *(const LAS u32x4*)(st + (it * 64 + pos) * GS + pc * 8); } }
    const int dir = w >> 2, dvb = w & 3, r = lane & 31, hh = lane >> 5;
    const LAS bf16_t* KL = (const LAS bf16_t*)(F.lds + (dir ? G_OP1 : G_OP0));
    f32x16 acc0, acc1;
#pragma unroll
    for (int i = 0; i < 16; ++i) { acc0[i] = 0.f; acc1[i] = 0.f; }
#pragma unroll
    for (int ks = 0; ks < 4; ++ks) {
        const bf16x8 a = *(const LAS bf16x8*)(vt + (32 * dvb + r) * GS + 16 * ks + 8 * hh);
        const bf16x8 b0 = *(const LAS bf16x8*)(KL + r * GS + 16 * ks + 8 * hh);
        const bf16x8 b1 = *(const LAS bf16x8*)(KL + (32 + r) * GS + 16 * ks + 8 * hh);
        acc0 = MFMA32(a, b0, acc0); acc1 = MFMA32(a, b1, acc1);
    }
    const int chain = (bh << 1) | dir;
    bf16_t* kvt = (bf16_t*)(wsl + WS_KVT) + ((size_t)chain * GNC + n) * 128 * 64;
#pragma unroll
    for (int i = 0; i < 16; ++i) { const int dv = 32 * dvb + crow16(i, hh); kvt[dv * 64 + r] = (bf16_t)f2bf(acc0[i]); kvt[dv * 64 + 32 + r] = (bf16_t)f2bf(acc1[i]); }
    if (tid < 128) { const int d = tid & 63, dd = tid >> 6; ((float*)(wsl + WS_DEC))[((size_t)((bh << 1) | dd) * GNC + n) * 64 + d] = ((const LAS float*)(F.lds + G_DEC))[dd * 64 + d]; }
}
__device__ __forceinline__ void gla_passB(Frame& F, unsigned char* wsl) {
    const bf16_t* KVT = (const bf16_t*)(wsl + WS_KVT); const float* DEC = (const float*)(wsl + WS_DEC); bf16_t* SPT = (bf16_t*)(wsl + WS_SPT);
    const int t0 = blockIdx.x * 512 + F.tid, tstride = F.G * 512;
    for (int t = t0; t < 64 * 4096; t += 2 * tstride) {
        const int tb = t + tstride; const bool hasb = tb < 64 * 4096; const int t2 = hasb ? tb : t;
        const int chA = t >> 12, remA = t & 4095, dvA = remA >> 5, dkA = (remA & 31) * 2, dirA = chA & 1;
        const int chB = t2 >> 12, remB = t2 & 4095, dvB = remB >> 5, dkB = (remB & 31) * 2, dirB = chB & 1;
        float a0 = 0.f, a1 = 0.f, b0 = 0.f, b1 = 0.f;
#pragma unroll 11
        for (int st = 0; st < GNC; ++st) { const int nA = dirA ? GNC - 1 - st : st, nB = dirB ? GNC - 1 - st : st;
            const size_t oA = (((size_t)chA * GNC + nA) * 128 + dvA) * 64 + dkA, oB = (((size_t)chB * GNC + nB) * 128 + dvB) * 64 + dkB;
            *(unsigned*)(SPT + oA) = pk2(a0, a1); if (hasb) *(unsigned*)(SPT + oB) = pk2(b0, b1);
            const unsigned kva_ = *(const unsigned*)(KVT + oA); const f32x2 kvA = (f32x2){__builtin_bit_cast(float, kva_ << 16), __builtin_bit_cast(float, kva_ & 0xffff0000u)}, dcA = *(const f32x2*)(DEC + ((size_t)chA * GNC + nA) * 64 + dkA);
            const unsigned kvb_ = *(const unsigned*)(KVT + oB); const f32x2 kvB = (f32x2){__builtin_bit_cast(float, kvb_ << 16), __builtin_bit_cast(float, kvb_ & 0xffff0000u)}, dcB = *(const f32x2*)(DEC + ((size_t)chB * GNC + nB) * 64 + dkB);
            a0 = dcA[0] * a0 + kvA[0]; a1 = dcA[1] * a1 + kvA[1]; b0 = dcB[0] * b0 + kvB[0]; b1 = dcB[1] * b1 + kvB[1]; }
    }
}
__device__ __forceinline__ void gla_passC_item(Frame& F, int item, int l, unsigned char* wsl) {
    constexpr int C_QD = 0, C_KI = 18432, C_SP = 36864, C_VT = 73728, C_PART = 92160, C_OS = 0, RB = GS * 2, OSS = 132;
    const int n = item % GNC, bh = item / GNC, b = bh >> 2, h = bh & 3;
    const int w = F.wave, tid = opaque_v(F.tid), lane = tid & 63, cb = w >> 2, dvb = w & 3, r = lane & 31, hh = lane >> 5;
    const bf16_t* gqk = (const bf16_t*)(wsl + WS_GQK) + (size_t)item * 4 * 4096;
    const bf16_t* gvt = (const bf16_t*)(wsl + WS_GVT) + (size_t)item * 8192;
    const bf16_t* spt0 = (const bf16_t*)(wsl + WS_SPT) + ((size_t)((bh << 1) | 0) * GNC + n) * 128 * 64;
    const bf16_t* spt1 = (const bf16_t*)(wsl + WS_SPT) + ((size_t)((bh << 1) | 1) * GNC + n) * 128 * 64;
    const bf16_t* U = (const bf16_t*)(wsl + WS_U); bf16_t* Y = (bf16_t*)(wsl + WS_Y);
    u32x4 raw[10], rgr[2];
#pragma unroll
    for (int it = 0; it < 4; ++it) raw[it] = *(const u32x4*)(gqk + it * 4096 + tid * 8);
    raw[4] = *(const u32x4*)(spt0 + tid * 8); raw[5] = *(const u32x4*)(spt0 + 4096 + tid * 8); raw[6] = *(const u32x4*)(spt1 + tid * 8); raw[7] = *(const u32x4*)(spt1 + 4096 + tid * 8);
    raw[8] = *(const u32x4*)(gvt + tid * 8); raw[9] = *(const u32x4*)(gvt + 4096 + tid * 8);
#pragma unroll
    for (int it = 0; it < 2; ++it) { const int e = it * 512 + tid, pos = e >> 4, p = 64 * n - 48 + pos;
        rgr[it] = *(const u32x4*)(U + ((size_t)b * L + max(p, 0)) * INC + O_AR + h * 128 + 8 * (e & 15)); }
    const float gv = (kin(10) + l * 512 + h * 128 + 32 * dvb)[r];
    { const int row = tid >> 3, pc = tid & 7; LAS unsigned char* dst = F.lds + row * RB + pc * 16;
      *(LAS u32x4*)(dst + C_QD) = raw[0]; *(LAS u32x4*)(dst + C_KI) = raw[1]; *(LAS u32x4*)(dst + C_QD + 64 * RB) = raw[2]; *(LAS u32x4*)(dst + C_KI + 64 * RB) = raw[3];
      *(LAS u32x4*)(dst + C_SP) = raw[4]; *(LAS u32x4*)(dst + C_SP + 64 * RB) = raw[5]; *(LAS u32x4*)(dst + C_SP + 128 * RB) = raw[6]; *(LAS u32x4*)(dst + C_SP + 192 * RB) = raw[7];
      *(LAS u32x4*)(dst + C_VT) = raw[8]; *(LAS u32x4*)(dst + C_VT + 64 * RB) = raw[9]; }
    __syncthreads();
    f32x16 o;
#pragma unroll
    for (int i = 0; i < 16; ++i) o[i] = 0.f;
    const LAS unsigned char* fb = F.lds + r * RB + 16 * hh;
    const LAS unsigned char* vb = F.lds + C_VT + (32 * dvb + r) * RB + 8 * hh;
#pragma unroll
    for (int dir = 0; dir < 2; ++dir) {
        bf16x8 qf[4];
#pragma unroll
        for (int ks = 0; ks < 4; ++ks) qf[ks] = *(const LAS bf16x8*)(fb + C_QD + (dir * 64 + 32 * cb) * RB + 32 * ks);
#pragma unroll
        for (int sb = 0; sb < 2; ++sb) {
            f32x16 X;
#pragma unroll
            for (int i = 0; i < 16; ++i) X[i] = 0.f;
#pragma unroll
            for (int ks = 0; ks < 4; ++ks) X = MFMA32(*(const LAS bf16x8*)(fb + C_KI + (dir * 64 + 32 * sb) * RB + 32 * ks), qf[ks], X);
            const int cidx = 32 * cb + r;
#pragma unroll
            for (int i = 0; i < 16; ++i) { const int sidx = 32 * sb + crow16(i, hh); const bool keep = dir ? (sidx > cidx) : (sidx <= cidx); X[i] = keep ? X[i] : 0.f; }
#pragma unroll
            for (int ks2 = 0; ks2 < 2; ++ks2) {
                u32x4 xp; xp.x = pk2(X[8 * ks2 + 0], X[8 * ks2 + 1]); xp.y = pk2(X[8 * ks2 + 2], X[8 * ks2 + 3]); xp.z = pk2(X[8 * ks2 + 4], X[8 * ks2 + 5]); xp.w = pk2(X[8 * ks2 + 6], X[8 * ks2 + 7]);
                const s16x4 vlo = *(const LAS s16x4*)(vb + (32 * sb + 16 * ks2) * 2), vhi = *(const LAS s16x4*)(vb + (32 * sb + 16 * ks2 + 8) * 2);
                o = MFMA32(__builtin_bit_cast(bf16x8, xp), __builtin_shufflevector(vlo, vhi, 0, 1, 2, 3, 4, 5, 6, 7), o);
            }
        }
#pragma unroll
        for (int ks = 0; ks < 4; ++ks) o = MFMA32(qf[ks], *(const LAS bf16x8*)(fb + C_SP + (dir * 128 + 32 * dvb) * RB + 32 * ks), o);
    }
    LAS float* part = (LAS float*)(F.lds + C_PART);
#pragma unroll
    for (int i = 0; i < 16; ++i) { float q = o[i] * o[i];
        q = row_shr_add<1>(q); q = row_shr_add<2>(q); q = row_shr_add<4>(q); q = row_shr_add<8>(q);
        const int qi = __builtin_bit_cast(int, q);
        const float s0 = __builtin_bit_cast(float, __builtin_amdgcn_readlane(qi, 15)) + __builtin_bit_cast(float, __builtin_amdgcn_readlane(qi, 31));
        const float s1 = __builtin_bit_cast(float, __builtin_amdgcn_readlane(qi, 47)) + __builtin_bit_cast(float, __builtin_amdgcn_readlane(qi, 63));
        if (r == 0) part[(cb * 4 + dvb) * 32 + crow16(i, hh)] = hh ? s1 : s0; }
    __syncthreads();
    LAS float* os = (LAS float*)(F.lds + C_OS);
#pragma unroll
    for (int i = 0; i < 16; ++i) { const int rw = crow16(i, hh);
        const float ss = (part[(cb * 4 + 0) * 32 + rw] + part[(cb * 4 + 1) * 32 + rw]) + (part[(cb * 4 + 2) * 32 + rw] + part[(cb * 4 + 3) * 32 + rw]);
        const float rs = rsqrtf(ss * (1.0f / 128.0f) + 1e-6f);
        os[(32 * cb + rw) * OSS + 32 * dvb + r] = o[i] * rs * gv; }
    __syncthreads();
#pragma unroll
    for (int it = 0; it < 2; ++it) { const int e = it * 512 + tid, pos = e >> 4, dv0 = 8 * (e & 15), p = 64 * n - 48 + pos;
        if (p >= 0) { const f32x4 a0 = *(const LAS f32x4*)(os + pos * OSS + dv0), a1 = *(const LAS f32x4*)(os + pos * OSS + dv0 + 4); const u32x4 g = rgr[it]; float y[8];
#pragma unroll
            for (int j = 0; j < 4; ++j) { const float g0 = __builtin_bit_cast(float, g[j] << 16), g1 = __builtin_bit_cast(float, g[j] & 0xffff0000u);
                const float x0 = j < 2 ? a0[2 * j] : a1[2 * j - 4], x1 = j < 2 ? a0[2 * j + 1] : a1[2 * j - 3];
                y[2 * j] = x0 * (g0 / (1.0f + __expf(-g0))); y[2 * j + 1] = x1 * (g1 / (1.0f + __expf(-g1))); }
            u32x4 wv; wv.x = pk2(y[0], y[1]); wv.y = pk2(y[2], y[3]); wv.z = pk2(y[4], y[5]); wv.w = pk2(y[6], y[7]);
            *(u32x4*)(Y + ((size_t)b * L + p) * D + h * 128 + dv0) = wv; } }
}

constexpr int SW_KS = 136, SW_VS = 40;
constexpr int SW_K = 0, SW_V = 2 * 2 * 32 * SW_KS * 2;
constexpr int SW_PART = SW_V + 2 * 2 * 128 * SW_VS * 2;
constexpr int SW_OS = 1032;
__device__ __forceinline__ void swa_item(Frame& F, int item, int l, unsigned char* wsl) {
    const bf16_t* U = (const bf16_t*)(wsl + WS_U); bf16_t* Y = (bf16_t*)(wsl + WS_Y);
    const int qb = item % 65, b = item / 65, q0 = 32 * qb, tid = opaque_v(F.tid), lane = tid & 63, w = F.wave, r = lane & 31, hh = lane >> 5;
    const int head = w, kvh = w >> 2, qp = q0 + r;
    const float slope = exp2f(-(float)(head + 1));
    const float sk = (kin(11) + l * 8)[head];
    bf16x8 Qf[8];
    { const bf16_t* qrow = U + ((size_t)b * L + min(qp, L - 1)) * INC + O_BQ + head * 128;
#pragma unroll
      for (int ks = 0; ks < 8; ++ks) Qf[ks] = *(const bf16x8*)(qrow + 16 * ks + 8 * hh); }
    f32x16 O[4];
#pragma unroll
    for (int db = 0; db < 4; ++db)
#pragma unroll
        for (int i = 0; i < 16; ++i) O[db][i] = 0.f;
    const float sc2 = 0.08838834764831845f * 1.4426950408889634f, slope2 = slope * 1.4426950408889634f;
    float m = sk * 1.4426950408889634f, lsum = hh == 0 ? 1.0f : 0.0f;
    const int tlo = max(1, qb - 4), thi = min(64, qb + 4), ntile = 1 + (thi - tlo + 1), nch = (ntile + 1) >> 1;
    LAS bf16_t* Ks = (LAS bf16_t*)(F.lds + SW_K); LAS bf16_t* Vs = (LAS bf16_t*)(F.lds + SW_V);
    u32x4 kx[2][4], vx[2][4];
#define SWA_FETCH(chn, par_) do { _Pragma("unroll") for (int it = 0; it < 4; ++it) { const int e = it * 512 + tid; const int key = e & 31, d8 = (e >> 5) & 15, kv2 = (e >> 9) & 1, sl_ = e >> 10; \
            const int ti_ = (chn) * 2 + sl_; const int tl_ = ti_ == 0 ? 0 : tlo + ti_ - 1; const int kp_ = min(32 * tl_ + key, L - 1); const bf16_t* krow = U + ((size_t)b * L + kp_) * INC; \
            const int kkey_ = (e >> 4) & 31, kd8_ = e & 15; const bf16_t* krow2 = U + ((size_t)b * L + min(32 * tl_ + kkey_, L - 1)) * INC;        \
            kx[par_][it] = *(const u32x4*)(krow2 + O_BK + kv2 * 128 + 8 * kd8_); vx[par_][it] = *(const u32x4*)(krow + O_BV + kv2 * 128 + 8 * d8); } } while (0)
    SWA_FETCH(0, 0);
    if (nch > 1) SWA_FETCH(1, 1);
    for (int c2 = 0; c2 < nch; c2 += 2) {
#pragma unroll
      for (int par = 0; par < 2; ++par) {
        const int ch = c2 + par; if (ch >= nch) break;
        __syncthreads();
#pragma unroll
        for (int it = 0; it < 4; ++it) { const int e = it * 512 + tid; const int key = e & 31, d8 = (e >> 5) & 15, kv2 = (e >> 9) & 1, sl = e >> 10;
            *(LAS u32x4*)(Ks + ((sl * 2 + kv2) * 32 + ((e >> 4) & 31)) * SW_KS + 8 * (e & 15)) = kx[par][it];
            LAS bf16_t* vb = Vs + ((sl * 2 + kv2) * 128 + 8 * d8) * SW_VS + key;
#pragma unroll
            for (int j = 0; j < 4; ++j) { vb[(2 * j) * SW_VS] = (bf16_t)(vx[par][it][j] & 0xffffu); vb[(2 * j + 1) * SW_VS] = (bf16_t)(vx[par][it][j] >> 16); } }
        if (ch + 2 < nch) SWA_FETCH(ch + 2, par);
        __syncthreads();
#pragma unroll 1
        for (int sl = 0; sl < 2; ++sl) {
            const int ti = ch * 2 + sl; if (ti >= ntile) break;
            const int tl = ti == 0 ? 0 : tlo + ti - 1, kp0 = 32 * tl;
            f32x16 S;
#pragma unroll
            for (int i = 0; i < 16; ++i) S[i] = 0.f;
            const LAS bf16_t* kt = Ks + ((sl * 2 + kvh) * 32 + r) * SW_KS + 8 * hh;
#pragma unroll
            for (int ks = 0; ks < 8; ++ks) { const bf16x8 a = *(const LAS bf16x8*)(kt + 16 * ks); S = MFMA32(a, Qf[ks], S); }
            float mx = -1e30f;
            const float fb = (float)(qp - kp0 - 4 * hh);
            if (tl != 0 && abs(qb - tl) <= 3 && tl < 64) {
#pragma unroll
                for (int i = 0; i < 16; ++i) { const float dist = fabsf(fb - (float)((i & 3) + 8 * (i >> 2))); const float sv = S[i] * sc2 - slope2 * dist; S[i] = sv; mx = fmaxf(mx, sv); }
            } else {
#pragma unroll
                for (int i = 0; i < 16; ++i) { const int kp = kp0 + crow16(i, hh); const float dist = fabsf(fb - (float)((i & 3) + 8 * (i >> 2)));
                    const bool ok = (tl == 0) ? (kp < NMETA || dist <= 128.f) : (kp < L && dist <= 128.f);
                    const float sv = ok ? S[i] * sc2 - slope2 * dist : -1e30f; S[i] = sv; mx = fmaxf(mx, sv); }
            }
            mx = fmaxf(mx, xor32(mx));
            float mn = m, alpha = 1.0f;
            if (__builtin_amdgcn_ballot_w64(mx - m > 8.0f) != 0ull) { mn = fmaxf(m, mx); alpha = __builtin_amdgcn_exp2f(m - mn); m = mn; }
            float ps = 0.f;
#pragma unroll
            for (int i = 0; i < 16; ++i) { const float pv = __builtin_amdgcn_exp2f(S[i] - mn); S[i] = pv; ps += pv; }
            lsum = lsum * alpha + ps;
            if (__builtin_amdgcn_ballot_w64(alpha != 1.0f) != 0ull) {
#pragma unroll
                for (int db = 0; db < 4; ++db)
#pragma unroll
                    for (int i = 0; i < 16; ++i) O[db][i] *= alpha; }
            const LAS bf16_t* vt = Vs + ((sl * 2 + kvh) * 128 + r) * SW_VS + 4 * hh;
#pragma unroll
            for (int ks2 = 0; ks2 < 2; ++ks2) {
                u32x4 xp; xp.x = pk2(S[8 * ks2 + 0], S[8 * ks2 + 1]); xp.y = pk2(S[8 * ks2 + 2], S[8 * ks2 + 3]); xp.z = pk2(S[8 * ks2 + 4], S[8 * ks2 + 5]); xp.w = pk2(S[8 * ks2 + 6], S[8 * ks2 + 7]);
                const bf16x8 pb = __builtin_bit_cast(bf16x8, xp);
#pragma unroll
                for (int db = 0; db < 4; ++db) {
                    const s16x4 lo = *(const LAS s16x4*)(vt + (32 * db) * SW_VS + 16 * ks2), hi = *(const LAS s16x4*)(vt + (32 * db) * SW_VS + 16 * ks2 + 8);
                    O[db] = MFMA32(__builtin_shufflevector(lo, hi, 0, 1, 2, 3, 4, 5, 6, 7), pb, O[db]); }
            }
        }
      }
    }
#undef SWA_FETCH
    const float lt = lsum + xor32(lsum), inv = 1.0f / lt;
    float ss = 0.f;
#pragma unroll
    for (int db = 0; db < 4; ++db)
#pragma unroll
        for (int i = 0; i < 16; ++i) { O[db][i] *= inv; ss += O[db][i] * O[db][i]; }
    ss += xor32(ss);
    __syncthreads();
    LAS float* part = (LAS float*)(F.lds + SW_PART); LAS bf16_t* os = (LAS bf16_t*)F.lds;
    if (hh == 0) part[w * 32 + r] = ss;
#pragma unroll
    for (int db = 0; db < 4; ++db)
#pragma unroll
        for (int g = 0; g < 4; ++g) { u32x2 pk; pk.x = pk2(O[db][4 * g], O[db][4 * g + 1]); pk.y = pk2(O[db][4 * g + 2], O[db][4 * g + 3]);
            *(LAS u32x2*)(os + r * SW_OS + w * 128 + 32 * db + 8 * g + 4 * hh) = pk; }
    __syncthreads();
    { const int q = tid >> 4, pc = tid & 15, p = q0 + q;
      if (p < L) { float tot = 0.f;
#pragma unroll
          for (int ww = 0; ww < 8; ++ww) tot += part[ww * 32 + q];
          const float rs = rsqrtf(tot * (1.0f / 1024.0f) + 1e-6f); const LAS float* sg = (const LAS float*)(F.lds + MIXC_SG); bf16_t* yrow = Y + ((size_t)b * L + p) * D + 512;
#pragma unroll
          for (int k = 0; k < 8; ++k) { const int c = 8 * pc + 128 * k; const u32x4 v = *(const LAS u32x4*)(os + q * SW_OS + c);
              const f32x4 g0 = *(const LAS f32x4*)(sg + c), g1 = *(const LAS f32x4*)(sg + c + 4); u32x4 o;
              o.x = pk2(__builtin_bit_cast(float, v.x << 16) * rs * g0[0], __builtin_bit_cast(float, v.x & 0xffff0000u) * rs * g0[1]);
              o.y = pk2(__builtin_bit_cast(float, v.y << 16) * rs * g0[2], __builtin_bit_cast(float, v.y & 0xffff0000u) * rs * g0[3]);
              o.z = pk2(__builtin_bit_cast(float, v.z << 16) * rs * g1[0], __builtin_bit_cast(float, v.z & 0xffff0000u) * rs * g1[1]);
              o.w = pk2(__builtin_bit_cast(float, v.w << 16) * rs * g1[2], __builtin_bit_cast(float, v.w & 0xffff0000u) * rs * g1[3]);
              *(u32x4*)(yrow + c) = o; } } }
}

__device__ __forceinline__ float logsigmoidf_(float x) { return fminf(x, 0.f) - log1pf(expf(-fabsf(x))); }

__device__ __forceinline__ int q_publish(Frame& F, int fetched) {
    LAS int* slot = (LAS int*)(F.lds + LDSCTL_OFF + 512);
    __syncthreads();
    if (F.tid == 0) *slot = fetched;
    __syncthreads();
    return *slot;
}
__device__ __forceinline__ void p_mix1(Frame& F, int l) {
    unsigned char* const wsl = launder_ws(F.ws);
    unsigned* const qw = (unsigned*)(wsl + WS_CTL) + CW_Q + (l * 4 + 0) * 64;
    constexpr int N_SWA = NB * 65, N_GLA = NB * 4 * GNC, N_HP = NB * 33 * 4, N_ALL = N_SWA + N_GLA + N_HP;
    int fetched = 0;
    if (F.tid == 0) fetched = (int)atomicAdd(qw, 1u);
    { const float* sgg = kin(12) + l * 1024; const float* cwg = kin(13) + (size_t)l * 3 * 1536; const float* cbg = kin(14) + l * 1536;
      if (F.tid < 256) *(LAS f32x4*)(F.lds + MIXC_SG + 16 * F.tid) = ((const f32x4*)sgg)[F.tid];
      for (int e = F.tid; e < 1152; e += 512) *(LAS f32x4*)(F.lds + MIXC_CW + 16 * e) = ((const f32x4*)cwg)[e];
      if (F.tid < 384) *(LAS f32x4*)(F.lds + MIXC_CB + 16 * F.tid) = ((const f32x4*)cbg)[F.tid]; }
    int u = q_publish(F, fetched);
    while (u < N_ALL) {
        if (F.tid == 0) fetched = (int)atomicAdd(qw, 1u);
        if (u < N_SWA) swa_item(F, u, l, wsl);
        else if (u < N_SWA + N_GLA) gla_passA_item(F, u - N_SWA, l, wsl);
        else hy_pre_item(F, u - N_SWA - N_GLA, l, wsl);
        u = q_publish(F, fetched);
    }
    __syncthreads();
}

__device__ __forceinline__ void p_mix2(Frame& F, int l) {
    unsigned char* const wsl = launder_ws(F.ws);
    gla_passB(F, wsl);
    hy_conv_phase(F, l, wsl);
}

__device__ __forceinline__ void p_mix3(Frame& F, int l) {
    unsigned char* const wsl = launder_ws(F.ws);
    unsigned* const qw = (unsigned*)(wsl + WS_CTL) + CW_Q + (l * 4 + 2) * 64;
    constexpr int N_GC = NB * 4 * GNC, N_HN = NB * 33, N_ALL = N_GC + N_HN;
    int fetched = 0;
    if (F.tid == 0) fetched = (int)atomicAdd(qw, 1u);
    if (F.tid < 128) *(LAS f32x4*)(F.lds + MIXC_HG + 16 * F.tid) = ((const f32x4*)(kin(22) + l * 512))[F.tid];
    int u = q_publish(F, fetched);
    while (u < N_ALL) {
        if (F.tid == 0) fetched = (int)atomicAdd(qw, 1u);
        if (u < N_HN) hy_norm_item(F, u, l, wsl);
        else gla_passC_item(F, u - N_HN, l, wsl);
        u = q_publish(F, fetched);
    }
    __syncthreads();
}

constexpr int R_RS = 2056;
constexpr int R_AH = 0, R_AL = 8 * R_RS * 2, R_PART = 2 * 8 * R_RS * 2, R_LG = R_PART + 8 * 8 * 32 * 4, R_LCNT = R_LG + 1024, R_REC = R_LCNT + 128;
template <bool DUMMY>
__device__ __forceinline__ void p_ln1_router(Frame& F, int l) {
    unsigned char* const wsl = launder_ws(F.ws); unsigned* const ctl = (unsigned*)(wsl + WS_CTL);
    const bf16_t* MX = (const bf16_t*)(wsl + WS_R1); const bf16_t* hin = (const bf16_t*)(wsl + WS_HB); bf16_t* h = (bf16_t*)(wsl + (DUMMY ? WS_DUM : WS_HB)); unsigned char* hb = wsl + (DUMMY ? WS_DUM + (size_t)T * D * 4 : WS_HB8);
    int* cnt = (int*)(ctl + CW_CNT + l * 512 + (DUMMY ? 256 : 0)); int* list = (int*)(wsl + (DUMMY ? WS_DUM + (size_t)T * D * 6 : WS_LIST));
    int* tok_e = (int*)(wsl + (DUMMY ? WS_DUM + (size_t)T * D * 6 + (size_t)NEXP * T * 4 : WS_TOKE)); int* tok_p = tok_e + (DUMMY ? 2 * T : (WS_TOKP - WS_TOKE) / 4); float* tok_w = (float*)(tok_e + (DUMMY ? 4 * T : (WS_TOKW - WS_TOKE) / 4));
    const LAS float* g = (const LAS float*)(F.lds + 81920); const LAS float* bt = g + D;
    { const float* gg = kin(25) + (size_t)l * D; const float* gb = kin(26) + (size_t)l * D; *(LAS f32x4*)(F.lds + 81920 + 16 * F.tid) = ((const f32x4*)gg)[F.tid]; *(LAS f32x4*)(F.lds + 81920 + 8192 + 16 * F.tid) = ((const f32x4*)gb)[F.tid]; }
    const LAS float* be = (const LAS float*)(F.lds + 81920 + 16384); const LAS float* bg = be + 16;
    if (F.tid < 16) ((LAS float*)(F.lds + 81920 + 16384))[F.tid] = (kin(30) + l * 16)[F.tid]; else if (F.tid < 20) ((LAS float*)(F.lds + 81920 + 16384))[F.tid] = (kin(28) + l * 4)[F.tid - 16];
    const bf16_t* wr = (const bf16_t*)(wsl + WS_WR) + (size_t)l * 256 * 512;
    const int lane = opaque_v(F.lane), w = F.wave, n = lane & 15, kg = lane >> 4;
    LAS bf16_t* AH = (LAS bf16_t*)(F.lds + R_AH); LAS bf16_t* AL = (LAS bf16_t*)(F.lds + R_AL); LAS float* PART = (LAS float*)(F.lds + R_PART); LAS float* LG = (LAS float*)(F.lds + R_LG);
    constexpr int NGRP = T / 8;
    bf16x8 wfr[8][4];
#pragma unroll
    for (int si = 0; si < 8; ++si) { const bf16_t* wp = wr + ((size_t)(8 * w + si) * 4 * 64 + lane) * 8;
#pragma unroll
        for (int q = 0; q < 4; ++q) wfr[si][q] = *(const bf16x8*)(wp + 512 * q); }
    LAS int* lcnt = (LAS int*)(F.lds + R_LCNT); LAS int* rec = (LAS int*)(F.lds + R_REC);
    if (F.tid < 32) lcnt[F.tid] = 0;
    int nloc = 0;
    f32x4 v[8];
    u32x2 hxr[8], mxr[8];
    int gi = F.vcu;
    if (gi < NGRP) {
#pragma unroll
        for (int j = 0; j < 8; ++j) { hxr[j] = ((const u32x2*)(hin + (size_t)(8 * gi + w) * D))[lane + 64 * j]; mxr[j] = ((const u32x2*)(MX + (size_t)(8 * gi + w) * D))[lane + 64 * j]; } }
    __syncthreads();
    for (; gi < NGRP; gi += F.G) {
        const int row = 8 * gi + w;
#pragma unroll
        for (int j = 0; j < 8; ++j) { const u32x2 hx = hxr[j], mx = j < 4 ? mxr[j] : ((const u32x2*)(MX + (size_t)row * D))[lane + 64 * j];
            v[j] = (f32x4){__builtin_bit_cast(float, hx.x << 16), __builtin_bit_cast(float, hx.x & 0xffff0000u), __builtin_bit_cast(float, hx.y << 16), __builtin_bit_cast(float, hx.y & 0xffff0000u)} * ALPHA
                 + (f32x4){__builtin_bit_cast(float, mx.x << 16), __builtin_bit_cast(float, mx.x & 0xffff0000u), __builtin_bit_cast(float, mx.y << 16), __builtin_bit_cast(float, mx.y & 0xffff0000u)}; }
        ln_wave_store<true>(v, g, bt, h + (size_t)row * D, hb + (size_t)row * D, nullptr, lane);
#pragma unroll
        for (int j = 0; j < 8; ++j) { const unsigned h01 = pk2(v[j][0], v[j][1]), h23 = pk2(v[j][2], v[j][3]);
            const unsigned l01 = pk2(v[j][0] - __builtin_bit_cast(float, h01 << 16), v[j][1] - __builtin_bit_cast(float, h01 & 0xffff0000u)), l23 = pk2(v[j][2] - __builtin_bit_cast(float, h23 << 16), v[j][3] - __builtin_bit_cast(float, h23 & 0xffff0000u));
            *(LAS u32x2*)(AH + w * R_RS + (lane + 64 * j) * 4) = (u32x2){h01, h23};
            *(LAS u32x2*)(AL + w * R_RS + (lane + 64 * j) * 4) = (u32x2){l01, l23}; }
        asm volatile("" ::: "memory");
        { const int gn = gi + F.G;
          if (gn < NGRP) {
#pragma unroll
            for (int j = 0; j < 8; ++j) { hxr[j] = ((const u32x2*)(hin + (size_t)(8 * gn + w) * D))[lane + 64 * j]; if (j < 4) mxr[j] = ((const u32x2*)(MX + (size_t)(8 * gn + w) * D))[lane + 64 * j]; } } }
        __syncthreads();
        f32x4 a0 = (f32x4){0.f, 0.f, 0.f, 0.f}, a1 = (f32x4){0.f, 0.f, 0.f, 0.f};
        { const LAS bf16_t* ah = AH + (n & 7) * R_RS + 8 * kg; const LAS bf16_t* al = AL + (n & 7) * R_RS + 8 * kg;
#pragma unroll
          for (int si = 0; si < 8; ++si) { const int st = 8 * w + si;
              const bf16x8 xh = *(const LAS bf16x8*)(ah + 32 * st), xl = *(const LAS bf16x8*)(al + 32 * st);
              const bf16x8 bh0 = wfr[si][0], bl0 = wfr[si][1], bh1 = wfr[si][2], bl1 = wfr[si][3];
              a0 = __builtin_amdgcn_mfma_f32_16x16x32_bf16(xh, bh0, a0, 0, 0, 0); a0 = __builtin_amdgcn_mfma_f32_16x16x32_bf16(xh, bl0, a0, 0, 0, 0); a0 = __builtin_amdgcn_mfma_f32_16x16x32_bf16(xl, bh0, a0, 0, 0, 0);
              a1 = __builtin_amdgcn_mfma_f32_16x16x32_bf16(xh, bh1, a1, 0, 0, 0); a1 = __builtin_amdgcn_mfma_f32_16x16x32_bf16(xh, bl1, a1, 0, 0, 0); a1 = __builtin_amdgcn_mfma_f32_16x16x32_bf16(xl, bh1, a1, 0, 0, 0);
              if (si == 3) __builtin_amdgcn_sched_barrier(0); } }
        if (kg < 2) {
#pragma unroll
            for (int r = 0; r < 4; ++r) { PART[(w * 8 + 4 * kg + r) * 32 + n] = a0[r]; PART[(w * 8 + 4 * kg + r) * 32 + 16 + n] = a1[r]; } }
        __syncthreads();
        if (lane < 32) { float sacc = 0.f;
#pragma unroll
            for (int ww = 0; ww < 8; ++ww) sacc += PART[(ww * 8 + w) * 32 + lane];
            LG[w * 32 + lane] = sacc; }
        LDS_WAIT();
        if (lane == 0) {
            const f32x4 l0 = *(const LAS f32x4*)(LG + w * 32), l1 = *(const LAS f32x4*)(LG + w * 32 + 4), l2 = *(const LAS f32x4*)(LG + w * 32 + 8), l3 = *(const LAS f32x4*)(LG + w * 32 + 12), l4 = *(const LAS f32x4*)(LG + w * 32 + 16);
            float gl[4];
#pragma unroll
            for (int j = 0; j < 4; ++j) gl[j] = l0[j] + bg[j];
            int gsel = 0; float gm = gl[0];
#pragma unroll
            for (int j = 1; j < 4; ++j) if (gl[j] > gm) { gm = gl[j]; gsel = j; }
            float den = 0.f;
#pragma unroll
            for (int j = 0; j < 4; ++j) den += expf(gl[j] - gm);
            const float gtop = 1.0f / den;
            float el[4];
            const float k0 = gsel == 0 ? 1.f : 0.f, k1 = gsel == 1 ? 1.f : 0.f, k2 = gsel == 2 ? 1.f : 0.f, k3 = gsel == 3 ? 1.f : 0.f;
#pragma unroll
            for (int j = 0; j < 4; ++j) el[j] = (k0 * l1[j] + k1 * l2[j]) + (k2 * l3[j] + k3 * l4[j]) + be[gsel * 4 + j];
            int i1 = 0; float m1 = el[0];
#pragma unroll
            for (int j = 1; j < 4; ++j) if (el[j] > m1) { m1 = el[j]; i1 = j; }
            int i2 = -1; float m2 = -3.0e38f;
#pragma unroll
            for (int j = 0; j < 4; ++j) if (j != i1 && el[j] > m2) { m2 = el[j]; i2 = j; }
            const float ex = expf(m2 - m1); const float w1 = gtop / (1.0f + ex), w2 = gtop * ex / (1.0f + ex);
            const int e1 = gsel * 4 + i1, e2 = gsel * 4 + i2;
            const int li1 = __hip_atomic_fetch_add(lcnt + e1, 1, __ATOMIC_RELAXED, __HIP_MEMORY_SCOPE_WORKGROUP), li2 = __hip_atomic_fetch_add(lcnt + e2, 1, __ATOMIC_RELAXED, __HIP_MEMORY_SCOPE_WORKGROUP);
            const int k = nloc * 8 + w; rec[4 * k] = row; rec[4 * k + 1] = e1 | (e2 << 8); rec[4 * k + 2] = li1; rec[4 * k + 3] = li2;
            tok_e[2 * row] = e1; tok_e[2 * row + 1] = e2; tok_w[2 * row] = w1; tok_w[2 * row + 1] = w2;
        }
        ++nloc;
    }
    __syncthreads();
    if (F.tid < 16) { const int c = lcnt[F.tid]; lcnt[16 + F.tid] = c ? atomicAdd(&cnt[16 * F.tid], c) : 0; }
    __syncthreads();
    if (F.tid < nloc * 8) { const int row = rec[4 * F.tid], ee = rec[4 * F.tid + 1], e1 = ee & 255, e2 = ee >> 8;
        const int p1 = lcnt[16 + e1] + rec[4 * F.tid + 2], p2 = lcnt[16 + e2] + rec[4 * F.tid + 3];
        list[(size_t)e1 * T + p1] = row; list[(size_t)e2 * T + p2] = row; tok_p[2 * row] = p1; tok_p[2 * row + 1] = p2; }
    __syncthreads();
}

__device__ __forceinline__ void moe_table(Frame& F, int l) {
    LAS int* tab = (LAS int*)(F.lds + LDSCTL_OFF + 256);
    unsigned* const ctl = (unsigned*)(launder_ws(F.ws) + WS_CTL);
    const int* cnt = (const int*)(ctl + CW_CNT + l * 512);
    __syncthreads();
    if (F.tid < 16) tab[F.tid] = __hip_atomic_load(cnt + 16 * F.tid, __ATOMIC_RELAXED, __HIP_MEMORY_SCOPE_AGENT);
    __syncthreads();
    if (F.tid == 0) { int pp = 0;
        for (int e = 0; e < 16; ++e) { const int c = tab[e]; tab[16 + e] = pp; tab[33 + e] = pp * 256; pp += (c + 255) >> 8; }
        tab[32] = pp; }
    __syncthreads();
}

template <bool DUMMY>
__device__ __forceinline__ void p_ln2(Frame& F, int l) {
    unsigned char* const wsl = launder_ws(F.ws);
    bf16_t* hb = (bf16_t*)(wsl + WS_HB); const unsigned char* O = (const unsigned char*)(wsl + WS_O);
    const int* tok_e = (const int*)(wsl + WS_TOKE); const int* tok_p = (const int*)(wsl + WS_TOKP); const float* tok_w = (const float*)(wsl + WS_TOKW);
    const LAS int* tab = (const LAS int*)(F.lds + LDSCTL_OFF + 256);
    const LAS float* g = (const LAS float*)(F.lds + 65536); const LAS float* bt = g + D;
    { const float* gg = kin(34) + (size_t)l * D; const float* gb = kin(35) + (size_t)l * D; *(LAS f32x4*)(F.lds + 65536 + 16 * F.tid) = ((const f32x4*)gg)[F.tid]; *(LAS f32x4*)(F.lds + 65536 + 8192 + 16 * F.tid) = ((const f32x4*)gb)[F.tid]; }
    __syncthreads();
    const int gw = F.vcu * 8 + F.wave, NGW = F.G * 8, lane = opaque_v(F.lane);
    u32x2 hv[8]; int oa[8], ob[8]; float w0 = 0.f, w1 = 0.f;
    int te0 = 0, te1 = 0, tp0 = 0, tp1 = 0; float tw0 = 0.f, tw1 = 0.f;
    { const int rk = gw + lane * NGW; if (lane < 16 && rk < T) { te0 = tok_e[2 * rk]; te1 = tok_e[2 * rk + 1]; tp0 = tok_p[2 * rk]; tp1 = tok_p[2 * rk + 1]; tw0 = tok_w[2 * rk]; tw1 = tok_w[2 * rk + 1]; } }
    int kk = 0;
#define LN2_ISSUE(rw) do { const int e0_ = __builtin_amdgcn_readlane(te0, kk), e1_ = __builtin_amdgcn_readlane(te1, kk); \
        const size_t r0_ = (size_t)(tab[33 + e0_] + __builtin_amdgcn_readlane(tp0, kk)), r1_ = (size_t)(tab[33 + e1_] + __builtin_amdgcn_readlane(tp1, kk)); \
        w0 = __builtin_bit_cast(float, __builtin_amdgcn_readlane(__builtin_bit_cast(int, tw0), kk)) * (1.0f / 64.0f); w1 = __builtin_bit_cast(float, __builtin_amdgcn_readlane(__builtin_bit_cast(int, tw1), kk)) * (1.0f / 64.0f); ++kk; \
        _Pragma("unroll") for (int j = 0; j < 8; ++j) { const int i4 = lane + 64 * j; hv[j] = ((const u32x2*)(hb + (size_t)(rw) * D))[i4]; oa[j] = ((const int*)(O + r0_ * D))[i4]; ob[j] = ((const int*)(O + r1_ * D))[i4]; } } while (0)
    int row = gw;
    if (row < T) LN2_ISSUE(row);
    for (; row < T; row += NGW) {
        f32x4 v[8];
#pragma unroll
        for (int j = 0; j < 8; ++j) { f32x4 m;
            const f32x2 a01 = __builtin_amdgcn_cvt_pk_f32_fp8(oa[j], false), a23 = __builtin_amdgcn_cvt_pk_f32_fp8(oa[j], true), b01 = __builtin_amdgcn_cvt_pk_f32_fp8(ob[j], false), b23 = __builtin_amdgcn_cvt_pk_f32_fp8(ob[j], true);
            m[0] = w0 * a01[0] + w1 * b01[0]; m[1] = w0 * a01[1] + w1 * b01[1]; m[2] = w0 * a23[0] + w1 * b23[0]; m[3] = w0 * a23[1] + w1 * b23[1];
            v[j] = (f32x4){__builtin_bit_cast(float, hv[j].x << 16), __builtin_bit_cast(float, hv[j].x & 0xffff0000u), __builtin_bit_cast(float, hv[j].y << 16), __builtin_bit_cast(float, hv[j].y & 0xffff0000u)} * ALPHA + m; }
        const int nrow = row + NGW;
        if (nrow < T) LN2_ISSUE(nrow);
        float* orow = nullptr;
        if (l == DEPTH - 1) { const int bb = row / L, pp = row % L; if (pp >= NMETA) orow = kout() + ((size_t)bb * SEQ + (pp - NMETA)) * D; }
        if (DUMMY) ln_wave_store(v, g, bt, (bf16_t*)(wsl + WS_DUM) + (size_t)row * D, nullptr, nullptr, lane);
        else if (l == DEPTH - 1) ln_wave_store<false, true>(v, g, bt, nullptr, nullptr, orow, lane);
        else ln_wave_store(v, g, bt, hb + (size_t)row * D, nullptr, orow, lane);
    }
#undef LN2_ISSUE
}


__device__ __forceinline__ void outproj_tail(Frame& F, int l, unsigned char* wsl) {
    if (F.vcu >= 128) return;
    const bf16_t* Yb = (const bf16_t*)(wsl + WS_Y) + (size_t)16384 * D; const bf16_t* Wt = (const bf16_t*)(wsl + WS_WOUT) + (size_t)l * D * D + (size_t)(16 * F.vcu) * D;
    const int lane = opaque_v(F.lane), w = F.wave, n = lane & 15, kg = lane >> 4;
    f32x4 acc[8];
#pragma unroll
    for (int mb = 0; mb < 8; ++mb) acc[mb] = (f32x4){0.f, 0.f, 0.f, 0.f};
    const bf16_t* ap = Yb + (size_t)n * D + 256 * w + 8 * kg; const bf16_t* bp = Wt + (size_t)n * D + 256 * w + 8 * kg;
#pragma unroll 2
    for (int ks = 0; ks < 8; ++ks) {
        const bf16x8 bfr = *(const bf16x8*)(bp + 32 * ks);
        bf16x8 af[8];
#pragma unroll
        for (int mb = 0; mb < 8; ++mb) af[mb] = *(const bf16x8*)(ap + (size_t)(16 * mb) * D + 32 * ks);
#pragma unroll
        for (int mb = 0; mb < 8; ++mb) acc[mb] = __builtin_amdgcn_mfma_f32_16x16x32_bf16(af[mb], bfr, acc[mb], 0, 0, 0);
    }
    LAS f32x4* red = (LAS f32x4*)F.lds;
    __syncthreads();
#pragma unroll
    for (int mb = 0; mb < 8; ++mb) red[(w * 8 + mb) * 64 + lane] = acc[mb];
    __syncthreads();
    { const int mb = F.tid >> 6;
      f32x4 sacc = red[(0 * 8 + mb) * 64 + lane];
#pragma unroll
      for (int ww = 1; ww < 8; ++ww) sacc += red[(ww * 8 + mb) * 64 + lane];
      const int col = 16 * F.vcu + n; const float bias = (kin(24) + (size_t)l * D)[col];
      bf16_t* MX = (bf16_t*)(wsl + WS_R1);
#pragma unroll
      for (int r = 0; r < 4; ++r) { const size_t o = (size_t)(16384 + 16 * mb + 4 * kg + r) * D + col; MX[o] = (bf16_t)f2bf(sacc[r] + bias); } }
    __syncthreads();
}

#ifndef REP_LN
#define REP_LN 1
#endif
#ifndef REP_PRO
#define REP_PRO 1
#endif
#ifndef REP_MIX
#define REP_MIX 1
#endif
#ifndef REP_GEMM
#define REP_GEMM 1
#endif
#define IN(k) (lo <= (k) && (k) < hi)
#define SEAM(k) do { if (IN(k) && IN((k) + 1)) xcd_barrier(bar); } while (0)
template <int l>
__device__ __forceinline__ void run_layer(Frame& F, const int lo, const int hi, const XcdBarrier& bar) {
        const int P = 1 + l * NPH;
        if (IN(P + 0)) {
            unsigned char* const wsl = launder_ws(F.ws);
            pg::PlainSched S; S.init(MPAD / 256, INCP / 256, F.G, (int)blockIdx.x);
            pg::EpiInProj E{(bf16_t*)(wsl + WS_U), kin(5) + (size_t)l * INC};
            for (int rep = 0; rep < REP_GEMM; ++rep) pg::gemm_phase<false>(F.lds, wsl + WS_HB, (const bf16_t*)(wsl + WS_WIN) + (size_t)l * INCP * D, D, S, E);
        }
        SEAM(P + 0);
        if (IN(P + 1)) for (int rep = 0; rep < REP_MIX; ++rep) p_mix1(F, l);
        SEAM(P + 1);
        if (IN(P + 2)) for (int rep = 0; rep < REP_MIX; ++rep) p_mix2(F, l);
        SEAM(P + 2);
        if (IN(P + 3)) for (int rep = 0; rep < REP_MIX; ++rep) p_mix3(F, l);
        SEAM(P + 3);
        if (IN(P + 4)) {
            unsigned char* const wsl = launder_ws(F.ws);
            pg::PlainSched S; S.init(64, D / 256, F.G, (int)blockIdx.x);
            pg::EpiOutProj E{(bf16_t*)(wsl + WS_R1), kin(24) + (size_t)l * D};
            for (int rep = 0; rep < REP_GEMM; ++rep) pg::gemm_phase<false>(F.lds, wsl + WS_Y, (const bf16_t*)(wsl + WS_WOUT) + (size_t)l * D * D, D, S, E);
            outproj_tail(F, l, wsl);
        }
        SEAM(P + 4);
        if (IN(P + 5)) { if (REP_LN > 1) p_ln1_router<true>(F, l); p_ln1_router<false>(F, l); }
        SEAM(P + 5);
        if (IN(P + 6)) {
            moe_table(F, l);
            unsigned char* const wsl = launder_ws(F.ws);
            pg::MoeSched S; S.tab = (const LAS int*)(F.lds + LDSCTL_OFF + 256); S.list = (const int*)(wsl + WS_LIST); S.nN = 8; S.G = F.G; S.c = F.vcu; S.gather = 1; S.nrowsB = 2048;
            pg::EpiGateUp8 E{(unsigned char*)(wsl + WS_HM)};
            for (int rep = 0; rep < REP_GEMM; ++rep) pg::gemm_phase<true>(F.lds, wsl + WS_HB8, wsl + WS_WGU + (size_t)l * NEXP * 2048 * D, D / 2, S, E);
        }
        SEAM(P + 6);
        if (IN(P + 7)) {
            moe_table(F, l);
            unsigned char* const wsl = launder_ws(F.ws);
            pg::MoeSched S; S.tab = (const LAS int*)(F.lds + LDSCTL_OFF + 256); S.list = nullptr; S.nN = 8; S.G = F.G; S.c = F.vcu; S.gather = 0; S.nrowsB = 2048;
            pg::EpiDown8 E{(unsigned char*)(wsl + WS_O)};
            for (int rep = 0; rep < REP_GEMM; ++rep) pg::gemm_phase<true>(F.lds, wsl + WS_HM, wsl + WS_WD + (size_t)l * NEXP * D * DEXP, DEXP / 2, S, E);
        }
        SEAM(P + 7);
        if (IN(P + 8)) { moe_table(F, l); if (REP_LN > 1) p_ln2<true>(F, l); p_ln2<false>(F, l); }
        SEAM(P + 8);
}

__global__ void __launch_bounds__(512, 2) mk_fwd(Args args) {
    extern __shared__ __attribute__((aligned(16))) unsigned char lds_raw[];
    Frame F;
    F.lds = (LAS unsigned char*)lds_raw;
    F.MISC = (volatile LAS unsigned*)(F.lds + MISC_OFF);
    F.tid = threadIdx.x; F.lane = F.tid & 63; F.wave = __builtin_amdgcn_readfirstlane(F.tid >> 6);
    F.G = gridDim.x; { const int bx = blockIdx.x; F.vcu = (F.G % 8 == 0) ? (bx % 8) * (F.G / 8) + bx / 8 : bx; }
    F.ws = args.ws; F.ctl = (unsigned*)(args.ws + WS_CTL);
    for (int u = F.tid; u < (LDS_BYTES - LDSCTL_OFF) / 4; u += 512) ((LAS unsigned*)(F.lds + LDSCTL_OFF))[u] = 0u;
    __syncthreads();
    const int lo = args.ph_lo, hi = args.ph_hi;
    const bool multi = (hi - lo) > 1;
    XcdBarrier bar; bar.bar = F.ctl + CW_BAR; bar.x = 0; bar.st = nullptr;
    if (multi) bar = xcd_barrier_post(F.ctl + CW_BAR, F.MISC + 8);

    if (IN(0)) { for (int rep = 0; rep < REP_PRO; ++rep) p_prologue(F); }
    SEAM(0);
    run_layer<0>(F, lo, hi, bar); run_layer<1>(F, lo, hi, bar); run_layer<2>(F, lo, hi, bar); run_layer<3>(F, lo, hi, bar);
}

#ifndef MK_CUT
#define MK_CUT 0
#endif
extern "C" void kernel_launch(void* const* d_in, const int* in_sizes, int n_in, void* d_out, int out_size, void* d_ws, size_t ws_size, hipStream_t stream) {
    static bool attr = false;
    if (!attr) { (void)hipFuncSetAttribute((const void*)mk_fwd, hipFuncAttributeMaxDynamicSharedMemorySize, LDS_BYTES); attr = true; }
    (void)hipMemsetAsync(d_ws, 0, CTL_BYTES, stream);
    Args a{};
    for (int i = 0; i < 36; ++i) a.in[i] = (const float*)d_in[i];
    a.out = (float*)d_out; a.ws = (unsigned char*)d_ws;
    const int NP = 1 + DEPTH * NPH;
#if MK_CUT
    for (int p = 0; p < NP; ++p) { a.ph_lo = p; a.ph_hi = p + 1; hipLaunchKernelGGL(mk_fwd, dim3(256), dim3(512), LDS_BYTES, stream, a); }
#else
    a.ph_lo = 0; a.ph_hi = NP; hipLaunchKernelGGL(mk_fwd, dim3(256), dim3(512), LDS_BYTES, stream, a);
#endif
}
```

```cpp
#include <hip/hip_runtime.h>
#include <stdint.h>

#define LAS __attribute__((address_space(3)))
#define GAS __attribute__((address_space(1)))
typedef unsigned short bf16_t;
typedef short bf16x8 __attribute__((ext_vector_type(8)));
typedef float f32x4 __attribute__((ext_vector_type(4)));
typedef float f32x2 __attribute__((ext_vector_type(2)));
typedef unsigned u32x4 __attribute__((ext_vector_type(4)));
typedef unsigned u32x2 __attribute__((ext_vector_type(2)));

constexpr int D = 2048, NB = 8, SEQ = 2048, NMETA = 16, L = SEQ + NMETA, T = NB * L, DEPTH = 4;
constexpr int MPAD = 16640;
constexpr int INC = 4640, INCP = 4864;
constexpr int O_AQ = 0, O_AK = 256, O_AV = 512, O_GF = 1024, O_GB = 1040, O_AR = 1056, O_BQ = 1568, O_BK = 2592, O_BV = 2848, O_CU = 3104;
constexpr int NEXP = 16, DEXP = 1024;
constexpr float ALPHA = 1.681792830507429f;
constexpr int NPH = 9;
constexpr int HMROWS = 2 * T + 4096;

constexpr size_t al256(size_t x) { return (x + 255) & ~(size_t)255; }
constexpr size_t WS_CTL = 0, CTL_BYTES = 1u << 20;
constexpr size_t WS_WIN = WS_CTL + CTL_BYTES;
constexpr size_t WS_WOUT = WS_WIN + (size_t)DEPTH * INCP * D * 2;
constexpr size_t WS_WGU = WS_WOUT + (size_t)DEPTH * D * D * 2;
constexpr size_t WS_WD = WS_WGU + (size_t)DEPTH * NEXP * 2048 * D * 2;
constexpr size_t WS_HB8 = WS_WD + (size_t)DEPTH * NEXP * D * DEXP * 2;
constexpr size_t WS_H = WS_HB8 + (size_t)MPAD * D;
constexpr size_t WS_HB = WS_H + (size_t)T * D * 4;
constexpr size_t WS_Y = WS_HB + (size_t)MPAD * D * 2;
constexpr size_t WS_LIST = WS_Y + (size_t)MPAD * D * 2;
constexpr size_t WS_TOKE = WS_LIST + (size_t)NEXP * T * 4;
constexpr size_t WS_TOKP = WS_TOKE + (size_t)2 * T * 4;
constexpr size_t WS_TOKW = WS_TOKP + (size_t)2 * T * 4;
constexpr size_t WS_HF = WS_TOKW + (size_t)2 * T * 4;
constexpr size_t WS_HBW = WS_HF + (size_t)L * 512 * 4;
constexpr int GLEN = 4736, GCEN = 2336, ZL = 2112;
constexpr int ZROW = 3520, ZOFF = 576;
constexpr size_t WS_FG = al256(WS_HBW + (size_t)L * 512 * 4);
constexpr size_t WS_WR = al256(WS_FG + (size_t)DEPTH * 512 * 2 * GLEN * 2);
constexpr size_t WS_REG = al256(WS_WR + (size_t)DEPTH * 64 * 2 * 2 * 512 * 2);
constexpr size_t WS_U = WS_REG;
constexpr int GNC = 33;
constexpr size_t WS_KVT = al256(WS_U + (size_t)T * INC * 2);
constexpr size_t WS_DEC = WS_KVT + (size_t)64 * GNC * 128 * 64 * 4;
constexpr size_t WS_SPT = WS_DEC + (size_t)64 * GNC * 64 * 4;
constexpr size_t WS_GQK = WS_SPT + (size_t)64 * GNC * 128 * 64 * 2;
constexpr size_t WS_GVT = WS_GQK + (size_t)NB * 4 * GNC * 4 * 64 * 64 * 2;
constexpr size_t WS_SW = WS_GVT + (size_t)NB * 4 * GNC * 128 * 64 * 2;
constexpr size_t WS_X0T = WS_SW + (size_t)T * 1024 * 4;
constexpr size_t WS_ZT = WS_X0T + (size_t)512 * NB * ZL * 2;
constexpr size_t WS_YT = WS_ZT + (size_t)512 * NB * ZL * 2;
constexpr size_t WS_END1 = WS_YT + (size_t)512 * NB * ZL * 2;
constexpr size_t WS_R1 = WS_REG;
constexpr size_t WS_HM = WS_R1 + (size_t)T * D * 4;
constexpr size_t WS_O = WS_HM + (size_t)HMROWS * DEXP * 2;
constexpr size_t WS_END2 = WS_O + (size_t)HMROWS * D * 2;
constexpr size_t WS_DUM = al256(WS_END2);
static_assert(WS_END1 < 2100000000ull && WS_DUM + (size_t)T * D * 6 + (size_t)NEXP * T * 4 + (size_t)T * 32 < 2100000000ull, "d_ws budget");
constexpr int CW_BAR = 4096;
constexpr int CW_Q = 12288;
constexpr int CW_CNT = 16384;

constexpr int RING_BYTES = 131072;
constexpr int LDSCTL_OFF = RING_BYTES;
constexpr int MISC_OFF = LDSCTL_OFF + 1024;
constexpr int LDS_BYTES = 147456;

#define LDS_WAIT() asm volatile("s_waitcnt lgkmcnt(0)" ::: "memory")
#define VM_WAIT() asm volatile("s_waitcnt vmcnt(0)" ::: "memory")
__device__ __forceinline__ unsigned f2bf(float f) { unsigned u = __builtin_bit_cast(unsigned, f); return (u + 0x7fffu + ((u >> 16) & 1u)) >> 16; }
__device__ __forceinline__ unsigned pk2i(float lo, float hi) { return f2bf(lo) | (f2bf(hi) << 16); }
__device__ __forceinline__ unsigned pk2(float lo, float hi) { unsigned r; asm("v_cvt_pk_bf16_f32 %0, %1, %2" : "=v"(r) : "v"(lo), "v"(hi)); return r; }
__device__ __forceinline__ float bf2f(unsigned short b) { return __builtin_bit_cast(float, (unsigned)b << 16); }
template <int N> __device__ __forceinline__ float dpp_row_shr_add(float v) { const int t = __builtin_amdgcn_update_dpp(0, __builtin_bit_cast(int, v), 0x110 + N, 0xf, 0xf, true); return v + __builtin_bit_cast(float, t); }
__device__ __forceinline__ float wave_sum(float v) {
    v = dpp_row_shr_add<1>(v); v = dpp_row_shr_add<2>(v); v = dpp_row_shr_add<4>(v); v = dpp_row_shr_add<8>(v);
    const int vi = __builtin_bit_cast(int, v);
    return (__builtin_bit_cast(float, __builtin_amdgcn_readlane(vi, 15)) + __builtin_bit_cast(float, __builtin_amdgcn_readlane(vi, 31))) + (__builtin_bit_cast(float, __builtin_amdgcn_readlane(vi, 47)) + __builtin_bit_cast(float, __builtin_amdgcn_readlane(vi, 63)));
}
__device__ __forceinline__ float xor32(float v) {
    const int vi = __builtin_bit_cast(int, v);
    auto r = __builtin_amdgcn_permlane32_swap(vi, vi, false, false);
    return __builtin_bit_cast(float, (threadIdx.x & 32) ? r[0] : r[1]);
}
__device__ __forceinline__ float wave_max(float v) {
#pragma unroll
    for (int o = 1; o < 64; o <<= 1) v = fmaxf(v, __shfl_xor(v, o));
    return v;
}

#define XB_TMO      128
#define XB_XCNT(j)  (256  + 64 * (j))
#define XB_XSUB(j)  (1280 + 64 * (j))
#define XB_XGEN(j)  (2304 + 64 * (j))
#define XB_TOP      3328
#define XB_TOPGEN   3392
#define XCD_BAR_WORDS 3456
#define XB_SPIN_CAP (1u << 18)
__device__ __forceinline__ unsigned xb_ld(unsigned* p)              { return __hip_atomic_load(p, __ATOMIC_RELAXED, __HIP_MEMORY_SCOPE_AGENT); }
__device__ __forceinline__ unsigned xb_add(unsigned* p, unsigned v) { return __hip_atomic_fetch_add(p, v, __ATOMIC_RELAXED, __HIP_MEMORY_SCOPE_AGENT); }
__device__ __forceinline__ unsigned xb_xcc_id() { return (unsigned)__builtin_amdgcn_s_getreg((3 << 11) | 20) & 0xFu; }
#define XB_SPIN(cond, bar) do { unsigned _sp = 0; while (cond) { __builtin_amdgcn_s_sleep(1); \
    if ((++_sp & 255u) == 0u) { if (xb_ld(&(bar)[XB_TMO])) break; if (_sp > XB_SPIN_CAP) { atomicAdd(&(bar)[XB_TMO], 1u); break; } } } } while (0)
struct XcdBarrier { unsigned* bar; unsigned x; volatile LAS unsigned* st; };
__device__ __forceinline__ XcdBarrier xcd_barrier_post(unsigned* bar, volatile LAS unsigned* st) {
    XcdBarrier b; b.bar = bar; b.x = xb_xcc_id(); b.st = st;
    if (threadIdx.x == 0) (void)xb_add(&bar[XB_XCNT(b.x)], 1u);
    return b;
}
__device__ __forceinline__ void xcd_barrier_complete(unsigned* bar, unsigned x, unsigned& nloc, unsigned& nx) {
    const unsigned G = gridDim.x * gridDim.y * gridDim.z;
    unsigned sum, cnt, mine, sp = 0u;
    for (;;) {
        sum = 0u; cnt = 0u; mine = 0u;
#pragma unroll
        for (unsigned j = 0; j < 16; ++j) { const unsigned c = xb_ld(&bar[XB_XCNT(j)]); sum += c; cnt += (c > 0u) ? 1u : 0u; mine = (j == x) ? c : mine; }
        if (sum == G) break;
        __builtin_amdgcn_s_sleep(1);
        if ((++sp & 255u) == 0u) { if (xb_ld(&bar[XB_TMO])) break; if (sp > XB_SPIN_CAP) { atomicAdd(&bar[XB_TMO], 1u); break; } }
    }
    nloc = mine > 0u ? mine : 1u; nx = cnt > 0u ? cnt : 1u;
}
__device__ __forceinline__ void xcd_barrier(const XcdBarrier& b) {
    asm volatile("s_waitcnt vmcnt(0)" ::: "memory");
    __syncthreads();
    if (threadIdx.x == 0) {
        unsigned* bar = b.bar;
        __builtin_amdgcn_s_waitcnt(0);
        unsigned nloc = b.st[0], nx = b.st[1];
        if (nloc == 0u) { xcd_barrier_complete(bar, b.x, nloc, nx); b.st[0] = nloc; b.st[1] = nx; }
        const unsigned old = xb_add(&bar[XB_XSUB(b.x)], 1u);
        const unsigned gen = old / nloc;
        if (old + 1u == (gen + 1u) * nloc) {
            __builtin_amdgcn_fence(__ATOMIC_RELEASE, "agent");
            asm volatile("s_waitcnt vmcnt(0)" ::: "memory");
            const unsigned og = xb_add(&bar[XB_TOP], 1u);
            const unsigned tg = og / nx;
            if (og + 1u == (tg + 1u) * nx) xb_add(&bar[XB_TOPGEN], 1u);
            else XB_SPIN(xb_ld(&bar[XB_TOPGEN]) == tg, bar);
            __builtin_amdgcn_fence(__ATOMIC_ACQUIRE, "agent");
            xb_add(&bar[XB_XGEN(b.x)], 1u);
            asm volatile("s_waitcnt vmcnt(0)" ::: "memory");
        } else {
            XB_SPIN(xb_ld(&bar[XB_XGEN(b.x)]) == gen, bar);
            __builtin_amdgcn_fence(__ATOMIC_ACQUIRE, "agent");
            asm volatile("s_waitcnt vmcnt(0)" ::: "memory");
        }
    }
    __syncthreads();
}

namespace pg {
constexpr int BM = 256, BK = 64, HALF = 128, HTB = HALF * BK * 2, STAGE_BYTES = 8 * HTB, NXCD = 8, WGM = 8;
__host__ __device__ __forceinline__ int lds_byte(int r, int c) { const int st = (r >> 4) * 2 + (c >> 5), rr = r & 15, cc = c & 31, ob = rr * 64 + cc * 2; return st * 1024 + (ob ^ (((ob >> 9) & 1) << 5)); }
__host__ __device__ __forceinline__ void stage_rc(int b, int& R, int& C) { const int st = b / 1024, sb = b % 1024, swz = sb ^ (((sb >> 9) & 1) << 5); R = (st >> 1) * 16 + swz / 64; C = (st & 1) * 32 + (swz % 64) / 2; }

__host__ __device__ __forceinline__ int perm32(int rho) { const int n = rho >> 4, i = rho & 15; return 8 * (i >> 2) + 4 * n + (i & 3); }
struct Unit { int e, pm, pn, mvalid, crow0; };

struct PlainSched {
    int nM, nN, nwg, G, c;
    __device__ void init(int nM_, int nN_, int G_, int c_) { nM = nM_; nN = nN_; nwg = nM * nN; G = G_; c = c_; }
    __device__ bool next(int i, Unit& u) const {
        const long Lx = (long)i * G + c; if (Lx >= nwg) return false;
        int wgid = (int)Lx; { const int q = nwg / NXCD, r = nwg % NXCD, xcd = wgid % NXCD, off = wgid / NXCD; wgid = (xcd < r ? xcd * (q + 1) : r * (q + 1) + (xcd - r) * q) + off; }
        const int nig = WGM * nN, gid = wgid / nig, fm = gid * WGM, gsz = (nM - fm) < WGM ? (nM - fm) : WGM;
        u.pm = fm + ((wgid % nig) % gsz); u.pn = (wgid % nig) / gsz; u.e = 0; u.crow0 = u.pm * BM; u.mvalid = min(BM, T - u.pm * BM); return true;
    }
    __device__ __forceinline__ int arow(const Unit& u, int r) const { return min(u.pm * BM + r, T - 1); }
    __device__ __forceinline__ int brow0(const Unit& u) const { return u.pn * BM; }
};
struct MoeSched {
    const LAS int* tab; const int* list; int nN, G, c, gather, nrowsB;
    __device__ bool next(int i, Unit& u) const {
        const int Lx = i * G + c; const int panel = Lx / nN;
        if (panel >= __builtin_amdgcn_readfirstlane(tab[32])) return false;
        int e = 0;
#pragma unroll 1
        for (int j = 1; j < 16; ++j) if (panel >= __builtin_amdgcn_readfirstlane(tab[16 + j])) e = j;
        u.e = e; u.pm = panel - __builtin_amdgcn_readfirstlane(tab[16 + e]); u.pn = Lx % nN; u.crow0 = __builtin_amdgcn_readfirstlane(tab[33 + e]) + u.pm * BM;
        u.mvalid = min(BM, __builtin_amdgcn_readfirstlane(tab[e]) - u.pm * BM); return true;
    }
    __device__ __forceinline__ int arow(const Unit& u, int r) const {
        const int rr = min(r, u.mvalid - 1);
        return gather ? list[(size_t)u.e * T + u.pm * BM + rr] : (u.crow0 + rr);
    }
    __device__ __forceinline__ int brow0(const Unit& u) const { return u.e * nrowsB + u.pn * BM; }
};

typedef int i32x8 __attribute__((ext_vector_type(8)));
typedef int i32x4_ __attribute__((ext_vector_type(4)));
__host__ __device__ __forceinline__ int lds_byte8(int r, int kb) { const int st = (r >> 4) * 2 + (kb >> 1), rr = r & 15; return st * 1024 + rr * 64 + 32 * ((kb & 1) ^ (rr >> 3)); }
template <bool FP8, class Epi, class Sched>
__device__ __forceinline__ void gemm_phase(LAS unsigned char* lds, const void* A, const void* Bt, const int K  , const Sched& S, const Epi& E) {
    const int tid = threadIdx.x, wid = __builtin_amdgcn_readfirstlane(tid >> 6), lane = tid & 63, wr = wid >> 2, wc = wid & 3, fr = lane & 15, fq = lane >> 4;
    const int nt = K / BK;
    unsigned voffB[2];
#pragma unroll
    for (int i = 0; i < 2; ++i) { int R, C; stage_rc(tid * 16 + i * 8192, R, C); const int Rb = Epi::PERM ? ((R & ~31) + perm32(R & 31)) : R; voffB[i] = (unsigned)(Rb * K + C) * 2u; }
    const size_t kstep = (size_t)(BK * 2);
    const size_t hstep = (size_t)HALF * K * 2;
    const unsigned rowb = (unsigned)K * 2u;
    const unsigned ldsw = (unsigned)wid * 1024u;
    const int aoff = FP8 ? lds_byte8(wr * 64 + fr, fq) : lds_byte(wr * 64 + fr, fq * 8), boff = FP8 ? lds_byte8(wc * 32 + fr, fq) : lds_byte(wc * 32 + fr, fq * 8);
#define PG_SA(b, h) (((b) * 2 + (h)) * HTB)
#define PG_SB(b, h) ((4 + (b) * 2 + (h)) * HTB)
#define PG_STAGE_B(bufoff, gbase) do { _Pragma("unroll") for (int _i = 0; _i < 2; ++_i) \
        __builtin_amdgcn_global_load_lds((const unsigned*)((const char*)(gbase) + voffB[_i]), (LAS unsigned*)(lds + (bufoff) + ldsw + _i * 8192), 16, 0, 0); } while (0)
#define PG_STAGE_A(bufoff, gbase, v0, v1) do { \
        __builtin_amdgcn_global_load_lds((const unsigned*)((const char*)(gbase) + (v0)), (LAS unsigned*)(lds + (bufoff) + ldsw), 16, 0, 0); \
        __builtin_amdgcn_global_load_lds((const unsigned*)((const char*)(gbase) + (v1)), (LAS unsigned*)(lds + (bufoff) + ldsw + 8192), 16, 0, 0); } while (0)
#define PG_LDA(dst, b, h) do { _Pragma("unroll") for (int m = 0; m < 4; ++m) _Pragma("unroll") for (int k = 0; k < 2; ++k) dst[m][k] = *(const LAS bf16x8*)(lds + PG_SA(b, h) + aoff + m * 2048 + (FP8 ? k * 16 : k * 1024)); } while (0)
#define PG_LDB(dst, b, h) do { _Pragma("unroll") for (int n = 0; n < 2; ++n) _Pragma("unroll") for (int k = 0; k < 2; ++k) dst[n][k] = *(const LAS bf16x8*)(lds + PG_SB(b, h) + boff + n * 2048 + (FP8 ? k * 16 : k * 1024)); } while (0)
#define PG_MMA(ai, bj, At, Bt_) do { __builtin_amdgcn_s_setprio(1); if constexpr (FP8) { _Pragma("unroll") for (int m = 0; m < 4; ++m) _Pragma("unroll") for (int n = 0; n < 2; ++n) { \
            const i32x8 bq_ = __builtin_shufflevector(__builtin_bit_cast(i32x4_, Bt_[n][0]), __builtin_bit_cast(i32x4_, Bt_[n][1]), 0, 1, 2, 3, 4, 5, 6, 7), aq_ = __builtin_shufflevector(__builtin_bit_cast(i32x4_, At[m][0]), __builtin_bit_cast(i32x4_, At[m][1]), 0, 1, 2, 3, 4, 5, 6, 7); \
            acc[ai][bj][m][n] = __builtin_amdgcn_mfma_scale_f32_16x16x128_f8f6f4(bq_, aq_, acc[ai][bj][m][n], 0, 0, 0, 0x7f7f7f7f, 0, 0x7f7f7f7f); } } \
        else { _Pragma("unroll") for (int m = 0; m < 4; ++m) _Pragma("unroll") for (int n = 0; n < 2; ++n) _Pragma("unroll") for (int k = 0; k < 2; ++k) \
        acc[ai][bj][m][n] = __builtin_amdgcn_mfma_f32_16x16x32_bf16(Bt_[n][k], At[m][k], acc[ai][bj][m][n], 0, 0, 0); } __builtin_amdgcn_s_setprio(0); } while (0)
#define PG_WAIT_V(n) asm volatile("s_waitcnt vmcnt(" #n ")" ::: "memory")
#define PG_WAIT_L(n) asm volatile("s_waitcnt lgkmcnt(" #n ")" ::: "memory")
#define PG_BAR __builtin_amdgcn_s_barrier()
#define PG_SCHED __builtin_amdgcn_sched_barrier(0)
#define PG_SETA(v, u) do { int R0_, C0_, R1_, C1_; stage_rc(tid * 16, R0_, C0_); stage_rc(tid * 16 + 8192, R1_, C1_); \
        v##00 = (unsigned)S.arow(u, R0_) * rowb + (unsigned)C0_ * 2u; v##01 = (unsigned)S.arow(u, R1_) * rowb + (unsigned)C1_ * 2u; \
        v##10 = (unsigned)S.arow(u, HALF + R0_) * rowb + (unsigned)C0_ * 2u; v##11 = (unsigned)S.arow(u, HALF + R1_) * rowb + (unsigned)C1_ * 2u; } while (0)
    Unit cur, nxt; int ui = 0;
    if (!S.next(0, cur)) return;
    f32x4 acc[2][2][4][2];
#pragma unroll
    for (int a = 0; a < 2; ++a)
#pragma unroll
        for (int b = 0; b < 2; ++b)
#pragma unroll
            for (int m = 0; m < 4; ++m)
#pragma unroll
                for (int n = 0; n < 2; ++n) acc[a][b][m][n] = (f32x4){0.f, 0.f, 0.f, 0.f};
    bf16x8 At[4][2], B0[2][2], B1[2][2];
    unsigned vc00, vc01, vc10, vc11;
    PG_SETA(vc, cur);
    const char* Ab = (const char*)A;
    const char* cB = (const char*)Bt + (size_t)S.brow0(cur) * rowb;
    PG_STAGE_B(PG_SB(0, 0), cB); PG_STAGE_B(PG_SB(0, 1), cB + hstep); PG_STAGE_A(PG_SA(0, 0), Ab, vc00, vc01); PG_STAGE_A(PG_SA(0, 1), Ab, vc10, vc11);
    if (wr == 1) PG_BAR;
    PG_WAIT_V(2); PG_BAR;
    PG_STAGE_B(PG_SB(1, 0), cB + kstep); PG_STAGE_A(PG_SA(1, 0), Ab + kstep, vc00, vc01); PG_STAGE_B(PG_SB(1, 1), cB + hstep + kstep);
    PG_WAIT_V(6); PG_BAR;
    for (;;) {
        const bool has_next = S.next(ui + 1, nxt);
        const char* nB = has_next ? (const char*)Bt + (size_t)S.brow0(nxt) * rowb : cB;
        for (int t = 0; t < nt; t += 2) {
            const bool last = (t == nt - 2);
            const char* a1 = Ab + (size_t)(t + 1) * kstep;
            const char* a2 = last ? Ab : Ab + (size_t)(t + 2) * kstep; const char* b2 = last ? nB : cB + (size_t)(t + 2) * kstep;
            const char* a3 = a2 + kstep; const char* b3 = b2 + kstep;
            PG_LDB(B0, 0, 0); PG_LDB(B1, 0, 1); PG_SCHED; PG_LDA(At, 0, 0); PG_STAGE_A(PG_SA(1, 1), a1, vc10, vc11);
            if (last && has_next) { PG_SETA(vc, nxt); }
            PG_WAIT_V(8); PG_WAIT_L(0); PG_BAR; PG_MMA(0, 0, At, B0); PG_MMA(0, 1, At, B1); PG_BAR; PG_SCHED;
            PG_LDA(At, 0, 1); PG_STAGE_B(PG_SB(0, 0), b2); PG_STAGE_B(PG_SB(0, 1), b2 + hstep); PG_STAGE_A(PG_SA(0, 0), a2, vc00, vc01);
            PG_WAIT_V(8); PG_WAIT_L(0); PG_BAR; PG_MMA(1, 0, At, B0); PG_MMA(1, 1, At, B1); PG_BAR; PG_SCHED;
            PG_LDB(B0, 1, 0); PG_LDB(B1, 1, 1); PG_SCHED; PG_LDA(At, 1, 0); PG_STAGE_A(PG_SA(0, 1), a2, vc10, vc11);
            PG_WAIT_V(8); PG_WAIT_L(0); PG_BAR; PG_MMA(0, 0, At, B0); PG_MMA(0, 1, At, B1); PG_BAR; PG_SCHED;
            PG_LDA(At, 1, 1); PG_STAGE_B(PG_SB(1, 0), b3); PG_STAGE_B(PG_SB(1, 1), b3 + hstep); PG_STAGE_A(PG_SA(1, 0), a3, vc00, vc01);
            PG_WAIT_V(8); PG_WAIT_L(0); PG_BAR; PG_MMA(1, 0, At, B0); PG_MMA(1, 1, At, B1); PG_BAR; PG_SCHED;
        }
        if (wr == 0) PG_BAR;
        E(acc, cur, wr, wc, fr, fq);
        if (!has_next) break;
#pragma unroll
        for (int a = 0; a < 2; ++a)
#pragma unroll
            for (int b = 0; b < 2; ++b)
#pragma unroll
                for (int m = 0; m < 4; ++m)
#pragma unroll
                    for (int n = 0; n < 2; ++n) acc[a][b][m][n] = (f32x4){0.f, 0.f, 0.f, 0.f};
        cur = nxt; cB = nB; ++ui;
        if (wr == 1) PG_BAR;
    }
    PG_WAIT_V(0);
    PG_BAR;
#undef PG_SA
#undef PG_SB
#undef PG_STAGE_A
#undef PG_STAGE_B
#undef PG_LDA
#undef PG_LDB
#undef PG_MMA
#undef PG_WAIT_V
#undef PG_WAIT_L
#undef PG_BAR
#undef PG_SCHED
#undef PG_SETA
}

struct EpiInProj {
    static constexpr bool PERM = true;
    bf16_t* U; const float* bias;
    __device__ __forceinline__ void operator()(const f32x4 (&acc)[2][2][4][2], const Unit& u, int wr, int wc, int fr, int fq) const {
        const int col0 = u.pn * BM + wc * 32 + 8 * fq;
        f32x4 bv[2][2]; bool cv[2];
#pragma unroll
        for (int bj = 0; bj < 2; ++bj) { const int c = col0 + bj * HALF; cv[bj] = c < INC;
#pragma unroll
            for (int n = 0; n < 2; ++n) bv[bj][n] = cv[bj] ? *(const f32x4*)(bias + c + 4 * n) : (f32x4){0.f, 0.f, 0.f, 0.f}; }
#pragma unroll
        for (int ai = 0; ai < 2; ++ai)
#pragma unroll
            for (int m = 0; m < 4; ++m) { const int r = ai * HALF + wr * 64 + m * 16 + fr;
                if (r < u.mvalid) { bf16_t* rowp = U + (size_t)(u.crow0 + r) * INC + col0;
#pragma unroll
                    for (int bj = 0; bj < 2; ++bj) if (cv[bj]) { const f32x4 v0 = acc[ai][bj][m][0] + bv[bj][0], v1 = acc[ai][bj][m][1] + bv[bj][1];
                        u32x4 w; w.x = pk2(v0[0], v0[1]); w.y = pk2(v0[2], v0[3]); w.z = pk2(v1[0], v1[1]); w.w = pk2(v1[2], v1[3]); *(u32x4*)(rowp + bj * HALF) = w; } } }
    }
};
struct EpiOutProj {
    static constexpr bool PERM = true;
    bf16_t* MX; const float* bias;
    __device__ __forceinline__ void operator()(const f32x4 (&acc)[2][2][4][2], const Unit& u, int wr, int wc, int fr, int fq) const {
        const int col0 = u.pn * BM + wc * 32 + 8 * fq;
        f32x4 bv[2][2];
#pragma unroll
        for (int bj = 0; bj < 2; ++bj)
#pragma unroll
            for (int n = 0; n < 2; ++n) bv[bj][n] = *(const f32x4*)(bias + col0 + bj * HALF + 4 * n);
#pragma unroll
        for (int ai = 0; ai < 2; ++ai)
#pragma unroll
            for (int m = 0; m < 4; ++m) { const int r = ai * HALF + wr * 64 + m * 16 + fr;
                if (r < u.mvalid) { bf16_t* rowp = MX + (size_t)(u.crow0 + r) * D + col0;
#pragma unroll
                    for (int bj = 0; bj < 2; ++bj) { const f32x4 v0 = acc[ai][bj][m][0] + bv[bj][0], v1 = acc[ai][bj][m][1] + bv[bj][1];
                        u32x4 w; w.x = pk2(v0[0], v0[1]); w.y = pk2(v0[2], v0[3]); w.z = pk2(v1[0], v1[1]); w.w = pk2(v1[2], v1[3]); *(u32x4*)(rowp + bj * HALF) = w; } } }
    }
};
struct EpiGateUp {
    static constexpr bool PERM = false;
    bf16_t* Hm;
    __device__ __forceinline__ void operator()(const f32x4 (&acc)[2][2][4][2], const Unit& u, int wr, int wc, int fr, int fq) const {
        const int col0 = u.pn * 128 + wc * 16 + 4 * fq;
#pragma unroll
        for (int ai = 0; ai < 2; ++ai)
#pragma unroll
            for (int m = 0; m < 4; ++m) { const int r = ai * HALF + wr * 64 + m * 16 + fr;
                if (r < u.mvalid) { bf16_t* rowp = Hm + (size_t)(u.crow0 + r) * DEXP + col0;
#pragma unroll
                    for (int bj = 0; bj < 2; ++bj) { const f32x4 g = acc[ai][bj][m][0], up = acc[ai][bj][m][1]; float o[4];
#pragma unroll
                        for (int j = 0; j < 4; ++j) o[j] = g[j] / (1.0f + __expf(-g[j])) * up[j];
                        u32x2 w; w.x = pk2(o[0], o[1]); w.y = pk2(o[2], o[3]); *(u32x2*)(rowp + bj * 64) = w; } } }
    }
};
struct EpiGateUp8 {
    static constexpr bool PERM = false;
    unsigned char* Hm;
    __device__ __forceinline__ void operator()(const f32x4 (&acc)[2][2][4][2], const Unit& u, int wr, int wc, int fr, int fq) const {
        const int col0 = u.pn * 128 + wc * 32 + 8 * fq;
#pragma unroll
        for (int ai = 0; ai < 2; ++ai)
#pragma unroll
            for (int m = 0; m < 4; ++m) { const int r = ai * HALF + wr * 64 + m * 16 + fr;
                if (r < u.mvalid) { int pk[2];
#pragma unroll
                    for (int bj = 0; bj < 2; ++bj) { const f32x4 g = acc[ai][bj][m][0] * (1.0f / 64.0f), up = acc[ai][bj][m][1] * (16.0f / 64.0f); float o[4];
#pragma unroll
                        for (int j = 0; j < 4; ++j) o[j] = g[j] / (1.0f + __expf(-g[j])) * up[j];
                        int q = __builtin_amdgcn_cvt_pk_fp8_f32(o[0], o[1], 0, false); pk[bj] = __builtin_amdgcn_cvt_pk_fp8_f32(o[2], o[3], q, true); }
                    *(u32x2*)(Hm + (size_t)(u.crow0 + r) * DEXP + col0) = (u32x2){(unsigned)pk[0], (unsigned)pk[1]}; } }
    }
};
struct EpiDown8 {
    static constexpr bool PERM = true;
    unsigned char* O;
    __device__ __forceinline__ void operator()(const f32x4 (&acc)[2][2][4][2], const Unit& u, int wr, int wc, int fr, int fq) const {
        const int col0 = u.pn * BM + wc * 32 + 8 * fq;
#pragma unroll
        for (int ai = 0; ai < 2; ++ai)
#pragma unroll
            for (int m = 0; m < 4; ++m) { const int r = ai * HALF + wr * 64 + m * 16 + fr;
                if (r < u.mvalid) { unsigned char* rowp = O + (size_t)(u.crow0 + r) * D + col0;
#pragma unroll
                    for (int bj = 0; bj < 2; ++bj) { const f32x4 v0 = acc[ai][bj][m][0] * (1.0f / 16.0f), v1 = acc[ai][bj][m][1] * (1.0f / 16.0f);
                        int p0 = __builtin_amdgcn_cvt_pk_fp8_f32(v0[0], v0[1], 0, false); p0 = __builtin_amdgcn_cvt_pk_fp8_f32(v0[2], v0[3], p0, true);
                        int p1 = __builtin_amdgcn_cvt_pk_fp8_f32(v1[0], v1[1], 0, false); p1 = __builtin_amdgcn_cvt_pk_fp8_f32(v1[2], v1[3], p1, true);
                        *(u32x2*)(rowp + bj * HALF) = (u32x2){(unsigned)p0, (unsigned)p1}; } } }
    }
};
struct EpiDown {
    static constexpr bool PERM = false;
    bf16_t* O;
    __device__ __forceinline__ void operator()(const f32x4 (&acc)[2][2][4][2], const Unit& u, int wr, int wc, int fr, int fq) const {
        const int col0 = u.pn * BM + wc * 32 + 4 * fq;
#pragma unroll
        for (int ai = 0; ai < 2; ++ai)
#pragma unroll
            for (int m = 0; m < 4; ++m) { const int r = ai * HALF + wr * 64 + m * 16 + fr;
                if (r < u.mvalid) { bf16_t* rowp = O + (size_t)(u.crow0 + r) * D + col0;
#pragma unroll
                    for (int bj = 0; bj < 2; ++bj)
#pragma unroll
                        for (int n = 0; n < 2; ++n) { const f32x4 v = acc[ai][bj][m][n]; u32x2 w; w.x = pk2i(v[0], v[1]); w.y = pk2i(v[2], v[3]); *(u32x2*)(rowp + bj * HALF + n * 16) = w; } } }
    }
};
}

struct Frame {
    LAS unsigned char* lds; volatile LAS unsigned* MISC; unsigned* ctl; unsigned char* ws;
    int tid, lane, wave, vcu, G;
};
__device__ __forceinline__ int opaque_v(int v) { asm volatile("" : "+v"(v)); return v; }
__device__ __forceinline__ unsigned char* launder_ws(unsigned char* p) { GAS unsigned char* q = (GAS unsigned char*)p; asm volatile("" : "+s"(q)); return (unsigned char*)q; }
struct Args { const float* in[36]; float* out; unsigned char* ws; int ph_lo, ph_hi; };
struct ArgsG { const GAS float* in_[36]; GAS float* out_; GAS unsigned char* ws_; int ph_lo, ph_hi;
 };
#define CAS __attribute__((address_space(4)))
__device__ __forceinline__ const CAS ArgsG* kargp() { const CAS ArgsG* p = (const CAS ArgsG*)__builtin_amdgcn_kernarg_segment_ptr(); asm volatile("" : "+s"(p)); return p; }
__device__ __forceinline__ const float* kin(int k) { return (const float*)kargp()->in_[k]; }
__device__ __forceinline__ float* kout() { return (float*)kargp()->out_; }

__device__ __forceinline__ void transpose64(const float* colp4, int ldw, int K, bf16_t* WT, int k0, int j0, LAS float* scr, int lane) {
    const int kr = lane >> 4, c4 = lane & 15;
    f32x4 t[16];
#pragma unroll
    for (int i = 0; i < 16; ++i) t[i] = colp4 ? *(const f32x4*)(colp4 + (size_t)(k0 + kr + 4 * i) * ldw) : (f32x4){0.f, 0.f, 0.f, 0.f};
    const int ch = lane >> 4, nr = lane & 15;
#pragma unroll
    for (int hf = 0; hf < 2; ++hf) {
#pragma unroll
        for (int i = 0; i < 8; ++i) { LAS float* d = scr + (kr + 4 * i) * 66 + 4 * c4; const f32x4 x = t[hf * 8 + i]; *(LAS f32x2*)d = (f32x2){x[0], x[1]}; *(LAS f32x2*)(d + 2) = (f32x2){x[2], x[3]}; }
        LDS_WAIT();
#pragma unroll
        for (int it = 0; it < 4; ++it) { const int n = nr + 16 * it; const LAS float* sp = scr + (8 * ch) * 66 + n;
            u32x4 o; o.x = pk2(sp[0], sp[66]); o.y = pk2(sp[2 * 66], sp[3 * 66]); o.z = pk2(sp[4 * 66], sp[5 * 66]); o.w = pk2(sp[6 * 66], sp[7 * 66]);
            *(u32x4*)(WT + (size_t)(j0 + n) * K + k0 + 32 * hf + 8 * ch) = o; }
        LDS_WAIT();
    }
}
__device__ __forceinline__ void transpose64_fp8(const float* colp4, int ldw, int K, unsigned char* WT, int k0, int j0, LAS float* scr, int lane) {
    const int kr = lane >> 4, c4 = lane & 15;
    f32x4 t[16];
#pragma unroll
    for (int i = 0; i < 16; ++i) t[i] = *(const f32x4*)(colp4 + (size_t)(k0 + kr + 4 * i) * ldw);
    const int ch = lane >> 5, nr = lane & 31;
#pragma unroll
    for (int hf = 0; hf < 2; ++hf) {
#pragma unroll
        for (int i = 0; i < 8; ++i) { LAS float* d = scr + (kr + 4 * i) * 66 + 4 * c4; const f32x4 x = t[hf * 8 + i]; *(LAS f32x2*)d = (f32x2){x[0], x[1]}; *(LAS f32x2*)(d + 2) = (f32x2){x[2], x[3]}; }
        LDS_WAIT();
#pragma unroll
        for (int it = 0; it < 2; ++it) { const int n = nr + 32 * it; const LAS float* sp = scr + (16 * ch) * 66 + n; int q[4];
#pragma unroll
            for (int g = 0; g < 4; ++g) { int pk = __builtin_amdgcn_cvt_pk_fp8_f32(sp[(4 * g) * 66] * 64.0f, sp[(4 * g + 1) * 66] * 64.0f, 0, false); q[g] = __builtin_amdgcn_cvt_pk_fp8_f32(sp[(4 * g + 2) * 66] * 64.0f, sp[(4 * g + 3) * 66] * 64.0f, pk, true); }
            *(u32x4*)(WT + (size_t)(j0 + n) * K + k0 + 32 * hf + 16 * ch) = (u32x4){(unsigned)q[0], (unsigned)q[1], (unsigned)q[2], (unsigned)q[3]}; }
        LDS_WAIT();
    }
}
__device__ __forceinline__ f32x4 ldg4(const float* p) { return *(const f32x4*)p; }
__device__ __forceinline__ f32x4 ldg4(const LAS float* p) { return *(const LAS f32x4*)p; }
template <bool HB8 = false, bool OUT_ONLY = false, class GP = const float*>
__device__ __forceinline__ void ln_wave_store(f32x4 (&v)[8], GP g, GP b, bf16_t* resrow, unsigned char* f8row, float* orow, int lane) {
    float s = 0.f;
#pragma unroll
    for (int j = 0; j < 8; ++j) s += (v[j][0] + v[j][1]) + (v[j][2] + v[j][3]);
    const float mean = wave_sum(s) * (1.0f / D);
    float q = 0.f;
#pragma unroll
    for (int j = 0; j < 8; ++j) { v[j] = v[j] - mean; q += (v[j][0] * v[j][0] + v[j][1] * v[j][1]) + (v[j][2] * v[j][2] + v[j][3] * v[j][3]); }
    const float rstd = rsqrtf(wave_sum(q) * (1.0f / D) + 1e-5f);
#pragma unroll
    for (int j = 0; j < 8; ++j) {
        const int i4 = lane + 64 * j;
        const f32x4 gv = ldg4(g + 4 * i4), bv = ldg4(b + 4 * i4);
        if (HB8 && (j & 1) == 0) __builtin_amdgcn_sched_barrier(0);
        const f32x4 o = v[j] * rstd * gv + bv;
        v[j] = o;
        if (OUT_ONLY) { if (orow) ((f32x4*)orow)[i4] = o; continue; }
        { u32x2 w; w.x = pk2(o[0], o[1]); w.y = pk2(o[2], o[3]); ((u32x2*)resrow)[i4] = w; }
        if (HB8) { int pk = __builtin_amdgcn_cvt_pk_fp8_f32(o[0], o[1], 0, false); pk = __builtin_amdgcn_cvt_pk_fp8_f32(o[2], o[3], pk, true); ((int*)f8row)[i4] = pk; }
        if (orow) ((f32x4*)orow)[i4] = o;
    }
}

__device__ __forceinline__ void hy_filter_item(Frame& F, int item, unsigned char* wsl);
__device__ __forceinline__ void hy_filter_tails(Frame& F, unsigned char* wsl);
__device__ __forceinline__ void p_prologue(Frame& F) {
    unsigned char* const wsl = launder_ws(F.ws); unsigned* const ctl = (unsigned*)(wsl + WS_CTL);
    LAS float* scr = (LAS float*)(F.lds + F.wave * 16384);
    const int gw = F.vcu * 8 + F.wave, NGW = F.G * 8, lane = F.lane;
    bf16_t* WIN = (bf16_t*)(wsl + WS_WIN); bf16_t* WOUT = (bf16_t*)(wsl + WS_WOUT); bf16_t* WGU = (bf16_t*)(wsl + WS_WGU); bf16_t* WD = (bf16_t*)(wsl + WS_WD);
    constexpr int I_IN = 32 * (INCP / 64), I_OUT = 32 * 32, I_GU = 32 * 32, I_D = 16 * 32;
    constexpr int N_IN = DEPTH * I_IN, N_OUT = DEPTH * I_OUT, N_GU = DEPTH * NEXP * I_GU, N_D = DEPTH * NEXP * I_D, N_TR = N_IN + N_OUT + N_GU + N_D;
    const int c4 = lane & 15, kr4 = lane >> 4;
    struct TrItem { const float* colp; unsigned char* wt; int ldw, K, k0, j0, f8; };
#define TR_DECODE(itv, d) do { int r_ = (itv); \
        if (r_ < N_IN) { const int ll = r_ / I_IN, q = r_ % I_IN, nb = q % (INCP / 64), kb = q / (INCP / 64); const int n = nb * 64 + 4 * c4; \
            d.colp = n < INC ? kin(4) + (size_t)ll * D * INC + n : nullptr; d.ldw = INC; d.K = D; d.wt = (unsigned char*)(WIN + (size_t)ll * INCP * D); d.k0 = kb * 64; d.j0 = nb * 64; d.f8 = 0; } \
        else if (r_ < N_IN + N_OUT) { r_ -= N_IN; const int ll = r_ / I_OUT, q = r_ % I_OUT, nb = q % 32, kb = q / 32; const int n = nb * 64 + 4 * c4; \
            d.colp = kin(23) + (size_t)ll * D * D + n; d.ldw = D; d.K = D; d.wt = (unsigned char*)(WOUT + (size_t)ll * D * D); d.k0 = kb * 64; d.j0 = nb * 64; d.f8 = 0; } \
        else if (r_ < N_IN + N_OUT + N_GU) { r_ -= N_IN + N_OUT; const int le = r_ / I_GU, q = r_ % I_GU, nb = q % 32, kb = q / 32; const int j = nb * 64 + 4 * c4; \
            const int pn = j >> 8, cp = j & 255, bj = cp >> 7, wc = (cp >> 5) & 3, nn = (cp >> 4) & 1, fq = (cp >> 2) & 3; const int hid = pn * 128 + wc * 32 + fq * 8 + bj * 4; \
            d.colp = (nn ? kin(32) : kin(31)) + (size_t)le * D * DEXP + hid; d.ldw = DEXP; d.K = D; d.wt = (unsigned char*)WGU + (size_t)le * 2048 * D; d.k0 = kb * 64; d.j0 = nb * 64; d.f8 = 1; } \
        else { r_ -= N_IN + N_OUT + N_GU; const int le = r_ / I_D, q = r_ % I_D, nb = q % 32, kb = q / 32; const int n = nb * 64 + 4 * c4; \
            d.colp = kin(33) + (size_t)le * DEXP * D + n; d.ldw = D; d.K = DEXP; d.wt = (unsigned char*)WD + (size_t)le * D * DEXP; d.k0 = kb * 64; d.j0 = nb * 64; d.f8 = 1; } } while (0)
#define TR_LOAD(d, t) do { _Pragma("unroll") for (int i = 0; i < 16; ++i) t[i] = d.colp ? *(const f32x4*)(d.colp + (size_t)(d.k0 + kr4 + 4 * i) * d.ldw) : (f32x4){0.f, 0.f, 0.f, 0.f}; } while (0)
    { int it = gw; TrItem dc, dn; f32x4 tc[16], tn[16];
      if (it < N_TR) { TR_DECODE(it, dc); TR_LOAD(dc, tc); }
      for (; it < N_TR; it += NGW) {
          const int itn = it + NGW;
          if (itn < N_TR) { TR_DECODE(itn, dn); TR_LOAD(dn, tn); }
#pragma unroll
          for (int hf = 0; hf < 2; ++hf) {
#pragma unroll
              for (int i = 0; i < 8; ++i) { LAS float* dd = scr + (kr4 + 4 * i) * 66 + 4 * c4; const f32x4 x = tc[hf * 8 + i]; *(LAS f32x2*)dd = (f32x2){x[0], x[1]}; *(LAS f32x2*)(dd + 2) = (f32x2){x[2], x[3]}; }
              LDS_WAIT();
              if (dc.f8) { const int ch = lane >> 5, nr = lane & 31;
#pragma unroll
                  for (int i2 = 0; i2 < 2; ++i2) { const int n = nr + 32 * i2; const LAS float* sp = scr + (16 * ch) * 66 + n; int q[4];
#pragma unroll
                      for (int g = 0; g < 4; ++g) { int pk = __builtin_amdgcn_cvt_pk_fp8_f32(sp[(4 * g) * 66] * 64.0f, sp[(4 * g + 1) * 66] * 64.0f, 0, false); q[g] = __builtin_amdgcn_cvt_pk_fp8_f32(sp[(4 * g + 2) * 66] * 64.0f, sp[(4 * g + 3) * 66] * 64.0f, pk, true); }
                      *(u32x4*)(dc.wt + (size_t)(dc.j0 + n) * dc.K + dc.k0 + 32 * hf + 16 * ch) = (u32x4){(unsigned)q[0], (unsigned)q[1], (unsigned)q[2], (unsigned)q[3]}; }
              } else { const int ch = lane >> 4, nr = lane & 15;
#pragma unroll
                  for (int i2 = 0; i2 < 4; ++i2) { const int n = nr + 16 * i2; const LAS float* sp = scr + (8 * ch) * 66 + n;
                      u32x4 o; o.x = pk2(sp[0], sp[66]); o.y = pk2(sp[2 * 66], sp[3 * 66]); o.z = pk2(sp[4 * 66], sp[5 * 66]); o.w = pk2(sp[6 * 66], sp[7 * 66]);
                      *(u32x4*)((bf16_t*)dc.wt + (size_t)(dc.j0 + n) * dc.K + dc.k0 + 32 * hf + 8 * ch) = o; } }
              LDS_WAIT();
          }
          dc = dn;
#pragma unroll
          for (int i = 0; i < 16; ++i) tc[i] = tn[i];
      } }
#undef TR_DECODE
#undef TR_LOAD
    { bf16_t* WR = (bf16_t*)(wsl + WS_WR);
      for (int idx = blockIdx.x * 512 + F.tid; idx < DEPTH * 64 * 2 * 64; idx += F.G * 512) {
          const int ln = idx & 63, t = (idx >> 6) & 1, sst = (idx >> 7) & 63, ll = idx >> 13, n = ln & 15, kg = ln >> 4, c = 16 * t + n;
          unsigned hi[8], lo[8];
#pragma unroll
          for (int j = 0; j < 8; ++j) { const int k = 32 * sst + 8 * kg + j;
              const float wv = c < 4 ? kin(27)[((size_t)ll * D + k) * 4 + c] : (c < 20 ? kin(29)[((size_t)ll * D + k) * 16 + c - 4] : 0.f);
              hi[j] = f2bf(wv); lo[j] = f2bf(wv - __builtin_bit_cast(float, hi[j] << 16)); }
          bf16_t* o = WR + ((size_t)ll * 256 + (sst * 2 + t) * 2) * 512 + ln * 8;
          *(u32x4*)o = (u32x4){hi[0] | (hi[1] << 16), hi[2] | (hi[3] << 16), hi[4] | (hi[5] << 16), hi[6] | (hi[7] << 16)};
          *(u32x4*)(o + 512) = (u32x4){lo[0] | (lo[1] << 16), lo[2] | (lo[3] << 16), lo[4] | (lo[5] << 16), lo[6] | (lo[7] << 16)}; } }
    hy_filter_tails(F, wsl);
    for (int it = blockIdx.x; it < DEPTH * 66; it += F.G) hy_filter_item(F, it, wsl);
    __syncthreads();
    bf16_t* hb = (bf16_t*)(wsl + WS_HB);
    for (int row = gw; row < T; row += NGW) {
        const int bb = row / L, p = row % L;
        const float* src = p < NMETA ? kin(1) + (size_t)p * D : kin(0) + ((size_t)bb * SEQ + (p - NMETA)) * D;
        f32x4 v[8];
#pragma unroll
        for (int j = 0; j < 8; ++j) v[j] = ((const f32x4*)src)[lane + 64 * j];
        ln_wave_store(v, kin(2), kin(3), hb + (size_t)row * D, nullptr, nullptr, lane);
    }
}


__device__ __forceinline__ void hy_filter_item(Frame& F, int item, unsigned char* wsl) {
    const int half = item & 1, blk = (item >> 1) % 33, l = item / 66, tid = F.tid;
    const float* w1 = kin(15) + (size_t)l * 33 * 64; const float* b1 = kin(16) + l * 64; const float* freq = kin(17) + l * 128;
    const float* w2 = kin(18) + (size_t)l * 64 * 64; const float* b2 = kin(19) + l * 64; const float* w3 = kin(20) + (size_t)l * 64 * 1024;
    LAS float* z = (LAS float*)F.lds;
    LAS float* h1 = z + 64 * 33;
    LAS float* h2 = h1 + 64 * 64;
    LAS bf16_t* ot = (LAS bf16_t*)(h2 + 64 * 64);
    const int d0 = blk * 64;
    __syncthreads();
    for (int e = tid; e < 64 * 33; e += 512) { const int pl = e / 33, k = e % 33, i = d0 + pl; float v;
        if (k == 0) v = (float)i / (float)(L - 1);
        else { const int j = (k - 1) & 15; const double band = 1e-4 + (double)j * ((15.0 - 1e-4) / 15.0); double turns = band * (double)i / (double)L; turns -= (double)(long long)turns;
               const float ang = (float)(turns * 6.283185307179586476925); v = k < 17 ? __cosf(ang) : -__sinf(ang); }
        z[e] = v; }
    __syncthreads();
    { const int j = tid & 63, pg = tid >> 6; const float fq = freq[j], bb = b1[j];
      float a[8];
#pragma unroll
      for (int r = 0; r < 8; ++r) a[r] = bb;
      for (int k = 0; k < 33; ++k) { const float w = w1[k * 64 + j];
#pragma unroll
          for (int r = 0; r < 8; ++r) a[r] += z[(pg * 8 + r) * 33 + k] * w; }
#pragma unroll
      for (int r = 0; r < 8; ++r) h1[(pg * 8 + r) * 64 + j] = __sinf(fq * a[r]); }
    __syncthreads();
    { const int j = tid & 63, pg = tid >> 6; const float fq = freq[64 + j], bb = b2[j];
      float a[8];
#pragma unroll
      for (int r = 0; r < 8; ++r) a[r] = bb;
      for (int k = 0; k < 64; ++k) { const float w = w2[k * 64 + j];
#pragma unroll
          for (int r = 0; r < 8; ++r) a[r] += h1[(pg * 8 + r) * 64 + k] * w; }
#pragma unroll
      for (int r = 0; r < 8; ++r) h2[(pg * 8 + r) * 64 + j] = __sinf(fq * a[r]); }
    __syncthreads();
    { const int c = tid;
      const float mind = logf(1e-2f) / 1.5f, maxd = logf(1e-2f) / 0.3f;
      const float adel = fabsf(mind + (float)c * ((maxd - mind) / 511.0f));
      for (int pq = 0; pq < 64; pq += 8) {
          float a[8];
#pragma unroll
          for (int r = 0; r < 8; ++r) a[r] = 0.f;
          for (int k = 0; k < 64; ++k) { const float w = w3[k * 1024 + half * 512 + c];
#pragma unroll
              for (int r = 0; r < 8; ++r) a[r] += h2[(pq + r) * 64 + k] * w; }
#pragma unroll
          for (int r = 0; r < 8; ++r) { const int i = d0 + pq + r; const float tt = (float)i / (float)(L - 1); ot[c * 66 + pq + r] = (bf16_t)f2bf(a[r] * __expf(-tt * adel)); } } }
    __syncthreads();
    { bf16_t* FG = (bf16_t*)(wsl + WS_FG) + (size_t)l * 512 * 2 * GLEN;
      const int dl = tid & 63, cg = tid >> 6, d = d0 + dl;
      if (d < L && !(half == 1 && d == 0)) {
          const int m = half ? GCEN + d : GCEN - d;
          for (int c = cg; c < 512; c += 8) { const bf16_t v = ot[c * 66 + dl]; bf16_t* row = FG + (size_t)c * 2 * GLEN; row[m] = v; row[GLEN + m - 1] = v; } } }
}
__device__ __forceinline__ void hy_filter_tails(Frame& F, unsigned char* wsl) {
    bf16_t* FG = (bf16_t*)(wsl + WS_FG);
    constexpr int LO0 = GCEN - (L - 1), HI0 = GCEN + (L - 1) + 1;
    constexpr int NT0 = LO0 + (GLEN - HI0), NT1 = (LO0 - 1) + (GLEN - (HI0 - 1));
    for (size_t idx = (size_t)blockIdx.x * 512 + F.tid; idx < (size_t)DEPTH * 512 * (NT0 + NT1); idx += (size_t)F.G * 512) {
        const int rowi = (int)(idx / (NT0 + NT1)); int k = (int)(idx % (NT0 + NT1));
        bf16_t* row = FG + (size_t)rowi * 2 * GLEN;
        if (k < NT0) { const int m = k < LO0 ? k : HI0 + (k - LO0); row[m] = 0; }
        else { k -= NT0; const int m = k < LO0 - 1 ? k : (HI0 - 1) + (k - (LO0 - 1)); row[GLEN + m] = 0; } }
}

constexpr int MIXC_SG = 98304, MIXC_CW = 102400, MIXC_CB = 120832, MIXC_HG = 98304;
__device__ __forceinline__ void hy_pre_item(Frame& F, int item, int l, unsigned char* wsl) {
    const bf16_t* U = (const bf16_t*)(wsl + WS_U);
    bf16_t* X0T = (bf16_t*)(wsl + WS_X0T); bf16_t* ZT = (bf16_t*)(wsl + WS_ZT);
    const LAS float* cw = (const LAS float*)(F.lds + MIXC_CW); const LAS float* cb = (const LAS float*)(F.lds + MIXC_CB);
    const int cc = item & 3, pt = (item >> 2) % 33, b = item / (4 * 33), tid = opaque_v(F.tid);
    const int c8 = tid & 15, pl = tid >> 4, c0 = cc * 128 + 8 * c8;
    LAS bf16_t* zt = (LAS bf16_t*)F.lds; LAS bf16_t* xt = zt + 128 * 72;
    __syncthreads();
    u32x4 raw[2][3][3];
#pragma unroll
    for (int ps = 0; ps < 2; ++ps) { const int p = pt * 64 + pl + 32 * ps; const bool pv = p < L;
#pragma unroll
        for (int g = 0; g < 3; ++g) { const bf16_t* ub = U + ((size_t)b * L + (pv ? p : 0)) * INC + O_CU + g * 512 + c0; const u32x4 z4 = (u32x4){0u, 0u, 0u, 0u};
            raw[ps][g][0] = (pv && p > 0) ? *(const u32x4*)(ub - INC) : z4; raw[ps][g][1] = pv ? *(const u32x4*)ub : z4; raw[ps][g][2] = (p + 1 < L) ? *(const u32x4*)(ub + INC) : z4; } }
#pragma unroll
    for (int ps = 0; ps < 2; ++ps) { const int p = pt * 64 + pl + 32 * ps; const bool pv = p < L;
        float uc[3][8];
#pragma unroll
        for (int g = 0; g < 3; ++g) { const int col = g * 512 + c0;
            const f32x4 wa0 = *(const LAS f32x4*)(cw + col), wa1 = *(const LAS f32x4*)(cw + col + 4), wb0 = *(const LAS f32x4*)(cw + 1536 + col), wb1 = *(const LAS f32x4*)(cw + 1536 + col + 4),
                        wc0 = *(const LAS f32x4*)(cw + 3072 + col), wc1 = *(const LAS f32x4*)(cw + 3072 + col + 4), bb0 = *(const LAS f32x4*)(cb + col), bb1 = *(const LAS f32x4*)(cb + col + 4);
            const u32x4 rm = raw[ps][g][0], r0 = raw[ps][g][1], rp = raw[ps][g][2];
#pragma unroll
            for (int j = 0; j < 4; ++j) {
                const float m0 = __builtin_bit_cast(float, rm[j] << 16), m1 = __builtin_bit_cast(float, rm[j] & 0xffff0000u), x0 = __builtin_bit_cast(float, r0[j] << 16), x1 = __builtin_bit_cast(float, r0[j] & 0xffff0000u),
                            q0 = __builtin_bit_cast(float, rp[j] << 16), q1 = __builtin_bit_cast(float, rp[j] & 0xffff0000u);
                const int e = 2 * j; const float w0a = e < 4 ? wa0[e & 3] : wa1[e & 3], w0b = e < 4 ? wb0[e & 3] : wb1[e & 3], w0c = e < 4 ? wc0[e & 3] : wc1[e & 3], b0_ = e < 4 ? bb0[e & 3] : bb1[e & 3];
                const float w1a = e < 4 ? wa0[(e + 1) & 3] : wa1[(e + 1) & 3], w1b = e < 4 ? wb0[(e + 1) & 3] : wb1[(e + 1) & 3], w1c = e < 4 ? wc0[(e + 1) & 3] : wc1[(e + 1) & 3], b1_ = e < 4 ? bb0[(e + 1) & 3] : bb1[(e + 1) & 3];
                uc[g][e] = pv ? (b0_ + m0 * w0a + x0 * w0b + q0 * w0c) : 0.f; uc[g][e + 1] = pv ? (b1_ + m1 * w1a + x1 * w1b + q1 * w1c) : 0.f; } }
#pragma unroll
        for (int j = 0; j < 8; ++j) { zt[(8 * c8 + j) * 72 + pl + 32 * ps] = (bf16_t)f2bf(uc[1][j] * uc[2][j]); xt[(8 * c8 + j) * 72 + pl + 32 * ps] = (bf16_t)f2bf(uc[0][j]); } }
    __syncthreads();
#pragma unroll
    for (int it = 0; it < 2; ++it) { const int cr = (tid >> 3) + 64 * it, pc = tid & 7;
      const size_t o = ((size_t)(cc * 128 + cr) * NB + b) * ZL + pt * 64 + pc * 8;
      *(u32x4*)(ZT + o) = *(const LAS u32x4*)(zt + cr * 72 + pc * 8);
      *(u32x4*)(X0T + o) = *(const LAS u32x4*)(xt + cr * 72 + pc * 8); }
}

__device__ __forceinline__ void hy_conv_phase(Frame& F, int l, unsigned char* wsl) {
    const bf16_t* ZT = (const bf16_t*)(wsl + WS_ZT); const bf16_t* X0T = (const bf16_t*)(wsl + WS_X0T); bf16_t* YT = (bf16_t*)(wsl + WS_YT);
    const bf16_t* FG = (const bf16_t*)(wsl + WS_FG) + (size_t)l * 512 * 2 * GLEN;
    const float* skip = kin(21) + l * 512;
    LAS unsigned char* Zs = F.lds;
    LAS unsigned char* Gs = F.lds + 8 * ZROW * 2;
    const int tid = F.tid, lane = F.lane, wave = F.wave;
    __syncthreads();
    for (int e = tid; e < 8 * ZROW * 2 / 16; e += 512) *(LAS u32x4*)(Zs + e * 16) = (u32x4){0u, 0u, 0u, 0u};
    const int pp = wave & 1, q = wave >> 1;
    const int T0 = 576 * q + 16 * pp, D0 = -(576 * q + 544 + 32 * pp), S0 = T0 + D0;
    const int n = lane & 15, kg = lane >> 4, bb = n & 7, u = n >> 3;
    const unsigned zb = (unsigned)(bb * ZROW * 2 + 2 * (ZOFF + S0 + 32 * u + 8 * kg));
    const int par = n & 1, e0 = GCEN + D0 + 8 * kg - n;
    const unsigned ab = (unsigned)(8 * ZROW * 2 + par * GLEN * 2 + 2 * (e0 - par));
    for (int c = F.vcu; c < 512; c += F.G) {
        __syncthreads();
        for (int e = tid; e < 8 * (ZL / 8); e += 512) { const int b = e / (ZL / 8), pc = e % (ZL / 8);
            *(LAS u32x4*)(Zs + (b * ZROW + ZOFF + pc * 8) * 2) = *(const u32x4*)(ZT + ((size_t)c * NB + b) * ZL + pc * 8); }
        for (int e = tid; e < 2 * GLEN / 8; e += 512) *(LAS u32x4*)(Gs + e * 16) = *(const u32x4*)(FG + (size_t)c * 2 * GLEN + e * 8);
        __syncthreads();
        f32x4 acc[9];
#pragma unroll
        for (int k = 0; k < 9; ++k) acc[k] = (f32x4){0.f, 0.f, 0.f, 0.f};
        bf16x8 ring[18];
#pragma unroll
        for (int s2 = 0; s2 < 17; ++s2) ring[s2] = *(const LAS bf16x8*)(F.lds + zb + 64 * s2);
        u32x4 an;
#pragma unroll
        for (int d = 0; d < 4; ++d) an[d] = *(const LAS unsigned*)(F.lds + ab + 4 * d);
        for (int jo = 0; jo < 5; ++jo) {
            const unsigned zo = zb + (unsigned)jo * 18u * 64u, ao = ab + (unsigned)jo * 18u * 64u;
#pragma unroll
            for (int jj = 0; jj < 18; ++jj) {
                const bf16x8 acur = __builtin_bit_cast(bf16x8, an);
                ring[(jj + 17) % 18] = *(const LAS bf16x8*)(F.lds + zo + 64 * (jj + 17));
#pragma unroll
                for (int d = 0; d < 4; ++d) an[d] = *(const LAS unsigned*)(F.lds + ao + 64 * (jj + 1) + 4 * d);
#pragma unroll
                for (int k = 0; k < 9; ++k) acc[k] = __builtin_amdgcn_mfma_f32_16x16x32_bf16(acur, ring[(jj + 2 * k) % 18], acc[k], 0, 0, 0);
            }
        }
        const float sk = skip[c];
#pragma unroll
        for (int k = 0; k < 9; ++k) { const int t = T0 + 64 * k + 32 * u + 4 * kg;
            if (t < L) { const size_t o = ((size_t)c * NB + bb) * ZL + t;
                const u32x2 xv = *(const u32x2*)(X0T + o); const u32x2 zv = *(const LAS u32x2*)(Zs + (bb * ZROW + ZOFF + t) * 2);
                float y[4];
                y[0] = __builtin_bit_cast(float, xv.x << 16) * (acc[k][0] + sk * __builtin_bit_cast(float, zv.x << 16));
                y[1] = __builtin_bit_cast(float, xv.x & 0xffff0000u) * (acc[k][1] + sk * __builtin_bit_cast(float, zv.x & 0xffff0000u));
                y[2] = __builtin_bit_cast(float, xv.y << 16) * (acc[k][2] + sk * __builtin_bit_cast(float, zv.y << 16));
                y[3] = __builtin_bit_cast(float, xv.y & 0xffff0000u) * (acc[k][3] + sk * __builtin_bit_cast(float, zv.y & 0xffff0000u));
                u32x2 w; w.x = pk2(y[0], y[1]); w.y = pk2(y[2], y[3]); *(u32x2*)(YT + o) = w; } }
    }
    __syncthreads();
}

__device__ __forceinline__ void hy_norm_item(Frame& F, int item, int l, unsigned char* wsl) {
    const bf16_t* YT = (const bf16_t*)(wsl + WS_YT); bf16_t* Y = (bf16_t*)(wsl + WS_Y); const LAS float* hg = (const LAS float*)(F.lds + MIXC_HG);
    const int pt = item % 33, b = item / 33, p0 = pt * 64, tid = opaque_v(F.tid);
    LAS bf16_t* tl = (LAS bf16_t*)F.lds;
    LAS float* part = (LAS float*)(F.lds + 512 * 72 * 2);
    LAS float* rsv = part + 512;
    __syncthreads();
#pragma unroll
    for (int it = 0; it < 8; ++it) { const int c = (tid >> 3) + 64 * it, pc = tid & 7;
        *(LAS u32x4*)(tl + c * 72 + pc * 8) = *(const u32x4*)(YT + ((size_t)c * NB + b) * ZL + p0 + pc * 8); }
    __syncthreads();
    { const int pos = tid & 63, cg = tid >> 6; float sacc = 0.f;
      for (int c = cg * 64; c < cg * 64 + 64; ++c) { const float v = bf2f(tl[c * 72 + pos]); sacc += v * v; }
      part[cg * 64 + pos] = sacc; }
    __syncthreads();
    if (tid < 64) { float sacc = 0.f;
#pragma unroll
        for (int g = 0; g < 8; ++g) sacc += part[g * 64 + tid];
        rsv[tid] = rsqrtf(sacc * (1.0f / 512.0f) + 1e-6f); }
    __syncthreads();
    { const int pos = tid >> 3, pc = tid & 7, p = p0 + pos;
      if (p < L) { const float rs = rsv[pos]; bf16_t* yrow = Y + ((size_t)b * L + p) * D + 1536;
#pragma unroll
          for (int it = 0; it < 8; ++it) { const int c = it * 64 + pc * 8; float v[8];
#pragma unroll
              for (int j = 0; j < 8; ++j) v[j] = bf2f(tl[(c + j) * 72 + pos]) * rs * hg[c + j];
              u32x4 w; w.x = pk2(v[0], v[1]); w.y = pk2(v[2], v[3]); w.z = pk2(v[4], v[5]); w.w = pk2(v[6], v[7]);
              *(u32x4*)(yrow + c) = w; } } }
}


constexpr int GS = 72;
constexpr int G_OP0 = 0, G_OP1 = 9216, G_VT = 18432, G_DEC = 36864, G_PART = 37376, G_W = 38400, G_ST = 49152;
typedef float f32x16 __attribute__((ext_vector_type(16)));
typedef short s16x4 __attribute__((ext_vector_type(4)));
__device__ __forceinline__ float logsigmoid_fast(float x) { return fminf(x, 0.f) - __logf(1.0f + __expf(-fabsf(x))); }
template <int N> __device__ __forceinline__ float row_shr_add(float v) { const int t = __builtin_amdgcn_update_dpp(0, __builtin_bit_cast(int, v), 0x110 + N, 0xf, 0xf, true); return v + __builtin_bit_cast(float, t); }
__device__ __forceinline__ float wave_incl_scan(float v, int lane) {
    v = row_shr_add<1>(v); v = row_shr_add<2>(v); v = row_shr_add<4>(v); v = row_shr_add<8>(v);
    { const int t = __builtin_amdgcn_update_dpp(0, __builtin_bit_cast(int, v), 0x142, 0xa, 0xf, false); v += __builtin_bit_cast(float, t); }
    { const int t = __builtin_amdgcn_update_dpp(0, __builtin_bit_cast(int, v), 0x143, 0xc, 0xf, false); v += __builtin_bit_cast(float, t); }
    return v;
}
__device__ __forceinline__ float lane_bcast63(float v) { return __builtin_bit_cast(float, __builtin_amdgcn_readlane(__builtin_bit_cast(int, v), 63)); }
__device__ __forceinline__ int crow16(int i, int hh) { return (i & 3) + 8 * (i >> 2) + 4 * hh; }
#define MFMA32(a, b, c) __builtin_amdgcn_mfma_f32_32x32x16_bf16((a), (b), (c), 0, 0, 0)
__device__ __forceinline__ void gla_passA_item(Frame& F, int item, int l, unsigned char* wsl) {
    const int n = item % GNC, bh = item / GNC, b = bh >> 2, h = bh & 3, tid = opaque_v(F.tid), w = F.wave, lane = tid & 63;
    LAS float* gw = (LAS float*)(F.lds + G_W);
    const bf16_t* U = (const bf16_t*)(wsl + WS_U);
    const int d0 = 8 * w, p = 64 * n - 48 + lane; const bool valid = p >= 0;
    const bf16_t* urow = U + ((size_t)b * L + (valid ? p : 0)) * INC;
    const u32x4 g0 = *(const u32x4*)(urow + O_GF), g1 = *(const u32x4*)(urow + O_GF + 8), g2 = *(const u32x4*)(urow + O_GB), g3 = *(const u32x4*)(urow + O_GB + 8);
    const u32x4 qraw = *(const u32x4*)(urow + O_AQ + h * 64 + d0), kraw = *(const u32x4*)(urow + O_AK + h * 64 + d0);
    const u32x4 v0 = *(const u32x4*)(urow + O_AV + h * 128 + 16 * w), v1 = *(const u32x4*)(urow + O_AV + h * 128 + 16 * w + 8);
    __syncthreads();
    for (int e = tid; e < 2176; e += 512) { float v;
        if (e < 2048) { const int dirw = e >> 10, rr = (e >> 6) & 15, d = e & 63; v = (dirw ? kin(8) : kin(6))[(size_t)l * 16 * 256 + rr * 256 + h * 64 + d]; }
        else { const int dirw = (e - 2048) >> 6, d = e & 63; v = (dirw ? kin(9) : kin(7))[l * 256 + h * 64 + d]; }
        gw[e] = v; }
    __syncthreads();
    float glf[16], glb[16];
    {
#pragma unroll
      for (int r = 0; r < 4; ++r) { glf[2 * r] = __builtin_bit_cast(float, g0[r] << 16); glf[2 * r + 1] = __builtin_bit_cast(float, g0[r] & 0xffff0000u); glf[8 + 2 * r] = __builtin_bit_cast(float, g1[r] << 16); glf[9 + 2 * r] = __builtin_bit_cast(float, g1[r] & 0xffff0000u);
          glb[2 * r] = __builtin_bit_cast(float, g2[r] << 16); glb[2 * r + 1] = __builtin_bit_cast(float, g2[r] & 0xffff0000u); glb[8 + 2 * r] = __builtin_bit_cast(float, g3[r] << 16); glb[9 + 2 * r] = __builtin_bit_cast(float, g3[r] & 0xffff0000u); } }
    float cF[8], cB[8], tF[8], tB[8];
#pragma unroll
    for (int dirw = 0; dirw < 2; ++dirw) {
        float x[8];
        { const f32x4 b0 = *(const LAS f32x4*)(gw + 2048 + dirw * 64 + d0), b1 = *(const LAS f32x4*)(gw + 2048 + dirw * 64 + d0 + 4);
#pragma unroll
          for (int j = 0; j < 4; ++j) { x[j] = b0[j]; x[4 + j] = b1[j]; } }
#pragma unroll
        for (int r = 0; r < 16; ++r) {
            const f32x4 a0 = *(const LAS f32x4*)(gw + dirw * 1024 + r * 64 + d0), a1 = *(const LAS f32x4*)(gw + dirw * 1024 + r * 64 + d0 + 4);
            const float g = dirw ? glb[r] : glf[r];
#pragma unroll
            for (int j = 0; j < 4; ++j) { x[j] += g * a0[j]; x[4 + j] += g * a1[j]; }
            if ((r & 3) == 3) asm volatile("" : "+v"(x[0]), "+v"(x[1]), "+v"(x[2]), "+v"(x[3]), "+v"(x[4]), "+v"(x[5]), "+v"(x[6]), "+v"(x[7]));
        }
#pragma unroll
        for (int dd = 0; dd < 8; ++dd) {
            const float lg = valid ? logsigmoid_fast(x[dd]) * (1.0f / 16.0f) : 0.f;
            const float ps = wave_incl_scan(lg, lane), tot = lane_bcast63(ps);
            if (dirw == 0) { cF[dd] = ps; tF[dd] = tot; } else { cB[dd] = tot - ps + lg; tB[dd] = tot; }
            if ((dd & 1) == 1) { if (dirw == 0) asm volatile("" : "+v"(cF[dd]), "+v"(cF[dd - 1])); else asm volatile("" : "+v"(cB[dd]), "+v"(cB[dd - 1])); }
        }
    }
    LAS bf16_t* op0 = (LAS bf16_t*)(F.lds + G_OP0); LAS bf16_t* op1 = (LAS bf16_t*)(F.lds + G_OP1); LAS float* dec = (LAS float*)(F.lds + G_DEC);
    unsigned pq0[4], pq1[4], pq2[4], pq3[4];
#pragma unroll
    for (int dd = 0; dd < 8; ++dd) {
        const float qv = valid ? ((dd & 1) ? __builtin_bit_cast(float, qraw[dd >> 1] & 0xffff0000u) : __builtin_bit_cast(float, qraw[dd >> 1] << 16)) : 0.f;
        const float kv = valid ? ((dd & 1) ? __builtin_bit_cast(float, kraw[dd >> 1] & 0xffff0000u) : __builtin_bit_cast(float, kraw[dd >> 1] << 16)) : 0.f;
        op0[(d0 + dd) * GS + lane] = (bf16_t)f2bf(kv * __expf(tF[dd] - cF[dd]));
        op1[(d0 + dd) * GS + lane] = (bf16_t)f2bf(kv * __expf(tB[dd] - cB[dd]));
        if (lane == 0) { dec[d0 + dd] = __expf(tF[dd]); dec[64 + d0 + dd] = __expf(tB[dd]); }
        const unsigned a0 = f2bf(qv * 0.125f * __expf(cF[dd])), a1 = f2bf(kv * __expf(-cF[dd])), a2 = f2bf(qv * 0.125f * __expf(cB[dd])), a3 = f2bf(kv * __expf(-cB[dd]));
        if (dd & 1) { pq0[dd >> 1] |= a0 << 16; pq1[dd >> 1] |= a1 << 16; pq2[dd >> 1] |= a2 << 16; pq3[dd >> 1] |= a3 << 16; }
        else { pq0[dd >> 1] = a0; pq1[dd >> 1] = a1; pq2[dd >> 1] = a2; pq3[dd >> 1] = a3; }
    }
    { LAS bf16_t* st = (LAS bf16_t*)(F.lds + G_ST) + lane * GS + d0;
      *(LAS u32x4*)(st) = (u32x4){pq0[0], pq0[1], pq0[2], pq0[3]}; *(LAS u32x4*)(st + 64 * GS) = (u32x4){pq1[0], pq1[1], pq1[2], pq1[3]};
      *(LAS u32x4*)(st + 128 * GS) = (u32x4){pq2[0], pq2[1], pq2[2], pq2[3]}; *(LAS u32x4*)(st + 192 * GS) = (u32x4){pq3[0], pq3[1], pq3[2], pq3[3]}; }
    LAS bf16_t* vt = (LAS bf16_t*)(F.lds + G_VT);
    {
#pragma unroll
      for (int j = 0; j < 4; ++j) { const int dv = 16 * w + 2 * j;
          vt[dv * GS + lane] = valid ? (bf16_t)(v0[j] & 0xffffu) : (bf16_t)0; vt[(dv + 1) * GS + lane] = valid ? (bf16_t)(v0[j] >> 16) : (bf16_t)0;
          vt[(dv + 8) * GS + lane] = valid ? (bf16_t)(v1[j] & 0xffffu) : (bf16_t)0; vt[(dv + 9) * GS + lane] = valid ? (bf16_t)(v1[j] >> 16) : (bf16_t)0; } }
    __syncthreads();
    { bf16_t* gvt = (bf16_t*)(wsl + WS_GVT) + (size_t)item * 8192;
#pragma unroll
      for (int it = 0; it < 2; ++it) { const int e = it * 512 + tid, dv = e >> 3, pc = e & 7; *(u32x4*)(gvt + dv * 64 + pc * 8) = *(const LAS u32x4*)(vt + dv * GS + pc * 8); } }
    { bf16_t* gqk = (bf16_t*)(wsl + WS_GQK) + (size_t)item * 4 * 4096; const LAS bf16_t* st = (const LAS bf16_t*)(F.lds + G_ST);
#pragma unroll
      for (int it = 0; it < 4; ++it) { const int pos = tid >> 3, pc = tid & 7; *(u32x4*)(gqk + it * 4096 + pos * 64 + pc * 8) = *(const LAS u32x4*)(st + (it * 64 + pos) * GS + pc * 8); } }
    const int dir = w >> 2, dvb = w & 3, r = lane & 31, hh = lane >> 5;
    const LAS bf16_t* KL = (const LAS bf16_t*)(F.lds + (dir ? G_OP1 : G_OP0));
    f32x16 acc0, acc1;
#pragma unroll
    for (int i = 0; i < 16; ++i) { acc0[i] = 0.f; acc1[i] = 0.f; }
#pragma unroll
    for (int ks = 0; ks < 4; ++ks) {
        const bf16x8 a = *(const LAS bf16x8*)(vt + (32 * dvb + r) * GS + 16 * ks + 8 * hh);
        const bf16x8 b0 = *(const LAS bf16x8*)(KL + r * GS + 16 * ks + 8 * hh);
        const bf16x8 b1 = *(const LAS bf16x8*)(KL + (32 + r) * GS + 16 * ks + 8 * hh);
        acc0 = MFMA32(a, b0, acc0); acc1 = MFMA32(a, b1, acc1);
    }
    const int chain = (bh << 1) | dir;
    bf16_t* kvt = (bf16_t*)(wsl + WS_KVT) + ((size_t)chain * GNC + n) * 128 * 64;
#pragma unroll
    for (int i = 0; i < 16; ++i) { const int dv = 32 * dvb + crow16(i, hh); kvt[dv * 64 + r] = (bf16_t)f2bf(acc0[i]); kvt[dv * 64 + 32 + r] = (bf16_t)f2bf(acc1[i]); }
    if (tid < 128) { const int d = tid & 63, dd = tid >> 6; ((float*)(wsl + WS_DEC))[((size_t)((bh << 1) | dd) * GNC + n) * 64 + d] = ((const LAS float*)(F.lds + G_DEC))[dd * 64 + d]; }
}
__device__ __forceinline__ void gla_passB(Frame& F, unsigned char* wsl) {
    const bf16_t* KVT = (const bf16_t*)(wsl + WS_KVT); const float* DEC = (const float*)(wsl + WS_DEC); bf16_t* SPT = (bf16_t*)(wsl + WS_SPT);
    const int t0 = blockIdx.x * 512 + F.tid, tstride = F.G * 512;
    for (int t = t0; t < 64 * 4096; t += 2 * tstride) {
        const int tb = t + tstride; const bool hasb = tb < 64 * 4096; const int t2 = hasb ? tb : t;
        const int chA = t >> 12, remA = t & 4095, dvA = remA >> 5, dkA = (remA & 31) * 2, dirA = chA & 1;
        const int chB = t2 >> 12, remB = t2 & 4095, dvB = remB >> 5, dkB = (remB & 31) * 2, dirB = chB & 1;
        float a0 = 0.f, a1 = 0.f, b0 = 0.f, b1 = 0.f;
#pragma unroll 11
        for (int st = 0; st < GNC; ++st) { const int nA = dirA ? GNC - 1 - st : st, nB = dirB ? GNC - 1 - st : st;
            const size_t oA = (((size_t)chA * GNC + nA) * 128 + dvA) * 64 + dkA, oB = (((size_t)chB * GNC + nB) * 128 + dvB) * 64 + dkB;
            *(unsigned*)(SPT + oA) = pk2(a0, a1); if (hasb) *(unsigned*)(SPT + oB) = pk2(b0, b1);
            const unsigned kva_ = *(const unsigned*)(KVT + oA); const f32x2 kvA = (f32x2){__builtin_bit_cast(float, kva_ << 16), __builtin_bit_cast(float, kva_ & 0xffff0000u)}, dcA = *(const f32x2*)(DEC + ((size_t)chA * GNC + nA) * 64 + dkA);
            const unsigned kvb_ = *(const unsigned*)(KVT + oB); const f32x2 kvB = (f32x2){__builtin_bit_cast(float, kvb_ << 16), __builtin_bit_cast(float, kvb_ & 0xffff0000u)}, dcB = *(const f32x2*)(DEC + ((size_t)chB * GNC + nB) * 64 + dkB);
            a0 = dcA[0] * a0 + kvA[0]; a1 = dcA[1] * a1 + kvA[1]; b0 = dcB[0] * b0 + kvB[0]; b1 = dcB[1] * b1 + kvB[1]; }
    }
}
__device__ __forceinline__ void gla_passC_item(Frame& F, int item, int l, unsigned char* wsl) {
    constexpr int C_QD = 0, C_KI = 18432, C_SP = 36864, C_VT = 73728, C_PART = 92160, C_OS = 0, RB = GS * 2, OSS = 132;
    const int n = item % GNC, bh = item / GNC, b = bh >> 2, h = bh & 3;
    const int w = F.wave, tid = opaque_v(F.tid), lane = tid & 63, cb = w >> 2, dvb = w & 3, r = lane & 31, hh = lane >> 5;
    const bf16_t* gqk = (const bf16_t*)(wsl + WS_GQK) + (size_t)item * 4 * 4096;
    const bf16_t* gvt = (const bf16_t*)(wsl + WS_GVT) + (size_t)item * 8192;
    const bf16_t* spt0 = (const bf16_t*)(wsl + WS_SPT) + ((size_t)((bh << 1) | 0) * GNC + n) * 128 * 64;
    const bf16_t* spt1 = (const bf16_t*)(wsl + WS_SPT) + ((size_t)((bh << 1) | 1) * GNC + n) * 128 * 64;
    const bf16_t* U = (const bf16_t*)(wsl + WS_U); bf16_t* Y = (bf16_t*)(wsl + WS_Y);
    u32x4 raw[10], rgr[2];
#pragma unroll
    for (int it = 0; it < 4; ++it) raw[it] = *(const u32x4*)(gqk + it * 4096 + tid * 8);
    raw[4] = *(const u32x4*)(spt0 + tid * 8); raw[5] = *(const u32x4*)(spt0 + 4096 + tid * 8); raw[6] = *(const u32x4*)(spt1 + tid * 8); raw[7] = *(const u32x4*)(spt1 + 4096 + tid * 8);
    raw[8] = *(const u32x4*)(gvt + tid * 8); raw[9] = *(const u32x4*)(gvt + 4096 + tid * 8);
#pragma unroll
    for (int it = 0; it < 2; ++it) { const int e = it * 512 + tid, pos = e >> 4, p = 64 * n - 48 + pos;
        rgr[it] = *(const u32x4*)(U + ((size_t)b * L + max(p, 0)) * INC + O_AR + h * 128 + 8 * (e & 15)); }
    const float gv = (kin(10) + l * 512 + h * 128 + 32 * dvb)[r];
    { const int row = tid >> 3, pc = tid & 7; LAS unsigned char* dst = F.lds + row * RB + pc * 16;
      *(LAS u32x4*)(dst + C_QD) = raw[0]; *(LAS u32x4*)(dst + C_KI) = raw[1]; *(LAS u32x4*)(dst + C_QD + 64 * RB) = raw[2]; *(LAS u32x4*)(dst + C_KI + 64 * RB) = raw[3];
      *(LAS u32x4*)(dst + C_SP) = raw[4]; *(LAS u32x4*)(dst + C_SP + 64 * RB) = raw[5]; *(LAS u32x4*)(dst + C_SP + 128 * RB) = raw[6]; *(LAS u32x4*)(dst + C_SP + 192 * RB) = raw[7];
      *(LAS u32x4*)(dst + C_VT) = raw[8]; *(LAS u32x4*)(dst + C_VT + 64 * RB) = raw[9]; }
    __syncthreads();
    f32x16 o;
#pragma unroll
    for (int i = 0; i < 16; ++i) o[i] = 0.f;
    const LAS unsigned char* fb = F.lds + r * RB + 16 * hh;
    const LAS unsigned char* vb = F.lds + C_VT + (32 * dvb + r) * RB + 8 * hh;
#pragma unroll
    for (int dir = 0; dir < 2; ++dir) {
        bf16x8 qf[4];
#pragma unroll
        for (int ks = 0; ks < 4; ++ks) qf[ks] = *(const LAS bf16x8*)(fb + C_QD + (dir * 64 + 32 * cb) * RB + 32 * ks);
#pragma unroll
        for (int sb = 0; sb < 2; ++sb) {
            f32x16 X;
#pragma unroll
            for (int i = 0; i < 16; ++i) X[i] = 0.f;
#pragma unroll
            for (int ks = 0; ks < 4; ++ks) X = MFMA32(*(const LAS bf16x8*)(fb + C_KI + (dir * 64 + 32 * sb) * RB + 32 * ks), qf[ks], X);
            const int cidx = 32 * cb + r;
#pragma unroll
            for (int i = 0; i < 16; ++i) { const int sidx = 32 * sb + crow16(i, hh); const bool keep = dir ? (sidx > cidx) : (sidx <= cidx); X[i] = keep ? X[i] : 0.f; }
#pragma unroll
            for (int ks2 = 0; ks2 < 2; ++ks2) {
                u32x4 xp; xp.x = pk2(X[8 * ks2 + 0], X[8 * ks2 + 1]); xp.y = pk2(X[8 * ks2 + 2], X[8 * ks2 + 3]); xp.z = pk2(X[8 * ks2 + 4], X[8 * ks2 + 5]); xp.w = pk2(X[8 * ks2 + 6], X[8 * ks2 + 7]);
                const s16x4 vlo = *(const LAS s16x4*)(vb + (32 * sb + 16 * ks2) * 2), vhi = *(const LAS s16x4*)(vb + (32 * sb + 16 * ks2 + 8) * 2);
                o = MFMA32(__builtin_bit_cast(bf16x8, xp), __builtin_shufflevector(vlo, vhi, 0, 1, 2, 3, 4, 5, 6, 7), o);
            }
        }
#pragma unroll
        for (int ks = 0; ks < 4; ++ks) o = MFMA32(qf[ks], *(const LAS bf16x8*)(fb + C_SP + (dir * 128 + 32 * dvb) * RB + 32 * ks), o);
    }
    LAS float* part = (LAS float*)(F.lds + C_PART);
#pragma unroll
    for (int i = 0; i < 16; ++i) { float q = o[i] * o[i];
        q = row_shr_add<1>(q); q = row_shr_add<2>(q); q = row_shr_add<4>(q); q = row_shr_add<8>(q);
        const int qi = __builtin_bit_cast(int, q);
        const float s0 = __builtin_bit_cast(float, __builtin_amdgcn_readlane(qi, 15)) + __builtin_bit_cast(float, __builtin_amdgcn_readlane(qi, 31));
        const float s1 = __builtin_bit_cast(float, __builtin_amdgcn_readlane(qi, 47)) + __builtin_bit_cast(float, __builtin_amdgcn_readlane(qi, 63));
        if (r == 0) part[(cb * 4 + dvb) * 32 + crow16(i, hh)] = hh ? s1 : s0; }
    __syncthreads();
    LAS float* os = (LAS float*)(F.lds + C_OS);
#pragma unroll
    for (int i = 0; i < 16; ++i) { const int rw = crow16(i, hh);
        const float ss = (part[(cb * 4 + 0) * 32 + rw] + part[(cb * 4 + 1) * 32 + rw]) + (part[(cb * 4 + 2) * 32 + rw] + part[(cb * 4 + 3) * 32 + rw]);
        const float rs = rsqrtf(ss * (1.0f / 128.0f) + 1e-6f);
        os[(32 * cb + rw) * OSS + 32 * dvb + r] = o[i] * rs * gv; }
    __syncthreads();
#pragma unroll
    for (int it = 0; it < 2; ++it) { const int e = it * 512 + tid, pos = e >> 4, dv0 = 8 * (e & 15), p = 64 * n - 48 + pos;
        if (p >= 0) { const f32x4 a0 = *(const LAS f32x4*)(os + pos * OSS + dv0), a1 = *(const LAS f32x4*)(os + pos * OSS + dv0 + 4); const u32x4 g = rgr[it]; float y[8];
#pragma unroll
            for (int j = 0; j < 4; ++j) { const float g0 = __builtin_bit_cast(float, g[j] << 16), g1 = __builtin_bit_cast(float, g[j] & 0xffff0000u);
                const float x0 = j < 2 ? a0[2 * j] : a1[2 * j - 4], x1 = j < 2 ? a0[2 * j + 1] : a1[2 * j - 3];
                y[2 * j] = x0 * (g0 / (1.0f + __expf(-g0))); y[2 * j + 1] = x1 * (g1 / (1.0f + __expf(-g1))); }
            u32x4 wv; wv.x = pk2(y[0], y[1]); wv.y = pk2(y[2], y[3]); wv.z = pk2(y[4], y[5]); wv.w = pk2(y[6], y[7]);
            *(u32x4*)(Y + ((size_t)b * L + p) * D + h * 128 + dv0) = wv; } }
}

constexpr int SW_KS = 136, SW_VS = 40;
constexpr int SW_K = 0, SW_V = 2 * 2 * 32 * SW_KS * 2;
constexpr int SW_PART = SW_V + 2 * 2 * 128 * SW_VS * 2;
constexpr int SW_OS = 1032;
__device__ __forceinline__ void swa_item(Frame& F, int item, int l, unsigned char* wsl) {
    const bf16_t* U = (const bf16_t*)(wsl + WS_U); bf16_t* Y = (bf16_t*)(wsl + WS_Y);
    const int qb = item % 65, b = item / 65, q0 = 32 * qb, tid = opaque_v(F.tid), lane = tid & 63, w = F.wave, r = lane & 31, hh = lane >> 5;
    const int head = w, kvh = w >> 2, qp = q0 + r;
    const float slope = exp2f(-(float)(head + 1));
    const float sk = (kin(11) + l * 8)[head];
    bf16x8 Qf[8];
    { const bf16_t* qrow = U + ((size_t)b * L + min(qp, L - 1)) * INC + O_BQ + head * 128;
#pragma unroll
      for (int ks = 0; ks < 8; ++ks) Qf[ks] = *(const bf16x8*)(qrow + 16 * ks + 8 * hh); }
    f32x16 O[4];
#pragma unroll
    for (int db = 0; db < 4; ++db)
#pragma unroll
        for (int i = 0; i < 16; ++i) O[db][i] = 0.f;
    const float sc2 = 0.08838834764831845f * 1.4426950408889634f, slope2 = slope * 1.4426950408889634f;
    float m = sk * 1.4426950408889634f, lsum = hh == 0 ? 1.0f : 0.0f;
    const int tlo = max(1, qb - 4), thi = min(64, qb + 4), ntile = 1 + (thi - tlo + 1), nch = (ntile + 1) >> 1;
    LAS bf16_t* Ks = (LAS bf16_t*)(F.lds + SW_K); LAS bf16_t* Vs = (LAS bf16_t*)(F.lds + SW_V);
    u32x4 kx[2][4], vx[2][4];
#define SWA_FETCH(chn, par_) do { _Pragma("unroll") for (int it = 0; it < 4; ++it) { const int e = it * 512 + tid; const int key = e & 31, d8 = (e >> 5) & 15, kv2 = (e >> 9) & 1, sl_ = e >> 10; \
            const int ti_ = (chn) * 2 + sl_; const int tl_ = ti_ == 0 ? 0 : tlo + ti_ - 1; const int kp_ = min(32 * tl_ + key, L - 1); const bf16_t* krow = U + ((size_t)b * L + kp_) * INC; \
            const int kkey_ = (e >> 4) & 31, kd8_ = e & 15; const bf16_t* krow2 = U + ((size_t)b * L + min(32 * tl_ + kkey_, L - 1)) * INC;        \
            kx[par_][it] = *(const u32x4*)(krow2 + O_BK + kv2 * 128 + 8 * kd8_); vx[par_][it] = *(const u32x4*)(krow + O_BV + kv2 * 128 + 8 * d8); } } while (0)
    SWA_FETCH(0, 0);
    if (nch > 1) SWA_FETCH(1, 1);
    for (int c2 = 0; c2 < nch; c2 += 2) {
#pragma unroll
      for (int par = 0; par < 2; ++par) {
        const int ch = c2 + par; if (ch >= nch) break;
        __syncthreads();
#pragma unroll
        for (int it = 0; it < 4; ++it) { const int e = it * 512 + tid; const int key = e & 31, d8 = (e >> 5) & 15, kv2 = (e >> 9) & 1, sl = e >> 10;
            *(LAS u32x4*)(Ks + ((sl * 2 + kv2) * 32 + ((e >> 4) & 31)) * SW_KS + 8 * (e & 15)) = kx[par][it];
            LAS bf16_t* vb = Vs + ((sl * 2 + kv2) * 128 + 8 * d8) * SW_VS + key;
#pragma unroll
            for (int j = 0; j < 4; ++j) { vb[(2 * j) * SW_VS] = (bf16_t)(vx[par][it][j] & 0xffffu); vb[(2 * j + 1) * SW_VS] = (bf16_t)(vx[par][it][j] >> 16); } }
        if (ch + 2 < nch) SWA_FETCH(ch + 2, par);
        __syncthreads();
#pragma unroll 1
        for (int sl = 0; sl < 2; ++sl) {
            const int ti = ch * 2 + sl; if (ti >= ntile) break;
            const int tl = ti == 0 ? 0 : tlo + ti - 1, kp0 = 32 * tl;
            f32x16 S;
#pragma unroll
            for (int i = 0; i < 16; ++i) S[i] = 0.f;
            const LAS bf16_t* kt = Ks + ((sl * 2 + kvh) * 32 + r) * SW_KS + 8 * hh;
#pragma unroll
            for (int ks = 0; ks < 8; ++ks) { const bf16x8 a = *(const LAS bf16x8*)(kt + 16 * ks); S = MFMA32(a, Qf[ks], S); }
            float mx = -1e30f;
            const float fb = (float)(qp - kp0 - 4 * hh);
            if (tl != 0 && abs(qb - tl) <= 3 && tl < 64) {
#pragma unroll
                for (int i = 0; i < 16; ++i) { const float dist = fabsf(fb - (float)((i & 3) + 8 * (i >> 2))); const float sv = S[i] * sc2 - slope2 * dist; S[i] = sv; mx = fmaxf(mx, sv); }
            } else {
#pragma unroll
                for (int i = 0; i < 16; ++i) { const int kp = kp0 + crow16(i, hh); const float dist = fabsf(fb - (float)((i & 3) + 8 * (i >> 2)));
                    const bool ok = (tl == 0) ? (kp < NMETA || dist <= 128.f) : (kp < L && dist <= 128.f);
                    const float sv = ok ? S[i] * sc2 - slope2 * dist : -1e30f; S[i] = sv; mx = fmaxf(mx, sv); }
            }
            mx = fmaxf(mx, xor32(mx));
            float mn = m, alpha = 1.0f;
            if (__builtin_amdgcn_ballot_w64(mx - m > 8.0f) != 0ull) { mn = fmaxf(m, mx); alpha = __builtin_amdgcn_exp2f(m - mn); m = mn; }
            float ps = 0.f;
#pragma unroll
            for (int i = 0; i < 16; ++i) { const float pv = __builtin_amdgcn_exp2f(S[i] - mn); S[i] = pv; ps += pv; }
            lsum = lsum * alpha + ps;
            if (__builtin_amdgcn_ballot_w64(alpha != 1.0f) != 0ull) {
#pragma unroll
                for (int db = 0; db < 4; ++db)
#pragma unroll
                    for (int i = 0; i < 16; ++i) O[db][i] *= alpha; }
            const LAS bf16_t* vt = Vs + ((sl * 2 + kvh) * 128 + r) * SW_VS + 4 * hh;
#pragma unroll
            for (int ks2 = 0; ks2 < 2; ++ks2) {
                u32x4 xp; xp.x = pk2(S[8 * ks2 + 0], S[8 * ks2 + 1]); xp.y = pk2(S[8 * ks2 + 2], S[8 * ks2 + 3]); xp.z = pk2(S[8 * ks2 + 4], S[8 * ks2 + 5]); xp.w = pk2(S[8 * ks2 + 6], S[8 * ks2 + 7]);
                const bf16x8 pb = __builtin_bit_cast(bf16x8, xp);
#pragma unroll
                for (int db = 0; db < 4; ++db) {
                    const s16x4 lo = *(const LAS s16x4*)(vt + (32 * db) * SW_VS + 16 * ks2), hi = *(const LAS s16x4*)(vt + (32 * db) * SW_VS + 16 * ks2 + 8);
                    O[db] = MFMA32(__builtin_shufflevector(lo, hi, 0, 1, 2, 3, 4, 5, 6, 7), pb, O[db]); }
            }
        }
      }
    }
#undef SWA_FETCH
    const float lt = lsum + xor32(lsum), inv = 1.0f / lt;
    float ss = 0.f;
#pragma unroll
    for (int db = 0; db < 4; ++db)
#pragma unroll
        for (int i = 0; i < 16; ++i) { O[db][i] *= inv; ss += O[db][i] * O[db][i]; }
    ss += xor32(ss);
    __syncthreads();
    LAS float* part = (LAS float*)(F.lds + SW_PART); LAS bf16_t* os = (LAS bf16_t*)F.lds;
    if (hh == 0) part[w * 32 + r] = ss;
#pragma unroll
    for (int db = 0; db < 4; ++db)
#pragma unroll
        for (int g = 0; g < 4; ++g) { u32x2 pk; pk.x = pk2(O[db][4 * g], O[db][4 * g + 1]); pk.y = pk2(O[db][4 * g + 2], O[db][4 * g + 3]);
            *(LAS u32x2*)(os + r * SW_OS + w * 128 + 32 * db + 8 * g + 4 * hh) = pk; }
    __syncthreads();
    { const int q = tid >> 4, pc = tid & 15, p = q0 + q;
      if (p < L) { float tot = 0.f;
#pragma unroll
          for (int ww = 0; ww < 8; ++ww) tot += part[ww * 32 + q];
          const float rs = rsqrtf(tot * (1.0f / 1024.0f) + 1e-6f); const LAS float* sg = (const LAS float*)(F.lds + MIXC_SG); bf16_t* yrow = Y + ((size_t)b * L + p) * D + 512;
#pragma unroll
          for (int k = 0; k < 8; ++k) { const int c = 8 * pc + 128 * k; const u32x4 v = *(const LAS u32x4*)(os + q * SW_OS + c);
              const f32x4 g0 = *(const LAS f32x4*)(sg + c), g1 = *(const LAS f32x4*)(sg + c + 4); u32x4 o;
              o.x = pk2(__builtin_bit_cast(float, v.x << 16) * rs * g0[0], __builtin_bit_cast(float, v.x & 0xffff0000u) * rs * g0[1]);
              o.y = pk2(__builtin_bit_cast(float, v.y << 16) * rs * g0[2], __builtin_bit_cast(float, v.y & 0xffff0000u) * rs * g0[3]);
              o.z = pk2(__builtin_bit_cast(float, v.z << 16) * rs * g1[0], __builtin_bit_cast(float, v.z & 0xffff0000u) * rs * g1[1]);
              o.w = pk2(__builtin_bit_cast(float, v.w << 16) * rs * g1[2], __builtin_bit_cast(float, v.w & 0xffff0000u) * rs * g1[3]);
              *(u32x4*)(yrow + c) = o; } } }
}

__device__ __forceinline__ float logsigmoidf_(float x) { return fminf(x, 0.f) - log1pf(expf(-fabsf(x))); }

__device__ __forceinline__ int q_publish(Frame& F, int fetched) {
    LAS int* slot = (LAS int*)(F.lds + LDSCTL_OFF + 512);
    __syncthreads();
    if (F.tid == 0) *slot = fetched;
    __syncthreads();
    return *slot;
}
__device__ __forceinline__ void p_mix1(Frame& F, int l) {
    unsigned char* const wsl = launder_ws(F.ws);
    unsigned* const qw = (unsigned*)(wsl + WS_CTL) + CW_Q + (l * 4 + 0) * 64;
    constexpr int N_SWA = NB * 65, N_GLA = NB * 4 * GNC, N_HP = NB * 33 * 4, N_ALL = N_SWA + N_GLA + N_HP;
    int fetched = 0;
    if (F.tid == 0) fetched = (int)atomicAdd(qw, 1u);
    { const float* sgg = kin(12) + l * 1024; const float* cwg = kin(13) + (size_t)l * 3 * 1536; const float* cbg = kin(14) + l * 1536;
      if (F.tid < 256) *(LAS f32x4*)(F.lds + MIXC_SG + 16 * F.tid) = ((const f32x4*)sgg)[F.tid];
      for (int e = F.tid; e < 1152; e += 512) *(LAS f32x4*)(F.lds + MIXC_CW + 16 * e) = ((const f32x4*)cwg)[e];
      if (F.tid < 384) *(LAS f32x4*)(F.lds + MIXC_CB + 16 * F.tid) = ((const f32x4*)cbg)[F.tid]; }
    int u = q_publish(F, fetched);
    while (u < N_ALL) {
        if (F.tid == 0) fetched = (int)atomicAdd(qw, 1u);
        if (u < N_SWA) swa_item(F, u, l, wsl);
        else if (u < N_SWA + N_GLA) gla_passA_item(F, u - N_SWA, l, wsl);
        else hy_pre_item(F, u - N_SWA - N_GLA, l, wsl);
        u = q_publish(F, fetched);
    }
    __syncthreads();
}

__device__ __forceinline__ void p_mix2(Frame& F, int l) {
    unsigned char* const wsl = launder_ws(F.ws);
    gla_passB(F, wsl);
    hy_conv_phase(F, l, wsl);
}

__device__ __forceinline__ void p_mix3(Frame& F, int l) {
    unsigned char* const wsl = launder_ws(F.ws);
    unsigned* const qw = (unsigned*)(wsl + WS_CTL) + CW_Q + (l * 4 + 2) * 64;
    constexpr int N_GC = NB * 4 * GNC, N_HN = NB * 33, N_ALL = N_GC + N_HN;
    int fetched = 0;
    if (F.tid == 0) fetched = (int)atomicAdd(qw, 1u);
    if (F.tid < 128) *(LAS f32x4*)(F.lds + MIXC_HG + 16 * F.tid) = ((const f32x4*)(kin(22) + l * 512))[F.tid];
    int u = q_publish(F, fetched);
    while (u < N_ALL) {
        if (F.tid == 0) fetched = (int)atomicAdd(qw, 1u);
        if (u < N_HN) hy_norm_item(F, u, l, wsl);
        else gla_passC_item(F, u - N_HN, l, wsl);
        u = q_publish(F, fetched);
    }
    __syncthreads();
}

constexpr int R_RS = 2056;
constexpr int R_AH = 0, R_AL = 8 * R_RS * 2, R_PART = 2 * 8 * R_RS * 2, R_LG = R_PART + 8 * 8 * 32 * 4, R_LCNT = R_LG + 1024, R_REC = R_LCNT + 128;
template <bool DUMMY>
__device__ __forceinline__ void p_ln1_router(Frame& F, int l) {
    unsigned char* const wsl = launder_ws(F.ws); unsigned* const ctl = (unsigned*)(wsl + WS_CTL);
    const bf16_t* MX = (const bf16_t*)(wsl + WS_R1); const bf16_t* hin = (const bf16_t*)(wsl + WS_HB); bf16_t* h = (bf16_t*)(wsl + (DUMMY ? WS_DUM : WS_HB)); unsigned char* hb = wsl + (DUMMY ? WS_DUM + (size_t)T * D * 4 : WS_HB8);
    int* cnt = (int*)(ctl + CW_CNT + l * 512 + (DUMMY ? 256 : 0)); int* list = (int*)(wsl + (DUMMY ? WS_DUM + (size_t)T * D * 6 : WS_LIST));
    int* tok_e = (int*)(wsl + (DUMMY ? WS_DUM + (size_t)T * D * 6 + (size_t)NEXP * T * 4 : WS_TOKE)); int* tok_p = tok_e + (DUMMY ? 2 * T : (WS_TOKP - WS_TOKE) / 4); float* tok_w = (float*)(tok_e + (DUMMY ? 4 * T : (WS_TOKW - WS_TOKE) / 4));
    const LAS float* g = (const LAS float*)(F.lds + 81920); const LAS float* bt = g + D;
    { const float* gg = kin(25) + (size_t)l * D; const float* gb = kin(26) + (size_t)l * D; *(LAS f32x4*)(F.lds + 81920 + 16 * F.tid) = ((const f32x4*)gg)[F.tid]; *(LAS f32x4*)(F.lds + 81920 + 8192 + 16 * F.tid) = ((const f32x4*)gb)[F.tid]; }
    const LAS float* be = (const LAS float*)(F.lds + 81920 + 16384); const LAS float* bg = be + 16;
    if (F.tid < 16) ((LAS float*)(F.lds + 81920 + 16384))[F.tid] = (kin(30) + l * 16)[F.tid]; else if (F.tid < 20) ((LAS float*)(F.lds + 81920 + 16384))[F.tid] = (kin(28) + l * 4)[F.tid - 16];
    const bf16_t* wr = (const bf16_t*)(wsl + WS_WR) + (size_t)l * 256 * 512;
    const int lane = opaque_v(F.lane), w = F.wave, n = lane & 15, kg = lane >> 4;
    LAS bf16_t* AH = (LAS bf16_t*)(F.lds + R_AH); LAS bf16_t* AL = (LAS bf16_t*)(F.lds + R_AL); LAS float* PART = (LAS float*)(F.lds + R_PART); LAS float* LG = (LAS float*)(F.lds + R_LG);
    constexpr int NGRP = T / 8;
    bf16x8 wfr[8][4];
#pragma unroll
    for (int si = 0; si < 8; ++si) { const bf16_t* wp = wr + ((size_t)(8 * w + si) * 4 * 64 + lane) * 8;
#pragma unroll
        for (int q = 0; q < 4; ++q) wfr[si][q] = *(const bf16x8*)(wp + 512 * q); }
    LAS int* lcnt = (LAS int*)(F.lds + R_LCNT); LAS int* rec = (LAS int*)(F.lds + R_REC);
    if (F.tid < 32) lcnt[F.tid] = 0;
    int nloc = 0;
    f32x4 v[8];
    u32x2 hxr[8], mxr[8];
    int gi = F.vcu;
    if (gi < NGRP) {
#pragma unroll
        for (int j = 0; j < 8; ++j) { hxr[j] = ((const u32x2*)(hin + (size_t)(8 * gi + w) * D))[lane + 64 * j]; mxr[j] = ((const u32x2*)(MX + (size_t)(8 * gi + w) * D))[lane + 64 * j]; } }
    __syncthreads();
    for (; gi < NGRP; gi += F.G) {
        const int row = 8 * gi + w;
#pragma unroll
        for (int j = 0; j < 8; ++j) { const u32x2 hx = hxr[j], mx = j < 4 ? mxr[j] : ((const u32x2*)(MX + (size_t)row * D))[lane + 64 * j];
            v[j] = (f32x4){__builtin_bit_cast(float, hx.x << 16), __builtin_bit_cast(float, hx.x & 0xffff0000u), __builtin_bit_cast(float, hx.y << 16), __builtin_bit_cast(float, hx.y & 0xffff0000u)} * ALPHA
                 + (f32x4){__builtin_bit_cast(float, mx.x << 16), __builtin_bit_cast(float, mx.x & 0xffff0000u), __builtin_bit_cast(float, mx.y << 16), __builtin_bit_cast(float, mx.y & 0xffff0000u)}; }
        ln_wave_store<true>(v, g, bt, h + (size_t)row * D, hb + (size_t)row * D, nullptr, lane);
#pragma unroll
        for (int j = 0; j < 8; ++j) { const unsigned h01 = pk2(v[j][0], v[j][1]), h23 = pk2(v[j][2], v[j][3]);
            const unsigned l01 = pk2(v[j][0] - __builtin_bit_cast(float, h01 << 16), v[j][1] - __builtin_bit_cast(float, h01 & 0xffff0000u)), l23 = pk2(v[j][2] - __builtin_bit_cast(float, h23 << 16), v[j][3] - __builtin_bit_cast(float, h23 & 0xffff0000u));
            *(LAS u32x2*)(AH + w * R_RS + (lane + 64 * j) * 4) = (u32x2){h01, h23};
            *(LAS u32x2*)(AL + w * R_RS + (lane + 64 * j) * 4) = (u32x2){l01, l23}; }
        asm volatile("" ::: "memory");
        { const int gn = gi + F.G;
          if (gn < NGRP) {
#pragma unroll
            for (int j = 0; j < 8; ++j) { hxr[j] = ((const u32x2*)(hin + (size_t)(8 * gn + w) * D))[lane + 64 * j]; if (j < 4) mxr[j] = ((const u32x2*)(MX + (size_t)(8 * gn + w) * D))[lane + 64 * j]; } } }
        __syncthreads();
        f32x4 a0 = (f32x4){0.f, 0.f, 0.f, 0.f}, a1 = (f32x4){0.f, 0.f, 0.f, 0.f};
        { const LAS bf16_t* ah = AH + (n & 7) * R_RS + 8 * kg; const LAS bf16_t* al = AL + (n & 7) * R_RS + 8 * kg;
#pragma unroll
          for (int si = 0; si < 8; ++si) { const int st = 8 * w + si;
              const bf16x8 xh = *(const LAS bf16x8*)(ah + 32 * st), xl = *(const LAS bf16x8*)(al + 32 * st);
              const bf16x8 bh0 = wfr[si][0], bl0 = wfr[si][1], bh1 = wfr[si][2], bl1 = wfr[si][3];
              a0 = __builtin_amdgcn_mfma_f32_16x16x32_bf16(xh, bh0, a0, 0, 0, 0); a0 = __builtin_amdgcn_mfma_f32_16x16x32_bf16(xh, bl0, a0, 0, 0, 0); a0 = __builtin_amdgcn_mfma_f32_16x16x32_bf16(xl, bh0, a0, 0, 0, 0);
              a1 = __builtin_amdgcn_mfma_f32_16x16x32_bf16(xh, bh1, a1, 0, 0, 0); a1 = __builtin_amdgcn_mfma_f32_16x16x32_bf16(xh, bl1, a1, 0, 0, 0); a1 = __builtin_amdgcn_mfma_f32_16x16x32_bf16(xl, bh1, a1, 0, 0, 0);
              if (si == 3) __builtin_amdgcn_sched_barrier(0); } }
        if (kg < 2) {
#pragma unroll
            for (int r = 0; r < 4; ++r) { PART[(w * 8 + 4 * kg + r) * 32 + n] = a0[r]; PART[(w * 8 + 4 * kg + r) * 32 + 16 + n] = a1[r]; } }
        __syncthreads();
        if (lane < 32) { float sacc = 0.f;
#pragma unroll
            for (int ww = 0; ww < 8; ++ww) sacc += PART[(ww * 8 + w) * 32 + lane];
            LG[w * 32 + lane] = sacc; }
        LDS_WAIT();
        if (lane == 0) {
            const f32x4 l0 = *(const LAS f32x4*)(LG + w * 32), l1 = *(const LAS f32x4*)(LG + w * 32 + 4), l2 = *(const LAS f32x4*)(LG + w * 32 + 8), l3 = *(const LAS f32x4*)(LG + w * 32 + 12), l4 = *(const LAS f32x4*)(LG + w * 32 + 16);
            float gl[4];
#pragma unroll
            for (int j = 0; j < 4; ++j) gl[j] = l0[j] + bg[j];
            int gsel = 0; float gm = gl[0];
#pragma unroll
            for (int j = 1; j < 4; ++j) if (gl[j] > gm) { gm = gl[j]; gsel = j; }
            float den = 0.f;
#pragma unroll
            for (int j = 0; j < 4; ++j) den += expf(gl[j] - gm);
            const float gtop = 1.0f / den;
            float el[4];
            const float k0 = gsel == 0 ? 1.f : 0.f, k1 = gsel == 1 ? 1.f : 0.f, k2 = gsel == 2 ? 1.f : 0.f, k3 = gsel == 3 ? 1.f : 0.f;
#pragma unroll
            for (int j = 0; j < 4; ++j) el[j] = (k0 * l1[j] + k1 * l2[j]) + (k2 * l3[j] + k3 * l4[j]) + be[gsel * 4 + j];
            int i1 = 0; float m1 = el[0];
#pragma unroll
            for (int j = 1; j < 4; ++j) if (el[j] > m1) { m1 = el[j]; i1 = j; }
            int i2 = -1; float m2 = -3.0e38f;
#pragma unroll
            for (int j = 0; j < 4; ++j) if (j != i1 && el[j] > m2) { m2 = el[j]; i2 = j; }
            const float ex = expf(m2 - m1); const float w1 = gtop / (1.0f + ex), w2 = gtop * ex / (1.0f + ex);
            const int e1 = gsel * 4 + i1, e2 = gsel * 4 + i2;
            const int li1 = __hip_atomic_fetch_add(lcnt + e1, 1, __ATOMIC_RELAXED, __HIP_MEMORY_SCOPE_WORKGROUP), li2 = __hip_atomic_fetch_add(lcnt + e2, 1, __ATOMIC_RELAXED, __HIP_MEMORY_SCOPE_WORKGROUP);
            const int k = nloc * 8 + w; rec[4 * k] = row; rec[4 * k + 1] = e1 | (e2 << 8); rec[4 * k + 2] = li1; rec[4 * k + 3] = li2;
            tok_e[2 * row] = e1; tok_e[2 * row + 1] = e2; tok_w[2 * row] = w1; tok_w[2 * row + 1] = w2;
        }
        ++nloc;
    }
    __syncthreads();
    if (F.tid < 16) { const int c = lcnt[F.tid]; lcnt[16 + F.tid] = c ? atomicAdd(&cnt[16 * F.tid], c) : 0; }
    __syncthreads();
    if (F.tid < nloc * 8) { const int row = rec[4 * F.tid], ee = rec[4 * F.tid + 1], e1 = ee & 255, e2 = ee >> 8;
        const int p1 = lcnt[16 + e1] + rec[4 * F.tid + 2], p2 = lcnt[16 + e2] + rec[4 * F.tid + 3];
        list[(size_t)e1 * T + p1] = row; list[(size_t)e2 * T + p2] = row; tok_p[2 * row] = p1; tok_p[2 * row + 1] = p2; }
    __syncthreads();
}

__device__ __forceinline__ void moe_table(Frame& F, int l) {
    LAS int* tab = (LAS int*)(F.lds + LDSCTL_OFF + 256);
    unsigned* const ctl = (unsigned*)(launder_ws(F.ws) + WS_CTL);
    const int* cnt = (const int*)(ctl + CW_CNT + l * 512);
    __syncthreads();
    if (F.tid < 16) tab[F.tid] = __hip_atomic_load(cnt + 16 * F.tid, __ATOMIC_RELAXED, __HIP_MEMORY_SCOPE_AGENT);
    __syncthreads();
    if (F.tid == 0) { int pp = 0;
        for (int e = 0; e < 16; ++e) { const int c = tab[e]; tab[16 + e] = pp; tab[33 + e] = pp * 256; pp += (c + 255) >> 8; }
        tab[32] = pp; }
    __syncthreads();
}

template <bool DUMMY>
__device__ __forceinline__ void p_ln2(Frame& F, int l) {
    unsigned char* const wsl = launder_ws(F.ws);
    bf16_t* hb = (bf16_t*)(wsl + WS_HB); const unsigned char* O = (const unsigned char*)(wsl + WS_O);
    const int* tok_e = (const int*)(wsl + WS_TOKE); const int* tok_p = (const int*)(wsl + WS_TOKP); const float* tok_w = (const float*)(wsl + WS_TOKW);
    const LAS int* tab = (const LAS int*)(F.lds + LDSCTL_OFF + 256);
    const LAS float* g = (const LAS float*)(F.lds + 65536); const LAS float* bt = g + D;
    { const float* gg = kin(34) + (size_t)l * D; const float* gb = kin(35) + (size_t)l * D; *(LAS f32x4*)(F.lds + 65536 + 16 * F.tid) = ((const f32x4*)gg)[F.tid]; *(LAS f32x4*)(F.lds + 65536 + 8192 + 16 * F.tid) = ((const f32x4*)gb)[F.tid]; }
    __syncthreads();
    const int gw = F.vcu * 8 + F.wave, NGW = F.G * 8, lane = opaque_v(F.lane);
    u32x2 hv[8]; int oa[8], ob[8]; float w0 = 0.f, w1 = 0.f;
    int te0 = 0, te1 = 0, tp0 = 0, tp1 = 0; float tw0 = 0.f, tw1 = 0.f;
    { const int rk = gw + lane * NGW; if (lane < 16 && rk < T) { te0 = tok_e[2 * rk]; te1 = tok_e[2 * rk + 1]; tp0 = tok_p[2 * rk]; tp1 = tok_p[2 * rk + 1]; tw0 = tok_w[2 * rk]; tw1 = tok_w[2 * rk + 1]; } }
    int kk = 0;
#define LN2_ISSUE(rw) do { const int e0_ = __builtin_amdgcn_readlane(te0, kk), e1_ = __builtin_amdgcn_readlane(te1, kk); \
        const size_t r0_ = (size_t)(tab[33 + e0_] + __builtin_amdgcn_readlane(tp0, kk)), r1_ = (size_t)(tab[33 + e1_] + __builtin_amdgcn_readlane(tp1, kk)); \
        w0 = __builtin_bit_cast(float, __builtin_amdgcn_readlane(__builtin_bit_cast(int, tw0), kk)) * (1.0f / 64.0f); w1 = __builtin_bit_cast(float, __builtin_amdgcn_readlane(__builtin_bit_cast(int, tw1), kk)) * (1.0f / 64.0f); ++kk; \
        _Pragma("unroll") for (int j = 0; j < 8; ++j) { const int i4 = lane + 64 * j; hv[j] = ((const u32x2*)(hb + (size_t)(rw) * D))[i4]; oa[j] = ((const int*)(O + r0_ * D))[i4]; ob[j] = ((const int*)(O + r1_ * D))[i4]; } } while (0)
    int row = gw;
    if (row < T) LN2_ISSUE(row);
    for (; row < T; row += NGW) {
        f32x4 v[8];
#pragma unroll
        for (int j = 0; j < 8; ++j) { f32x4 m;
            const f32x2 a01 = __builtin_amdgcn_cvt_pk_f32_fp8(oa[j], false), a23 = __builtin_amdgcn_cvt_pk_f32_fp8(oa[j], true), b01 = __builtin_amdgcn_cvt_pk_f32_fp8(ob[j], false), b23 = __builtin_amdgcn_cvt_pk_f32_fp8(ob[j], true);
            m[0] = w0 * a01[0] + w1 * b01[0]; m[1] = w0 * a01[1] + w1 * b01[1]; m[2] = w0 * a23[0] + w1 * b23[0]; m[3] = w0 * a23[1] + w1 * b23[1];
            v[j] = (f32x4){__builtin_bit_cast(float, hv[j].x << 16), __builtin_bit_cast(float, hv[j].x & 0xffff0000u), __builtin_bit_cast(float, hv[j].y << 16), __builtin_bit_cast(float, hv[j].y & 0xffff0000u)} * ALPHA + m; }
        const int nrow = row + NGW;
        if (nrow < T) LN2_ISSUE(nrow);
        float* orow = nullptr;
        if (l == DEPTH - 1) { const int bb = row / L, pp = row % L; if (pp >= NMETA) orow = kout() + ((size_t)bb * SEQ + (pp - NMETA)) * D; }
        if (DUMMY) ln_wave_store(v, g, bt, (bf16_t*)(wsl + WS_DUM) + (size_t)row * D, nullptr, nullptr, lane);
        else if (l == DEPTH - 1) ln_wave_store<false, true>(v, g, bt, nullptr, nullptr, orow, lane);
        else ln_wave_store(v, g, bt, hb + (size_t)row * D, nullptr, orow, lane);
    }
#undef LN2_ISSUE
}


__device__ __forceinline__ void outproj_tail(Frame& F, int l, unsigned char* wsl) {
    if (F.vcu >= 128) return;
    const bf16_t* Yb = (const bf16_t*)(wsl + WS_Y) + (size_t)16384 * D; const bf16_t* Wt = (const bf16_t*)(wsl + WS_WOUT) + (size_t)l * D * D + (size_t)(16 * F.vcu) * D;
    const int lane = opaque_v(F.lane), w = F.wave, n = lane & 15, kg = lane >> 4;
    f32x4 acc[8];
#pragma unroll
    for (int mb = 0; mb < 8; ++mb) acc[mb] = (f32x4){0.f, 0.f, 0.f, 0.f};
    const bf16_t* ap = Yb + (size_t)n * D + 256 * w + 8 * kg; const bf16_t* bp = Wt + (size_t)n * D + 256 * w + 8 * kg;
#pragma unroll 2
    for (int ks = 0; ks < 8; ++ks) {
        const bf16x8 bfr = *(const bf16x8*)(bp + 32 * ks);
        bf16x8 af[8];
#pragma unroll
        for (int mb = 0; mb < 8; ++mb) af[mb] = *(const bf16x8*)(ap + (size_t)(16 * mb) * D + 32 * ks);
#pragma unroll
        for (int mb = 0; mb < 8; ++mb) acc[mb] = __builtin_amdgcn_mfma_f32_16x16x32_bf16(af[mb], bfr, acc[mb], 0, 0, 0);
    }
    LAS f32x4* red = (LAS f32x4*)F.lds;
    __syncthreads();
#pragma unroll
    for (int mb = 0; mb < 8; ++mb) red[(w * 8 + mb) * 64 + lane] = acc[mb];
    __syncthreads();
    { const int mb = F.tid >> 6;
      f32x4 sacc = red[(0 * 8 + mb) * 64 + lane];
#pragma unroll
      for (int ww = 1; ww < 8; ++ww) sacc += red[(ww * 8 + mb) * 64 + lane];
      const int col = 16 * F.vcu + n; const float bias = (kin(24) + (size_t)l * D)[col];
      bf16_t* MX = (bf16_t*)(wsl + WS_R1);
#pragma unroll
      for (int r = 0; r < 4; ++r) { const size_t o = (size_t)(16384 + 16 * mb + 4 * kg + r) * D + col; MX[o] = (bf16_t)f2bf(sacc[r] + bias); } }
    __syncthreads();
}

#ifndef REP_LN
#define REP_LN 1
#endif
#ifndef REP_PRO
#define REP_PRO 1
#endif
#ifndef REP_MIX
#define REP_MIX 1
#endif
#ifndef REP_GEMM
#define REP_GEMM 1
#endif
#define IN(k) (lo <= (k) && (k) < hi)
#define SEAM(k) do { if (IN(k) && IN((k) + 1)) xcd_barrier(bar); } while (0)
template <int l>
__device__ __forceinline__ void run_layer(Frame& F, const int lo, const int hi, const XcdBarrier& bar) {
        const int P = 1 + l * NPH;
        if (IN(P + 0)) {
            unsigned char* const wsl = launder_ws(F.ws);
            pg::PlainSched S; S.init(MPAD / 256, INCP / 256, F.G, (int)blockIdx.x);
            pg::EpiInProj E{(bf16_t*)(wsl + WS_U), kin(5) + (size_t)l * INC};
            for (int rep = 0; rep < REP_GEMM; ++rep) pg::gemm_phase<false>(F.lds, wsl + WS_HB, (const bf16_t*)(wsl + WS_WIN) + (size_t)l * INCP * D, D, S, E);
        }
        SEAM(P + 0);
        if (IN(P + 1)) for (int rep = 0; rep < REP_MIX; ++rep) p_mix1(F, l);
        SEAM(P + 1);
        if (IN(P + 2)) for (int rep = 0; rep < REP_MIX; ++rep) p_mix2(F, l);
        SEAM(P + 2);
        if (IN(P + 3)) for (int rep = 0; rep < REP_MIX; ++rep) p_mix3(F, l);
        SEAM(P + 3);
        if (IN(P + 4)) {
            unsigned char* const wsl = launder_ws(F.ws);
            pg::PlainSched S; S.init(64, D / 256, F.G, (int)blockIdx.x);
            pg::EpiOutProj E{(bf16_t*)(wsl + WS_R1), kin(24) + (size_t)l * D};
            for (int rep = 0; rep < REP_GEMM; ++rep) pg::gemm_phase<false>(F.lds, wsl + WS_Y, (const bf16_t*)(wsl + WS_WOUT) + (size_t)l * D * D, D, S, E);
            outproj_tail(F, l, wsl);
        }
        SEAM(P + 4);
        if (IN(P + 5)) { if (REP_LN > 1) p_ln1_router<true>(F, l); p_ln1_router<false>(F, l); }
        SEAM(P + 5);
        if (IN(P + 6)) {
            moe_table(F, l);
            unsigned char* const wsl = launder_ws(F.ws);
            pg::MoeSched S; S.tab = (const LAS int*)(F.lds + LDSCTL_OFF + 256); S.list = (const int*)(wsl + WS_LIST); S.nN = 8; S.G = F.G; S.c = F.vcu; S.gather = 1; S.nrowsB = 2048;
            pg::EpiGateUp8 E{(unsigned char*)(wsl + WS_HM)};
            for (int rep = 0; rep < REP_GEMM; ++rep) pg::gemm_phase<true>(F.lds, wsl + WS_HB8, wsl + WS_WGU + (size_t)l * NEXP * 2048 * D, D / 2, S, E);
        }
        SEAM(P + 6);
        if (IN(P + 7)) {
            moe_table(F, l);
            unsigned char* const wsl = launder_ws(F.ws);
            pg::MoeSched S; S.tab = (const LAS int*)(F.lds + LDSCTL_OFF + 256); S.list = nullptr; S.nN = 8; S.G = F.G; S.c = F.vcu; S.gather = 0; S.nrowsB = 2048;
            pg::EpiDown8 E{(unsigned char*)(wsl + WS_O)};
            for (int rep = 0; rep < REP_GEMM; ++rep) pg::gemm_phase<true>(F.lds, wsl + WS_HM, wsl + WS_WD + (size_t)l * NEXP * D * DEXP, DEXP / 2, S, E);
        }
        SEAM(P + 7);
        if (IN(P + 8)) { moe_table(F, l); if (REP_LN > 1) p_ln2<true>(F, l); p_ln2<false>(F, l); }
        SEAM(P + 8);
}

__global__ void __launch_bounds__(512, 2) mk_fwd(Args args) {
    extern __shared__ __attribute__((aligned(16))) unsigned char lds_raw[];
    Frame F;
    F.lds = (LAS unsigned char*)lds_raw;
    F.MISC = (volatile LAS unsigned*)(F.lds + MISC_OFF);
    F.tid = threadIdx.x; F.lane = F.tid & 63; F.wave = __builtin_amdgcn_readfirstlane(F.tid >> 6);
    F.G = gridDim.x; { const int bx = blockIdx.x; F.vcu = (F.G % 8 == 0) ? (bx % 8) * (F.G / 8) + bx / 8 : bx; }
    F.ws = args.ws; F.ctl = (unsigned*)(args.ws + WS_CTL);
    for (int u = F.tid; u < (LDS_BYTES - LDSCTL_OFF) / 4; u += 512) ((LAS unsigned*)(F.lds + LDSCTL_OFF))[u] = 0u;
    __syncthreads();
    const int lo = args.ph_lo, hi = args.ph_hi;
    const bool multi = (hi - lo) > 1;
    XcdBarrier bar; bar.bar = F.ctl + CW_BAR; bar.x = 0; bar.st = nullptr;
    if (multi) bar = xcd_barrier_post(F.ctl + CW_BAR, F.MISC + 8);

    if (IN(0)) { for (int rep = 0; rep < REP_PRO; ++rep) p_prologue(F); }
    SEAM(0);
    run_layer<0>(F, lo, hi, bar); run_layer<1>(F, lo, hi, bar); run_layer<2>(F, lo, hi, bar); run_layer<3>(F, lo, hi, bar);
}

#ifndef MK_CUT
#define MK_CUT 0
#endif
extern "C" void kernel_launch(void* const* d_in, const int* in_sizes, int n_in, void* d_out, int out_size, void* d_ws, size_t ws_size, hipStream_t stream) {
    static bool attr = false;
    if (!attr) { (void)hipFuncSetAttribute((const void*)mk_fwd, hipFuncAttributeMaxDynamicSharedMemorySize, LDS_BYTES); attr = true; }
    (void)hipMemsetAsync(d_ws, 0, CTL_BYTES, stream);
    Args a{};
    for (int i = 0; i < 36; ++i) a.in[i] = (const float*)d_in[i];
    a.out = (float*)d_out; a.ws = (unsigned char*)d_ws;
    const int NP = 1 + DEPTH * NPH;
#if MK_CUT
    for (int p = 0; p < NP; ++p) { a.ph_lo = p; a.ph_hi = p + 1; hipLaunchKernelGGL(mk_fwd, dim3(256), dim3(512), LDS_BYTES, stream, a); }
#else
    a.ph_lo = 0; a.ph_hi = NP; hipLaunchKernelGGL(mk_fwd, dim3(256), dim3(512), LDS_BYTES, stream, a);
#endif
}
```

```cpp
#include <hip/hip_runtime.h>
#include <stdint.h>

#define LAS __attribute__((address_space(3)))
#define GAS __attribute__((address_space(1)))
typedef unsigned short bf16_t;
typedef short bf16x8 __attribute__((ext_vector_type(8)));
typedef float f32x4 __attribute__((ext_vector_type(4)));
typedef float f32x2 __attribute__((ext_vector_type(2)));
typedef unsigned u32x4 __attribute__((ext_vector_type(4)));
typedef unsigned u32x2 __attribute__((ext_vector_type(2)));

constexpr int D = 2048, NB = 8, SEQ = 2048, NMETA = 16, L = SEQ + NMETA, T = NB * L, DEPTH = 4;
constexpr int MPAD = 16640;
constexpr int INC = 4640, INCP = 4864;
constexpr int O_AQ = 0, O_AK = 256, O_AV = 512, O_GF = 1024, O_GB = 1040, O_AR = 1056, O_BQ = 1568, O_BK = 2592, O_BV = 2848, O_CU = 3104;
constexpr int NEXP = 16, DEXP = 1024;
constexpr float ALPHA = 1.681792830507429f;
constexpr int NPH = 9;
constexpr int HMROWS = 2 * T + 4096;

constexpr size_t al256(size_t x) { return (x + 255) & ~(size_t)255; }
constexpr size_t WS_CTL = 0, CTL_BYTES = 1u << 20;
constexpr size_t WS_WIN = WS_CTL + CTL_BYTES;
constexpr size_t WS_WOUT = WS_WIN + (size_t)DEPTH * INCP * D * 2;
constexpr size_t WS_WGU = WS_WOUT + (size_t)DEPTH * D * D * 2;
constexpr size_t WS_WD = WS_WGU + (size_t)DEPTH * NEXP * 2048 * D * 2;
constexpr size_t WS_HB8 = WS_WD + (size_t)DEPTH * NEXP * D * DEXP * 2;
constexpr size_t WS_H = WS_HB8 + (size_t)MPAD * D;
constexpr size_t WS_HB = WS_H + (size_t)T * D * 4;
constexpr size_t WS_Y = WS_HB + (size_t)MPAD * D * 2;
constexpr size_t WS_LIST = WS_Y + (size_t)MPAD * D * 2;
constexpr size_t WS_TOKE = WS_LIST + (size_t)NEXP * T * 4;
constexpr size_t WS_TOKP = WS_TOKE + (size_t)2 * T * 4;
constexpr size_t WS_TOKW = WS_TOKP + (size_t)2 * T * 4;
constexpr size_t WS_HF = WS_TOKW + (size_t)2 * T * 4;
constexpr size_t WS_HBW = WS_HF + (size_t)L * 512 * 4;
constexpr int GLEN = 4736, GCEN = 2336, ZL = 2112;
constexpr int ZROW = 3520, ZOFF = 576;
constexpr size_t WS_FG = al256(WS_HBW + (size_t)L * 512 * 4);
constexpr size_t WS_WR = al256(WS_FG + (size_t)DEPTH * 512 * 2 * GLEN * 2);
constexpr size_t WS_REG = al256(WS_WR + (size_t)DEPTH * 64 * 2 * 2 * 512 * 2);
constexpr size_t WS_U = WS_REG;
constexpr int GNC = 33;
constexpr size_t WS_KVT = al256(WS_U + (size_t)T * INC * 2);
constexpr size_t WS_DEC = WS_KVT + (size_t)64 * GNC * 128 * 64 * 4;
constexpr size_t WS_SPT = WS_DEC + (size_t)64 * GNC * 64 * 4;
constexpr size_t WS_GQK = WS_SPT + (size_t)64 * GNC * 128 * 64 * 2;
constexpr size_t WS_GVT = WS_GQK + (size_t)NB * 4 * GNC * 4 * 64 * 64 * 2;
constexpr size_t WS_SW = WS_GVT + (size_t)NB * 4 * GNC * 128 * 64 * 2;
constexpr size_t WS_X0T = WS_SW + (size_t)T * 1024 * 4;
constexpr size_t WS_ZT = WS_X0T + (size_t)512 * NB * ZL * 2;
constexpr size_t WS_YT = WS_ZT + (size_t)512 * NB * ZL * 2;
constexpr size_t WS_END1 = WS_YT + (size_t)512 * NB * ZL * 2;
constexpr size_t WS_R1 = WS_REG;
constexpr size_t WS_HM = WS_R1 + (size_t)T * D * 4;
constexpr size_t WS_O = WS_HM + (size_t)HMROWS * DEXP * 2;
constexpr size_t WS_END2 = WS_O + (size_t)HMROWS * D * 2;
constexpr size_t WS_DUM = al256(WS_END2);
static_assert(WS_END1 < 2100000000ull && WS_DUM + (size_t)T * D * 6 + (size_t)NEXP * T * 4 + (size_t)T * 32 < 2100000000ull, "d_ws budget");
constexpr int CW_BAR = 4096;
constexpr int CW_Q = 12288;
constexpr int CW_CNT = 16384;

constexpr int RING_BYTES = 131072;
constexpr int LDSCTL_OFF = RING_BYTES;
constexpr int MISC_OFF = LDSCTL_OFF + 1024;
constexpr int LDS_BYTES = 147456;

#define LDS_WAIT() asm volatile("s_waitcnt lgkmcnt(0)" ::: "memory")
#define VM_WAIT() asm volatile("s_waitcnt vmcnt(0)" ::: "memory")
__device__ __forceinline__ unsigned f2bf(float f) { unsigned u = __builtin_bit_cast(unsigned, f); return (u + 0x7fffu + ((u >> 16) & 1u)) >> 16; }
__device__ __forceinline__ unsigned pk2i(float lo, float hi) { return f2bf(lo) | (f2bf(hi) << 16); }
__device__ __forceinline__ unsigned pk2(float lo, float hi) { unsigned r; asm("v_cvt_pk_bf16_f32 %0, %1, %2" : "=v"(r) : "v"(lo), "v"(hi)); return r; }
__device__ __forceinline__ float bf2f(unsigned short b) { return __builtin_bit_cast(float, (unsigned)b << 16); }
template <int N> __device__ __forceinline__ float dpp_row_shr_add(float v) { const int t = __builtin_amdgcn_update_dpp(0, __builtin_bit_cast(int, v), 0x110 + N, 0xf, 0xf, true); return v + __builtin_bit_cast(float, t); }
__device__ __forceinline__ float wave_sum(float v) {
    v = dpp_row_shr_add<1>(v); v = dpp_row_shr_add<2>(v); v = dpp_row_shr_add<4>(v); v = dpp_row_shr_add<8>(v);
    const int vi = __builtin_bit_cast(int, v);
    return (__builtin_bit_cast(float, __builtin_amdgcn_readlane(vi, 15)) + __builtin_bit_cast(float, __builtin_amdgcn_readlane(vi, 31))) + (__builtin_bit_cast(float, __builtin_amdgcn_readlane(vi, 47)) + __builtin_bit_cast(float, __builtin_amdgcn_readlane(vi, 63)));
}
__device__ __forceinline__ float xor32(float v) {
    const int vi = __builtin_bit_cast(int, v);
    auto r = __builtin_amdgcn_permlane32_swap(vi, vi, false, false);
    return __builtin_bit_cast(float, (threadIdx.x & 32) ? r[0] : r[1]);
}
__device__ __forceinline__ float wave_max(float v) {
#pragma unroll
    for (int o = 1; o < 64; o <<= 1) v = fmaxf(v, __shfl_xor(v, o));
    return v;
}

#define XB_TMO      128
#define XB_XCNT(j)  (256  + 64 * (j))
#define XB_XSUB(j)  (1280 + 64 * (j))
#define XB_XGEN(j)  (2304 + 64 * (j))
#define XB_TOP      3328
#define XB_TOPGEN   3392
#define XCD_BAR_WORDS 3456
#define XB_SPIN_CAP (1u << 18)
__device__ __forceinline__ unsigned xb_ld(unsigned* p)              { return __hip_atomic_load(p, __ATOMIC_RELAXED, __HIP_MEMORY_SCOPE_AGENT); }
__device__ __forceinline__ unsigned xb_add(unsigned* p, unsigned v) { return __hip_atomic_fetch_add(p, v, __ATOMIC_RELAXED, __HIP_MEMORY_SCOPE_AGENT); }
__device__ __forceinline__ unsigned xb_xcc_id() { return (unsigned)__builtin_amdgcn_s_getreg((3 << 11) | 20) & 0xFu; }
#define XB_SPIN(cond, bar) do { unsigned _sp = 0; while (cond) { __builtin_amdgcn_s_sleep(1); \
    if ((++_sp & 255u) == 0u) { if (xb_ld(&(bar)[XB_TMO])) break; if (_sp > XB_SPIN_CAP) { atomicAdd(&(bar)[XB_TMO], 1u); break; } } } } while (0)
struct XcdBarrier { unsigned* bar; unsigned x; volatile LAS unsigned* st; };
__device__ __forceinline__ XcdBarrier xcd_barrier_post(unsigned* bar, volatile LAS unsigned* st) {
    XcdBarrier b; b.bar = bar; b.x = xb_xcc_id(); b.st = st;
    if (threadIdx.x == 0) (void)xb_add(&bar[XB_XCNT(b.x)], 1u);
    return b;
}
__device__ __forceinline__ void xcd_barrier_complete(unsigned* bar, unsigned x, unsigned& nloc, unsigned& nx) {
    const unsigned G = gridDim.x * gridDim.y * gridDim.z;
    unsigned sum, cnt, mine, sp = 0u;
    for (;;) {
        sum = 0u; cnt = 0u; mine = 0u;
#pragma unroll
        for (unsigned j = 0; j < 16; ++j) { const unsigned c = xb_ld(&bar[XB_XCNT(j)]); sum += c; cnt += (c > 0u) ? 1u : 0u; mine = (j == x) ? c : mine; }
        if (sum == G) break;
        __builtin_amdgcn_s_sleep(1);
        if ((++sp & 255u) == 0u) { if (xb_ld(&bar[XB_TMO])) break; if (sp > XB_SPIN_CAP) { atomicAdd(&bar[XB_TMO], 1u); break; } }
    }
    nloc = mine > 0u ? mine : 1u; nx = cnt > 0u ? cnt : 1u;
}
__device__ __forceinline__ void xcd_barrier(const XcdBarrier& b) {
    asm volatile("s_waitcnt vmcnt(0)" ::: "memory");
    __syncthreads();
    if (threadIdx.x == 0) {
        unsigned* bar = b.bar;
        __builtin_amdgcn_s_waitcnt(0);
        unsigned nloc = b.st[0], nx = b.st[1];
        if (nloc == 0u) { xcd_barrier_complete(bar, b.x, nloc, nx); b.st[0] = nloc; b.st[1] = nx; }
        const unsigned old = xb_add(&bar[XB_XSUB(b.x)], 1u);
        const unsigned gen = old / nloc;
        if (old + 1u == (gen + 1u) * nloc) {
            __builtin_amdgcn_fence(__ATOMIC_RELEASE, "agent");
            asm volatile("s_waitcnt vmcnt(0)" ::: "memory");
            const unsigned og = xb_add(&bar[XB_TOP], 1u);
            const unsigned tg = og / nx;
            if (og + 1u == (tg + 1u) * nx) xb_add(&bar[XB_TOPGEN], 1u);
            else XB_SPIN(xb_ld(&bar[XB_TOPGEN]) == tg, bar);
            __builtin_amdgcn_fence(__ATOMIC_ACQUIRE, "agent");
            xb_add(&bar[XB_XGEN(b.x)], 1u);
            asm volatile("s_waitcnt vmcnt(0)" ::: "memory");
        } else {
            XB_SPIN(xb_ld(&bar[XB_XGEN(b.x)]) == gen, bar);
            __builtin_amdgcn_fence(__ATOMIC_ACQUIRE, "agent");
            asm volatile("s_waitcnt vmcnt(0)" ::: "memory");
        }
    }
    __syncthreads();
}

namespace pg {
constexpr int BM = 256, BK = 64, HALF = 128, HTB = HALF * BK * 2, STAGE_BYTES = 8 * HTB, NXCD = 8, WGM = 8;
__host__ __device__ __forceinline__ int lds_byte(int r, int c) { const int st = (r >> 4) * 2 + (c >> 5), rr = r & 15, cc = c & 31, ob = rr * 64 + cc * 2; return st * 1024 + (ob ^ (((ob >> 9) & 1) << 5)); }
__host__ __device__ __forceinline__ void stage_rc(int b, int& R, int& C) { const int st = b / 1024, sb = b % 1024, swz = sb ^ (((sb >> 9) & 1) << 5); R = (st >> 1) * 16 + swz / 64; C = (st & 1) * 32 + (swz % 64) / 2; }

__host__ __device__ __forceinline__ int perm32(int rho) { const int n = rho >> 4, i = rho & 15; return 8 * (i >> 2) + 4 * n + (i & 3); }
struct Unit { int e, pm, pn, mvalid, crow0; };

struct PlainSched {
    int nM, nN, nwg, G, c;
    __device__ void init(int nM_, int nN_, int G_, int c_) { nM = nM_; nN = nN_; nwg = nM * nN; G = G_; c = c_; }
    __device__ bool next(int i, Unit& u) const {
        const long Lx = (long)i * G + c; if (Lx >= nwg) return false;
        int wgid = (int)Lx; { const int q = nwg / NXCD, r = nwg % NXCD, xcd = wgid % NXCD, off = wgid / NXCD; wgid = (xcd < r ? xcd * (q + 1) : r * (q + 1) + (xcd - r) * q) + off; }
        const int nig = WGM * nN, gid = wgid / nig, fm = gid * WGM, gsz = (nM - fm) < WGM ? (nM - fm) : WGM;
        u.pm = fm + ((wgid % nig) % gsz); u.pn = (wgid % nig) / gsz; u.e = 0; u.crow0 = u.pm * BM; u.mvalid = min(BM, T - u.pm * BM); return true;
    }
    __device__ __forceinline__ int arow(const Unit& u, int r) const { return min(u.pm * BM + r, T - 1); }
    __device__ __forceinline__ int brow0(const Unit& u) const { return u.pn * BM; }
};
struct MoeSched {
    const LAS int* tab; const int* list; int nN, G, c, gather, nrowsB;
    __device__ bool next(int i, Unit& u) const {
        const int Lx = i * G + c; const int panel = Lx / nN;
        if (panel >= __builtin_amdgcn_readfirstlane(tab[32])) return false;
        int e = 0;
#pragma unroll 1
        for (int j = 1; j < 16; ++j) if (panel >= __builtin_amdgcn_readfirstlane(tab[16 + j])) e = j;
        u.e = e; u.pm = panel - __builtin_amdgcn_readfirstlane(tab[16 + e]); u.pn = Lx % nN; u.crow0 = __builtin_amdgcn_readfirstlane(tab[33 + e]) + u.pm * BM;
        u.mvalid = min(BM, __builtin_amdgcn_readfirstlane(tab[e]) - u.pm * BM); return true;
    }
    __device__ __forceinline__ int arow(const Unit& u, int r) const {
        const int rr = min(r, u.mvalid - 1);
        return gather ? list[(size_t)u.e * T + u.pm * BM + rr] : (u.crow0 + rr);
    }
    __device__ __forceinline__ int brow0(const Unit& u) const { return u.e * nrowsB + u.pn * BM; }
};

typedef int i32x8 __attribute__((ext_vector_type(8)));
typedef int i32x4_ __attribute__((ext_vector_type(4)));
__host__ __device__ __forceinline__ int lds_byte8(int r, int kb) { const int st = (r >> 4) * 2 + (kb >> 1), rr = r & 15; return st * 1024 + rr * 64 + 32 * ((kb & 1) ^ (rr >> 3)); }
template <bool FP8, class Epi, class Sched>
__device__ __forceinline__ void gemm_phase(LAS unsigned char* lds, const void* A, const void* Bt, const int K  , const Sched& S, const Epi& E) {
    const int tid = threadIdx.x, wid = __builtin_amdgcn_readfirstlane(tid >> 6), lane = tid & 63, wr = wid >> 2, wc = wid & 3, fr = lane & 15, fq = lane >> 4;
    const int nt = K / BK;
    unsigned voffB[2];
#pragma unroll
    for (int i = 0; i < 2; ++i) { int R, C; stage_rc(tid * 16 + i * 8192, R, C); const int Rb = Epi::PERM ? ((R & ~31) + perm32(R & 31)) : R; voffB[i] = (unsigned)(Rb * K + C) * 2u; }
    const size_t kstep = (size_t)(BK * 2);
    const size_t hstep = (size_t)HALF * K * 2;
    const unsigned rowb = (unsigned)K * 2u;
    const unsigned ldsw = (unsigned)wid * 1024u;
    const int aoff = FP8 ? lds_byte8(wr * 64 + fr, fq) : lds_byte(wr * 64 + fr, fq * 8), boff = FP8 ? lds_byte8(wc * 32 + fr, fq) : lds_byte(wc * 32 + fr, fq * 8);
#define PG_SA(b, h) (((b) * 2 + (h)) * HTB)
#define PG_SB(b, h) ((4 + (b) * 2 + (h)) * HTB)
#define PG_STAGE_B(bufoff, gbase) do { _Pragma("unroll") for (int _i = 0; _i < 2; ++_i) \
        __builtin_amdgcn_global_load_lds((const unsigned*)((const char*)(gbase) + voffB[_i]), (LAS unsigned*)(lds + (bufoff) + ldsw + _i * 8192), 16, 0, 0); } while (0)
#define PG_STAGE_A(bufoff, gbase, v0, v1) do { \
        __builtin_amdgcn_global_load_lds((const unsigned*)((const char*)(gbase) + (v0)), (LAS unsigned*)(lds + (bufoff) + ldsw), 16, 0, 0); \
        __builtin_amdgcn_global_load_lds((const unsigned*)((const char*)(gbase) + (v1)), (LAS unsigned*)(lds + (bufoff) + ldsw + 8192), 16, 0, 0); } while (0)
#define PG_LDA(dst, b, h) do { _Pragma("unroll") for (int m = 0; m < 4; ++m) _Pragma("unroll") for (int k = 0; k < 2; ++k) dst[m][k] = *(const LAS bf16x8*)(lds + PG_SA(b, h) + aoff + m * 2048 + (FP8 ? k * 16 : k * 1024)); } while (0)
#define PG_LDB(dst, b, h) do { _Pragma("unroll") for (int n = 0; n < 2; ++n) _Pragma("unroll") for (int k = 0; k < 2; ++k) dst[n][k] = *(const LAS bf16x8*)(lds + PG_SB(b, h) + boff + n * 2048 + (FP8 ? k * 16 : k * 1024)); } while (0)
#define PG_MMA(ai, bj, At, Bt_) do { __builtin_amdgcn_s_setprio(1); if constexpr (FP8) { _Pragma("unroll") for (int m = 0; m < 4; ++m) _Pragma("unroll") for (int n = 0; n < 2; ++n) { \
            const i32x8 bq_ = __builtin_shufflevector(__builtin_bit_cast(i32x4_, Bt_[n][0]), __builtin_bit_cast(i32x4_, Bt_[n][1]), 0, 1, 2, 3, 4, 5, 6, 7), aq_ = __builtin_shufflevector(__builtin_bit_cast(i32x4_, At[m][0]), __builtin_bit_cast(i32x4_, At[m][1]), 0, 1, 2, 3, 4, 5, 6, 7); \
            acc[ai][bj][m][n] = __builtin_amdgcn_mfma_scale_f32_16x16x128_f8f6f4(bq_, aq_, acc[ai][bj][m][n], 0, 0, 0, 0x7f7f7f7f, 0, 0x7f7f7f7f); } } \
        else { _Pragma("unroll") for (int m = 0; m < 4; ++m) _Pragma("unroll") for (int n = 0; n < 2; ++n) _Pragma("unroll") for (int k = 0; k < 2; ++k) \
        acc[ai][bj][m][n] = __builtin_amdgcn_mfma_f32_16x16x32_bf16(Bt_[n][k], At[m][k], acc[ai][bj][m][n], 0, 0, 0); } __builtin_amdgcn_s_setprio(0); } while (0)
#define PG_WAIT_V(n) asm volatile("s_waitcnt vmcnt(" #n ")" ::: "memory")
#define PG_WAIT_L(n) asm volatile("s_waitcnt lgkmcnt(" #n ")" ::: "memory")
#define PG_BAR __builtin_amdgcn_s_barrier()
#define PG_SCHED __builtin_amdgcn_sched_barrier(0)
#define PG_SETA(v, u) do { int R0_, C0_, R1_, C1_; stage_rc(tid * 16, R0_, C0_); stage_rc(tid * 16 + 8192, R1_, C1_); \
        v##00 = (unsigned)S.arow(u, R0_) * rowb + (unsigned)C0_ * 2u; v##01 = (unsigned)S.arow(u, R1_) * rowb + (unsigned)C1_ * 2u; \
        v##10 = (unsigned)S.arow(u, HALF + R0_) * rowb + (unsigned)C0_ * 2u; v##11 = (unsigned)S.arow(u, HALF + R1_) * rowb + (unsigned)C1_ * 2u; } while (0)
    Unit cur, nxt; int ui = 0;
    if (!S.next(0, cur)) return;
    f32x4 acc[2][2][4][2];
#pragma unroll
    for (int a = 0; a < 2; ++a)
#pragma unroll
        for (int b = 0; b < 2; ++b)
#pragma unroll
            for (int m = 0; m < 4; ++m)
#pragma unroll
                for (int n = 0; n < 2; ++n) acc[a][b][m][n] = (f32x4){0.f, 0.f, 0.f, 0.f};
    bf16x8 At[4][2], B0[2][2], B1[2][2];
    unsigned vc00, vc01, vc10, vc11;
    PG_SETA(vc, cur);
    const char* Ab = (const char*)A;
    const char* cB = (const char*)Bt + (size_t)S.brow0(cur) * rowb;
    PG_STAGE_B(PG_SB(0, 0), cB); PG_STAGE_B(PG_SB(0, 1), cB + hstep); PG_STAGE_A(PG_SA(0, 0), Ab, vc00, vc01); PG_STAGE_A(PG_SA(0, 1), Ab, vc10, vc11);
    if (wr == 1) PG_BAR;
    PG_WAIT_V(2); PG_BAR;
    PG_STAGE_B(PG_SB(1, 0), cB + kstep); PG_STAGE_A(PG_SA(1, 0), Ab + kstep, vc00, vc01); PG_STAGE_B(PG_SB(1, 1), cB + hstep + kstep);
    PG_WAIT_V(6); PG_BAR;
    for (;;) {
        const bool has_next = S.next(ui + 1, nxt);
        const char* nB = has_next ? (const char*)Bt + (size_t)S.brow0(nxt) * rowb : cB;
        for (int t = 0; t < nt; t += 2) {
            const bool last = (t == nt - 2);
            const char* a1 = Ab + (size_t)(t + 1) * kstep;
            const char* a2 = last ? Ab : Ab + (size_t)(t + 2) * kstep; const char* b2 = last ? nB : cB + (size_t)(t + 2) * kstep;
            const char* a3 = a2 + kstep; const char* b3 = b2 + kstep;
            PG_LDB(B0, 0, 0); PG_LDB(B1, 0, 1); PG_SCHED; PG_LDA(At, 0, 0); PG_STAGE_A(PG_SA(1, 1), a1, vc10, vc11);
            if (last && has_next) { PG_SETA(vc, nxt); }
            PG_WAIT_V(8); PG_WAIT_L(0); PG_BAR; PG_MMA(0, 0, At, B0); PG_MMA(0, 1, At, B1); PG_BAR; PG_SCHED;
            PG_LDA(At, 0, 1); PG_STAGE_B(PG_SB(0, 0), b2); PG_STAGE_B(PG_SB(0, 1), b2 + hstep); PG_STAGE_A(PG_SA(0, 0), a2, vc00, vc01);
            PG_WAIT_V(8); PG_WAIT_L(0); PG_BAR; PG_MMA(1, 0, At, B0); PG_MMA(1, 1, At, B1); PG_BAR; PG_SCHED;
            PG_LDB(B0, 1, 0); PG_LDB(B1, 1, 1); PG_SCHED; PG_LDA(At, 1, 0); PG_STAGE_A(PG_SA(0, 1), a2, vc10, vc11);
            PG_WAIT_V(8); PG_WAIT_L(0); PG_BAR; PG_MMA(0, 0, At, B0); PG_MMA(0, 1, At, B1); PG_BAR; PG_SCHED;
            PG_LDA(At, 1, 1); PG_STAGE_B(PG_SB(1, 0), b3); PG_STAGE_B(PG_SB(1, 1), b3 + hstep); PG_STAGE_A(PG_SA(1, 0), a3, vc00, vc01);
            PG_WAIT_V(8); PG_WAIT_L(0); PG_BAR; PG_MMA(1, 0, At, B0); PG_MMA(1, 1, At, B1); PG_BAR; PG_SCHED;
        }
        if (wr == 0) PG_BAR;
        E(acc, cur, wr, wc, fr, fq);
        if (!has_next) break;
#pragma unroll
        for (int a = 0; a < 2; ++a)
#pragma unroll
            for (int b = 0; b < 2; ++b)
#pragma unroll
                for (int m = 0; m < 4; ++m)
#pragma unroll
                    for (int n = 0; n < 2; ++n) acc[a][b][m][n] = (f32x4){0.f, 0.f, 0.f, 0.f};
        cur = nxt; cB = nB; ++ui;
        if (wr == 1) PG_BAR;
    }
    PG_WAIT_V(0);
    PG_BAR;
#undef PG_SA
#undef PG_SB
#undef PG_STAGE_A
#undef PG_STAGE_B
#undef PG_LDA
#undef PG_LDB
#undef PG_MMA
#undef PG_WAIT_V
#undef PG_WAIT_L
#undef PG_BAR
#undef PG_SCHED
#undef PG_SETA
}

struct EpiInProj {
    static constexpr bool PERM = true;
    bf16_t* U; const float* bias;
    __device__ __forceinline__ void operator()(const f32x4 (&acc)[2][2][4][2], const Unit& u, int wr, int wc, int fr, int fq) const {
        const int col0 = u.pn * BM + wc * 32 + 8 * fq;
        f32x4 bv[2][2]; bool cv[2];
#pragma unroll
        for (int bj = 0; bj < 2; ++bj) { const int c = col0 + bj * HALF; cv[bj] = c < INC;
#pragma unroll
            for (int n = 0; n < 2; ++n) bv[bj][n] = cv[bj] ? *(const f32x4*)(bias + c + 4 * n) : (f32x4){0.f, 0.f, 0.f, 0.f}; }
#pragma unroll
        for (int ai = 0; ai < 2; ++ai)
#pragma unroll
            for (int m = 0; m < 4; ++m) { const int r = ai * HALF + wr * 64 + m * 16 + fr;
                if (r < u.mvalid) { bf16_t* rowp = U + (size_t)(u.crow0 + r) * INC + col0;
#pragma unroll
                    for (int bj = 0; bj < 2; ++bj) if (cv[bj]) { const f32x4 v0 = acc[ai][bj][m][0] + bv[bj][0], v1 = acc[ai][bj][m][1] + bv[bj][1];
                        u32x4 w; w.x = pk2(v0[0], v0[1]); w.y = pk2(v0[2], v0[3]); w.z = pk2(v1[0], v1[1]); w.w = pk2(v1[2], v1[3]); *(u32x4*)(rowp + bj * HALF) = w; } } }
    }
};
struct EpiOutProj {
    static constexpr bool PERM = true;
    bf16_t* MX; const float* bias;
    __device__ __forceinline__ void operator()(const f32x4 (&acc)[2][2][4][2], const Unit& u, int wr, int wc, int fr, int fq) const {
        const int col0 = u.pn * BM + wc * 32 + 8 * fq;
        f32x4 bv[2][2];
#pragma unroll
        for (int bj = 0; bj < 2; ++bj)
#pragma unroll
            for (int n = 0; n < 2; ++n) bv[bj][n] = *(const f32x4*)(bias + col0 + bj * HALF + 4 * n);
#pragma unroll
        for (int ai = 0; ai < 2; ++ai)
#pragma unroll
            for (int m = 0; m < 4; ++m) { const int r = ai * HALF + wr * 64 + m * 16 + fr;
                if (r < u.mvalid) { bf16_t* rowp = MX + (size_t)(u.crow0 + r) * D + col0;
#pragma unroll
                    for (int bj = 0; bj < 2; ++bj) { const f32x4 v0 = acc[ai][bj][m][0] + bv[bj][0], v1 = acc[ai][bj][m][1] + bv[bj][1];
                        u32x4 w; w.x = pk2(v0[0], v0[1]); w.y = pk2(v0[2], v0[3]); w.z = pk2(v1[0], v1[1]); w.w = pk2(v1[2], v1[3]); *(u32x4*)(rowp + bj * HALF) = w; } } }
    }
};
struct EpiGateUp {
    static constexpr bool PERM = false;
    bf16_t* Hm;
    __device__ __forceinline__ void operator()(const f32x4 (&acc)[2][2][4][2], const Unit& u, int wr, int wc, int fr, int fq) const {
        const int col0 = u.pn * 128 + wc * 16 + 4 * fq;
#pragma unroll
        for (int ai = 0; ai < 2; ++ai)
#pragma unroll
            for (int m = 0; m < 4; ++m) { const int r = ai * HALF + wr * 64 + m * 16 + fr;
                if (r < u.mvalid) { bf16_t* rowp = Hm + (size_t)(u.crow0 + r) * DEXP + col0;
#pragma unroll
                    for (int bj = 0; bj < 2; ++bj) { const f32x4 g = acc[ai][bj][m][0], up = acc[ai][bj][m][1]; float o[4];
#pragma unroll
                        for (int j = 0; j < 4; ++j) o[j] = g[j] / (1.0f + __expf(-g[j])) * up[j];
                        u32x2 w; w.x = pk2(o[0], o[1]); w.y = pk2(o[2], o[3]); *(u32x2*)(rowp + bj * 64) = w; } } }
    }
};
struct EpiGateUp8 {
    static constexpr bool PERM = false;
    unsigned char* Hm;
    __device__ __forceinline__ void operator()(const f32x4 (&acc)[2][2][4][2], const Unit& u, int wr, int wc, int fr, int fq) const {
        const int col0 = u.pn * 128 + wc * 32 + 8 * fq;
#pragma unroll
        for (int ai = 0; ai < 2; ++ai)
#pragma unroll
            for (int m = 0; m < 4; ++m) { const int r = ai * HALF + wr * 64 + m * 16 + fr;
                if (r < u.mvalid) { int pk[2];
#pragma unroll
                    for (int bj = 0; bj < 2; ++bj) { const f32x4 g = acc[ai][bj][m][0] * (1.0f / 64.0f), up = acc[ai][bj][m][1] * (16.0f / 64.0f); float o[4];
#pragma unroll
                        for (int j = 0; j < 4; ++j) o[j] = g[j] / (1.0f + __expf(-g[j])) * up[j];
                        int q = __builtin_amdgcn_cvt_pk_fp8_f32(o[0], o[1], 0, false); pk[bj] = __builtin_amdgcn_cvt_pk_fp8_f32(o[2], o[3], q, true); }
                    *(u32x2*)(Hm + (size_t)(u.crow0 + r) * DEXP + col0) = (u32x2){(unsigned)pk[0], (unsigned)pk[1]}; } }
    }
};
struct EpiDown8 {
    static constexpr bool PERM = true;
    unsigned char* O;
    __device__ __forceinline__ void operator()(const f32x4 (&acc)[2][2][4][2], const Unit& u, int wr, int wc, int fr, int fq) const {
        const int col0 = u.pn * BM + wc * 32 + 8 * fq;
#pragma unroll
        for (int ai = 0; ai < 2; ++ai)
#pragma unroll
            for (int m = 0; m < 4; ++m) { const int r = ai * HALF + wr * 64 + m * 16 + fr;
                if (r < u.mvalid) { unsigned char* rowp = O + (size_t)(u.crow0 + r) * D + col0;
#pragma unroll
                    for (int bj = 0; bj < 2; ++bj) { const f32x4 v0 = acc[ai][bj][m][0] * (1.0f / 16.0f), v1 = acc[ai][bj][m][1] * (1.0f / 16.0f);
                        int p0 = __builtin_amdgcn_cvt_pk_fp8_f32(v0[0], v0[1], 0, false); p0 = __builtin_amdgcn_cvt_pk_fp8_f32(v0[2], v0[3], p0, true);
                        int p1 = __builtin_amdgcn_cvt_pk_fp8_f32(v1[0], v1[1], 0, false); p1 = __builtin_amdgcn_cvt_pk_fp8_f32(v1[2], v1[3], p1, true);
                        *(u32x2*)(rowp + bj * HALF) = (u32x2){(unsigned)p0, (unsigned)p1}; } } }
    }
};
struct EpiDown {
    static constexpr bool PERM = false;
    bf16_t* O;
    __device__ __forceinline__ void operator()(const f32x4 (&acc)[2][2][4][2], const Unit& u, int wr, int wc, int fr, int fq) const {
        const int col0 = u.pn * BM + wc * 32 + 4 * fq;
#pragma unroll
        for (int ai = 0; ai < 2; ++ai)
#pragma unroll
            for (int m = 0; m < 4; ++m) { const int r = ai * HALF + wr * 64 + m * 16 + fr;
                if (r < u.mvalid) { bf16_t* rowp = O + (size_t)(u.crow0 + r) * D + col0;
#pragma unroll
                    for (int bj = 0; bj < 2; ++bj)
#pragma unroll
                        for (int n = 0; n < 2; ++n) { const f32x4 v = acc[ai][bj][m][n]; u32x2 w; w.x = pk2i(v[0], v[1]); w.y = pk2i(v[2], v[3]); *(u32x2*)(rowp + bj * HALF + n * 16) = w; } } }
    }
};
}

struct Frame {
    LAS unsigned char* lds; volatile LAS unsigned* MISC; unsigned* ctl; unsigned char* ws;
    int tid, lane, wave, vcu, G;
};
__device__ __forceinline__ int opaque_v(int v) { asm volatile("" : "+v"(v)); return v; }
__device__ __forceinline__ unsigned char* launder_ws(unsigned char* p) { GAS unsigned char* q = (GAS unsigned char*)p; asm volatile("" : "+s"(q)); return (unsigned char*)q; }
struct Args { const float* in[36]; float* out; unsigned char* ws; int ph_lo, ph_hi; };
struct ArgsG { const GAS float* in_[36]; GAS float* out_; GAS unsigned char* ws_; int ph_lo, ph_hi;
 };
#define CAS __attribute__((address_space(4)))
__device__ __forceinline__ const CAS ArgsG* kargp() { const CAS ArgsG* p = (const CAS ArgsG*)__builtin_amdgcn_kernarg_segment_ptr(); asm volatile("" : "+s"(p)); return p; }
__device__ __forceinline__ const float* kin(int k) { return (const float*)kargp()->in_[k]; }
__device__ __forceinline__ float* kout() { return (float*)kargp()->out_; }

__device__ __forceinline__ void transpose64(const float* colp4, int ldw, int K, bf16_t* WT, int k0, int j0, LAS float* scr, int lane) {
    const int kr = lane >> 4, c4 = lane & 15;
    f32x4 t[16];
#pragma unroll
    for (int i = 0; i < 16; ++i) t[i] = colp4 ? *(const f32x4*)(colp4 + (size_t)(k0 + kr + 4 * i) * ldw) : (f32x4){0.f, 0.f, 0.f, 0.f};
    const int ch = lane >> 4, nr = lane & 15;
#pragma unroll
    for (int hf = 0; hf < 2; ++hf) {
#pragma unroll
        for (int i = 0; i < 8; ++i) { LAS float* d = scr + (kr + 4 * i) * 66 + 4 * c4; const f32x4 x = t[hf * 8 + i]; *(LAS f32x2*)d = (f32x2){x[0], x[1]}; *(LAS f32x2*)(d + 2) = (f32x2){x[2], x[3]}; }
        LDS_WAIT();
#pragma unroll
        for (int it = 0; it < 4; ++it) { const int n = nr + 16 * it; const LAS float* sp = scr + (8 * ch) * 66 + n;
            u32x4 o; o.x = pk2(sp[0], sp[66]); o.y = pk2(sp[2 * 66], sp[3 * 66]); o.z = pk2(sp[4 * 66], sp[5 * 66]); o.w = pk2(sp[6 * 66], sp[7 * 66]);
            *(u32x4*)(WT + (size_t)(j0 + n) * K + k0 + 32 * hf + 8 * ch) = o; }
        LDS_WAIT();
    }
}
__device__ __forceinline__ void transpose64_fp8(const float* colp4, int ldw, int K, unsigned char* WT, int k0, int j0, LAS float* scr, int lane) {
    const int kr = lane >> 4, c4 = lane & 15;
    f32x4 t[16];
#pragma unroll
    for (int i = 0; i < 16; ++i) t[i] = *(const f32x4*)(colp4 + (size_t)(k0 + kr + 4 * i) * ldw);
    const int ch = lane >> 5, nr = lane & 31;
#pragma unroll
    for (int hf = 0; hf < 2; ++hf) {
#pragma unroll
        for (int i = 0; i < 8; ++i) { LAS float* d = scr + (kr + 4 * i) * 66 + 4 * c4; const f32x4 x = t[hf * 8 + i]; *(LAS f32x2*)d = (f32x2){x[0], x[1]}; *(LAS f32x2*)(d + 2) = (f32x2){x[2], x[3]}; }
        LDS_WAIT();
#pragma unroll
        for (int it = 0; it < 2; ++it) { const int n = nr + 32 * it; const LAS float* sp = scr + (16 * ch) * 66 + n; int q[4];
#pragma unroll
            for (int g = 0; g < 4; ++g) { int pk = __builtin_amdgcn_cvt_pk_fp8_f32(sp[(4 * g) * 66] * 64.0f, sp[(4 * g + 1) * 66] * 64.0f, 0, false); q[g] = __builtin_amdgcn_cvt_pk_fp8_f32(sp[(4 * g + 2) * 66] * 64.0f, sp[(4 * g + 3) * 66] * 64.0f, pk, true); }
            *(u32x4*)(WT + (size_t)(j0 + n) * K + k0 + 32 * hf + 16 * ch) = (u32x4){(unsigned)q[0], (unsigned)q[1], (unsigned)q[2], (unsigned)q[3]}; }
        LDS_WAIT();
    }
}
__device__ __forceinline__ f32x4 ldg4(const float* p) { return *(const f32x4*)p; }
__device__ __forceinline__ f32x4 ldg4(const LAS float* p) { return *(const LAS f32x4*)p; }
template <bool HB8 = false, bool OUT_ONLY = false, class GP = const float*>
__device__ __forceinline__ void ln_wave_store(f32x4 (&v)[8], GP g, GP b, bf16_t* resrow, unsigned char* f8row, float* orow, int lane) {
    float s = 0.f;
#pragma unroll
    for (int j = 0; j < 8; ++j) s += (v[j][0] + v[j][1]) + (v[j][2] + v[j][3]);
    const float mean = wave_sum(s) * (1.0f / D);
    float q = 0.f;
#pragma unroll
    for (int j = 0; j < 8; ++j) { v[j] = v[j] - mean; q += (v[j][0] * v[j][0] + v[j][1] * v[j][1]) + (v[j][2] * v[j][2] + v[j][3] * v[j][3]); }
    const float rstd = rsqrtf(wave_sum(q) * (1.0f / D) + 1e-5f);
#pragma unroll
    for (int j = 0; j < 8; ++j) {
        const int i4 = lane + 64 * j;
        const f32x4 gv = ldg4(g + 4 * i4), bv = ldg4(b + 4 * i4);
        if (HB8 && (j & 1) == 0) __builtin_amdgcn_sched_barrier(0);
        const f32x4 o = v[j] * rstd * gv + bv;
        v[j] = o;
        if (OUT_ONLY) { if (orow) ((f32x4*)orow)[i4] = o; continue; }
        { u32x2 w; w.x = pk2(o[0], o[1]); w.y = pk2(o[2], o[3]); ((u32x2*)resrow)[i4] = w; }
        if (HB8) { int pk = __builtin_amdgcn_cvt_pk_fp8_f32(o[0], o[1], 0, false); pk = __builtin_amdgcn_cvt_pk_fp8_f32(o[2], o[3], pk, true); ((int*)f8row)[i4] = pk; }
        if (orow) ((f32x4*)orow)[i4] = o;
    }
}

__device__ __forceinline__ void hy_filter_item(Frame& F, int item, unsigned char* wsl);
__device__ __forceinline__ void hy_filter_tails(Frame& F, unsigned char* wsl);
__device__ __forceinline__ void p_prologue(Frame& F) {
    unsigned char* const wsl = launder_ws(F.ws); unsigned* const ctl = (unsigned*)(wsl + WS_CTL);
    LAS float* scr = (LAS float*)(F.lds + F.wave * 16384);
    const int gw = F.vcu * 8 + F.wave, NGW = F.G * 8, lane = F.lane;
    bf16_t* WIN = (bf16_t*)(wsl + WS_WIN); bf16_t* WOUT = (bf16_t*)(wsl + WS_WOUT); bf16_t* WGU = (bf16_t*)(wsl + WS_WGU); bf16_t* WD = (bf16_t*)(wsl + WS_WD);
    constexpr int I_IN = 32 * (INCP / 64), I_OUT = 32 * 32, I_GU = 32 * 32, I_D = 16 * 32;
    constexpr int N_IN = DEPTH * I_IN, N_OUT = DEPTH * I_OUT, N_GU = DEPTH * NEXP * I_GU, N_D = DEPTH * NEXP * I_D, N_TR = N_IN + N_OUT + N_GU + N_D;
    const int c4 = lane & 15, kr4 = lane >> 4;
    struct TrItem { const float* colp; unsigned char* wt; int ldw, K, k0, j0, f8; };
#define TR_DECODE(itv, d) do { int r_ = (itv); \
        if (r_ < N_IN) { const int ll = r_ / I_IN, q = r_ % I_IN, nb = q % (INCP / 64), kb = q / (INCP / 64); const int n = nb * 64 + 4 * c4; \
            d.colp = n < INC ? kin(4) + (size_t)ll * D * INC + n : nullptr; d.ldw = INC; d.K = D; d.wt = (unsigned char*)(WIN + (size_t)ll * INCP * D); d.k0 = kb * 64; d.j0 = nb * 64; d.f8 = 0; } \
        else if (r_ < N_IN + N_OUT) { r_ -= N_IN; const int ll = r_ / I_OUT, q = r_ % I_OUT, nb = q % 32, kb = q / 32; const int n = nb * 64 + 4 * c4; \
            d.colp = kin(23) + (size_t)ll * D * D + n; d.ldw = D; d.K = D; d.wt = (unsigned char*)(WOUT + (size_t)ll * D * D); d.k0 = kb * 64; d.j0 = nb * 64; d.f8 = 0; } \
        else if (r_ < N_IN + N_OUT + N_GU) { r_ -= N_IN + N_OUT; const int le = r_ / I_GU, q = r_ % I_GU, nb = q % 32, kb = q / 32; const int j = nb * 64 + 4 * c4; \
            const int pn = j >> 8, cp = j & 255, bj = cp >> 7, wc = (cp >> 5) & 3, nn = (cp >> 4) & 1, fq = (cp >> 2) & 3; const int hid = pn * 128 + wc * 32 + fq * 8 + bj * 4; \
            d.colp = (nn ? kin(32) : kin(31)) + (size_t)le * D * DEXP + hid; d.ldw = DEXP; d.K = D; d.wt = (unsigned char*)WGU + (size_t)le * 2048 * D; d.k0 = kb * 64; d.j0 = nb * 64; d.f8 = 1; } \
        else { r_ -= N_IN + N_OUT + N_GU; const int le = r_ / I_D, q = r_ % I_D, nb = q % 32, kb = q / 32; const int n = nb * 64 + 4 * c4; \
            d.colp = kin(33) + (size_t)le * DEXP * D + n; d.ldw = D; d.K = DEXP; d.wt = (unsigned char*)WD + (size_t)le * D * DEXP; d.k0 = kb * 64; d.j0 = nb * 64; d.f8 = 1; } } while (0)
#define TR_LOAD(d, t) do { _Pragma("unroll") for (int i = 0; i < 16; ++i) t[i] = d.colp ? *(const f32x4*)(d.colp + (size_t)(d.k0 + kr4 + 4 * i) * d.ldw) : (f32x4){0.f, 0.f, 0.f, 0.f}; } while (0)
    { int it = gw; TrItem dc, dn; f32x4 tc[16], tn[16];
      if (it < N_TR) { TR_DECODE(it, dc); TR_LOAD(dc, tc); }
      for (; it < N_TR; it += NGW) {
          const int itn = it + NGW;
          if (itn < N_TR) { TR_DECODE(itn, dn); TR_LOAD(dn, tn); }
#pragma unroll
          for (int hf = 0; hf < 2; ++hf) {
#pragma unroll
              for (int i = 0; i < 8; ++i) { LAS float* dd = scr + (kr4 + 4 * i) * 66 + 4 * c4; const f32x4 x = tc[hf * 8 + i]; *(LAS f32x2*)dd = (f32x2){x[0], x[1]}; *(LAS f32x2*)(dd + 2) = (f32x2){x[2], x[3]}; }
              LDS_WAIT();
              if (dc.f8) { const int ch = lane >> 5, nr = lane & 31;
#pragma unroll
                  for (int i2 = 0; i2 < 2; ++i2) { const int n = nr + 32 * i2; const LAS float* sp = scr + (16 * ch) * 66 + n; int q[4];
#pragma unroll
                      for (int g = 0; g < 4; ++g) { int pk = __builtin_amdgcn_cvt_pk_fp8_f32(sp[(4 * g) * 66] * 64.0f, sp[(4 * g + 1) * 66] * 64.0f, 0, false); q[g] = __builtin_amdgcn_cvt_pk_fp8_f32(sp[(4 * g + 2) * 66] * 64.0f, sp[(4 * g + 3) * 66] * 64.0f, pk, true); }
                      *(u32x4*)(dc.wt + (size_t)(dc.j0 + n) * dc.K + dc.k0 + 32 * hf + 16 * ch) = (u32x4){(unsigned)q[0], (unsigned)q[1], (unsigned)q[2], (unsigned)q[3]}; }
              } else { const int ch = lane >> 4, nr = lane & 15;
#pragma unroll
                  for (int i2 = 0; i2 < 4; ++i2) { const int n = nr + 16 * i2; const LAS float* sp = scr + (8 * ch) * 66 + n;
                      u32x4 o; o.x = pk2(sp[0], sp[66]); o.y = pk2(sp[2 * 66], sp[3 * 66]); o.z = pk2(sp[4 * 66], sp[5 * 66]); o.w = pk2(sp[6 * 66], sp[7 * 66]);
                      *(u32x4*)((bf16_t*)dc.wt + (size_t)(dc.j0 + n) * dc.K + dc.k0 + 32 * hf + 8 * ch) = o; } }
              LDS_WAIT();
          }
          dc = dn;
#pragma unroll
          for (int i = 0; i < 16; ++i) tc[i] = tn[i];
      } }
#undef TR_DECODE
#undef TR_LOAD
    { bf16_t* WR = (bf16_t*)(wsl + WS_WR);
      for (int idx = blockIdx.x * 512 + F.tid; idx < DEPTH * 64 * 2 * 64; idx += F.G * 512) {
          const int ln = idx & 63, t = (idx >> 6) & 1, sst = (idx >> 7) & 63, ll = idx >> 13, n = ln & 15, kg = ln >> 4, c = 16 * t + n;
          unsigned hi[8], lo[8];
#pragma unroll
          for (int j = 0; j < 8; ++j) { const int k = 32 * sst + 8 * kg + j;
              const float wv = c < 4 ? kin(27)[((size_t)ll * D + k) * 4 + c] : (c < 20 ? kin(29)[((size_t)ll * D + k) * 16 + c - 4] : 0.f);
              hi[j] = f2bf(wv); lo[j] = f2bf(wv - __builtin_bit_cast(float, hi[j] << 16)); }
          bf16_t* o = WR + ((size_t)ll * 256 + (sst * 2 + t) * 2) * 512 + ln * 8;
          *(u32x4*)o = (u32x4){hi[0] | (hi[1] << 16), hi[2] | (hi[3] << 16), hi[4] | (hi[5] << 16), hi[6] | (hi[7] << 16)};
          *(u32x4*)(o + 512) = (u32x4){lo[0] | (lo[1] << 16), lo[2] | (lo[3] << 16), lo[4] | (lo[5] << 16), lo[6] | (lo[7] << 16)}; } }
    hy_filter_tails(F, wsl);
    for (int it = blockIdx.x; it < DEPTH * 66; it += F.G) hy_filter_item(F, it, wsl);
    __syncthreads();
    bf16_t* hb = (bf16_t*)(wsl + WS_HB);
    for (int row = gw; row < T; row += NGW) {
        const int bb = row / L, p = row % L;
        const float* src = p < NMETA ? kin(1) + (size_t)p * D : kin(0) + ((size_t)bb * SEQ + (p - NMETA)) * D;
        f32x4 v[8];
#pragma unroll
        for (int j = 0; j < 8; ++j) v[j] = ((const f32x4*)src)[lane + 64 * j];
        ln_wave_store(v, kin(2), kin(3), hb + (size_t)row * D, nullptr, nullptr, lane);
    }
}


__device__ __forceinline__ void hy_filter_item(Frame& F, int item, unsigned char* wsl) {
    const int half = item & 1, blk = (item >> 1) % 33, l = item / 66, tid = F.tid;
    const float* w1 = kin(15) + (size_t)l * 33 * 64; const float* b1 = kin(16) + l * 64; const float* freq = kin(17) + l * 128;
    const float* w2 = kin(18) + (size_t)l * 64 * 64; const float* b2 = kin(19) + l * 64; const float* w3 = kin(20) + (size_t)l * 64 * 1024;
    LAS float* z = (LAS float*)F.lds;
    LAS float* h1 = z + 64 * 33;
    LAS float* h2 = h1 + 64 * 64;
    LAS bf16_t* ot = (LAS bf16_t*)(h2 + 64 * 64);
    const int d0 = blk * 64;
    __syncthreads();
    for (int e = tid; e < 64 * 33; e += 512) { const int pl = e / 33, k = e % 33, i = d0 + pl; float v;
        if (k == 0) v = (float)i / (float)(L - 1);
        else { const int j = (k - 1) & 15; const double band = 1e-4 + (double)j * ((15.0 - 1e-4) / 15.0); double turns = band * (double)i / (double)L; turns -= (double)(long long)turns;
               const float ang = (float)(turns * 6.283185307179586476925); v = k < 17 ? __cosf(ang) : -__sinf(ang); }
        z[e] = v; }
    __syncthreads();
    { const int j = tid & 63, pg = tid >> 6; const float fq = freq[j], bb = b1[j];
      float a[8];
#pragma unroll
      for (int r = 0; r < 8; ++r) a[r] = bb;
      for (int k = 0; k < 33; ++k) { const float w = w1[k * 64 + j];
#pragma unroll
          for (int r = 0; r < 8; ++r) a[r] += z[(pg * 8 + r) * 33 + k] * w; }
#pragma unroll
      for (int r = 0; r < 8; ++r) h1[(pg * 8 + r) * 64 + j] = __sinf(fq * a[r]); }
    __syncthreads();
    { const int j = tid & 63, pg = tid >> 6; const float fq = freq[64 + j], bb = b2[j];
      float a[8];
#pragma unroll
      for (int r = 0; r < 8; ++r) a[r] = bb;
      for (int k = 0; k < 64; ++k) { const float w = w2[k * 64 + j];
#pragma unroll
          for (int r = 0; r < 8; ++r) a[r] += h1[(pg * 8 + r) * 64 + k] * w; }
#pragma unroll
      for (int r = 0; r < 8; ++r) h2[(pg * 8 + r) * 64 + j] = __sinf(fq * a[r]); }
    __syncthreads();
    { const int c = tid;
      const float mind = logf(1e-2f) / 1.5f, maxd = logf(1e-2f) / 0.3f;
      const float adel = fabsf(mind + (float)c * ((maxd - mind) / 511.0f));
      for (int pq = 0; pq < 64; pq += 8) {
          float a[8];
#pragma unroll
          for (int r = 0; r < 8; ++r) a[r] = 0.f;
          for (int k = 0; k < 64; ++k) { const float w = w3[k * 1024 + half * 512 + c];
#pragma unroll
              for (int r = 0; r < 8; ++r) a[r] += h2[(pq + r) * 64 + k] * w; }
#pragma unroll
          for (int r = 0; r < 8; ++r) { const int i = d0 + pq + r; const float tt = (float)i / (float)(L - 1); ot[c * 66 + pq + r] = (bf16_t)f2bf(a[r] * __expf(-tt * adel)); } } }
    __syncthreads();
    { bf16_t* FG = (bf16_t*)(wsl + WS_FG) + (size_t)l * 512 * 2 * GLEN;
      const int dl = tid & 63, cg = tid >> 6, d = d0 + dl;
      if (d < L && !(half == 1 && d == 0)) {
          const int m = half ? GCEN + d : GCEN - d;
          for (int c = cg; c < 512; c += 8) { const bf16_t v = ot[c * 66 + dl]; bf16_t* row = FG + (size_t)c * 2 * GLEN; row[m] = v; row[GLEN + m - 1] = v; } } }
}
__device__ __forceinline__ void hy_filter_tails(Frame& F, unsigned char* wsl) {
    bf16_t* FG = (bf16_t*)(wsl + WS_FG);
    constexpr int LO0 = GCEN - (L - 1), HI0 = GCEN + (L - 1) + 1;
    constexpr int NT0 = LO0 + (GLEN - HI0), NT1 = (LO0 - 1) + (GLEN - (HI0 - 1));
    for (size_t idx = (size_t)blockIdx.x * 512 + F.tid; idx < (size_t)DEPTH * 512 * (NT0 + NT1); idx += (size_t)F.G * 512) {
        const int rowi = (int)(idx / (NT0 + NT1)); int k = (int)(idx % (NT0 + NT1));
        bf16_t* row = FG + (size_t)rowi * 2 * GLEN;
        if (k < NT0) { const int m = k < LO0 ? k : HI0 + (k - LO0); row[m] = 0; }
        else { k -= NT0; const int m = k < LO0 - 1 ? k : (HI0 - 1) + (k - (LO0 - 1)); row[GLEN + m] = 0; } }
}

constexpr int MIXC_SG = 98304, MIXC_CW = 102400, MIXC_CB = 120832, MIXC_HG = 98304;
__device__ __forceinline__ void hy_pre_item(Frame& F, int item, int l, unsigned char* wsl) {
    const bf16_t* U = (const bf16_t*)(wsl + WS_U);
    bf16_t* X0T = (bf16_t*)(wsl + WS_X0T); bf16_t* ZT = (bf16_t*)(wsl + WS_ZT);
    const LAS float* cw = (const LAS float*)(F.lds + MIXC_CW); const LAS float* cb = (const LAS float*)(F.lds + MIXC_CB);
    const int cc = item & 3, pt = (item >> 2) % 33, b = item / (4 * 33), tid = opaque_v(F.tid);
    const int c8 = tid & 15, pl = tid >> 4, c0 = cc * 128 + 8 * c8;
    LAS bf16_t* zt = (LAS bf16_t*)F.lds; LAS bf16_t* xt = zt + 128 * 72;
    __syncthreads();
    u32x4 raw[2][3][3];
#pragma unroll
    for (int ps = 0; ps < 2; ++ps) { const int p = pt * 64 + pl + 32 * ps; const bool pv = p < L;
#pragma unroll
        for (int g = 0; g < 3; ++g) { const bf16_t* ub = U + ((size_t)b * L + (pv ? p : 0)) * INC + O_CU + g * 512 + c0; const u32x4 z4 = (u32x4){0u, 0u, 0u, 0u};
            raw[ps][g][0] = (pv && p > 0) ? *(const u32x4*)(ub - INC) : z4; raw[ps][g][1] = pv ? *(const u32x4*)ub : z4; raw[ps][g][2] = (p + 1 < L) ? *(const u32x4*)(ub + INC) : z4; } }
#pragma unroll
    for (int ps = 0; ps < 2; ++ps) { const int p = pt * 64 + pl + 32 * ps; const bool pv = p < L;
        float uc[3][8];
#pragma unroll
        for (int g = 0; g < 3; ++g) { const int col = g * 512 + c0;
            const f32x4 wa0 = *(const LAS f32x4*)(cw + col), wa1 = *(const LAS f32x4*)(cw + col + 4), wb0 = *(const LAS f32x4*)(cw + 1536 + col), wb1 = *(const LAS f32x4*)(cw + 1536 + col + 4),
                        wc0 = *(const LAS f32x4*)(cw + 3072 + col), wc1 = *(const LAS f32x4*)(cw + 3072 + col + 4), bb0 = *(const LAS f32x4*)(cb + col), bb1 = *(const LAS f32x4*)(cb + col + 4);
            const u32x4 rm = raw[ps][g][0], r0 = raw[ps][g][1], rp = raw[ps][g][2];
#pragma unroll
            for (int j = 0; j < 4; ++j) {
                const float m0 = __builtin_bit_cast(float, rm[j] << 16), m1 = __builtin_bit_cast(float, rm[j] & 0xffff0000u), x0 = __builtin_bit_cast(float, r0[j] << 16), x1 = __builtin_bit_cast(float, r0[j] & 0xffff0000u),
                            q0 = __builtin_bit_cast(float, rp[j] << 16), q1 = __builtin_bit_cast(float, rp[j] & 0xffff0000u);
                const int e = 2 * j; const float w0a = e < 4 ? wa0[e & 3] : wa1[e & 3], w0b = e < 4 ? wb0[e & 3] : wb1[e & 3], w0c = e < 4 ? wc0[e & 3] : wc1[e & 3], b0_ = e < 4 ? bb0[e & 3] : bb1[e & 3];
                const float w1a = e < 4 ? wa0[(e + 1) & 3] : wa1[(e + 1) & 3], w1b = e < 4 ? wb0[(e + 1) & 3] : wb1[(e + 1) & 3], w1c = e < 4 ? wc0[(e + 1) & 3] : wc1[(e + 1) & 3], b1_ = e < 4 ? bb0[(e + 1) & 3] : bb1[(e + 1) & 3];
                uc[g][e] = pv ? (b0_ + m0 * w0a + x0 * w0b + q0 * w0c) : 0.f; uc[g][e + 1] = pv ? (b1_ + m1 * w1a + x1 * w1b + q1 * w1c) : 0.f; } }
#pragma unroll
        for (int j = 0; j < 8; ++j) { const int col = (pl + 32 * ps + 8 * (c8 & 7)) & 63;
            zt[(8 * c8 + j) * 72 + col] = (bf16_t)f2bf(uc[1][j] * uc[2][j]); xt[(8 * c8 + j) * 72 + col] = (bf16_t)f2bf(uc[0][j]); } }
    __syncthreads();
#pragma unroll
    for (int it = 0; it < 2; ++it) { const int cr = (tid >> 3) + 64 * it, pc = tid & 7;
      const size_t o = ((size_t)(cc * 128 + cr) * NB + b) * ZL + pt * 64 + pc * 8;
      const int pcs = (pc + ((cr >> 3) & 7)) & 7;
      *(u32x4*)(ZT + o) = *(const LAS u32x4*)(zt + cr * 72 + pcs * 8);
      *(u32x4*)(X0T + o) = *(const LAS u32x4*)(xt + cr * 72 + pcs * 8); }
}

__device__ __forceinline__ void hy_conv_phase(Frame& F, int l, unsigned char* wsl) {
    const bf16_t* ZT = (const bf16_t*)(wsl + WS_ZT); const bf16_t* X0T = (const bf16_t*)(wsl + WS_X0T); bf16_t* YT = (bf16_t*)(wsl + WS_YT);
    const bf16_t* FG = (const bf16_t*)(wsl + WS_FG) + (size_t)l * 512 * 2 * GLEN;
    const float* skip = kin(21) + l * 512;
    LAS unsigned char* Zs = F.lds;
    LAS unsigned char* Gs = F.lds + 8 * ZROW * 2;
    const int tid = F.tid, lane = F.lane, wave = F.wave;
    __syncthreads();
    for (int e = tid; e < 8 * ZROW * 2 / 16; e += 512) *(LAS u32x4*)(Zs + e * 16) = (u32x4){0u, 0u, 0u, 0u};
    const int pp = wave & 1, q = wave >> 1;
    const int T0 = 576 * q + 16 * pp, D0 = -(576 * q + 544 + 32 * pp), S0 = T0 + D0;
    const int n = lane & 15, kg = lane >> 4, bb = n & 7, u = n >> 3;
    const unsigned zb = (unsigned)(bb * ZROW * 2 + 2 * (ZOFF + S0 + 32 * u + 8 * kg));
    const int par = n & 1, e0 = GCEN + D0 + 8 * kg - n;
    const unsigned ab = (unsigned)(8 * ZROW * 2 + par * GLEN * 2 + 2 * (e0 - par));
    for (int c = F.vcu; c < 512; c += F.G) {
        __syncthreads();
        for (int e = tid; e < 8 * (ZL / 8); e += 512) { const int b = e / (ZL / 8), pc = e % (ZL / 8);
            *(LAS u32x4*)(Zs + (b * ZROW + ZOFF + pc * 8) * 2) = *(const u32x4*)(ZT + ((size_t)c * NB + b) * ZL + pc * 8); }
        for (int e = tid; e < 2 * GLEN / 8; e += 512) *(LAS u32x4*)(Gs + e * 16) = *(const u32x4*)(FG + (size_t)c * 2 * GLEN + e * 8);
        __syncthreads();
        f32x4 acc[9];
#pragma unroll
        for (int k = 0; k < 9; ++k) acc[k] = (f32x4){0.f, 0.f, 0.f, 0.f};
        bf16x8 ring[18];
#pragma unroll
        for (int s2 = 0; s2 < 17; ++s2) ring[s2] = *(const LAS bf16x8*)(F.lds + zb + 64 * s2);
        u32x4 an;
#pragma unroll
        for (int d = 0; d < 4; ++d) an[d] = *(const LAS unsigned*)(F.lds + ab + 4 * d);
        for (int jo = 0; jo < 5; ++jo) {
            const unsigned zo = zb + (unsigned)jo * 18u * 64u, ao = ab + (unsigned)jo * 18u * 64u;
#pragma unroll
            for (int jj = 0; jj < 18; ++jj) {
                const bf16x8 acur = __builtin_bit_cast(bf16x8, an);
                ring[(jj + 17) % 18] = *(const LAS bf16x8*)(F.lds + zo + 64 * (jj + 17));
#pragma unroll
                for (int d = 0; d < 4; ++d) an[d] = *(const LAS unsigned*)(F.lds + ao + 64 * (jj + 1) + 4 * d);
#pragma unroll
                for (int k = 0; k < 9; ++k) acc[k] = __builtin_amdgcn_mfma_f32_16x16x32_bf16(acur, ring[(jj + 2 * k) % 18], acc[k], 0, 0, 0);
            }
        }
        const float sk = skip[c];
#pragma unroll
        for (int k = 0; k < 9; ++k) { const int t = T0 + 64 * k + 32 * u + 4 * kg;
            if (t < L) { const size_t o = ((size_t)c * NB + bb) * ZL + t;
                const u32x2 xv = *(const u32x2*)(X0T + o); const u32x2 zv = *(const LAS u32x2*)(Zs + (bb * ZROW + ZOFF + t) * 2);
                float y[4];
                y[0] = __builtin_bit_cast(float, xv.x << 16) * (acc[k][0] + sk * __builtin_bit_cast(float, zv.x << 16));
                y[1] = __builtin_bit_cast(float, xv.x & 0xffff0000u) * (acc[k][1] + sk * __builtin_bit_cast(float, zv.x & 0xffff0000u));
                y[2] = __builtin_bit_cast(float, xv.y << 16) * (acc[k][2] + sk * __builtin_bit_cast(float, zv.y << 16));
                y[3] = __builtin_bit_cast(float, xv.y & 0xffff0000u) * (acc[k][3] + sk * __builtin_bit_cast(float, zv.y & 0xffff0000u));
                u32x2 w; w.x = pk2(y[0], y[1]); w.y = pk2(y[2], y[3]); *(u32x2*)(YT + o) = w; } }
    }
    __syncthreads();
}

__device__ __forceinline__ void hy_norm_item(Frame& F, int item, int l, unsigned char* wsl) {
    const bf16_t* YT = (const bf16_t*)(wsl + WS_YT); bf16_t* Y = (bf16_t*)(wsl + WS_Y); const LAS float* hg = (const LAS float*)(F.lds + MIXC_HG);
    const int pt = item % 33, b = item / 33, p0 = pt * 64, tid = opaque_v(F.tid);
    LAS bf16_t* tl = (LAS bf16_t*)F.lds;
    LAS float* part = (LAS float*)(F.lds + 512 * 72 * 2);
    LAS float* rsv = part + 512;
    __syncthreads();
#pragma unroll
    for (int it = 0; it < 8; ++it) { const int c = (tid >> 3) + 64 * it, pc = tid & 7;
        *(LAS u32x4*)(tl + c * 72 + pc * 8) = *(const u32x4*)(YT + ((size_t)c * NB + b) * ZL + p0 + pc * 8); }
    __syncthreads();
    { const int pos = tid & 63, cg = tid >> 6; float sacc = 0.f;
      for (int c = cg * 64; c < cg * 64 + 64; ++c) { const float v = bf2f(tl[c * 72 + pos]); sacc += v * v; }
      part[cg * 64 + pos] = sacc; }
    __syncthreads();
    if (tid < 64) { float sacc = 0.f;
#pragma unroll
        for (int g = 0; g < 8; ++g) sacc += part[g * 64 + tid];
        rsv[tid] = rsqrtf(sacc * (1.0f / 512.0f) + 1e-6f); }
    __syncthreads();
    { const int pos = tid >> 3, pc = tid & 7, p = p0 + pos;
      if (p < L) { const float rs = rsv[pos]; bf16_t* yrow = Y + ((size_t)b * L + p) * D + 1536;
#pragma unroll
          for (int it = 0; it < 8; ++it) { const int c = it * 64 + pc * 8; float v[8];
#pragma unroll
              for (int j = 0; j < 8; ++j) v[j] = bf2f(tl[(c + j) * 72 + pos]) * rs * hg[c + j];
              u32x4 w; w.x = pk2(v[0], v[1]); w.y = pk2(v[2], v[3]); w.z = pk2(v[4], v[5]); w.w = pk2(v[6], v[7]);
              *(u32x4*)(yrow + c) = w; } } }
}


constexpr int GS = 72;
constexpr int G_OP0 = 0, G_OP1 = 9216, G_VT = 18432, G_DEC = 36864, G_PART = 37376, G_W = 38400, G_ST = 49152;
typedef float f32x16 __attribute__((ext_vector_type(16)));
typedef short s16x4 __attribute__((ext_vector_type(4)));
__device__ __forceinline__ float logsigmoid_fast(float x) { return fminf(x, 0.f) - __logf(1.0f + __expf(-fabsf(x))); }
template <int N> __device__ __forceinline__ float row_shr_add(float v) { const int t = __builtin_amdgcn_update_dpp(0, __builtin_bit_cast(int, v), 0x110 + N, 0xf, 0xf, true); return v + __builtin_bit_cast(float, t); }
__device__ __forceinline__ float wave_incl_scan(float v, int lane) {
    v = row_shr_add<1>(v); v = row_shr_add<2>(v); v = row_shr_add<4>(v); v = row_shr_add<8>(v);
    { const int t = __builtin_amdgcn_update_dpp(0, __builtin_bit_cast(int, v), 0x142, 0xa, 0xf, false); v += __builtin_bit_cast(float, t); }
    { const int t = __builtin_amdgcn_update_dpp(0, __builtin_bit_cast(int, v), 0x143, 0xc, 0xf, false); v += __builtin_bit_cast(float, t); }
    return v;
}
__device__ __forceinline__ float lane_bcast63(float v) { return __builtin_bit_cast(float, __builtin_amdgcn_readlane(__builtin_bit_cast(int, v), 63)); }
__device__ __forceinline__ int crow16(int i, int hh) { return (i & 3) + 8 * (i >> 2) + 4 * hh; }
#define MFMA32(a, b, c) __builtin_amdgcn_mfma_f32_32x32x16_bf16((a), (b), (c), 0, 0, 0)
__device__ __forceinline__ void gla_passA_item(Frame& F, int item, int l, unsigned char* wsl) {
    const int n = item % GNC, bh = item / GNC, b = bh >> 2, h = bh & 3, tid = opaque_v(F.tid), w = F.wave, lane = tid & 63;
    LAS float* gw = (LAS float*)(F.lds + G_W);
    const bf16_t* U = (const bf16_t*)(wsl + WS_U);
    const int d0 = 8 * w, p = 64 * n - 48 + lane; const bool valid = p >= 0;
    const bf16_t* urow = U + ((size_t)b * L + (valid ? p : 0)) * INC;
    const u32x4 g0 = *(const u32x4*)(urow + O_GF), g1 = *(const u32x4*)(urow + O_GF + 8), g2 = *(const u32x4*)(urow + O_GB), g3 = *(const u32x4*)(urow + O_GB + 8);
    const u32x4 qraw = *(const u32x4*)(urow + O_AQ + h * 64 + d0), kraw = *(const u32x4*)(urow + O_AK + h * 64 + d0);
    const u32x4 v0 = *(const u32x4*)(urow + O_AV + h * 128 + 16 * w), v1 = *(const u32x4*)(urow + O_AV + h * 128 + 16 * w + 8);
    __syncthreads();
    for (int e = tid; e < 2176; e += 512) { float v;
        if (e < 2048) { const int dirw = e >> 10, rr = (e >> 6) & 15, d = e & 63; v = (dirw ? kin(8) : kin(6))[(size_t)l * 16 * 256 + rr * 256 + h * 64 + d]; }
        else { const int dirw = (e - 2048) >> 6, d = e & 63; v = (dirw ? kin(9) : kin(7))[l * 256 + h * 64 + d]; }
        gw[e] = v; }
    __syncthreads();
    float glf[16], glb[16];
    {
#pragma unroll
      for (int r = 0; r < 4; ++r) { glf[2 * r] = __builtin_bit_cast(float, g0[r] << 16); glf[2 * r + 1] = __builtin_bit_cast(float, g0[r] & 0xffff0000u); glf[8 + 2 * r] = __builtin_bit_cast(float, g1[r] << 16); glf[9 + 2 * r] = __builtin_bit_cast(float, g1[r] & 0xffff0000u);
          glb[2 * r] = __builtin_bit_cast(float, g2[r] << 16); glb[2 * r + 1] = __builtin_bit_cast(float, g2[r] & 0xffff0000u); glb[8 + 2 * r] = __builtin_bit_cast(float, g3[r] << 16); glb[9 + 2 * r] = __builtin_bit_cast(float, g3[r] & 0xffff0000u); } }
    float cF[8], cB[8], tF[8], tB[8];
#pragma unroll
    for (int dirw = 0; dirw < 2; ++dirw) {
        float x[8];
        { const f32x4 b0 = *(const LAS f32x4*)(gw + 2048 + dirw * 64 + d0), b1 = *(const LAS f32x4*)(gw + 2048 + dirw * 64 + d0 + 4);
#pragma unroll
          for (int j = 0; j < 4; ++j) { x[j] = b0[j]; x[4 + j] = b1[j]; } }
#pragma unroll
        for (int r = 0; r < 16; ++r) {
            const f32x4 a0 = *(const LAS f32x4*)(gw + dirw * 1024 + r * 64 + d0), a1 = *(const LAS f32x4*)(gw + dirw * 1024 + r * 64 + d0 + 4);
            const float g = dirw ? glb[r] : glf[r];
#pragma unroll
            for (int j = 0; j < 4; ++j) { x[j] += g * a0[j]; x[4 + j] += g * a1[j]; }
            if ((r & 3) == 3) asm volatile("" : "+v"(x[0]), "+v"(x[1]), "+v"(x[2]), "+v"(x[3]), "+v"(x[4]), "+v"(x[5]), "+v"(x[6]), "+v"(x[7]));
        }
#pragma unroll
        for (int dd = 0; dd < 8; ++dd) {
            const float lg = valid ? logsigmoid_fast(x[dd]) * (1.0f / 16.0f) : 0.f;
            const float ps = wave_incl_scan(lg, lane), tot = lane_bcast63(ps);
            if (dirw == 0) { cF[dd] = ps; tF[dd] = tot; } else { cB[dd] = tot - ps + lg; tB[dd] = tot; }

        }
    }
    LAS bf16_t* op0 = (LAS bf16_t*)(F.lds + G_OP0); LAS bf16_t* op1 = (LAS bf16_t*)(F.lds + G_OP1); LAS float* dec = (LAS float*)(F.lds + G_DEC);
    unsigned pq0[4], pq1[4], pq2[4], pq3[4];
#pragma unroll
    for (int dd = 0; dd < 8; ++dd) {
        const float qv = valid ? ((dd & 1) ? __builtin_bit_cast(float, qraw[dd >> 1] & 0xffff0000u) : __builtin_bit_cast(float, qraw[dd >> 1] << 16)) : 0.f;
        const float kv = valid ? ((dd & 1) ? __builtin_bit_cast(float, kraw[dd >> 1] & 0xffff0000u) : __builtin_bit_cast(float, kraw[dd >> 1] << 16)) : 0.f;
        op0[(d0 + dd) * GS + lane] = (bf16_t)f2bf(kv * __expf(tF[dd] - cF[dd]));
        op1[(d0 + dd) * GS + lane] = (bf16_t)f2bf(kv * __expf(tB[dd] - cB[dd]));
        if (lane == 0) { dec[d0 + dd] = __expf(tF[dd]); dec[64 + d0 + dd] = __expf(tB[dd]); }
        const unsigned a0 = f2bf(qv * 0.125f * __expf(cF[dd])), a1 = f2bf(kv * __expf(-cF[dd])), a2 = f2bf(qv * 0.125f * __expf(cB[dd])), a3 = f2bf(kv * __expf(-cB[dd]));
        if (dd & 1) { pq0[dd >> 1] |= a0 << 16; pq1[dd >> 1] |= a1 << 16; pq2[dd >> 1] |= a2 << 16; pq3[dd >> 1] |= a3 << 16; }
        else { pq0[dd >> 1] = a0; pq1[dd >> 1] = a1; pq2[dd >> 1] = a2; pq3[dd >> 1] = a3; }
    }
    { LAS bf16_t* st = (LAS bf16_t*)(F.lds + G_ST) + lane * GS + d0;
      *(LAS u32x4*)(st) = (u32x4){pq0[0], pq0[1], pq0[2], pq0[3]}; *(LAS u32x4*)(st + 64 * GS) = (u32x4){pq1[0], pq1[1], pq1[2], pq1[3]};
      *(LAS u32x4*)(st + 128 * GS) = (u32x4){pq2[0], pq2[1], pq2[2], pq2[3]}; *(LAS u32x4*)(st + 192 * GS) = (u32x4){pq3[0], pq3[1], pq3[2], pq3[3]}; }
    LAS bf16_t* vt = (LAS bf16_t*)(F.lds + G_VT);
    {
#pragma unroll
      for (int j = 0; j < 4; ++j) { const int dv = 16 * w + 2 * j;
          vt[dv * GS + lane] = valid ? (bf16_t)(v0[j] & 0xffffu) : (bf16_t)0; vt[(dv + 1) * GS + lane] = valid ? (bf16_t)(v0[j] >> 16) : (bf16_t)0;
          vt[(dv + 8) * GS + lane] = valid ? (bf16_t)(v1[j] & 0xffffu) : (bf16_t)0; vt[(dv + 9) * GS + lane] = valid ? (bf16_t)(v1[j] >> 16) : (bf16_t)0; } }
    __syncthreads();
    { bf16_t* gvt = (bf16_t*)(wsl + WS_GVT) + (size_t)item * 8192;
#pragma unroll
      for (int it = 0; it < 2; ++it) { const int e = it * 512 + tid, dv = e >> 3, pc = e & 7; *(u32x4*)(gvt + dv * 64 + pc * 8) = *(const LAS u32x4*)(vt + dv * GS + pc * 8); } }
    { bf16_t* gqk = (bf16_t*)(wsl + WS_GQK) + (size_t)item * 4 * 4096; const LAS bf16_t* st = (const LAS bf16_t*)(F.lds + G_ST);
#pragma unroll
      for (int it = 0; it < 4; ++it) { const int pos = tid >> 3, pc = tid & 7; *(u32x4*)(gqk + it * 4096 + pos * 64 + pc * 8) = *(const LAS u32x4*)(st + (it * 64 + pos) * GS + pc * 8); } }
    const int dir = w >> 2, dvb = w & 3, r = lane & 31, hh = lane >> 5;
    const LAS bf16_t* KL = (const LAS bf16_t*)(F.lds + (dir ? G_OP1 : G_OP0));
    f32x16 acc0, acc1;
#pragma unroll
    for (int i = 0; i < 16; ++i) { acc0[i] = 0.f; acc1[i] = 0.f; }
#pragma unroll
    for (int ks = 0; ks < 4; ++ks) {
        const bf16x8 a = *(const LAS bf16x8*)(vt + (32 * dvb + r) * GS + 16 * ks + 8 * hh);
        const bf16x8 b0 = *(const LAS bf16x8*)(KL + r * GS + 16 * ks + 8 * hh);
        const bf16x8 b1 = *(const LAS bf16x8*)(KL + (32 + r) * GS + 16 * ks + 8 * hh);
        acc0 = MFMA32(a, b0, acc0); acc1 = MFMA32(a, b1, acc1);
    }
    const int chain = (bh << 1) | dir;
    bf16_t* kvt = (bf16_t*)(wsl + WS_KVT) + ((size_t)chain * GNC + n) * 128 * 64;
#pragma unroll
    for (int i = 0; i < 16; ++i) { const int dv = 32 * dvb + crow16(i, hh); kvt[dv * 64 + r] = (bf16_t)f2bf(acc0[i]); kvt[dv * 64 + 32 + r] = (bf16_t)f2bf(acc1[i]); }
    if (tid < 128) { const int d = tid & 63, dd = tid >> 6; ((float*)(wsl + WS_DEC))[((size_t)((bh << 1) | dd) * GNC + n) * 64 + d] = ((const LAS float*)(F.lds + G_DEC))[dd * 64 + d]; }
}
__device__ __forceinline__ void gla_passB(Frame& F, unsigned char* wsl) {
    const bf16_t* KVT = (const bf16_t*)(wsl + WS_KVT); const float* DEC = (const float*)(wsl + WS_DEC); bf16_t* SPT = (bf16_t*)(wsl + WS_SPT);
    const int t0 = blockIdx.x * 512 + F.tid, tstride = F.G * 512;
    for (int t = t0; t < 64 * 4096; t += 2 * tstride) {
        const int tb = t + tstride; const bool hasb = tb < 64 * 4096; const int t2 = hasb ? tb : t;
        const int chA = t >> 12, remA = t & 4095, dvA = remA >> 5, dkA = (remA & 31) * 2, dirA = chA & 1;
        const int chB = t2 >> 12, remB = t2 & 4095, dvB = remB >> 5, dkB = (remB & 31) * 2, dirB = chB & 1;
        float a0 = 0.f, a1 = 0.f, b0 = 0.f, b1 = 0.f;
#pragma unroll 11
        for (int st = 0; st < GNC; ++st) { const int nA = dirA ? GNC - 1 - st : st, nB = dirB ? GNC - 1 - st : st;
            const size_t oA = (((size_t)chA * GNC + nA) * 128 + dvA) * 64 + dkA, oB = (((size_t)chB * GNC + nB) * 128 + dvB) * 64 + dkB;
            *(unsigned*)(SPT + oA) = pk2(a0, a1); if (hasb) *(unsigned*)(SPT + oB) = pk2(b0, b1);
            const unsigned kva_ = *(const unsigned*)(KVT + oA); const f32x2 kvA = (f32x2){__builtin_bit_cast(float, kva_ << 16), __builtin_bit_cast(float, kva_ & 0xffff0000u)}, dcA = *(const f32x2*)(DEC + ((size_t)chA * GNC + nA) * 64 + dkA);
            const unsigned kvb_ = *(const unsigned*)(KVT + oB); const f32x2 kvB = (f32x2){__builtin_bit_cast(float, kvb_ << 16), __builtin_bit_cast(float, kvb_ & 0xffff0000u)}, dcB = *(const f32x2*)(DEC + ((size_t)chB * GNC + nB) * 64 + dkB);
            a0 = dcA[0] * a0 + kvA[0]; a1 = dcA[1] * a1 + kvA[1]; b0 = dcB[0] * b0 + kvB[0]; b1 = dcB[1] * b1 + kvB[1]; }
    }
}
__device__ __forceinline__ void gla_passC_item(Frame& F, int item, int l, unsigned char* wsl) {
    constexpr int C_QD = 0, C_KI = 18432, C_SP = 36864, C_VT = 73728, C_PART = 92160, C_OS = 0, RB = GS * 2, OSS = 132;
    const int n = item % GNC, bh = item / GNC, b = bh >> 2, h = bh & 3;
    const int w = F.wave, tid = opaque_v(F.tid), lane = tid & 63, cb = w >> 2, dvb = w & 3, r = lane & 31, hh = lane >> 5;
    const bf16_t* gqk = (const bf16_t*)(wsl + WS_GQK) + (size_t)item * 4 * 4096;
    const bf16_t* gvt = (const bf16_t*)(wsl + WS_GVT) + (size_t)item * 8192;
    const bf16_t* spt0 = (const bf16_t*)(wsl + WS_SPT) + ((size_t)((bh << 1) | 0) * GNC + n) * 128 * 64;
    const bf16_t* spt1 = (const bf16_t*)(wsl + WS_SPT) + ((size_t)((bh << 1) | 1) * GNC + n) * 128 * 64;
    const bf16_t* U = (const bf16_t*)(wsl + WS_U); bf16_t* Y = (bf16_t*)(wsl + WS_Y);
    u32x4 raw[10], rgr[2];
#pragma unroll
    for (int it = 0; it < 4; ++it) raw[it] = *(const u32x4*)(gqk + it * 4096 + tid * 8);
    raw[4] = *(const u32x4*)(spt0 + tid * 8); raw[5] = *(const u32x4*)(spt0 + 4096 + tid * 8); raw[6] = *(const u32x4*)(spt1 + tid * 8); raw[7] = *(const u32x4*)(spt1 + 4096 + tid * 8);
    raw[8] = *(const u32x4*)(gvt + tid * 8); raw[9] = *(const u32x4*)(gvt + 4096 + tid * 8);
#pragma unroll
    for (int it = 0; it < 2; ++it) { const int e = it * 512 + tid, pos = e >> 4, p = 64 * n - 48 + pos;
        rgr[it] = *(const u32x4*)(U + ((size_t)b * L + max(p, 0)) * INC + O_AR + h * 128 + 8 * (e & 15)); }
    const float gv = (kin(10) + l * 512 + h * 128 + 32 * dvb)[r];
    { const int row = tid >> 3, pc = tid & 7; LAS unsigned char* dst = F.lds + row * RB + pc * 16;
      *(LAS u32x4*)(dst + C_QD) = raw[0]; *(LAS u32x4*)(dst + C_KI) = raw[1]; *(LAS u32x4*)(dst + C_QD + 64 * RB) = raw[2]; *(LAS u32x4*)(dst + C_KI + 64 * RB) = raw[3];
      *(LAS u32x4*)(dst + C_SP) = raw[4]; *(LAS u32x4*)(dst + C_SP + 64 * RB) = raw[5]; *(LAS u32x4*)(dst + C_SP + 128 * RB) = raw[6]; *(LAS u32x4*)(dst + C_SP + 192 * RB) = raw[7];
      *(LAS u32x4*)(dst + C_VT) = raw[8]; *(LAS u32x4*)(dst + C_VT + 64 * RB) = raw[9]; }
    __syncthreads();
    f32x16 o;
#pragma unroll
    for (int i = 0; i < 16; ++i) o[i] = 0.f;
    const LAS unsigned char* fb = F.lds + r * RB + 16 * hh;
    const LAS unsigned char* vb = F.lds + C_VT + (32 * dvb + r) * RB + 8 * hh;
#pragma unroll
    for (int dir = 0; dir < 2; ++dir) {
        bf16x8 qf[4];
#pragma unroll
        for (int ks = 0; ks < 4; ++ks) qf[ks] = *(const LAS bf16x8*)(fb + C_QD + (dir * 64 + 32 * cb) * RB + 32 * ks);
#pragma unroll
        for (int sb = 0; sb < 2; ++sb) {
            f32x16 X;
#pragma unroll
            for (int i = 0; i < 16; ++i) X[i] = 0.f;
#pragma unroll
            for (int ks = 0; ks < 4; ++ks) X = MFMA32(*(const LAS bf16x8*)(fb + C_KI + (dir * 64 + 32 * sb) * RB + 32 * ks), qf[ks], X);
            const int cidx = 32 * cb + r;
#pragma unroll
            for (int i = 0; i < 16; ++i) { const int sidx = 32 * sb + crow16(i, hh); const bool keep = dir ? (sidx > cidx) : (sidx <= cidx); X[i] = keep ? X[i] : 0.f; }
#pragma unroll
            for (int ks2 = 0; ks2 < 2; ++ks2) {
                u32x4 xp; xp.x = pk2(X[8 * ks2 + 0], X[8 * ks2 + 1]); xp.y = pk2(X[8 * ks2 + 2], X[8 * ks2 + 3]); xp.z = pk2(X[8 * ks2 + 4], X[8 * ks2 + 5]); xp.w = pk2(X[8 * ks2 + 6], X[8 * ks2 + 7]);
                const s16x4 vlo = *(const LAS s16x4*)(vb + (32 * sb + 16 * ks2) * 2), vhi = *(const LAS s16x4*)(vb + (32 * sb + 16 * ks2 + 8) * 2);
                o = MFMA32(__builtin_bit_cast(bf16x8, xp), __builtin_shufflevector(vlo, vhi, 0, 1, 2, 3, 4, 5, 6, 7), o);
            }
        }
#pragma unroll
        for (int ks = 0; ks < 4; ++ks) o = MFMA32(qf[ks], *(const LAS bf16x8*)(fb + C_SP + (dir * 128 + 32 * dvb) * RB + 32 * ks), o);
    }
    LAS float* part = (LAS float*)(F.lds + C_PART);
#pragma unroll
    for (int i = 0; i < 16; ++i) { float q = o[i] * o[i];
        q = row_shr_add<1>(q); q = row_shr_add<2>(q); q = row_shr_add<4>(q); q = row_shr_add<8>(q);
        const int qi = __builtin_bit_cast(int, q);
        const float s0 = __builtin_bit_cast(float, __builtin_amdgcn_readlane(qi, 15)) + __builtin_bit_cast(float, __builtin_amdgcn_readlane(qi, 31));
        const float s1 = __builtin_bit_cast(float, __builtin_amdgcn_readlane(qi, 47)) + __builtin_bit_cast(float, __builtin_amdgcn_readlane(qi, 63));
        if (r == 0) part[(cb * 4 + dvb) * 32 + crow16(i, hh)] = hh ? s1 : s0; }
    __syncthreads();
    LAS float* os = (LAS float*)(F.lds + C_OS);
#pragma unroll
    for (int i = 0; i < 16; ++i) { const int rw = crow16(i, hh);
        const float ss = (part[(cb * 4 + 0) * 32 + rw] + part[(cb * 4 + 1) * 32 + rw]) + (part[(cb * 4 + 2) * 32 + rw] + part[(cb * 4 + 3) * 32 + rw]);
        const float rs = rsqrtf(ss * (1.0f / 128.0f) + 1e-6f);
        os[(32 * cb + rw) * OSS + 32 * dvb + r] = o[i] * rs * gv; }
    __syncthreads();
#pragma unroll
    for (int it = 0; it < 2; ++it) { const int e = it * 512 + tid, pos = e >> 4, dv0 = 8 * (e & 15), p = 64 * n - 48 + pos;
        if (p >= 0) { const f32x4 a0 = *(const LAS f32x4*)(os + pos * OSS + dv0), a1 = *(const LAS f32x4*)(os + pos * OSS + dv0 + 4); const u32x4 g = rgr[it]; float y[8];
#pragma unroll
            for (int j = 0; j < 4; ++j) { const float g0 = __builtin_bit_cast(float, g[j] << 16), g1 = __builtin_bit_cast(float, g[j] & 0xffff0000u);
                const float x0 = j < 2 ? a0[2 * j] : a1[2 * j - 4], x1 = j < 2 ? a0[2 * j + 1] : a1[2 * j - 3];
                y[2 * j] = x0 * (g0 / (1.0f + __expf(-g0))); y[2 * j + 1] = x1 * (g1 / (1.0f + __expf(-g1))); }
            u32x4 wv; wv.x = pk2(y[0], y[1]); wv.y = pk2(y[2], y[3]); wv.z = pk2(y[4], y[5]); wv.w = pk2(y[6], y[7]);
            *(u32x4*)(Y + ((size_t)b * L + p) * D + h * 128 + dv0) = wv; } }
}

constexpr int SW_KS = 136, SW_VS = 40;
constexpr int SW_K = 0, SW_V = 2 * 2 * 32 * SW_KS * 2;
constexpr int SW_PART = SW_V + 2 * 2 * 128 * SW_VS * 2;
constexpr int SW_OS = 1032;
__device__ __forceinline__ void swa_item(Frame& F, int item, int l, unsigned char* wsl) {
    const bf16_t* U = (const bf16_t*)(wsl + WS_U); bf16_t* Y = (bf16_t*)(wsl + WS_Y);
    const int qb = item % 65, b = item / 65, q0 = 32 * qb, tid = opaque_v(F.tid), lane = tid & 63, w = F.wave, r = lane & 31, hh = lane >> 5;
    const int head = w, kvh = w >> 2, qp = q0 + r;
    const float slope = exp2f(-(float)(head + 1));
    const float sk = (kin(11) + l * 8)[head];
    bf16x8 Qf[8];
    { const bf16_t* qrow = U + ((size_t)b * L + min(qp, L - 1)) * INC + O_BQ + head * 128;
#pragma unroll
      for (int ks = 0; ks < 8; ++ks) Qf[ks] = *(const bf16x8*)(qrow + 16 * ks + 8 * hh); }
    f32x16 O[4];
#pragma unroll
    for (int db = 0; db < 4; ++db)
#pragma unroll
        for (int i = 0; i < 16; ++i) O[db][i] = 0.f;
    const float sc2 = 0.08838834764831845f * 1.4426950408889634f, slope2 = slope * 1.4426950408889634f;
    float m = sk * 1.4426950408889634f, lsum = hh == 0 ? 1.0f : 0.0f;
    const int tlo = max(1, qb - 4), thi = min(64, qb + 4), ntile = 1 + (thi - tlo + 1), nch = (ntile + 1) >> 1;
    LAS bf16_t* Ks = (LAS bf16_t*)(F.lds + SW_K); LAS bf16_t* Vs = (LAS bf16_t*)(F.lds + SW_V);
    u32x4 kx[2][4], vx[2][4];
#define SWA_FETCH(chn, par_) do { _Pragma("unroll") for (int it = 0; it < 4; ++it) { const int e = it * 512 + tid; const int key = e & 31, d8 = (e >> 5) & 15, kv2 = (e >> 9) & 1, sl_ = e >> 10; \
            const int ti_ = (chn) * 2 + sl_; const int tl_ = ti_ == 0 ? 0 : tlo + ti_ - 1; const int kp_ = min(32 * tl_ + key, L - 1); const bf16_t* krow = U + ((size_t)b * L + kp_) * INC; \
            const int kkey_ = (e >> 4) & 31, kd8_ = e & 15; const bf16_t* krow2 = U + ((size_t)b * L + min(32 * tl_ + kkey_, L - 1)) * INC;        \
            kx[par_][it] = *(const u32x4*)(krow2 + O_BK + kv2 * 128 + 8 * kd8_); vx[par_][it] = *(const u32x4*)(krow + O_BV + kv2 * 128 + 8 * d8); } } while (0)
    SWA_FETCH(0, 0);
    if (nch > 1) SWA_FETCH(1, 1);
    for (int c2 = 0; c2 < nch; c2 += 2) {
#pragma unroll
      for (int par = 0; par < 2; ++par) {
        const int ch = c2 + par; if (ch >= nch) break;
        __syncthreads();
#pragma unroll
        for (int it = 0; it < 4; ++it) { const int e = it * 512 + tid; const int key = e & 31, d8 = (e >> 5) & 15, kv2 = (e >> 9) & 1, sl = e >> 10;
            *(LAS u32x4*)(Ks + ((sl * 2 + kv2) * 32 + ((e >> 4) & 31)) * SW_KS + 8 * (e & 15)) = kx[par][it];
            LAS bf16_t* vb = Vs + ((sl * 2 + kv2) * 128 + 8 * d8) * SW_VS + key;
#pragma unroll
            for (int j = 0; j < 4; ++j) { vb[(2 * j) * SW_VS] = (bf16_t)(vx[par][it][j] & 0xffffu); vb[(2 * j + 1) * SW_VS] = (bf16_t)(vx[par][it][j] >> 16); } }
        if (ch + 2 < nch) SWA_FETCH(ch + 2, par);
        __syncthreads();
#pragma unroll 1
        for (int sl = 0; sl < 2; ++sl) {
            const int ti = ch * 2 + sl; if (ti >= ntile) break;
            const int tl = ti == 0 ? 0 : tlo + ti - 1, kp0 = 32 * tl;
            f32x16 S;
#pragma unroll
            for (int i = 0; i < 16; ++i) S[i] = 0.f;
            const LAS bf16_t* kt = Ks + ((sl * 2 + kvh) * 32 + r) * SW_KS + 8 * hh;
#pragma unroll
            for (int ks = 0; ks < 8; ++ks) { const bf16x8 a = *(const LAS bf16x8*)(kt + 16 * ks); S = MFMA32(a, Qf[ks], S); }
            float mx = -1e30f;
            const float fb = (float)(qp - kp0 - 4 * hh);
            if (tl != 0 && abs(qb - tl) <= 3 && tl < 64) {
#pragma unroll
                for (int i = 0; i < 16; ++i) { const float dist = fabsf(fb - (float)((i & 3) + 8 * (i >> 2))); const float sv = S[i] * sc2 - slope2 * dist; S[i] = sv; mx = fmaxf(mx, sv); }
            } else {
#pragma unroll
                for (int i = 0; i < 16; ++i) { const int kp = kp0 + crow16(i, hh); const float dist = fabsf(fb - (float)((i & 3) + 8 * (i >> 2)));
                    const bool ok = (tl == 0) ? (kp < NMETA || dist <= 128.f) : (kp < L && dist <= 128.f);
                    const float sv = ok ? S[i] * sc2 - slope2 * dist : -1e30f; S[i] = sv; mx = fmaxf(mx, sv); }
            }
            mx = fmaxf(mx, xor32(mx));
            float mn = m, alpha = 1.0f;
            if (__builtin_amdgcn_ballot_w64(mx - m > 8.0f) != 0ull) { mn = fmaxf(m, mx); alpha = __builtin_amdgcn_exp2f(m - mn); m = mn; }
            float ps = 0.f;
#pragma unroll
            for (int i = 0; i < 16; ++i) { const float pv = __builtin_amdgcn_exp2f(S[i] - mn); S[i] = pv; ps += pv; }
            lsum = lsum * alpha + ps;
            if (__builtin_amdgcn_ballot_w64(alpha != 1.0f) != 0ull) {
#pragma unroll
                for (int db = 0; db < 4; ++db)
#pragma unroll
                    for (int i = 0; i < 16; ++i) O[db][i] *= alpha; }
            const LAS bf16_t* vt = Vs + ((sl * 2 + kvh) * 128 + r) * SW_VS + 4 * hh;
#pragma unroll
            for (int ks2 = 0; ks2 < 2; ++ks2) {
                u32x4 xp; xp.x = pk2(S[8 * ks2 + 0], S[8 * ks2 + 1]); xp.y = pk2(S[8 * ks2 + 2], S[8 * ks2 + 3]); xp.z = pk2(S[8 * ks2 + 4], S[8 * ks2 + 5]); xp.w = pk2(S[8 * ks2 + 6], S[8 * ks2 + 7]);
                const bf16x8 pb = __builtin_bit_cast(bf16x8, xp);
#pragma unroll
                for (int db = 0; db < 4; ++db) {
                    const s16x4 lo = *(const LAS s16x4*)(vt + (32 * db) * SW_VS + 16 * ks2), hi = *(const LAS s16x4*)(vt + (32 * db) * SW_VS + 16 * ks2 + 8);
                    O[db] = MFMA32(__builtin_shufflevector(lo, hi, 0, 1, 2, 3, 4, 5, 6, 7), pb, O[db]); }
            }
        }
      }
    }
#undef SWA_FETCH
    const float lt = lsum + xor32(lsum), inv = 1.0f / lt;
    float ss = 0.f;
#pragma unroll
    for (int db = 0; db < 4; ++db)
#pragma unroll
        for (int i = 0; i < 16; ++i) { O[db][i] *= inv; ss += O[db][i] * O[db][i]; }
    ss += xor32(ss);
    __syncthreads();
    LAS float* part = (LAS float*)(F.lds + SW_PART); LAS bf16_t* os = (LAS bf16_t*)F.lds;
    if (hh == 0) part[w * 32 + r] = ss;
#pragma unroll
    for (int db = 0; db < 4; ++db)
#pragma unroll
        for (int g = 0; g < 4; ++g) { u32x2 pk; pk.x = pk2(O[db][4 * g], O[db][4 * g + 1]); pk.y = pk2(O[db][4 * g + 2], O[db][4 * g + 3]);
            *(LAS u32x2*)(os + r * SW_OS + w * 128 + 32 * db + 8 * g + 4 * hh) = pk; }
    __syncthreads();
    { const int q = tid >> 4, pc = tid & 15, p = q0 + q;
      if (p < L) { float tot = 0.f;
#pragma unroll
          for (int ww = 0; ww < 8; ++ww) tot += part[ww * 32 + q];
          const float rs = rsqrtf(tot * (1.0f / 1024.0f) + 1e-6f); const LAS float* sg = (const LAS float*)(F.lds + MIXC_SG); bf16_t* yrow = Y + ((size_t)b * L + p) * D + 512;
#pragma unroll
          for (int k = 0; k < 8; ++k) { const int c = 8 * pc + 128 * k; const u32x4 v = *(const LAS u32x4*)(os + q * SW_OS + c);
              const f32x4 g0 = *(const LAS f32x4*)(sg + c), g1 = *(const LAS f32x4*)(sg + c + 4); u32x4 o;
              o.x = pk2(__builtin_bit_cast(float, v.x << 16) * rs * g0[0], __builtin_bit_cast(float, v.x & 0xffff0000u) * rs * g0[1]);
              o.y = pk2(__builtin_bit_cast(float, v.y << 16) * rs * g0[2], __builtin_bit_cast(float, v.y & 0xffff0000u) * rs * g0[3]);
              o.z = pk2(__builtin_bit_cast(float, v.z << 16) * rs * g1[0], __builtin_bit_cast(float, v.z & 0xffff0000u) * rs * g1[1]);
              o.w = pk2(__builtin_bit_cast(float, v.w << 16) * rs * g1[2], __builtin_bit_cast(float, v.w & 0xffff0000u) * rs * g1[3]);
              *(u32x4*)(yrow + c) = o; } } }
}

__device__ __forceinline__ float logsigmoidf_(float x) { return fminf(x, 0.f) - log1pf(expf(-fabsf(x))); }

__device__ __forceinline__ int q_publish(Frame& F, int fetched) {
    LAS int* slot = (LAS int*)(F.lds + LDSCTL_OFF + 512);
    __syncthreads();
    if (F.tid == 0) *slot = fetched;
    __syncthreads();
    return *slot;
}
__device__ __forceinline__ void p_mix1(Frame& F, int l) {
    unsigned char* const wsl = launder_ws(F.ws);
    unsigned* const qw = (unsigned*)(wsl + WS_CTL) + CW_Q + (l * 4 + 0) * 64;
    constexpr int N_SWA = NB * 65, N_GLA = NB * 4 * GNC, N_HP = NB * 33 * 4, N_ALL = N_SWA + N_GLA + N_HP;
    int fetched = 0;
    if (F.tid == 0) fetched = (int)atomicAdd(qw, 1u);
    { const float* sgg = kin(12) + l * 1024; const float* cwg = kin(13) + (size_t)l * 3 * 1536; const float* cbg = kin(14) + l * 1536;
      if (F.tid < 256) *(LAS f32x4*)(F.lds + MIXC_SG + 16 * F.tid) = ((const f32x4*)sgg)[F.tid];
      for (int e = F.tid; e < 1152; e += 512) *(LAS f32x4*)(F.lds + MIXC_CW + 16 * e) = ((const f32x4*)cwg)[e];
      if (F.tid < 384) *(LAS f32x4*)(F.lds + MIXC_CB + 16 * F.tid) = ((const f32x4*)cbg)[F.tid]; }
    int u = q_publish(F, fetched);
    while (u < N_ALL) {
        if (F.tid == 0) fetched = (int)atomicAdd(qw, 1u);
        if (u < N_SWA) swa_item(F, u, l, wsl);
        else if (u < N_SWA + N_GLA) gla_passA_item(F, u - N_SWA, l, wsl);
        else hy_pre_item(F, u - N_SWA - N_GLA, l, wsl);
        u = q_publish(F, fetched);
    }
    __syncthreads();
}

__device__ __forceinline__ void p_mix2(Frame& F, int l) {
    unsigned char* const wsl = launder_ws(F.ws);
    gla_passB(F, wsl);
    hy_conv_phase(F, l, wsl);
}

__device__ __forceinline__ void p_mix3(Frame& F, int l) {
    unsigned char* const wsl = launder_ws(F.ws);
    unsigned* const qw = (unsigned*)(wsl + WS_CTL) + CW_Q + (l * 4 + 2) * 64;
    constexpr int N_GC = NB * 4 * GNC, N_HN = NB * 33, N_ALL = N_GC + N_HN;
    int fetched = 0;
    if (F.tid == 0) fetched = (int)atomicAdd(qw, 1u);
    if (F.tid < 128) *(LAS f32x4*)(F.lds + MIXC_HG + 16 * F.tid) = ((const f32x4*)(kin(22) + l * 512))[F.tid];
    int u = q_publish(F, fetched);
    while (u < N_ALL) {
        if (F.tid == 0) fetched = (int)atomicAdd(qw, 1u);
        if (u < N_HN) hy_norm_item(F, u, l, wsl);
        else gla_passC_item(F, u - N_HN, l, wsl);
        u = q_publish(F, fetched);
    }
    __syncthreads();
}

constexpr int R_RS = 2056;
constexpr int R_AH = 0, R_AL = 8 * R_RS * 2, R_PART = 2 * 8 * R_RS * 2, R_LG = R_PART + 8 * 8 * 32 * 4, R_LCNT = R_LG + 1024, R_REC = R_LCNT + 128;
template <bool DUMMY>
__device__ __forceinline__ void p_ln1_router(Frame& F, int l) {
    unsigned char* const wsl = launder_ws(F.ws); unsigned* const ctl = (unsigned*)(wsl + WS_CTL);
    const bf16_t* MX = (const bf16_t*)(wsl + WS_R1); const bf16_t* hin = (const bf16_t*)(wsl + WS_HB); bf16_t* h = (bf16_t*)(wsl + (DUMMY ? WS_DUM : WS_HB)); unsigned char* hb = wsl + (DUMMY ? WS_DUM + (size_t)T * D * 4 : WS_HB8);
    int* cnt = (int*)(ctl + CW_CNT + l * 512 + (DUMMY ? 256 : 0)); int* list = (int*)(wsl + (DUMMY ? WS_DUM + (size_t)T * D * 6 : WS_LIST));
    int* tok_e = (int*)(wsl + (DUMMY ? WS_DUM + (size_t)T * D * 6 + (size_t)NEXP * T * 4 : WS_TOKE)); int* tok_p = tok_e + (DUMMY ? 2 * T : (WS_TOKP - WS_TOKE) / 4); float* tok_w = (float*)(tok_e + (DUMMY ? 4 * T : (WS_TOKW - WS_TOKE) / 4));
    const LAS float* g = (const LAS float*)(F.lds + 81920); const LAS float* bt = g + D;
    { const float* gg = kin(25) + (size_t)l * D; const float* gb = kin(26) + (size_t)l * D; *(LAS f32x4*)(F.lds + 81920 + 16 * F.tid) = ((const f32x4*)gg)[F.tid]; *(LAS f32x4*)(F.lds + 81920 + 8192 + 16 * F.tid) = ((const f32x4*)gb)[F.tid]; }
    const LAS float* be = (const LAS float*)(F.lds + 81920 + 16384); const LAS float* bg = be + 16;
    if (F.tid < 16) ((LAS float*)(F.lds + 81920 + 16384))[F.tid] = (kin(30) + l * 16)[F.tid]; else if (F.tid < 20) ((LAS float*)(F.lds + 81920 + 16384))[F.tid] = (kin(28) + l * 4)[F.tid - 16];
    const bf16_t* wr = (const bf16_t*)(wsl + WS_WR) + (size_t)l * 256 * 512;
    const int lane = opaque_v(F.lane), w = F.wave, n = lane & 15, kg = lane >> 4;
    LAS bf16_t* AH = (LAS bf16_t*)(F.lds + R_AH); LAS bf16_t* AL = (LAS bf16_t*)(F.lds + R_AL); LAS float* PART = (LAS float*)(F.lds + R_PART); LAS float* LG = (LAS float*)(F.lds + R_LG);
    constexpr int NGRP = T / 8;
    bf16x8 wfr[8][4];
#pragma unroll
    for (int si = 0; si < 8; ++si) { const bf16_t* wp = wr + ((size_t)(8 * w + si) * 4 * 64 + lane) * 8;
#pragma unroll
        for (int q = 0; q < 4; ++q) wfr[si][q] = *(const bf16x8*)(wp + 512 * q); }
    LAS int* lcnt = (LAS int*)(F.lds + R_LCNT); LAS int* rec = (LAS int*)(F.lds + R_REC);
    if (F.tid < 32) lcnt[F.tid] = 0;
    int nloc = 0;
    f32x4 v[8];
    u32x2 hxr[8], mxr[8];
    int gi = F.vcu;
    if (gi < NGRP) {
#pragma unroll
        for (int j = 0; j < 8; ++j) { hxr[j] = ((const u32x2*)(hin + (size_t)(8 * gi + w) * D))[lane + 64 * j]; mxr[j] = ((const u32x2*)(MX + (size_t)(8 * gi + w) * D))[lane + 64 * j]; } }
    __syncthreads();
    for (; gi < NGRP; gi += F.G) {
        const int row = 8 * gi + w;
#pragma unroll
        for (int j = 0; j < 8; ++j) { const u32x2 hx = hxr[j], mx = j < 4 ? mxr[j] : ((const u32x2*)(MX + (size_t)row * D))[lane + 64 * j];
            v[j] = (f32x4){__builtin_bit_cast(float, hx.x << 16), __builtin_bit_cast(float, hx.x & 0xffff0000u), __builtin_bit_cast(float, hx.y << 16), __builtin_bit_cast(float, hx.y & 0xffff0000u)} * ALPHA
                 + (f32x4){__builtin_bit_cast(float, mx.x << 16), __builtin_bit_cast(float, mx.x & 0xffff0000u), __builtin_bit_cast(float, mx.y << 16), __builtin_bit_cast(float, mx.y & 0xffff0000u)}; }
        ln_wave_store<true>(v, g, bt, h + (size_t)row * D, hb + (size_t)row * D, nullptr, lane);
#pragma unroll
        for (int j = 0; j < 8; ++j) { const unsigned h01 = pk2(v[j][0], v[j][1]), h23 = pk2(v[j][2], v[j][3]);
            const unsigned l01 = pk2(v[j][0] - __builtin_bit_cast(float, h01 << 16), v[j][1] - __builtin_bit_cast(float, h01 & 0xffff0000u)), l23 = pk2(v[j][2] - __builtin_bit_cast(float, h23 << 16), v[j][3] - __builtin_bit_cast(float, h23 & 0xffff0000u));
            *(LAS u32x2*)(AH + w * R_RS + (lane + 64 * j) * 4) = (u32x2){h01, h23};
            *(LAS u32x2*)(AL + w * R_RS + (lane + 64 * j) * 4) = (u32x2){l01, l23}; }
        asm volatile("" ::: "memory");
        { const int gn = gi + F.G;
          if (gn < NGRP) {
#pragma unroll
            for (int j = 0; j < 8; ++j) { hxr[j] = ((const u32x2*)(hin + (size_t)(8 * gn + w) * D))[lane + 64 * j]; if (j < 4) mxr[j] = ((const u32x2*)(MX + (size_t)(8 * gn + w) * D))[lane + 64 * j]; } } }
        __syncthreads();
        f32x4 a0 = (f32x4){0.f, 0.f, 0.f, 0.f}, a1 = (f32x4){0.f, 0.f, 0.f, 0.f};
        { const LAS bf16_t* ah = AH + (n & 7) * R_RS + 8 * kg; const LAS bf16_t* al = AL + (n & 7) * R_RS + 8 * kg;
#pragma unroll
          for (int si = 0; si < 8; ++si) { const int st = 8 * w + si;
              const bf16x8 xh = *(const LAS bf16x8*)(ah + 32 * st), xl = *(const LAS bf16x8*)(al + 32 * st);
              const bf16x8 bh0 = wfr[si][0], bl0 = wfr[si][1], bh1 = wfr[si][2], bl1 = wfr[si][3];
              a0 = __builtin_amdgcn_mfma_f32_16x16x32_bf16(xh, bh0, a0, 0, 0, 0); a0 = __builtin_amdgcn_mfma_f32_16x16x32_bf16(xh, bl0, a0, 0, 0, 0); a0 = __builtin_amdgcn_mfma_f32_16x16x32_bf16(xl, bh0, a0, 0, 0, 0);
              a1 = __builtin_amdgcn_mfma_f32_16x16x32_bf16(xh, bh1, a1, 0, 0, 0); a1 = __builtin_amdgcn_mfma_f32_16x16x32_bf16(xh, bl1, a1, 0, 0, 0); a1 = __builtin_amdgcn_mfma_f32_16x16x32_bf16(xl, bh1, a1, 0, 0, 0);
              if (si == 3) __builtin_amdgcn_sched_barrier(0); } }
        if (kg < 2) {
#pragma unroll
            for (int r = 0; r < 4; ++r) { PART[(w * 8 + 4 * kg + r) * 32 + n] = a0[r]; PART[(w * 8 + 4 * kg + r) * 32 + 16 + n] = a1[r]; } }
        __syncthreads();
        if (lane < 32) { float sacc = 0.f;
#pragma unroll
            for (int ww = 0; ww < 8; ++ww) sacc += PART[(ww * 8 + w) * 32 + lane];
            LG[w * 32 + lane] = sacc; }
        LDS_WAIT();
        if (lane == 0) {
            const f32x4 l0 = *(const LAS f32x4*)(LG + w * 32), l1 = *(const LAS f32x4*)(LG + w * 32 + 4), l2 = *(const LAS f32x4*)(LG + w * 32 + 8), l3 = *(const LAS f32x4*)(LG + w * 32 + 12), l4 = *(const LAS f32x4*)(LG + w * 32 + 16);
            float gl[4];
#pragma unroll
            for (int j = 0; j < 4; ++j) gl[j] = l0[j] + bg[j];
            int gsel = 0; float gm = gl[0];
#pragma unroll
            for (int j = 1; j < 4; ++j) if (gl[j] > gm) { gm = gl[j]; gsel = j; }
            float den = 0.f;
#pragma unroll
            for (int j = 0; j < 4; ++j) den += expf(gl[j] - gm);
            const float gtop = 1.0f / den;
            float el[4];
            const float k0 = gsel == 0 ? 1.f : 0.f, k1 = gsel == 1 ? 1.f : 0.f, k2 = gsel == 2 ? 1.f : 0.f, k3 = gsel == 3 ? 1.f : 0.f;
#pragma unroll
            for (int j = 0; j < 4; ++j) el[j] = (k0 * l1[j] + k1 * l2[j]) + (k2 * l3[j] + k3 * l4[j]) + be[gsel * 4 + j];
            int i1 = 0; float m1 = el[0];
#pragma unroll
            for (int j = 1; j < 4; ++j) if (el[j] > m1) { m1 = el[j]; i1 = j; }
            int i2 = -1; float m2 = -3.0e38f;
#pragma unroll
            for (int j = 0; j < 4; ++j) if (j != i1 && el[j] > m2) { m2 = el[j]; i2 = j; }
            const float ex = expf(m2 - m1); const float w1 = gtop / (1.0f + ex), w2 = gtop * ex / (1.0f + ex);
            const int e1 = gsel * 4 + i1, e2 = gsel * 4 + i2;
            const int li1 = __hip_atomic_fetch_add(lcnt + e1, 1, __ATOMIC_RELAXED, __HIP_MEMORY_SCOPE_WORKGROUP), li2 = __hip_atomic_fetch_add(lcnt + e2, 1, __ATOMIC_RELAXED, __HIP_MEMORY_SCOPE_WORKGROUP);
            const int k = nloc * 8 + w; rec[4 * k] = row; rec[4 * k + 1] = e1 | (e2 << 8); rec[4 * k + 2] = li1; rec[4 * k + 3] = li2;
            tok_e[2 * row] = e1; tok_e[2 * row + 1] = e2; tok_w[2 * row] = w1; tok_w[2 * row + 1] = w2;
        }
        ++nloc;
    }
    __syncthreads();
    if (F.tid < 16) { const int c = lcnt[F.tid]; lcnt[16 + F.tid] = c ? atomicAdd(&cnt[16 * F.tid], c) : 0; }
    __syncthreads();
    if (F.tid < nloc * 8) { const int row = rec[4 * F.tid], ee = rec[4 * F.tid + 1], e1 = ee & 255, e2 = ee >> 8;
        const int p1 = lcnt[16 + e1] + rec[4 * F.tid + 2], p2 = lcnt[16 + e2] + rec[4 * F.tid + 3];
        list[(size_t)e1 * T + p1] = row; list[(size_t)e2 * T + p2] = row; tok_p[2 * row] = p1; tok_p[2 * row + 1] = p2; }
    __syncthreads();
}

__device__ __forceinline__ void moe_table(Frame& F, int l) {
    LAS int* tab = (LAS int*)(F.lds + LDSCTL_OFF + 256);
    unsigned* const ctl = (unsigned*)(launder_ws(F.ws) + WS_CTL);
    const int* cnt = (const int*)(ctl + CW_CNT + l * 512);
    __syncthreads();
    if (F.tid < 16) tab[F.tid] = __hip_atomic_load(cnt + 16 * F.tid, __ATOMIC_RELAXED, __HIP_MEMORY_SCOPE_AGENT);
    __syncthreads();
    if (F.tid == 0) { int pp = 0;
        for (int e = 0; e < 16; ++e) { const int c = tab[e]; tab[16 + e] = pp; tab[33 + e] = pp * 256; pp += (c + 255) >> 8; }
        tab[32] = pp; }
    __syncthreads();
}

template <bool DUMMY>
__device__ __forceinline__ void p_ln2(Frame& F, int l) {
    unsigned char* const wsl = launder_ws(F.ws);
    bf16_t* hb = (bf16_t*)(wsl + WS_HB); const unsigned char* O = (const unsigned char*)(wsl + WS_O);
    const int* tok_e = (const int*)(wsl + WS_TOKE); const int* tok_p = (const int*)(wsl + WS_TOKP); const float* tok_w = (const float*)(wsl + WS_TOKW);
    const LAS int* tab = (const LAS int*)(F.lds + LDSCTL_OFF + 256);
    const LAS float* g = (const LAS float*)(F.lds + 65536); const LAS float* bt = g + D;
    { const float* gg = kin(34) + (size_t)l * D; const float* gb = kin(35) + (size_t)l * D; *(LAS f32x4*)(F.lds + 65536 + 16 * F.tid) = ((const f32x4*)gg)[F.tid]; *(LAS f32x4*)(F.lds + 65536 + 8192 + 16 * F.tid) = ((const f32x4*)gb)[F.tid]; }
    __syncthreads();
    const int gw = F.vcu * 8 + F.wave, NGW = F.G * 8, lane = opaque_v(F.lane);
    u32x2 hv[8]; int oa[8], ob[8]; float w0 = 0.f, w1 = 0.f;
    int te0 = 0, te1 = 0, tp0 = 0, tp1 = 0; float tw0 = 0.f, tw1 = 0.f;
    { const int rk = gw + lane * NGW; if (lane < 16 && rk < T) { te0 = tok_e[2 * rk]; te1 = tok_e[2 * rk + 1]; tp0 = tok_p[2 * rk]; tp1 = tok_p[2 * rk + 1]; tw0 = tok_w[2 * rk]; tw1 = tok_w[2 * rk + 1]; } }
    int kk = 0;
#define LN2_ISSUE(rw) do { const int e0_ = __builtin_amdgcn_readlane(te0, kk), e1_ = __builtin_amdgcn_readlane(te1, kk); \
        const size_t r0_ = (size_t)(tab[33 + e0_] + __builtin_amdgcn_readlane(tp0, kk)), r1_ = (size_t)(tab[33 + e1_] + __builtin_amdgcn_readlane(tp1, kk)); \
        w0 = __builtin_bit_cast(float, __builtin_amdgcn_readlane(__builtin_bit_cast(int, tw0), kk)) * (1.0f / 64.0f); w1 = __builtin_bit_cast(float, __builtin_amdgcn_readlane(__builtin_bit_cast(int, tw1), kk)) * (1.0f / 64.0f); ++kk; \
        _Pragma("unroll") for (int j = 0; j < 8; ++j) { const int i4 = lane + 64 * j; hv[j] = ((const u32x2*)(hb + (size_t)(rw) * D))[i4]; oa[j] = ((const int*)(O + r0_ * D))[i4]; ob[j] = ((const int*)(O + r1_ * D))[i4]; } } while (0)
    int row = gw;
    if (row < T) LN2_ISSUE(row);
    for (; row < T; row += NGW) {
        f32x4 v[8];
#pragma unroll
        for (int j = 0; j < 8; ++j) { f32x4 m;
            const f32x2 a01 = __builtin_amdgcn_cvt_pk_f32_fp8(oa[j], false), a23 = __builtin_amdgcn_cvt_pk_f32_fp8(oa[j], true), b01 = __builtin_amdgcn_cvt_pk_f32_fp8(ob[j], false), b23 = __builtin_amdgcn_cvt_pk_f32_fp8(ob[j], true);
            m[0] = w0 * a01[0] + w1 * b01[0]; m[1] = w0 * a01[1] + w1 * b01[1]; m[2] = w0 * a23[0] + w1 * b23[0]; m[3] = w0 * a23[1] + w1 * b23[1];
            v[j] = (f32x4){__builtin_bit_cast(float, hv[j].x << 16), __builtin_bit_cast(float, hv[j].x & 0xffff0000u), __builtin_bit_cast(float, hv[j].y << 16), __builtin_bit_cast(float, hv[j].y & 0xffff0000u)} * ALPHA + m; }
        const int nrow = row + NGW;
        if (nrow < T) LN2_ISSUE(nrow);
        float* orow = nullptr;
        if (l == DEPTH - 1) { const int bb = row / L, pp = row % L; if (pp >= NMETA) orow = kout() + ((size_t)bb * SEQ + (pp - NMETA)) * D; }
        if (DUMMY) ln_wave_store(v, g, bt, (bf16_t*)(wsl + WS_DUM) + (size_t)row * D, nullptr, nullptr, lane);
        else if (l == DEPTH - 1) ln_wave_store<false, true>(v, g, bt, nullptr, nullptr, orow, lane);
        else ln_wave_store(v, g, bt, hb + (size_t)row * D, nullptr, orow, lane);
    }
#undef LN2_ISSUE
}


__device__ __forceinline__ void outproj_tail(Frame& F, int l, unsigned char* wsl) {
    if (F.vcu >= 128) return;
    const bf16_t* Yb = (const bf16_t*)(wsl + WS_Y) + (size_t)16384 * D; const bf16_t* Wt = (const bf16_t*)(wsl + WS_WOUT) + (size_t)l * D * D + (size_t)(16 * F.vcu) * D;
    const int lane = opaque_v(F.lane), w = F.wave, n = lane & 15, kg = lane >> 4;
    f32x4 acc[8];
#pragma unroll
    for (int mb = 0; mb < 8; ++mb) acc[mb] = (f32x4){0.f, 0.f, 0.f, 0.f};
    const bf16_t* ap = Yb + (size_t)n * D + 256 * w + 8 * kg; const bf16_t* bp = Wt + (size_t)n * D + 256 * w + 8 * kg;
#pragma unroll 2
    for (int ks = 0; ks < 8; ++ks) {
        const bf16x8 bfr = *(const bf16x8*)(bp + 32 * ks);
        bf16x8 af[8];
#pragma unroll
        for (int mb = 0; mb < 8; ++mb) af[mb] = *(const bf16x8*)(ap + (size_t)(16 * mb) * D + 32 * ks);
#pragma unroll
        for (int mb = 0; mb < 8; ++mb) acc[mb] = __builtin_amdgcn_mfma_f32_16x16x32_bf16(af[mb], bfr, acc[mb], 0, 0, 0);
    }
    LAS f32x4* red = (LAS f32x4*)F.lds;
    __syncthreads();
#pragma unroll
    for (int mb = 0; mb < 8; ++mb) red[(w * 8 + mb) * 64 + lane] = acc[mb];
    __syncthreads();
    { const int mb = F.tid >> 6;
      f32x4 sacc = red[(0 * 8 + mb) * 64 + lane];
#pragma unroll
      for (int ww = 1; ww < 8; ++ww) sacc += red[(ww * 8 + mb) * 64 + lane];
      const int col = 16 * F.vcu + n; const float bias = (kin(24) + (size_t)l * D)[col];
      bf16_t* MX = (bf16_t*)(wsl + WS_R1);
#pragma unroll
      for (int r = 0; r < 4; ++r) { const size_t o = (size_t)(16384 + 16 * mb + 4 * kg + r) * D + col; MX[o] = (bf16_t)f2bf(sacc[r] + bias); } }
    __syncthreads();
}

#ifndef REP_LN
#define REP_LN 1
#endif
#ifndef REP_PRO
#define REP_PRO 1
#endif
#ifndef REP_MIX
#define REP_MIX 1
#endif
#ifndef REP_GEMM
#define REP_GEMM 1
#endif
#define IN(k) (lo <= (k) && (k) < hi)
#define SEAM(k) do { if (IN(k) && IN((k) + 1)) xcd_barrier(bar); } while (0)
template <int l>
__device__ __forceinline__ void run_layer(Frame& F, const int lo, const int hi, const XcdBarrier& bar) {
        const int P = 1 + l * NPH;
        if (IN(P + 0)) {
            unsigned char* const wsl = launder_ws(F.ws);
            pg::PlainSched S; S.init(MPAD / 256, INCP / 256, F.G, (int)blockIdx.x);
            pg::EpiInProj E{(bf16_t*)(wsl + WS_U), kin(5) + (size_t)l * INC};
            for (int rep = 0; rep < REP_GEMM; ++rep) pg::gemm_phase<false>(F.lds, wsl + WS_HB, (const bf16_t*)(wsl + WS_WIN) + (size_t)l * INCP * D, D, S, E);
        }
        SEAM(P + 0);
        if (IN(P + 1)) for (int rep = 0; rep < REP_MIX; ++rep) p_mix1(F, l);
        SEAM(P + 1);
        if (IN(P + 2)) for (int rep = 0; rep < REP_MIX; ++rep) p_mix2(F, l);
        SEAM(P + 2);
        if (IN(P + 3)) for (int rep = 0; rep < REP_MIX; ++rep) p_mix3(F, l);
        SEAM(P + 3);
        if (IN(P + 4)) {
            unsigned char* const wsl = launder_ws(F.ws);
            pg::PlainSched S; S.init(64, D / 256, F.G, (int)blockIdx.x);
            pg::EpiOutProj E{(bf16_t*)(wsl + WS_R1), kin(24) + (size_t)l * D};
            for (int rep = 0; rep < REP_GEMM; ++rep) pg::gemm_phase<false>(F.lds, wsl + WS_Y, (const bf16_t*)(wsl + WS_WOUT) + (size_t)l * D * D, D, S, E);
            outproj_tail(F, l, wsl);
        }
        SEAM(P + 4);
        if (IN(P + 5)) { if (REP_LN > 1) p_ln1_router<true>(F, l); p_ln1_router<false>(F, l); }
        SEAM(P + 5);
        if (IN(P + 6)) {
            moe_table(F, l);
            unsigned char* const wsl = launder_ws(F.ws);
            pg::MoeSched S; S.tab = (const LAS int*)(F.lds + LDSCTL_OFF + 256); S.list = (const int*)(wsl + WS_LIST); S.nN = 8; S.G = F.G; S.c = F.vcu; S.gather = 1; S.nrowsB = 2048;
            pg::EpiGateUp8 E{(unsigned char*)(wsl + WS_HM)};
            for (int rep = 0; rep < REP_GEMM; ++rep) pg::gemm_phase<true>(F.lds, wsl + WS_HB8, wsl + WS_WGU + (size_t)l * NEXP * 2048 * D, D / 2, S, E);
        }
        SEAM(P + 6);
        if (IN(P + 7)) {
            moe_table(F, l);
            unsigned char* const wsl = launder_ws(F.ws);
            pg::MoeSched S; S.tab = (const LAS int*)(F.lds + LDSCTL_OFF + 256); S.list = nullptr; S.nN = 8; S.G = F.G; S.c = F.vcu; S.gather = 0; S.nrowsB = 2048;
            pg::EpiDown8 E{(unsigned char*)(wsl + WS_O)};
            for (int rep = 0; rep < REP_GEMM; ++rep) pg::gemm_phase<true>(F.lds, wsl + WS_HM, wsl + WS_WD + (size_t)l * NEXP * D * DEXP, DEXP / 2, S, E);
        }
        SEAM(P + 7);
        if (IN(P + 8)) { moe_table(F, l); if (REP_LN > 1) p_ln2<true>(F, l); p_ln2<false>(F, l); }
        SEAM(P + 8);
}

__global__ void __launch_bounds__(512, 2) mk_fwd(Args args) {
    extern __shared__ __attribute__((aligned(16))) unsigned char lds_raw[];
    Frame F;
    F.lds = (LAS unsigned char*)lds_raw;
    F.MISC = (volatile LAS unsigned*)(F.lds + MISC_OFF);
    F.tid = threadIdx.x; F.lane = F.tid & 63; F.wave = __builtin_amdgcn_readfirstlane(F.tid >> 6);
    F.G = gridDim.x; { const int bx = blockIdx.x; F.vcu = (F.G % 8 == 0) ? (bx % 8) * (F.G / 8) + bx / 8 : bx; }
    F.ws = args.ws; F.ctl = (unsigned*)(args.ws + WS_CTL);
    for (int u = F.tid; u < (LDS_BYTES - LDSCTL_OFF) / 4; u += 512) ((LAS unsigned*)(F.lds + LDSCTL_OFF))[u] = 0u;
    __syncthreads();
    const int lo = args.ph_lo, hi = args.ph_hi;
    const bool multi = (hi - lo) > 1;
    XcdBarrier bar; bar.bar = F.ctl + CW_BAR; bar.x = 0; bar.st = nullptr;
    if (multi) bar = xcd_barrier_post(F.ctl + CW_BAR, F.MISC + 8);

    if (IN(0)) { for (int rep = 0; rep < REP_PRO; ++rep) p_prologue(F); }
    SEAM(0);
    run_layer<0>(F, lo, hi, bar); run_layer<1>(F, lo, hi, bar); run_layer<2>(F, lo, hi, bar); run_layer<3>(F, lo, hi, bar);
}

#ifndef MK_CUT
#define MK_CUT 0
#endif
extern "C" void kernel_launch(void* const* d_in, const int* in_sizes, int n_in, void* d_out, int out_size, void* d_ws, size_t ws_size, hipStream_t stream) {
    static bool attr = false;
    if (!attr) { (void)hipFuncSetAttribute((const void*)mk_fwd, hipFuncAttributeMaxDynamicSharedMemorySize, LDS_BYTES); attr = true; }
    (void)hipMemsetAsync(d_ws, 0, CTL_BYTES, stream);
    Args a{};
    for (int i = 0; i < 36; ++i) a.in[i] = (const float*)d_in[i];
    a.out = (float*)d_out; a.ws = (unsigned char*)d_ws;
    const int NP = 1 + DEPTH * NPH;
#if MK_CUT
    for (int p = 0; p < NP; ++p) { a.ph_lo = p; a.ph_hi = p + 1; hipLaunchKernelGGL(mk_fwd, dim3(256), dim3(512), LDS_BYTES, stream, a); }
#else
    a.ph_lo = 0; a.ph_hi = NP; hipLaunchKernelGGL(mk_fwd, dim3(256), dim3(512), LDS_BYTES, stream, a);
#endif
}
```

```cpp
#include <hip/hip_runtime.h>
#include <stdint.h>

#define LAS __attribute__((address_space(3)))
#define GAS __attribute__((address_space(1)))
typedef unsigned short bf16_t;
typedef short bf16x8 __attribute__((ext_vector_type(8)));
typedef float f32x4 __attribute__((ext_vector_type(4)));
typedef float f32x2 __attribute__((ext_vector_type(2)));
typedef unsigned u32x4 __attribute__((ext_vector_type(4)));
typedef unsigned u32x2 __attribute__((ext_vector_type(2)));

constexpr int D = 2048, NB = 8, SEQ = 2048, NMETA = 16, L = SEQ + NMETA, T = NB * L, DEPTH = 4;
constexpr int MPAD = 16640;
constexpr int INC = 4640, INCP = 4864;
constexpr int O_AQ = 0, O_AK = 256, O_AV = 512, O_GF = 1024, O_GB = 1040, O_AR = 1056, O_BQ = 1568, O_BK = 2592, O_BV = 2848, O_CU = 3104;
constexpr int NEXP = 16, DEXP = 1024;
constexpr float ALPHA = 1.681792830507429f;
constexpr int NPH = 9;
constexpr int HMROWS = 2 * T + 4096;

constexpr size_t al256(size_t x) { return (x + 255) & ~(size_t)255; }
constexpr size_t WS_CTL = 0, CTL_BYTES = 1u << 20;
constexpr size_t WS_WIN = WS_CTL + CTL_BYTES;
constexpr size_t WS_WOUT = WS_WIN + (size_t)DEPTH * INCP * D * 2;
constexpr size_t WS_WGU = WS_WOUT + (size_t)DEPTH * D * D * 2;
constexpr size_t WS_WD = WS_WGU + (size_t)DEPTH * NEXP * 2048 * D * 2;
constexpr size_t WS_HB8 = WS_WD + (size_t)DEPTH * NEXP * D * DEXP * 2;
constexpr size_t WS_H = WS_HB8 + (size_t)MPAD * D;
constexpr size_t WS_HB = WS_H + (size_t)T * D * 4;
constexpr size_t WS_Y = WS_HB + (size_t)MPAD * D * 2;
constexpr size_t WS_LIST = WS_Y + (size_t)MPAD * D * 2;
constexpr size_t WS_TOKE = WS_LIST + (size_t)NEXP * T * 4;
constexpr size_t WS_TOKP = WS_TOKE + (size_t)2 * T * 4;
constexpr size_t WS_TOKW = WS_TOKP + (size_t)2 * T * 4;
constexpr size_t WS_HF = WS_TOKW + (size_t)2 * T * 4;
constexpr size_t WS_HBW = WS_HF + (size_t)L * 512 * 4;
constexpr int GLEN = 4736, GCEN = 2336, ZL = 2112;
constexpr int ZROW = 3520, ZOFF = 576;
constexpr size_t WS_FG = al256(WS_HBW + (size_t)L * 512 * 4);
constexpr size_t WS_WR = al256(WS_FG + (size_t)DEPTH * 512 * 2 * GLEN * 2);
constexpr size_t WS_REG = al256(WS_WR + (size_t)DEPTH * 64 * 2 * 2 * 512 * 2);
constexpr size_t WS_U = WS_REG;
constexpr int GNC = 33;
constexpr size_t WS_KVT = al256(WS_U + (size_t)T * INC * 2);
constexpr size_t WS_DEC = WS_KVT + (size_t)64 * GNC * 128 * 64 * 4;
constexpr size_t WS_SPT = WS_DEC + (size_t)64 * GNC * 64 * 4;
constexpr size_t WS_GQK = WS_SPT + (size_t)64 * GNC * 128 * 64 * 2;
constexpr size_t WS_GVT = WS_GQK + (size_t)NB * 4 * GNC * 4 * 64 * 64 * 2;
constexpr size_t WS_SW = WS_GVT + (size_t)NB * 4 * GNC * 128 * 64 * 2;
constexpr size_t WS_X0T = WS_SW + (size_t)T * 1024 * 4;
constexpr size_t WS_ZT = WS_X0T + (size_t)512 * NB * ZL * 2;
constexpr size_t WS_YT = WS_ZT + (size_t)512 * NB * ZL * 2;
constexpr size_t WS_END1 = WS_YT + (size_t)512 * NB * ZL * 2;
constexpr size_t WS_R1 = WS_REG;
constexpr size_t WS_HM = WS_R1 + (size_t)T * D * 4;
constexpr size_t WS_O = WS_HM + (size_t)HMROWS * DEXP * 2;
constexpr size_t WS_END2 = WS_O + (size_t)HMROWS * D * 2;
constexpr size_t WS_DUM = al256(WS_END2);
static_assert(WS_END1 < 2100000000ull && WS_DUM + (size_t)T * D * 6 + (size_t)NEXP * T * 4 + (size_t)T * 32 < 2100000000ull, "d_ws budget");
constexpr int CW_BAR = 4096;
constexpr int CW_Q = 12288;
constexpr int CW_CNT = 16384;

constexpr int RING_BYTES = 131072;
constexpr int LDSCTL_OFF = RING_BYTES;
constexpr int MISC_OFF = LDSCTL_OFF + 1024;
constexpr int LDS_BYTES = 147456;

#define LDS_WAIT() asm volatile("s_waitcnt lgkmcnt(0)" ::: "memory")
#define VM_WAIT() asm volatile("s_waitcnt vmcnt(0)" ::: "memory")
__device__ __forceinline__ unsigned f2bf(float f) { unsigned u = __builtin_bit_cast(unsigned, f); return (u + 0x7fffu + ((u >> 16) & 1u)) >> 16; }
__device__ __forceinline__ unsigned pk2i(float lo, float hi) { return f2bf(lo) | (f2bf(hi) << 16); }
__device__ __forceinline__ unsigned pk2(float lo, float hi) { unsigned r; asm("v_cvt_pk_bf16_f32 %0, %1, %2" : "=v"(r) : "v"(lo), "v"(hi)); return r; }
__device__ __forceinline__ float bf2f(unsigned short b) { return __builtin_bit_cast(float, (unsigned)b << 16); }
template <int N> __device__ __forceinline__ float dpp_row_shr_add(float v) { const int t = __builtin_amdgcn_update_dpp(0, __builtin_bit_cast(int, v), 0x110 + N, 0xf, 0xf, true); return v + __builtin_bit_cast(float, t); }
__device__ __forceinline__ float wave_sum(float v) {
    v = dpp_row_shr_add<1>(v); v = dpp_row_shr_add<2>(v); v = dpp_row_shr_add<4>(v); v = dpp_row_shr_add<8>(v);
    const int vi = __builtin_bit_cast(int, v);
    return (__builtin_bit_cast(float, __builtin_amdgcn_readlane(vi, 15)) + __builtin_bit_cast(float, __builtin_amdgcn_readlane(vi, 31))) + (__builtin_bit_cast(float, __builtin_amdgcn_readlane(vi, 47)) + __builtin_bit_cast(float, __builtin_amdgcn_readlane(vi, 63)));
}
__device__ __forceinline__ float xor32(float v) {
    const int vi = __builtin_bit_cast(int, v);
    auto r = __builtin_amdgcn_permlane32_swap(vi, vi, false, false);
    return __builtin_bit_cast(float, (threadIdx.x & 32) ? r[0] : r[1]);
}
__device__ __forceinline__ float wave_max(float v) {
#pragma unroll
    for (int o = 1; o < 64; o <<= 1) v = fmaxf(v, __shfl_xor(v, o));
    return v;
}

#define XB_TMO      128
#define XB_XCNT(j)  (256  + 64 * (j))
#define XB_XSUB(j)  (1280 + 64 * (j))
#define XB_XGEN(j)  (2304 + 64 * (j))
#define XB_TOP      3328
#define XB_TOPGEN   3392
#define XCD_BAR_WORDS 3456
#define XB_SPIN_CAP (1u << 18)
__device__ __forceinline__ unsigned xb_ld(unsigned* p)              { return __hip_atomic_load(p, __ATOMIC_RELAXED, __HIP_MEMORY_SCOPE_AGENT); }
__device__ __forceinline__ unsigned xb_add(unsigned* p, unsigned v) { return __hip_atomic_fetch_add(p, v, __ATOMIC_RELAXED, __HIP_MEMORY_SCOPE_AGENT); }
__device__ __forceinline__ unsigned xb_xcc_id() { return (unsigned)__builtin_amdgcn_s_getreg((3 << 11) | 20) & 0xFu; }
#define XB_SPIN(cond, bar) do { unsigned _sp = 0; while (cond) { __builtin_amdgcn_s_sleep(1); \
    if ((++_sp & 255u) == 0u) { if (xb_ld(&(bar)[XB_TMO])) break; if (_sp > XB_SPIN_CAP) { atomicAdd(&(bar)[XB_TMO], 1u); break; } } } } while (0)
struct XcdBarrier { unsigned* bar; unsigned x; volatile LAS unsigned* st; };
__device__ __forceinline__ XcdBarrier xcd_barrier_post(unsigned* bar, volatile LAS unsigned* st) {
    XcdBarrier b; b.bar = bar; b.x = xb_xcc_id(); b.st = st;
    if (threadIdx.x == 0) (void)xb_add(&bar[XB_XCNT(b.x)], 1u);
    return b;
}
__device__ __forceinline__ void xcd_barrier_complete(unsigned* bar, unsigned x, unsigned& nloc, unsigned& nx) {
    const unsigned G = gridDim.x * gridDim.y * gridDim.z;
    unsigned sum, cnt, mine, sp = 0u;
    for (;;) {
        sum = 0u; cnt = 0u; mine = 0u;
#pragma unroll
        for (unsigned j = 0; j < 16; ++j) { const unsigned c = xb_ld(&bar[XB_XCNT(j)]); sum += c; cnt += (c > 0u) ? 1u : 0u; mine = (j == x) ? c : mine; }
        if (sum == G) break;
        __builtin_amdgcn_s_sleep(1);
        if ((++sp & 255u) == 0u) { if (xb_ld(&bar[XB_TMO])) break; if (sp > XB_SPIN_CAP) { atomicAdd(&bar[XB_TMO], 1u); break; } }
    }
    nloc = mine > 0u ? mine : 1u; nx = cnt > 0u ? cnt : 1u;
}
__device__ __forceinline__ void xcd_barrier(const XcdBarrier& b) {
    asm volatile("s_waitcnt vmcnt(0)" ::: "memory");
    __syncthreads();
    if (threadIdx.x == 0) {
        unsigned* bar = b.bar;
        __builtin_amdgcn_s_waitcnt(0);
        unsigned nloc = b.st[0], nx = b.st[1];
        if (nloc == 0u) { xcd_barrier_complete(bar, b.x, nloc, nx); b.st[0] = nloc; b.st[1] = nx; }
        const unsigned old = xb_add(&bar[XB_XSUB(b.x)], 1u);
        const unsigned gen = old / nloc;
        if (old + 1u == (gen + 1u) * nloc) {
            __builtin_amdgcn_fence(__ATOMIC_RELEASE, "agent");
            asm volatile("s_waitcnt vmcnt(0)" ::: "memory");
            const unsigned og = xb_add(&bar[XB_TOP], 1u);
            const unsigned tg = og / nx;
            if (og + 1u == (tg + 1u) * nx) xb_add(&bar[XB_TOPGEN], 1u);
            else XB_SPIN(xb_ld(&bar[XB_TOPGEN]) == tg, bar);
            __builtin_amdgcn_fence(__ATOMIC_ACQUIRE, "agent");
            xb_add(&bar[XB_XGEN(b.x)], 1u);
            asm volatile("s_waitcnt vmcnt(0)" ::: "memory");
        } else {
            XB_SPIN(xb_ld(&bar[XB_XGEN(b.x)]) == gen, bar);
            __builtin_amdgcn_fence(__ATOMIC_ACQUIRE, "agent");
            asm volatile("s_waitcnt vmcnt(0)" ::: "memory");
        }
    }
    __syncthreads();
}

namespace pg {
constexpr int BM = 256, BK = 64, HALF = 128, HTB = HALF * BK * 2, STAGE_BYTES = 8 * HTB, NXCD = 8, WGM = 8;
__host__ __device__ __forceinline__ int lds_byte(int r, int c) { const int st = (r >> 4) * 2 + (c >> 5), rr = r & 15, cc = c & 31, ob = rr * 64 + cc * 2; return st * 1024 + (ob ^ (((ob >> 9) & 1) << 5)); }
__host__ __device__ __forceinline__ void stage_rc(int b, int& R, int& C) { const int st = b / 1024, sb = b % 1024, swz = sb ^ (((sb >> 9) & 1) << 5); R = (st >> 1) * 16 + swz / 64; C = (st & 1) * 32 + (swz % 64) / 2; }

__host__ __device__ __forceinline__ int perm32(int rho) { const int n = rho >> 4, i = rho & 15; return 8 * (i >> 2) + 4 * n + (i & 3); }
struct Unit { int e, pm, pn, mvalid, crow0; };

struct PlainSched {
    int nM, nN, nwg, G, c;
    __device__ void init(int nM_, int nN_, int G_, int c_) { nM = nM_; nN = nN_; nwg = nM * nN; G = G_; c = c_; }
    __device__ bool next(int i, Unit& u) const {
        const long Lx = (long)i * G + c; if (Lx >= nwg) return false;
        int wgid = (int)Lx; { const int q = nwg / NXCD, r = nwg % NXCD, xcd = wgid % NXCD, off = wgid / NXCD; wgid = (xcd < r ? xcd * (q + 1) : r * (q + 1) + (xcd - r) * q) + off; }
        const int nig = WGM * nN, gid = wgid / nig, fm = gid * WGM, gsz = (nM - fm) < WGM ? (nM - fm) : WGM;
        u.pm = fm + ((wgid % nig) % gsz); u.pn = (wgid % nig) / gsz; u.e = 0; u.crow0 = u.pm * BM; u.mvalid = min(BM, T - u.pm * BM); return true;
    }
    __device__ __forceinline__ int arow(const Unit& u, int r) const { return min(u.pm * BM + r, T - 1); }
    __device__ __forceinline__ int brow0(const Unit& u) const { return u.pn * BM; }
};
struct MoeSched {
    const LAS int* tab; const int* list; int nN, G, c, gather, nrowsB;
    __device__ bool next(int i, Unit& u) const {
        const int Lx = i * G + c; const int panel = Lx / nN;
        if (panel >= __builtin_amdgcn_readfirstlane(tab[32])) return false;
        int e = 0;
#pragma unroll 1
        for (int j = 1; j < 16; ++j) if (panel >= __builtin_amdgcn_readfirstlane(tab[16 + j])) e = j;
        u.e = e; u.pm = panel - __builtin_amdgcn_readfirstlane(tab[16 + e]); u.pn = Lx % nN; u.crow0 = __builtin_amdgcn_readfirstlane(tab[33 + e]) + u.pm * BM;
        u.mvalid = min(BM, __builtin_amdgcn_readfirstlane(tab[e]) - u.pm * BM); return true;
    }
    __device__ __forceinline__ int arow(const Unit& u, int r) const {
        const int rr = min(r, u.mvalid - 1);
        return gather ? list[(size_t)u.e * T + u.pm * BM + rr] : (u.crow0 + rr);
    }
    __device__ __forceinline__ int brow0(const Unit& u) const { return u.e * nrowsB + u.pn * BM; }
};

typedef int i32x8 __attribute__((ext_vector_type(8)));
typedef int i32x4_ __attribute__((ext_vector_type(4)));
__host__ __device__ __forceinline__ int lds_byte8(int r, int kb) { const int st = (r >> 4) * 2 + (kb >> 1), rr = r & 15; return st * 1024 + rr * 64 + 32 * ((kb & 1) ^ (rr >> 3)); }
template <bool FP8, class Epi, class Sched>
__device__ __forceinline__ void gemm_phase(LAS unsigned char* lds, const void* A, const void* Bt, const int K  , const Sched& S, const Epi& E) {
    const int tid = threadIdx.x, wid = __builtin_amdgcn_readfirstlane(tid >> 6), lane = tid & 63, wr = wid >> 2, wc = wid & 3, fr = lane & 15, fq = lane >> 4;
    const int nt = K / BK;
    unsigned voffB[2];
#pragma unroll
    for (int i = 0; i < 2; ++i) { int R, C; stage_rc(tid * 16 + i * 8192, R, C); const int Rb = Epi::PERM ? ((R & ~31) + perm32(R & 31)) : R; voffB[i] = (unsigned)(Rb * K + C) * 2u; }
    const size_t kstep = (size_t)(BK * 2);
    const size_t hstep = (size_t)HALF * K * 2;
    const unsigned rowb = (unsigned)K * 2u;
    const unsigned ldsw = (unsigned)wid * 1024u;
    const int aoff = FP8 ? lds_byte8(wr * 64 + fr, fq) : lds_byte(wr * 64 + fr, fq * 8), boff = FP8 ? lds_byte8(wc * 32 + fr, fq) : lds_byte(wc * 32 + fr, fq * 8);
#define PG_SA(b, h) (((b) * 2 + (h)) * HTB)
#define PG_SB(b, h) ((4 + (b) * 2 + (h)) * HTB)
#define PG_STAGE_B(bufoff, gbase) do { _Pragma("unroll") for (int _i = 0; _i < 2; ++_i) \
        __builtin_amdgcn_global_load_lds((const unsigned*)((const char*)(gbase) + voffB[_i]), (LAS unsigned*)(lds + (bufoff) + ldsw + _i * 8192), 16, 0, 0); } while (0)
#define PG_STAGE_A(bufoff, gbase, v0, v1) do { \
        __builtin_amdgcn_global_load_lds((const unsigned*)((const char*)(gbase) + (v0)), (LAS unsigned*)(lds + (bufoff) + ldsw), 16, 0, 0); \
        __builtin_amdgcn_global_load_lds((const unsigned*)((const char*)(gbase) + (v1)), (LAS unsigned*)(lds + (bufoff) + ldsw + 8192), 16, 0, 0); } while (0)
#define PG_LDA(dst, b, h) do { _Pragma("unroll") for (int m = 0; m < 4; ++m) _Pragma("unroll") for (int k = 0; k < 2; ++k) dst[m][k] = *(const LAS bf16x8*)(lds + PG_SA(b, h) + aoff + m * 2048 + (FP8 ? k * 16 : k * 1024)); } while (0)
#define PG_LDB(dst, b, h) do { _Pragma("unroll") for (int n = 0; n < 2; ++n) _Pragma("unroll") for (int k = 0; k < 2; ++k) dst[n][k] = *(const LAS bf16x8*)(lds + PG_SB(b, h) + boff + n * 2048 + (FP8 ? k * 16 : k * 1024)); } while (0)
#define PG_MMA(ai, bj, At, Bt_) do { __builtin_amdgcn_s_setprio(1); if constexpr (FP8) { _Pragma("unroll") for (int m = 0; m < 4; ++m) _Pragma("unroll") for (int n = 0; n < 2; ++n) { \
            const i32x8 bq_ = __builtin_shufflevector(__builtin_bit_cast(i32x4_, Bt_[n][0]), __builtin_bit_cast(i32x4_, Bt_[n][1]), 0, 1, 2, 3, 4, 5, 6, 7), aq_ = __builtin_shufflevector(__builtin_bit_cast(i32x4_, At[m][0]), __builtin_bit_cast(i32x4_, At[m][1]), 0, 1, 2, 3, 4, 5, 6, 7); \
            acc[ai][bj][m][n] = __builtin_amdgcn_mfma_scale_f32_16x16x128_f8f6f4(bq_, aq_, acc[ai][bj][m][n], 0, 0, 0, 0x7f7f7f7f, 0, 0x7f7f7f7f); } } \
        else { _Pragma("unroll") for (int m = 0; m < 4; ++m) _Pragma("unroll") for (int n = 0; n < 2; ++n) _Pragma("unroll") for (int k = 0; k < 2; ++k) \
        acc[ai][bj][m][n] = __builtin_amdgcn_mfma_f32_16x16x32_bf16(Bt_[n][k], At[m][k], acc[ai][bj][m][n], 0, 0, 0); } __builtin_amdgcn_s_setprio(0); } while (0)
#define PG_WAIT_V(n) asm volatile("s_waitcnt vmcnt(" #n ")" ::: "memory")
#define PG_WAIT_L(n) asm volatile("s_waitcnt lgkmcnt(" #n ")" ::: "memory")
#define PG_BAR __builtin_amdgcn_s_barrier()
#define PG_SCHED __builtin_amdgcn_sched_barrier(0)
#define PG_SETA(v, u) do { int R0_, C0_, R1_, C1_; stage_rc(tid * 16, R0_, C0_); stage_rc(tid * 16 + 8192, R1_, C1_); \
        v##00 = (unsigned)S.arow(u, R0_) * rowb + (unsigned)C0_ * 2u; v##01 = (unsigned)S.arow(u, R1_) * rowb + (unsigned)C1_ * 2u; \
        v##10 = (unsigned)S.arow(u, HALF + R0_) * rowb + (unsigned)C0_ * 2u; v##11 = (unsigned)S.arow(u, HALF + R1_) * rowb + (unsigned)C1_ * 2u; } while (0)
    Unit cur, nxt; int ui = 0;
    if (!S.next(0, cur)) return;
    f32x4 acc[2][2][4][2];
#pragma unroll
    for (int a = 0; a < 2; ++a)
#pragma unroll
        for (int b = 0; b < 2; ++b)
#pragma unroll
            for (int m = 0; m < 4; ++m)
#pragma unroll
                for (int n = 0; n < 2; ++n) acc[a][b][m][n] = (f32x4){0.f, 0.f, 0.f, 0.f};
    bf16x8 At[4][2], B0[2][2], B1[2][2];
    unsigned vc00, vc01, vc10, vc11;
    PG_SETA(vc, cur);
    const char* Ab = (const char*)A;
    const char* cB = (const char*)Bt + (size_t)S.brow0(cur) * rowb;
    PG_STAGE_B(PG_SB(0, 0), cB); PG_STAGE_B(PG_SB(0, 1), cB + hstep); PG_STAGE_A(PG_SA(0, 0), Ab, vc00, vc01); PG_STAGE_A(PG_SA(0, 1), Ab, vc10, vc11);
    if (wr == 1) PG_BAR;
    PG_WAIT_V(2); PG_BAR;
    PG_STAGE_B(PG_SB(1, 0), cB + kstep); PG_STAGE_A(PG_SA(1, 0), Ab + kstep, vc00, vc01); PG_STAGE_B(PG_SB(1, 1), cB + hstep + kstep);
    PG_WAIT_V(6); PG_BAR;
    for (;;) {
        const bool has_next = S.next(ui + 1, nxt);
        const char* nB = has_next ? (const char*)Bt + (size_t)S.brow0(nxt) * rowb : cB;
        for (int t = 0; t < nt; t += 2) {
            const bool last = (t == nt - 2);
            const char* a1 = Ab + (size_t)(t + 1) * kstep;
            const char* a2 = last ? Ab : Ab + (size_t)(t + 2) * kstep; const char* b2 = last ? nB : cB + (size_t)(t + 2) * kstep;
            const char* a3 = a2 + kstep; const char* b3 = b2 + kstep;
            PG_LDB(B0, 0, 0); PG_LDB(B1, 0, 1); PG_SCHED; PG_LDA(At, 0, 0); PG_STAGE_A(PG_SA(1, 1), a1, vc10, vc11);
            if (last && has_next) { PG_SETA(vc, nxt); }
            PG_WAIT_V(8); PG_WAIT_L(0); PG_BAR; PG_MMA(0, 0, At, B0); PG_MMA(0, 1, At, B1); PG_BAR; PG_SCHED;
            PG_LDA(At, 0, 1); PG_STAGE_B(PG_SB(0, 0), b2); PG_STAGE_B(PG_SB(0, 1), b2 + hstep); PG_STAGE_A(PG_SA(0, 0), a2, vc00, vc01);
            PG_WAIT_V(8); PG_WAIT_L(0); PG_BAR; PG_MMA(1, 0, At, B0); PG_MMA(1, 1, At, B1); PG_BAR; PG_SCHED;
            PG_LDB(B0, 1, 0); PG_LDB(B1, 1, 1); PG_SCHED; PG_LDA(At, 1, 0); PG_STAGE_A(PG_SA(0, 1), a2, vc10, vc11);
            PG_WAIT_V(8); PG_WAIT_L(0); PG_BAR; PG_MMA(0, 0, At, B0); PG_MMA(0, 1, At, B1); PG_BAR; PG_SCHED;
            PG_LDA(At, 1, 1); PG_STAGE_B(PG_SB(1, 0), b3); PG_STAGE_B(PG_SB(1, 1), b3 + hstep); PG_STAGE_A(PG_SA(1, 0), a3, vc00, vc01);
            PG_WAIT_V(8); PG_WAIT_L(0); PG_BAR; PG_MMA(1, 0, At, B0); PG_MMA(1, 1, At, B1); PG_BAR; PG_SCHED;
        }
        if (wr == 0) PG_BAR;
        E(acc, cur, wr, wc, fr, fq);
        if (!has_next) break;
#pragma unroll
        for (int a = 0; a < 2; ++a)
#pragma unroll
            for (int b = 0; b < 2; ++b)
#pragma unroll
                for (int m = 0; m < 4; ++m)
#pragma unroll
                    for (int n = 0; n < 2; ++n) acc[a][b][m][n] = (f32x4){0.f, 0.f, 0.f, 0.f};
        cur = nxt; cB = nB; ++ui;
        if (wr == 1) PG_BAR;
    }
    PG_WAIT_V(0);
    PG_BAR;
#undef PG_SA
#undef PG_SB
#undef PG_STAGE_A
#undef PG_STAGE_B
#undef PG_LDA
#undef PG_LDB
#undef PG_MMA
#undef PG_WAIT_V
#undef PG_WAIT_L
#undef PG_BAR
#undef PG_SCHED
#undef PG_SETA
}

struct EpiInProj {
    static constexpr bool PERM = true;
    bf16_t* U; const float* bias;
    __device__ __forceinline__ void operator()(const f32x4 (&acc)[2][2][4][2], const Unit& u, int wr, int wc, int fr, int fq) const {
        const int col0 = u.pn * BM + wc * 32 + 8 * fq;
        f32x4 bv[2][2]; bool cv[2];
#pragma unroll
        for (int bj = 0; bj < 2; ++bj) { const int c = col0 + bj * HALF; cv[bj] = c < INC;
#pragma unroll
            for (int n = 0; n < 2; ++n) bv[bj][n] = cv[bj] ? *(const f32x4*)(bias + c + 4 * n) : (f32x4){0.f, 0.f, 0.f, 0.f}; }
#pragma unroll
        for (int ai = 0; ai < 2; ++ai)
#pragma unroll
            for (int m = 0; m < 4; ++m) { const int r = ai * HALF + wr * 64 + m * 16 + fr;
                if (r < u.mvalid) { bf16_t* rowp = U + (size_t)(u.crow0 + r) * INC + col0;
#pragma unroll
                    for (int bj = 0; bj < 2; ++bj) if (cv[bj]) { const f32x4 v0 = acc[ai][bj][m][0] + bv[bj][0], v1 = acc[ai][bj][m][1] + bv[bj][1];
                        u32x4 w; w.x = pk2(v0[0], v0[1]); w.y = pk2(v0[2], v0[3]); w.z = pk2(v1[0], v1[1]); w.w = pk2(v1[2], v1[3]); *(u32x4*)(rowp + bj * HALF) = w; } } }
    }
};
struct EpiOutProj {
    static constexpr bool PERM = true;
    bf16_t* MX; const float* bias;
    __device__ __forceinline__ void operator()(const f32x4 (&acc)[2][2][4][2], const Unit& u, int wr, int wc, int fr, int fq) const {
        const int col0 = u.pn * BM + wc * 32 + 8 * fq;
        f32x4 bv[2][2];
#pragma unroll
        for (int bj = 0; bj < 2; ++bj)
#pragma unroll
            for (int n = 0; n < 2; ++n) bv[bj][n] = *(const f32x4*)(bias + col0 + bj * HALF + 4 * n);
#pragma unroll
        for (int ai = 0; ai < 2; ++ai)
#pragma unroll
            for (int m = 0; m < 4; ++m) { const int r = ai * HALF + wr * 64 + m * 16 + fr;
                if (r < u.mvalid) { bf16_t* rowp = MX + (size_t)(u.crow0 + r) * D + col0;
#pragma unroll
                    for (int bj = 0; bj < 2; ++bj) { const f32x4 v0 = acc[ai][bj][m][0] + bv[bj][0], v1 = acc[ai][bj][m][1] + bv[bj][1];
                        u32x4 w; w.x = pk2(v0[0], v0[1]); w.y = pk2(v0[2], v0[3]); w.z = pk2(v1[0], v1[1]); w.w = pk2(v1[2], v1[3]); *(u32x4*)(rowp + bj * HALF) = w; } } }
    }
};
struct EpiGateUp {
    static constexpr bool PERM = false;
    bf16_t* Hm;
    __device__ __forceinline__ void operator()(const f32x4 (&acc)[2][2][4][2], const Unit& u, int wr, int wc, int fr, int fq) const {
        const int col0 = u.pn * 128 + wc * 16 + 4 * fq;
#pragma unroll
        for (int ai = 0; ai < 2; ++ai)
#pragma unroll
            for (int m = 0; m < 4; ++m) { const int r = ai * HALF + wr * 64 + m * 16 + fr;
                if (r < u.mvalid) { bf16_t* rowp = Hm + (size_t)(u.crow0 + r) * DEXP + col0;
#pragma unroll
                    for (int bj = 0; bj < 2; ++bj) { const f32x4 g = acc[ai][bj][m][0], up = acc[ai][bj][m][1]; float o[4];
#pragma unroll
                        for (int j = 0; j < 4; ++j) o[j] = g[j] / (1.0f + __expf(-g[j])) * up[j];
                        u32x2 w; w.x = pk2(o[0], o[1]); w.y = pk2(o[2], o[3]); *(u32x2*)(rowp + bj * 64) = w; } } }
    }
};
struct EpiGateUp8 {
    static constexpr bool PERM = false;
    unsigned char* Hm;
    __device__ __forceinline__ void operator()(const f32x4 (&acc)[2][2][4][2], const Unit& u, int wr, int wc, int fr, int fq) const {
        const int col0 = u.pn * 128 + wc * 32 + 8 * fq;
#pragma unroll
        for (int ai = 0; ai < 2; ++ai)
#pragma unroll
            for (int m = 0; m < 4; ++m) { const int r = ai * HALF + wr * 64 + m * 16 + fr;
                if (r < u.mvalid) { int pk[2];
#pragma unroll
                    for (int bj = 0; bj < 2; ++bj) { const f32x4 g = acc[ai][bj][m][0] * (1.0f / 64.0f), up = acc[ai][bj][m][1] * (16.0f / 64.0f); float o[4];
#pragma unroll
                        for (int j = 0; j < 4; ++j) o[j] = g[j] / (1.0f + __expf(-g[j])) * up[j];
                        int q = __builtin_amdgcn_cvt_pk_fp8_f32(o[0], o[1], 0, false); pk[bj] = __builtin_amdgcn_cvt_pk_fp8_f32(o[2], o[3], q, true); }
                    *(u32x2*)(Hm + (size_t)(u.crow0 + r) * DEXP + col0) = (u32x2){(unsigned)pk[0], (unsigned)pk[1]}; } }
    }
};
struct EpiDown8 {
    static constexpr bool PERM = true;
    unsigned char* O;
    __device__ __forceinline__ void operator()(const f32x4 (&acc)[2][2][4][2], const Unit& u, int wr, int wc, int fr, int fq) const {
        const int col0 = u.pn * BM + wc * 32 + 8 * fq;
#pragma unroll
        for (int ai = 0; ai < 2; ++ai)
#pragma unroll
            for (int m = 0; m < 4; ++m) { const int r = ai * HALF + wr * 64 + m * 16 + fr;
                if (r < u.mvalid) { unsigned char* rowp = O + (size_t)(u.crow0 + r) * D + col0;
#pragma unroll
                    for (int bj = 0; bj < 2; ++bj) { const f32x4 v0 = acc[ai][bj][m][0] * (1.0f / 16.0f), v1 = acc[ai][bj][m][1] * (1.0f / 16.0f);
                        int p0 = __builtin_amdgcn_cvt_pk_fp8_f32(v0[0], v0[1], 0, false); p0 = __builtin_amdgcn_cvt_pk_fp8_f32(v0[2], v0[3], p0, true);
                        int p1 = __builtin_amdgcn_cvt_pk_fp8_f32(v1[0], v1[1], 0, false); p1 = __builtin_amdgcn_cvt_pk_fp8_f32(v1[2], v1[3], p1, true);
                        *(u32x2*)(rowp + bj * HALF) = (u32x2){(unsigned)p0, (unsigned)p1}; } } }
    }
};
struct EpiDown {
    static constexpr bool PERM = false;
    bf16_t* O;
    __device__ __forceinline__ void operator()(const f32x4 (&acc)[2][2][4][2], const Unit& u, int wr, int wc, int fr, int fq) const {
        const int col0 = u.pn * BM + wc * 32 + 4 * fq;
#pragma unroll
        for (int ai = 0; ai < 2; ++ai)
#pragma unroll
            for (int m = 0; m < 4; ++m) { const int r = ai * HALF + wr * 64 + m * 16 + fr;
                if (r < u.mvalid) { bf16_t* rowp = O + (size_t)(u.crow0 + r) * D + col0;
#pragma unroll
                    for (int bj = 0; bj < 2; ++bj)
#pragma unroll
                        for (int n = 0; n < 2; ++n) { const f32x4 v = acc[ai][bj][m][n]; u32x2 w; w.x = pk2i(v[0], v[1]); w.y = pk2i(v[2], v[3]); *(u32x2*)(rowp + bj * HALF + n * 16) = w; } } }
    }
};
}

struct Frame {
    LAS unsigned char* lds; volatile LAS unsigned* MISC; unsigned* ctl; unsigned char* ws;
    int tid, lane, wave, vcu, G;
};
__device__ __forceinline__ int opaque_v(int v) { asm volatile("" : "+v"(v)); return v; }
__device__ __forceinline__ unsigned char* launder_ws(unsigned char* p) { GAS unsigned char* q = (GAS unsigned char*)p; asm volatile("" : "+s"(q)); return (unsigned char*)q; }
struct Args { const float* in[36]; float* out; unsigned char* ws; int ph_lo, ph_hi; };
struct ArgsG { const GAS float* in_[36]; GAS float* out_; GAS unsigned char* ws_; int ph_lo, ph_hi;
 };
#define CAS __attribute__((address_space(4)))
__device__ __forceinline__ const CAS ArgsG* kargp() { const CAS ArgsG* p = (const CAS ArgsG*)__builtin_amdgcn_kernarg_segment_ptr(); asm volatile("" : "+s"(p)); return p; }
__device__ __forceinline__ const float* kin(int k) { return (const float*)kargp()->in_[k]; }
__device__ __forceinline__ float* kout() { return (float*)kargp()->out_; }

__device__ __forceinline__ void transpose64(const float* colp4, int ldw, int K, bf16_t* WT, int k0, int j0, LAS float* scr, int lane) {
    const int kr = lane >> 4, c4 = lane & 15;
    f32x4 t[16];
#pragma unroll
    for (int i = 0; i < 16; ++i) t[i] = colp4 ? *(const f32x4*)(colp4 + (size_t)(k0 + kr + 4 * i) * ldw) : (f32x4){0.f, 0.f, 0.f, 0.f};
    const int ch = lane >> 4, nr = lane & 15;
#pragma unroll
    for (int hf = 0; hf < 2; ++hf) {
#pragma unroll
        for (int i = 0; i < 8; ++i) { LAS float* d = scr + (kr + 4 * i) * 66 + 4 * c4; const f32x4 x = t[hf * 8 + i]; *(LAS f32x2*)d = (f32x2){x[0], x[1]}; *(LAS f32x2*)(d + 2) = (f32x2){x[2], x[3]}; }
        LDS_WAIT();
#pragma unroll
        for (int it = 0; it < 4; ++it) { const int n = nr + 16 * it; const LAS float* sp = scr + (8 * ch) * 66 + n;
            u32x4 o; o.x = pk2(sp[0], sp[66]); o.y = pk2(sp[2 * 66], sp[3 * 66]); o.z = pk2(sp[4 * 66], sp[5 * 66]); o.w = pk2(sp[6 * 66], sp[7 * 66]);
            *(u32x4*)(WT + (size_t)(j0 + n) * K + k0 + 32 * hf + 8 * ch) = o; }
        LDS_WAIT();
    }
}
__device__ __forceinline__ void transpose64_fp8(const float* colp4, int ldw, int K, unsigned char* WT, int k0, int j0, LAS float* scr, int lane) {
    const int kr = lane >> 4, c4 = lane & 15;
    f32x4 t[16];
#pragma unroll
    for (int i = 0; i < 16; ++i) t[i] = *(const f32x4*)(colp4 + (size_t)(k0 + kr + 4 * i) * ldw);
    const int ch = lane >> 5, nr = lane & 31;
#pragma unroll
    for (int hf = 0; hf < 2; ++hf) {
#pragma unroll
        for (int i = 0; i < 8; ++i) { LAS float* d = scr + (kr + 4 * i) * 66 + 4 * c4; const f32x4 x = t[hf * 8 + i]; *(LAS f32x2*)d = (f32x2){x[0], x[1]}; *(LAS f32x2*)(d + 2) = (f32x2){x[2], x[3]}; }
        LDS_WAIT();
#pragma unroll
        for (int it = 0; it < 2; ++it) { const int n = nr + 32 * it; const LAS float* sp = scr + (16 * ch) * 66 + n; int q[4];
#pragma unroll
            for (int g = 0; g < 4; ++g) { int pk = __builtin_amdgcn_cvt_pk_fp8_f32(sp[(4 * g) * 66] * 64.0f, sp[(4 * g + 1) * 66] * 64.0f, 0, false); q[g] = __builtin_amdgcn_cvt_pk_fp8_f32(sp[(4 * g + 2) * 66] * 64.0f, sp[(4 * g + 3) * 66] * 64.0f, pk, true); }
            *(u32x4*)(WT + (size_t)(j0 + n) * K + k0 + 32 * hf + 16 * ch) = (u32x4){(unsigned)q[0], (unsigned)q[1], (unsigned)q[2], (unsigned)q[3]}; }
        LDS_WAIT();
    }
}
__device__ __forceinline__ f32x4 ldg4(const float* p) { return *(const f32x4*)p; }
__device__ __forceinline__ f32x4 ldg4(const LAS float* p) { return *(const LAS f32x4*)p; }
template <bool HB8 = false, bool OUT_ONLY = false, class GP = const float*>
__device__ __forceinline__ void ln_wave_store(f32x4 (&v)[8], GP g, GP b, bf16_t* resrow, unsigned char* f8row, float* orow, int lane) {
    float s = 0.f;
#pragma unroll
    for (int j = 0; j < 8; ++j) s += (v[j][0] + v[j][1]) + (v[j][2] + v[j][3]);
    const float mean = wave_sum(s) * (1.0f / D);
    float q = 0.f;
#pragma unroll
    for (int j = 0; j < 8; ++j) { v[j] = v[j] - mean; q += (v[j][0] * v[j][0] + v[j][1] * v[j][1]) + (v[j][2] * v[j][2] + v[j][3] * v[j][3]); }
    const float rstd = rsqrtf(wave_sum(q) * (1.0f / D) + 1e-5f);
#pragma unroll
    for (int j = 0; j < 8; ++j) {
        const int i4 = lane + 64 * j;
        const f32x4 gv = ldg4(g + 4 * i4), bv = ldg4(b + 4 * i4);
        if (HB8 && (j & 1) == 0) __builtin_amdgcn_sched_barrier(0);
        const f32x4 o = v[j] * rstd * gv + bv;
        v[j] = o;
        if (OUT_ONLY) { if (orow) ((f32x4*)orow)[i4] = o; continue; }
        { u32x2 w; w.x = pk2(o[0], o[1]); w.y = pk2(o[2], o[3]); ((u32x2*)resrow)[i4] = w; }
        if (HB8) { int pk = __builtin_amdgcn_cvt_pk_fp8_f32(o[0], o[1], 0, false); pk = __builtin_amdgcn_cvt_pk_fp8_f32(o[2], o[3], pk, true); ((int*)f8row)[i4] = pk; }
        if (orow) ((f32x4*)orow)[i4] = o;
    }
}

__device__ __forceinline__ void hy_filter_item(Frame& F, int item, unsigned char* wsl);
__device__ __forceinline__ void hy_filter_tails(Frame& F, unsigned char* wsl);
__device__ __forceinline__ void p_prologue(Frame& F) {
    unsigned char* const wsl = launder_ws(F.ws); unsigned* const ctl = (unsigned*)(wsl + WS_CTL);
    LAS float* scr = (LAS float*)(F.lds + F.wave * 16384);
    const int gw = F.vcu * 8 + F.wave, NGW = F.G * 8, lane = F.lane;
    bf16_t* WIN = (bf16_t*)(wsl + WS_WIN); bf16_t* WOUT = (bf16_t*)(wsl + WS_WOUT); bf16_t* WGU = (bf16_t*)(wsl + WS_WGU); bf16_t* WD = (bf16_t*)(wsl + WS_WD);
    constexpr int I_IN = 32 * (INCP / 64), I_OUT = 32 * 32, I_GU = 32 * 32, I_D = 16 * 32;
    constexpr int N_IN = DEPTH * I_IN, N_OUT = DEPTH * I_OUT, N_GU = DEPTH * NEXP * I_GU, N_D = DEPTH * NEXP * I_D, N_TR = N_IN + N_OUT + N_GU + N_D;
    const int c4 = lane & 15, kr4 = lane >> 4;
    struct TrItem { const float* colp; unsigned char* wt; int ldw, K, k0, j0, f8; };
#define TR_DECODE(itv, d) do { int r_ = (itv); \
        if (r_ < N_IN) { const int ll = r_ / I_IN, q = r_ % I_IN, nb = q % (INCP / 64), kb = q / (INCP / 64); const int n = nb * 64 + 4 * c4; \
            d.colp = n < INC ? kin(4) + (size_t)ll * D * INC + n : nullptr; d.ldw = INC; d.K = D; d.wt = (unsigned char*)(WIN + (size_t)ll * INCP * D); d.k0 = kb * 64; d.j0 = nb * 64; d.f8 = 0; } \
        else if (r_ < N_IN + N_OUT) { r_ -= N_IN; const int ll = r_ / I_OUT, q = r_ % I_OUT, nb = q % 32, kb = q / 32; const int n = nb * 64 + 4 * c4; \
            d.colp = kin(23) + (size_t)ll * D * D + n; d.ldw = D; d.K = D; d.wt = (unsigned char*)(WOUT + (size_t)ll * D * D); d.k0 = kb * 64; d.j0 = nb * 64; d.f8 = 0; } \
        else if (r_ < N_IN + N_OUT + N_GU) { r_ -= N_IN + N_OUT; const int le = r_ / I_GU, q = r_ % I_GU, nb = q % 32, kb = q / 32; const int j = nb * 64 + 4 * c4; \
            const int pn = j >> 8, cp = j & 255, bj = cp >> 7, wc = (cp >> 5) & 3, nn = (cp >> 4) & 1, fq = (cp >> 2) & 3; const int hid = pn * 128 + wc * 32 + fq * 8 + bj * 4; \
            d.colp = (nn ? kin(32) : kin(31)) + (size_t)le * D * DEXP + hid; d.ldw = DEXP; d.K = D; d.wt = (unsigned char*)WGU + (size_t)le * 2048 * D; d.k0 = kb * 64; d.j0 = nb * 64; d.f8 = 1; } \
        else { r_ -= N_IN + N_OUT + N_GU; const int le = r_ / I_D, q = r_ % I_D, nb = q % 32, kb = q / 32; const int n = nb * 64 + 4 * c4; \
            d.colp = kin(33) + (size_t)le * DEXP * D + n; d.ldw = D; d.K = DEXP; d.wt = (unsigned char*)WD + (size_t)le * D * DEXP; d.k0 = kb * 64; d.j0 = nb * 64; d.f8 = 1; } } while (0)
#define TR_LOAD(d, t) do { _Pragma("unroll") for (int i = 0; i < 16; ++i) t[i] = d.colp ? *(const f32x4*)(d.colp + (size_t)(d.k0 + kr4 + 4 * i) * d.ldw) : (f32x4){0.f, 0.f, 0.f, 0.f}; } while (0)
    { int it = gw; TrItem dc, dn; f32x4 tc[16], tn[16];
      if (it < N_TR) { TR_DECODE(it, dc); TR_LOAD(dc, tc); }
      for (; it < N_TR; it += NGW) {
          const int itn = it + NGW;
          if (itn < N_TR) { TR_DECODE(itn, dn); TR_LOAD(dn, tn); }
#pragma unroll
          for (int hf = 0; hf < 2; ++hf) {
#pragma unroll
              for (int i = 0; i < 8; ++i) { LAS float* dd = scr + (kr4 + 4 * i) * 66 + 4 * c4; const f32x4 x = tc[hf * 8 + i]; *(LAS f32x2*)dd = (f32x2){x[0], x[1]}; *(LAS f32x2*)(dd + 2) = (f32x2){x[2], x[3]}; }
              LDS_WAIT();
              if (dc.f8) { const int ch = lane >> 5, nr = lane & 31;
#pragma unroll
                  for (int i2 = 0; i2 < 2; ++i2) { const int n = nr + 32 * i2; const LAS float* sp = scr + (16 * ch) * 66 + n; int q[4];
#pragma unroll
                      for (int g = 0; g < 4; ++g) { int pk = __builtin_amdgcn_cvt_pk_fp8_f32(sp[(4 * g) * 66] * 64.0f, sp[(4 * g + 1) * 66] * 64.0f, 0, false); q[g] = __builtin_amdgcn_cvt_pk_fp8_f32(sp[(4 * g + 2) * 66] * 64.0f, sp[(4 * g + 3) * 66] * 64.0f, pk, true); }
                      *(u32x4*)(dc.wt + (size_t)(dc.j0 + n) * dc.K + dc.k0 + 32 * hf + 16 * ch) = (u32x4){(unsigned)q[0], (unsigned)q[1], (unsigned)q[2], (unsigned)q[3]}; }
              } else { const int ch = lane >> 4, nr = lane & 15;
#pragma unroll
                  for (int i2 = 0; i2 < 4; ++i2) { const int n = nr + 16 * i2; const LAS float* sp = scr + (8 * ch) * 66 + n;
                      u32x4 o; o.x = pk2(sp[0], sp[66]); o.y = pk2(sp[2 * 66], sp[3 * 66]); o.z = pk2(sp[4 * 66], sp[5 * 66]); o.w = pk2(sp[6 * 66], sp[7 * 66]);
                      *(u32x4*)((bf16_t*)dc.wt + (size_t)(dc.j0 + n) * dc.K + dc.k0 + 32 * hf + 8 * ch) = o; } }
              LDS_WAIT();
          }
          dc = dn;
#pragma unroll
          for (int i = 0; i < 16; ++i) tc[i] = tn[i];
      } }
#undef TR_DECODE
#undef TR_LOAD
    { bf16_t* WR = (bf16_t*)(wsl + WS_WR);
      for (int idx = blockIdx.x * 512 + F.tid; idx < DEPTH * 64 * 2 * 64; idx += F.G * 512) {
          const int ln = idx & 63, t = (idx >> 6) & 1, sst = (idx >> 7) & 63, ll = idx >> 13, n = ln & 15, kg = ln >> 4, c = 16 * t + n;
          unsigned hi[8], lo[8];
#pragma unroll
          for (int j = 0; j < 8; ++j) { const int k = 32 * sst + 8 * kg + j;
              const float wv = c < 4 ? kin(27)[((size_t)ll * D + k) * 4 + c] : (c < 20 ? kin(29)[((size_t)ll * D + k) * 16 + c - 4] : 0.f);
              hi[j] = f2bf(wv); lo[j] = f2bf(wv - __builtin_bit_cast(float, hi[j] << 16)); }
          bf16_t* o = WR + ((size_t)ll * 256 + (sst * 2 + t) * 2) * 512 + ln * 8;
          *(u32x4*)o = (u32x4){hi[0] | (hi[1] << 16), hi[2] | (hi[3] << 16), hi[4] | (hi[5] << 16), hi[6] | (hi[7] << 16)};
          *(u32x4*)(o + 512) = (u32x4){lo[0] | (lo[1] << 16), lo[2] | (lo[3] << 16), lo[4] | (lo[5] << 16), lo[6] | (lo[7] << 16)}; } }
    hy_filter_tails(F, wsl);
    for (int it = blockIdx.x; it < DEPTH * 66; it += F.G) hy_filter_item(F, it, wsl);
    __syncthreads();
    bf16_t* hb = (bf16_t*)(wsl + WS_HB);
    for (int row = gw; row < T; row += NGW) {
        const int bb = row / L, p = row % L;
        const float* src = p < NMETA ? kin(1) + (size_t)p * D : kin(0) + ((size_t)bb * SEQ + (p - NMETA)) * D;
        f32x4 v[8];
#pragma unroll
        for (int j = 0; j < 8; ++j) v[j] = ((const f32x4*)src)[lane + 64 * j];
        ln_wave_store(v, kin(2), kin(3), hb + (size_t)row * D, nullptr, nullptr, lane);
    }
}


__device__ __forceinline__ void hy_filter_item(Frame& F, int item, unsigned char* wsl) {
    const int half = item & 1, blk = (item >> 1) % 33, l = item / 66, tid = F.tid;
    const float* w1 = kin(15) + (size_t)l * 33 * 64; const float* b1 = kin(16) + l * 64; const float* freq = kin(17) + l * 128;
    const float* w2 = kin(18) + (size_t)l * 64 * 64; const float* b2 = kin(19) + l * 64; const float* w3 = kin(20) + (size_t)l * 64 * 1024;
    LAS float* z = (LAS float*)F.lds;
    LAS float* h1 = z + 64 * 33;
    LAS float* h2 = h1 + 64 * 64;
    LAS bf16_t* ot = (LAS bf16_t*)(h2 + 64 * 64);
    const int d0 = blk * 64;
    __syncthreads();
    for (int e = tid; e < 64 * 33; e += 512) { const int pl = e / 33, k = e % 33, i = d0 + pl; float v;
        if (k == 0) v = (float)i / (float)(L - 1);
        else { const int j = (k - 1) & 15; const double band = 1e-4 + (double)j * ((15.0 - 1e-4) / 15.0); double turns = band * (double)i / (double)L; turns -= (double)(long long)turns;
               const float ang = (float)(turns * 6.283185307179586476925); v = k < 17 ? __cosf(ang) : -__sinf(ang); }
        z[e] = v; }
    __syncthreads();
    { const int j = tid & 63, pg = tid >> 6; const float fq = freq[j], bb = b1[j];
      float a[8];
#pragma unroll
      for (int r = 0; r < 8; ++r) a[r] = bb;
      for (int k = 0; k < 33; ++k) { const float w = w1[k * 64 + j];
#pragma unroll
          for (int r = 0; r < 8; ++r) a[r] += z[(pg * 8 + r) * 33 + k] * w; }
#pragma unroll
      for (int r = 0; r < 8; ++r) h1[(pg * 8 + r) * 64 + j] = __sinf(fq * a[r]); }
    __syncthreads();
    { const int j = tid & 63, pg = tid >> 6; const float fq = freq[64 + j], bb = b2[j];
      float a[8];
#pragma unroll
      for (int r = 0; r < 8; ++r) a[r] = bb;
      for (int k = 0; k < 64; ++k) { const float w = w2[k * 64 + j];
#pragma unroll
          for (int r = 0; r < 8; ++r) a[r] += h1[(pg * 8 + r) * 64 + k] * w; }
#pragma unroll
      for (int r = 0; r < 8; ++r) h2[(pg * 8 + r) * 64 + j] = __sinf(fq * a[r]); }
    __syncthreads();
    { const int c = tid;
      const float mind = logf(1e-2f) / 1.5f, maxd = logf(1e-2f) / 0.3f;
      const float adel = fabsf(mind + (float)c * ((maxd - mind) / 511.0f));
      for (int pq = 0; pq < 64; pq += 8) {
          float a[8];
#pragma unroll
          for (int r = 0; r < 8; ++r) a[r] = 0.f;
          for (int k = 0; k < 64; ++k) { const float w = w3[k * 1024 + half * 512 + c];
#pragma unroll
              for (int r = 0; r < 8; ++r) a[r] += h2[(pq + r) * 64 + k] * w; }
#pragma unroll
          for (int r = 0; r < 8; ++r) { const int i = d0 + pq + r; const float tt = (float)i / (float)(L - 1); ot[c * 66 + pq + r] = (bf16_t)f2bf(a[r] * __expf(-tt * adel)); } } }
    __syncthreads();
    { bf16_t* FG = (bf16_t*)(wsl + WS_FG) + (size_t)l * 512 * 2 * GLEN;
      const int dl = tid & 63, cg = tid >> 6, d = d0 + dl;
      if (d < L && !(half == 1 && d == 0)) {
          const int m = half ? GCEN + d : GCEN - d;
          for (int c = cg; c < 512; c += 8) { const bf16_t v = ot[c * 66 + dl]; bf16_t* row = FG + (size_t)c * 2 * GLEN; row[m] = v; row[GLEN + m - 1] = v; } } }
}
__device__ __forceinline__ void hy_filter_tails(Frame& F, unsigned char* wsl) {
    bf16_t* FG = (bf16_t*)(wsl + WS_FG);
    constexpr int LO0 = GCEN - (L - 1), HI0 = GCEN + (L - 1) + 1;
    constexpr int NT0 = LO0 + (GLEN - HI0), NT1 = (LO0 - 1) + (GLEN - (HI0 - 1));
    for (size_t idx = (size_t)blockIdx.x * 512 + F.tid; idx < (size_t)DEPTH * 512 * (NT0 + NT1); idx += (size_t)F.G * 512) {
        const int rowi = (int)(idx / (NT0 + NT1)); int k = (int)(idx % (NT0 + NT1));
        bf16_t* row = FG + (size_t)rowi * 2 * GLEN;
        if (k < NT0) { const int m = k < LO0 ? k : HI0 + (k - LO0); row[m] = 0; }
        else { k -= NT0; const int m = k < LO0 - 1 ? k : (HI0 - 1) + (k - (LO0 - 1)); row[GLEN + m] = 0; } }
}

constexpr int MIXC_SG = 98304, MIXC_CW = 102400, MIXC_CB = 120832, MIXC_HG = 98304;
__device__ __forceinline__ void hy_pre_item(Frame& F, int item, int l, unsigned char* wsl) {
    const bf16_t* U = (const bf16_t*)(wsl + WS_U);
    bf16_t* X0T = (bf16_t*)(wsl + WS_X0T); bf16_t* ZT = (bf16_t*)(wsl + WS_ZT);
    const LAS float* cw = (const LAS float*)(F.lds + MIXC_CW); const LAS float* cb = (const LAS float*)(F.lds + MIXC_CB);
    const int cc = item & 3, pt = (item >> 2) % 33, b = item / (4 * 33), tid = opaque_v(F.tid);
    const int c8 = tid & 15, pl = tid >> 4, c0 = cc * 128 + 8 * c8;
    LAS bf16_t* zt = (LAS bf16_t*)F.lds; LAS bf16_t* xt = zt + 128 * 72;
    __syncthreads();
    u32x4 raw[2][3][3];
#pragma unroll
    for (int ps = 0; ps < 2; ++ps) { const int p = pt * 64 + pl + 32 * ps; const bool pv = p < L;
#pragma unroll
        for (int g = 0; g < 3; ++g) { const bf16_t* ub = U + ((size_t)b * L + (pv ? p : 0)) * INC + O_CU + g * 512 + c0; const u32x4 z4 = (u32x4){0u, 0u, 0u, 0u};
            raw[ps][g][0] = (pv && p > 0) ? *(const u32x4*)(ub - INC) : z4; raw[ps][g][1] = pv ? *(const u32x4*)ub : z4; raw[ps][g][2] = (p + 1 < L) ? *(const u32x4*)(ub + INC) : z4; } }
#pragma unroll
    for (int ps = 0; ps < 2; ++ps) { const int p = pt * 64 + pl + 32 * ps; const bool pv = p < L;
        float uc[3][8];
#pragma unroll
        for (int g = 0; g < 3; ++g) { const int col = g * 512 + c0;
            const f32x4 wa0 = *(const LAS f32x4*)(cw + col), wa1 = *(const LAS f32x4*)(cw + col + 4), wb0 = *(const LAS f32x4*)(cw + 1536 + col), wb1 = *(const LAS f32x4*)(cw + 1536 + col + 4),
                        wc0 = *(const LAS f32x4*)(cw + 3072 + col), wc1 = *(const LAS f32x4*)(cw + 3072 + col + 4), bb0 = *(const LAS f32x4*)(cb + col), bb1 = *(const LAS f32x4*)(cb + col + 4);
            const u32x4 rm = raw[ps][g][0], r0 = raw[ps][g][1], rp = raw[ps][g][2];
#pragma unroll
            for (int j = 0; j < 4; ++j) {
                const float m0 = __builtin_bit_cast(float, rm[j] << 16), m1 = __builtin_bit_cast(float, rm[j] & 0xffff0000u), x0 = __builtin_bit_cast(float, r0[j] << 16), x1 = __builtin_bit_cast(float, r0[j] & 0xffff0000u),
                            q0 = __builtin_bit_cast(float, rp[j] << 16), q1 = __builtin_bit_cast(float, rp[j] & 0xffff0000u);
                const int e = 2 * j; const float w0a = e < 4 ? wa0[e & 3] : wa1[e & 3], w0b = e < 4 ? wb0[e & 3] : wb1[e & 3], w0c = e < 4 ? wc0[e & 3] : wc1[e & 3], b0_ = e < 4 ? bb0[e & 3] : bb1[e & 3];
                const float w1a = e < 4 ? wa0[(e + 1) & 3] : wa1[(e + 1) & 3], w1b = e < 4 ? wb0[(e + 1) & 3] : wb1[(e + 1) & 3], w1c = e < 4 ? wc0[(e + 1) & 3] : wc1[(e + 1) & 3], b1_ = e < 4 ? bb0[(e + 1) & 3] : bb1[(e + 1) & 3];
                uc[g][e] = pv ? (b0_ + m0 * w0a + x0 * w0b + q0 * w0c) : 0.f; uc[g][e + 1] = pv ? (b1_ + m1 * w1a + x1 * w1b + q1 * w1c) : 0.f; } }
#pragma unroll
        for (int j = 0; j < 8; ++j) { const int col = (pl + 32 * ps + 8 * (c8 & 7)) & 63;
            zt[(8 * c8 + j) * 72 + col] = (bf16_t)f2bf(uc[1][j] * uc[2][j]); xt[(8 * c8 + j) * 72 + col] = (bf16_t)f2bf(uc[0][j]); } }
    __syncthreads();
#pragma unroll
    for (int it = 0; it < 2; ++it) { const int cr = (tid >> 3) + 64 * it, pc = tid & 7;
      const size_t o = ((size_t)(cc * 128 + cr) * NB + b) * ZL + pt * 64 + pc * 8;
      const int pcs = (pc + ((cr >> 3) & 7)) & 7;
      *(u32x4*)(ZT + o) = *(const LAS u32x4*)(zt + cr * 72 + pcs * 8);
      *(u32x4*)(X0T + o) = *(const LAS u32x4*)(xt + cr * 72 + pcs * 8); }
}

__device__ __forceinline__ void hy_conv_phase(Frame& F, int l, unsigned char* wsl) {
    const bf16_t* ZT = (const bf16_t*)(wsl + WS_ZT); const bf16_t* X0T = (const bf16_t*)(wsl + WS_X0T); bf16_t* YT = (bf16_t*)(wsl + WS_YT);
    const bf16_t* FG = (const bf16_t*)(wsl + WS_FG) + (size_t)l * 512 * 2 * GLEN;
    const float* skip = kin(21) + l * 512;
    LAS unsigned char* Zs = F.lds;
    LAS unsigned char* Gs = F.lds + 8 * ZROW * 2;
    const int tid = F.tid, lane = F.lane, wave = F.wave;
    __syncthreads();
    for (int e = tid; e < 8 * ZROW * 2 / 16; e += 512) *(LAS u32x4*)(Zs + e * 16) = (u32x4){0u, 0u, 0u, 0u};
    const int pp = wave & 1, q = wave >> 1;
    const int T0 = 576 * q + 16 * pp, D0 = -(576 * q + 544 + 32 * pp), S0 = T0 + D0;
    const int n = lane & 15, kg = lane >> 4, bb = n & 7, u = n >> 3;
    const unsigned zb = (unsigned)(bb * ZROW * 2 + 2 * (ZOFF + S0 + 32 * u + 8 * kg));
    const int par = n & 1, e0 = GCEN + D0 + 8 * kg - n;
    const unsigned ab = (unsigned)(8 * ZROW * 2 + par * GLEN * 2 + 2 * (e0 - par));
    for (int c = F.vcu; c < 512; c += F.G) {
        __syncthreads();
        for (int e = tid; e < 8 * (ZL / 8); e += 512) { const int b = e / (ZL / 8), pc = e % (ZL / 8);
            *(LAS u32x4*)(Zs + (b * ZROW + ZOFF + pc * 8) * 2) = *(const u32x4*)(ZT + ((size_t)c * NB + b) * ZL + pc * 8); }
        for (int e = tid; e < 2 * GLEN / 8; e += 512) *(LAS u32x4*)(Gs + e * 16) = *(const u32x4*)(FG + (size_t)c * 2 * GLEN + e * 8);
        __syncthreads();
        f32x4 acc[9];
#pragma unroll
        for (int k = 0; k < 9; ++k) acc[k] = (f32x4){0.f, 0.f, 0.f, 0.f};
        bf16x8 ring[18];
#pragma unroll
        for (int s2 = 0; s2 < 17; ++s2) ring[s2] = *(const LAS bf16x8*)(F.lds + zb + 64 * s2);
        u32x4 an;
#pragma unroll
        for (int d = 0; d < 4; ++d) an[d] = *(const LAS unsigned*)(F.lds + ab + 4 * d);
        for (int jo = 0; jo < 5; ++jo) {
            const unsigned zo = zb + (unsigned)jo * 18u * 64u, ao = ab + (unsigned)jo * 18u * 64u;
#pragma unroll
            for (int jj = 0; jj < 18; ++jj) {
                const bf16x8 acur = __builtin_bit_cast(bf16x8, an);
                ring[(jj + 17) % 18] = *(const LAS bf16x8*)(F.lds + zo + 64 * (jj + 17));
#pragma unroll
                for (int d = 0; d < 4; ++d) an[d] = *(const LAS unsigned*)(F.lds + ao + 64 * (jj + 1) + 4 * d);
#pragma unroll
                for (int k = 0; k < 9; ++k) acc[k] = __builtin_amdgcn_mfma_f32_16x16x32_bf16(acur, ring[(jj + 2 * k) % 18], acc[k], 0, 0, 0);
            }
        }
        const float sk = skip[c];
#pragma unroll
        for (int k = 0; k < 9; ++k) { const int t = T0 + 64 * k + 32 * u + 4 * kg;
            if (t < L) { const size_t o = ((size_t)c * NB + bb) * ZL + t;
                const u32x2 xv = *(const u32x2*)(X0T + o); const u32x2 zv = *(const LAS u32x2*)(Zs + (bb * ZROW + ZOFF + t) * 2);
                float y[4];
                y[0] = __builtin_bit_cast(float, xv.x << 16) * (acc[k][0] + sk * __builtin_bit_cast(float, zv.x << 16));
                y[1] = __builtin_bit_cast(float, xv.x & 0xffff0000u) * (acc[k][1] + sk * __builtin_bit_cast(float, zv.x & 0xffff0000u));
                y[2] = __builtin_bit_cast(float, xv.y << 16) * (acc[k][2] + sk * __builtin_bit_cast(float, zv.y << 16));
                y[3] = __builtin_bit_cast(float, xv.y & 0xffff0000u) * (acc[k][3] + sk * __builtin_bit_cast(float, zv.y & 0xffff0000u));
                u32x2 w; w.x = pk2(y[0], y[1]); w.y = pk2(y[2], y[3]); *(u32x2*)(YT + o) = w; } }
    }
    __syncthreads();
}

__device__ __forceinline__ void hy_norm_item(Frame& F, int item, int l, unsigned char* wsl) {
    const bf16_t* YT = (const bf16_t*)(wsl + WS_YT); bf16_t* Y = (bf16_t*)(wsl + WS_Y); const LAS float* hg = (const LAS float*)(F.lds + MIXC_HG);
    const int pt = item % 33, b = item / 33, p0 = pt * 64, tid = opaque_v(F.tid);
    LAS bf16_t* tl = (LAS bf16_t*)F.lds;
    LAS float* part = (LAS float*)(F.lds + 512 * 72 * 2);
    LAS float* rsv = part + 512;
    __syncthreads();
#pragma unroll
    for (int it = 0; it < 8; ++it) { const int c = (tid >> 3) + 64 * it, pc = tid & 7;
        *(LAS u32x4*)(tl + c * 72 + pc * 8) = *(const u32x4*)(YT + ((size_t)c * NB + b) * ZL + p0 + pc * 8); }
    __syncthreads();
    { const int pos = tid & 63, cg = tid >> 6; float sacc = 0.f;
      for (int c = cg * 64; c < cg * 64 + 64; ++c) { const float v = bf2f(tl[c * 72 + pos]); sacc += v * v; }
      part[cg * 64 + pos] = sacc; }
    __syncthreads();
    if (tid < 64) { float sacc = 0.f;
#pragma unroll
        for (int g = 0; g < 8; ++g) sacc += part[g * 64 + tid];
        rsv[tid] = rsqrtf(sacc * (1.0f / 512.0f) + 1e-6f); }
    __syncthreads();
    { const int pos = tid >> 3, pc = tid & 7, p = p0 + pos;
      if (p < L) { const float rs = rsv[pos]; bf16_t* yrow = Y + ((size_t)b * L + p) * D + 1536;
#pragma unroll
          for (int it = 0; it < 8; ++it) { const int c = it * 64 + pc * 8; float v[8];
#pragma unroll
              for (int j = 0; j < 8; ++j) v[j] = bf2f(tl[(c + j) * 72 + pos]) * rs * hg[c + j];
              u32x4 w; w.x = pk2(v[0], v[1]); w.y = pk2(v[2], v[3]); w.z = pk2(v[4], v[5]); w.w = pk2(v[6], v[7]);
              *(u32x4*)(yrow + c) = w; } } }
}


constexpr int GS = 72;
constexpr int G_OP0 = 0, G_OP1 = 9216, G_VT = 18432, G_DEC = 36864, G_PART = 37376, G_W = 38400, G_ST = 49152;
typedef float f32x16 __attribute__((ext_vector_type(16)));
typedef short s16x4 __attribute__((ext_vector_type(4)));
__device__ __forceinline__ float logsigmoid_fast(float x) { return fminf(x, 0.f) - __logf(1.0f + __expf(-fabsf(x))); }
template <int N> __device__ __forceinline__ float row_shr_add(float v) { const int t = __builtin_amdgcn_update_dpp(0, __builtin_bit_cast(int, v), 0x110 + N, 0xf, 0xf, true); return v + __builtin_bit_cast(float, t); }
__device__ __forceinline__ float wave_incl_scan(float v, int lane) {
    v = row_shr_add<1>(v); v = row_shr_add<2>(v); v = row_shr_add<4>(v); v = row_shr_add<8>(v);
    { const int t = __builtin_amdgcn_update_dpp(0, __builtin_bit_cast(int, v), 0x142, 0xa, 0xf, false); v += __builtin_bit_cast(float, t); }
    { const int t = __builtin_amdgcn_update_dpp(0, __builtin_bit_cast(int, v), 0x143, 0xc, 0xf, false); v += __builtin_bit_cast(float, t); }
    return v;
}
__device__ __forceinline__ float lane_bcast63(float v) { return __builtin_bit_cast(float, __builtin_amdgcn_readlane(__builtin_bit_cast(int, v), 63)); }
__device__ __forceinline__ int crow16(int i, int hh) { return (i & 3) + 8 * (i >> 2) + 4 * hh; }
#define MFMA32(a, b, c) __builtin_amdgcn_mfma_f32_32x32x16_bf16((a), (b), (c), 0, 0, 0)
__device__ __forceinline__ void gla_passA_item(Frame& F, int item, int l, unsigned char* wsl) {
    const int n = item % GNC, bh = item / GNC, b = bh >> 2, h = bh & 3, tid = opaque_v(F.tid), w = F.wave, lane = tid & 63;
    LAS float* gw = (LAS float*)(F.lds + G_W);
    const bf16_t* U = (const bf16_t*)(wsl + WS_U);
    const int d0 = 8 * w, p = 64 * n - 48 + lane; const bool valid = p >= 0;
    const bf16_t* urow = U + ((size_t)b * L + (valid ? p : 0)) * INC;
    const u32x4 g0 = *(const u32x4*)(urow + O_GF), g1 = *(const u32x4*)(urow + O_GF + 8), g2 = *(const u32x4*)(urow + O_GB), g3 = *(const u32x4*)(urow + O_GB + 8);
    const u32x4 qraw = *(const u32x4*)(urow + O_AQ + h * 64 + d0), kraw = *(const u32x4*)(urow + O_AK + h * 64 + d0);
    const u32x4 v0 = *(const u32x4*)(urow + O_AV + h * 128 + 16 * w), v1 = *(const u32x4*)(urow + O_AV + h * 128 + 16 * w + 8);
    __syncthreads();
    for (int e = tid; e < 2176; e += 512) { float v;
        if (e < 2048) { const int dirw = e >> 10, rr = (e >> 6) & 15, d = e & 63; v = (dirw ? kin(8) : kin(6))[(size_t)l * 16 * 256 + rr * 256 + h * 64 + d]; }
        else { const int dirw = (e - 2048) >> 6, d = e & 63; v = (dirw ? kin(9) : kin(7))[l * 256 + h * 64 + d]; }
        gw[e] = v; }
    __syncthreads();
    float glf[16], glb[16];
    {
#pragma unroll
      for (int r = 0; r < 4; ++r) { glf[2 * r] = __builtin_bit_cast(float, g0[r] << 16); glf[2 * r + 1] = __builtin_bit_cast(float, g0[r] & 0xffff0000u); glf[8 + 2 * r] = __builtin_bit_cast(float, g1[r] << 16); glf[9 + 2 * r] = __builtin_bit_cast(float, g1[r] & 0xffff0000u);
          glb[2 * r] = __builtin_bit_cast(float, g2[r] << 16); glb[2 * r + 1] = __builtin_bit_cast(float, g2[r] & 0xffff0000u); glb[8 + 2 * r] = __builtin_bit_cast(float, g3[r] << 16); glb[9 + 2 * r] = __builtin_bit_cast(float, g3[r] & 0xffff0000u); } }
    float cF[8], cB[8], tF[8], tB[8];
#pragma unroll
    for (int dirw = 0; dirw < 2; ++dirw) {
        float x[8];
        { const f32x4 b0 = *(const LAS f32x4*)(gw + 2048 + dirw * 64 + d0), b1 = *(const LAS f32x4*)(gw + 2048 + dirw * 64 + d0 + 4);
#pragma unroll
          for (int j = 0; j < 4; ++j) { x[j] = b0[j]; x[4 + j] = b1[j]; } }
#pragma unroll
        for (int r = 0; r < 16; ++r) {
            const f32x4 a0 = *(const LAS f32x4*)(gw + dirw * 1024 + r * 64 + d0), a1 = *(const LAS f32x4*)(gw + dirw * 1024 + r * 64 + d0 + 4);
            const float g = dirw ? glb[r] : glf[r];
#pragma unroll
            for (int j = 0; j < 4; ++j) { x[j] += g * a0[j]; x[4 + j] += g * a1[j]; }
            if ((r & 3) == 3) asm volatile("" : "+v"(x[0]), "+v"(x[1]), "+v"(x[2]), "+v"(x[3]), "+v"(x[4]), "+v"(x[5]), "+v"(x[6]), "+v"(x[7]));
        }
#pragma unroll
        for (int dd = 0; dd < 8; ++dd) {
            const float lg = valid ? logsigmoid_fast(x[dd]) * (1.0f / 16.0f) : 0.f;
            const float ps = wave_incl_scan(lg, lane), tot = lane_bcast63(ps);
            if (dirw == 0) { cF[dd] = ps; tF[dd] = tot; } else { cB[dd] = tot - ps + lg; tB[dd] = tot; }

        }
    }
    LAS bf16_t* op0 = (LAS bf16_t*)(F.lds + G_OP0); LAS bf16_t* op1 = (LAS bf16_t*)(F.lds + G_OP1); LAS float* dec = (LAS float*)(F.lds + G_DEC);
    unsigned pq0[4], pq1[4], pq2[4], pq3[4];
#pragma unroll
    for (int dd = 0; dd < 8; ++dd) {
        const float qv = valid ? ((dd & 1) ? __builtin_bit_cast(float, qraw[dd >> 1] & 0xffff0000u) : __builtin_bit_cast(float, qraw[dd >> 1] << 16)) : 0.f;
        const float kv = valid ? ((dd & 1) ? __builtin_bit_cast(float, kraw[dd >> 1] & 0xffff0000u) : __builtin_bit_cast(float, kraw[dd >> 1] << 16)) : 0.f;
        op0[(d0 + dd) * GS + lane] = (bf16_t)f2bf(kv * __expf(tF[dd] - cF[dd]));
        op1[(d0 + dd) * GS + lane] = (bf16_t)f2bf(kv * __expf(tB[dd] - cB[dd]));
        if (lane == 0) { dec[d0 + dd] = __expf(tF[dd]); dec[64 + d0 + dd] = __expf(tB[dd]); }
        const unsigned a0 = f2bf(qv * 0.125f * __expf(cF[dd])), a1 = f2bf(kv * __expf(-cF[dd])), a2 = f2bf(qv * 0.125f * __expf(cB[dd])), a3 = f2bf(kv * __expf(-cB[dd]));
        if (dd & 1) { pq0[dd >> 1] |= a0 << 16; pq1[dd >> 1] |= a1 << 16; pq2[dd >> 1] |= a2 << 16; pq3[dd >> 1] |= a3 << 16; }
        else { pq0[dd >> 1] = a0; pq1[dd >> 1] = a1; pq2[dd >> 1] = a2; pq3[dd >> 1] = a3; }
    }
    { LAS bf16_t* st = (LAS bf16_t*)(F.lds + G_ST) + lane * GS + d0;
      *(LAS u32x4*)(st) = (u32x4){pq0[0], pq0[1], pq0[2], pq0[3]}; *(LAS u32x4*)(st + 64 * GS) = (u32x4){pq1[0], pq1[1], pq1[2], pq1[3]};
      *(LAS u32x4*)(st + 128 * GS) = (u32x4){pq2[0], pq2[1], pq2[2], pq2[3]}; *(LAS u32x4*)(st + 192 * GS) = (u32x4){pq3[0], pq3[1], pq3[2], pq3[3]}; }
    LAS bf16_t* vt = (LAS bf16_t*)(F.lds + G_VT);
    {
#pragma unroll
      for (int j = 0; j < 4; ++j) { const int dv = 16 * w + 2 * j;
          vt[dv * GS + lane] = valid ? (bf16_t)(v0[j] & 0xffffu) : (bf16_t)0; vt[(dv + 1) * GS + lane] = valid ? (bf16_t)(v0[j] >> 16) : (bf16_t)0;
          vt[(dv + 8) * GS + lane] = valid ? (bf16_t)(v1[j] & 0xffffu) : (bf16_t)0; vt[(dv + 9) * GS + lane] = valid ? (bf16_t)(v1[j] >> 16) : (bf16_t)0; } }
    __syncthreads();
    { bf16_t* gvt = (bf16_t*)(wsl + WS_GVT) + (size_t)item * 8192;
#pragma unroll
      for (int it = 0; it < 2; ++it) { const int e = it * 512 + tid, dv = e >> 3, pc = e & 7; *(u32x4*)(gvt + dv * 64 + pc * 8) = *(const LAS u32x4*)(vt + dv * GS + pc * 8); } }
    { bf16_t* gqk = (bf16_t*)(wsl + WS_GQK) + (size_t)item * 4 * 4096; const LAS bf16_t* st = (const LAS bf16_t*)(F.lds + G_ST);
#pragma unroll
      for (int it = 0; it < 4; ++it) { const int pos = tid >> 3, pc = tid & 7; *(u32x4*)(gqk + it * 4096 + pos * 64 + pc * 8) = *(const LAS u32x4*)(st + (it * 64 + pos) * GS + pc * 8); } }
    const int dir = w >> 2, dvb = w & 3, r = lane & 31, hh = lane >> 5;
    const LAS bf16_t* KL = (const LAS bf16_t*)(F.lds + (dir ? G_OP1 : G_OP0));
    f32x16 acc0, acc1;
#pragma unroll
    for (int i = 0; i < 16; ++i) { acc0[i] = 0.f; acc1[i] = 0.f; }
#pragma unroll
    for (int ks = 0; ks < 4; ++ks) {
        const bf16x8 a = *(const LAS bf16x8*)(vt + (32 * dvb + r) * GS + 16 * ks + 8 * hh);
        const bf16x8 b0 = *(const LAS bf16x8*)(KL + r * GS + 16 * ks + 8 * hh);
        const bf16x8 b1 = *(const LAS bf16x8*)(KL + (32 + r) * GS + 16 * ks + 8 * hh);
        acc0 = MFMA32(a, b0, acc0); acc1 = MFMA32(a, b1, acc1);
    }
    const int chain = (bh << 1) | dir;
    bf16_t* kvt = (bf16_t*)(wsl + WS_KVT) + ((size_t)chain * GNC + n) * 128 * 64;
#pragma unroll
    for (int i = 0; i < 16; ++i) { const int dv = 32 * dvb + crow16(i, hh); kvt[dv * 64 + r] = (bf16_t)f2bf(acc0[i]); kvt[dv * 64 + 32 + r] = (bf16_t)f2bf(acc1[i]); }
    if (tid < 128) { const int d = tid & 63, dd = tid >> 6; ((float*)(wsl + WS_DEC))[((size_t)((bh << 1) | dd) * GNC + n) * 64 + d] = ((const LAS float*)(F.lds + G_DEC))[dd * 64 + d]; }
}
__device__ __forceinline__ void gla_passB(Frame& F, unsigned char* wsl) {
    const bf16_t* KVT = (const bf16_t*)(wsl + WS_KVT); const float* DEC = (const float*)(wsl + WS_DEC); bf16_t* SPT = (bf16_t*)(wsl + WS_SPT);
    const int t0 = blockIdx.x * 512 + F.tid, tstride = F.G * 512;
    for (int t = t0; t < 64 * 4096; t += 2 * tstride) {
        const int tb = t + tstride; const bool hasb = tb < 64 * 4096; const int t2 = hasb ? tb : t;
        const int chA = t >> 12, remA = t & 4095, dvA = remA >> 5, dkA = (remA & 31) * 2, dirA = chA & 1;
        const int chB = t2 >> 12, remB = t2 & 4095, dvB = remB >> 5, dkB = (remB & 31) * 2, dirB = chB & 1;
        float a0 = 0.f, a1 = 0.f, b0 = 0.f, b1 = 0.f;
#pragma unroll 11
        for (int st = 0; st < GNC; ++st) { const int nA = dirA ? GNC - 1 - st : st, nB = dirB ? GNC - 1 - st : st;
            const size_t oA = (((size_t)chA * GNC + nA) * 128 + dvA) * 64 + dkA, oB = (((size_t)chB * GNC + nB) * 128 + dvB) * 64 + dkB;
            *(unsigned*)(SPT + oA) = pk2(a0, a1); if (hasb) *(unsigned*)(SPT + oB) = pk2(b0, b1);
            const unsigned kva_ = *(const unsigned*)(KVT + oA); const f32x2 kvA = (f32x2){__builtin_bit_cast(float, kva_ << 16), __builtin_bit_cast(float, kva_ & 0xffff0000u)}, dcA = *(const f32x2*)(DEC + ((size_t)chA * GNC + nA) * 64 + dkA);
            const unsigned kvb_ = *(const unsigned*)(KVT + oB); const f32x2 kvB = (f32x2){__builtin_bit_cast(float, kvb_ << 16), __builtin_bit_cast(float, kvb_ & 0xffff0000u)}, dcB = *(const f32x2*)(DEC + ((size_t)chB * GNC + nB) * 64 + dkB);
            a0 = dcA[0] * a0 + kvA[0]; a1 = dcA[1] * a1 + kvA[1]; b0 = dcB[0] * b0 + kvB[0]; b1 = dcB[1] * b1 + kvB[1]; }
    }
}
__device__ __forceinline__ void gla_passC_item(Frame& F, int item, int l, unsigned char* wsl) {
    constexpr int C_QD = 0, C_KI = 18432, C_SP = 36864, C_VT = 73728, C_PART = 92160, C_OS = 0, RB = GS * 2, OSS = 132;
    const int n = item % GNC, bh = item / GNC, b = bh >> 2, h = bh & 3;
    const int w = F.wave, tid = opaque_v(F.tid), lane = tid & 63, cb = w >> 2, dvb = w & 3, r = lane & 31, hh = lane >> 5;
    const bf16_t* gqk = (const bf16_t*)(wsl + WS_GQK) + (size_t)item * 4 * 4096;
    const bf16_t* gvt = (const bf16_t*)(wsl + WS_GVT) + (size_t)item * 8192;
    const bf16_t* spt0 = (const bf16_t*)(wsl + WS_SPT) + ((size_t)((bh << 1) | 0) * GNC + n) * 128 * 64;
    const bf16_t* spt1 = (const bf16_t*)(wsl + WS_SPT) + ((size_t)((bh << 1) | 1) * GNC + n) * 128 * 64;
    const bf16_t* U = (const bf16_t*)(wsl + WS_U); bf16_t* Y = (bf16_t*)(wsl + WS_Y);
    u32x4 raw[10], rgr[2];
#pragma unroll
    for (int it = 0; it < 4; ++it) raw[it] = *(const u32x4*)(gqk + it * 4096 + tid * 8);
    raw[4] = *(const u32x4*)(spt0 + tid * 8); raw[5] = *(const u32x4*)(spt0 + 4096 + tid * 8); raw[6] = *(const u32x4*)(spt1 + tid * 8); raw[7] = *(const u32x4*)(spt1 + 4096 + tid * 8);
    raw[8] = *(const u32x4*)(gvt + tid * 8); raw[9] = *(const u32x4*)(gvt + 4096 + tid * 8);
#pragma unroll
    for (int it = 0; it < 2; ++it) { const int e = it * 512 + tid, pos = e >> 4, p = 64 * n - 48 + pos;
        rgr[it] = *(const u32x4*)(U + ((size_t)b * L + max(p, 0)) * INC + O_AR + h * 128 + 8 * (e & 15)); }
    const float gv = (kin(10) + l * 512 + h * 128 + 32 * dvb)[r];
    { const int row = tid >> 3, pc = tid & 7; LAS unsigned char* dst = F.lds + row * RB + pc * 16;
      *(LAS u32x4*)(dst + C_QD) = raw[0]; *(LAS u32x4*)(dst + C_KI) = raw[1]; *(LAS u32x4*)(dst + C_QD + 64 * RB) = raw[2]; *(LAS u32x4*)(dst + C_KI + 64 * RB) = raw[3];
      *(LAS u32x4*)(dst + C_SP) = raw[4]; *(LAS u32x4*)(dst + C_SP + 64 * RB) = raw[5]; *(LAS u32x4*)(dst + C_SP + 128 * RB) = raw[6]; *(LAS u32x4*)(dst + C_SP + 192 * RB) = raw[7];
      *(LAS u32x4*)(dst + C_VT) = raw[8]; *(LAS u32x4*)(dst + C_VT + 64 * RB) = raw[9]; }
    __syncthreads();
    f32x16 o;
#pragma unroll
    for (int i = 0; i < 16; ++i) o[i] = 0.f;
    const LAS unsigned char* fb = F.lds + r * RB + 16 * hh;
    const LAS unsigned char* vb = F.lds + C_VT + (32 * dvb + r) * RB + 8 * hh;
#pragma unroll
    for (int dir = 0; dir < 2; ++dir) {
        bf16x8 qf[4];
#pragma unroll
        for (int ks = 0; ks < 4; ++ks) qf[ks] = *(const LAS bf16x8*)(fb + C_QD + (dir * 64 + 32 * cb) * RB + 32 * ks);
#pragma unroll
        for (int sb = 0; sb < 2; ++sb) {
            f32x16 X;
#pragma unroll
            for (int i = 0; i < 16; ++i) X[i] = 0.f;
#pragma unroll
            for (int ks = 0; ks < 4; ++ks) X = MFMA32(*(const LAS bf16x8*)(fb + C_KI + (dir * 64 + 32 * sb) * RB + 32 * ks), qf[ks], X);
            const int cidx = 32 * cb + r;
#pragma unroll
            for (int i = 0; i < 16; ++i) { const int sidx = 32 * sb + crow16(i, hh); const bool keep = dir ? (sidx > cidx) : (sidx <= cidx); X[i] = keep ? X[i] : 0.f; }
#pragma unroll
            for (int ks2 = 0; ks2 < 2; ++ks2) {
                u32x4 xp; xp.x = pk2(X[8 * ks2 + 0], X[8 * ks2 + 1]); xp.y = pk2(X[8 * ks2 + 2], X[8 * ks2 + 3]); xp.z = pk2(X[8 * ks2 + 4], X[8 * ks2 + 5]); xp.w = pk2(X[8 * ks2 + 6], X[8 * ks2 + 7]);
                const s16x4 vlo = *(const LAS s16x4*)(vb + (32 * sb + 16 * ks2) * 2), vhi = *(const LAS s16x4*)(vb + (32 * sb + 16 * ks2 + 8) * 2);
                o = MFMA32(__builtin_bit_cast(bf16x8, xp), __builtin_shufflevector(vlo, vhi, 0, 1, 2, 3, 4, 5, 6, 7), o);
            }
        }
#pragma unroll
        for (int ks = 0; ks < 4; ++ks) o = MFMA32(qf[ks], *(const LAS bf16x8*)(fb + C_SP + (dir * 128 + 32 * dvb) * RB + 32 * ks), o);
    }
    LAS float* part = (LAS float*)(F.lds + C_PART);
#pragma unroll
    for (int i = 0; i < 16; ++i) { float q = o[i] * o[i];
        q = row_shr_add<1>(q); q = row_shr_add<2>(q); q = row_shr_add<4>(q); q = row_shr_add<8>(q);
        const int qi = __builtin_bit_cast(int, q);
        const float s0 = __builtin_bit_cast(float, __builtin_amdgcn_readlane(qi, 15)) + __builtin_bit_cast(float, __builtin_amdgcn_readlane(qi, 31));
        const float s1 = __builtin_bit_cast(float, __builtin_amdgcn_readlane(qi, 47)) + __builtin_bit_cast(float, __builtin_amdgcn_readlane(qi, 63));
        if (r == 0) part[(cb * 4 + dvb) * 32 + crow16(i, hh)] = hh ? s1 : s0; }
    __syncthreads();
    LAS float* os = (LAS float*)(F.lds + C_OS);
#pragma unroll
    for (int i = 0; i < 16; ++i) { const int rw = crow16(i, hh);
        const float ss = (part[(cb * 4 + 0) * 32 + rw] + part[(cb * 4 + 1) * 32 + rw]) + (part[(cb * 4 + 2) * 32 + rw] + part[(cb * 4 + 3) * 32 + rw]);
        const float rs = rsqrtf(ss * (1.0f / 128.0f) + 1e-6f);
        os[(32 * cb + rw) * OSS + 32 * dvb + r] = o[i] * rs * gv; }
    __syncthreads();
#pragma unroll
    for (int it = 0; it < 2; ++it) { const int e = it * 512 + tid, pos = e >> 4, dv0 = 8 * (e & 15), p = 64 * n - 48 + pos;
        if (p >= 0) { const f32x4 a0 = *(const LAS f32x4*)(os + pos * OSS + dv0), a1 = *(const LAS f32x4*)(os + pos * OSS + dv0 + 4); const u32x4 g = rgr[it]; float y[8];
#pragma unroll
            for (int j = 0; j < 4; ++j) { const float g0 = __builtin_bit_cast(float, g[j] << 16), g1 = __builtin_bit_cast(float, g[j] & 0xffff0000u);
                const float x0 = j < 2 ? a0[2 * j] : a1[2 * j - 4], x1 = j < 2 ? a0[2 * j + 1] : a1[2 * j - 3];
                y[2 * j] = x0 * (g0 / (1.0f + __expf(-g0))); y[2 * j + 1] = x1 * (g1 / (1.0f + __expf(-g1))); }
            u32x4 wv; wv.x = pk2(y[0], y[1]); wv.y = pk2(y[2], y[3]); wv.z = pk2(y[4], y[5]); wv.w = pk2(y[6], y[7]);
            *(u32x4*)(Y + ((size_t)b * L + p) * D + h * 128 + dv0) = wv; } }
}

constexpr int SW_KS = 136, SW_VS = 36;
constexpr int SW_K = 0, SW_V = 2 * 2 * 32 * SW_KS * 2;
constexpr int SW_PART = SW_V + 2 * 2 * 128 * SW_VS * 2;
constexpr int SW_OS = 1032;
__device__ __forceinline__ void swa_item(Frame& F, int item, int l, unsigned char* wsl) {
    const bf16_t* U = (const bf16_t*)(wsl + WS_U); bf16_t* Y = (bf16_t*)(wsl + WS_Y);
    const int qb = item % 65, b = item / 65, q0 = 32 * qb, tid = opaque_v(F.tid), lane = tid & 63, w = F.wave, r = lane & 31, hh = lane >> 5;
    const int head = w, kvh = w >> 2, qp = q0 + r;
    const float slope = exp2f(-(float)(head + 1));
    const float sk = (kin(11) + l * 8)[head];
    bf16x8 Qf[8];
    { const bf16_t* qrow = U + ((size_t)b * L + min(qp, L - 1)) * INC + O_BQ + head * 128;
#pragma unroll
      for (int ks = 0; ks < 8; ++ks) Qf[ks] = *(const bf16x8*)(qrow + 16 * ks + 8 * hh); }
    f32x16 O[4];
#pragma unroll
    for (int db = 0; db < 4; ++db)
#pragma unroll
        for (int i = 0; i < 16; ++i) O[db][i] = 0.f;
    const float sc2 = 0.08838834764831845f * 1.4426950408889634f, slope2 = slope * 1.4426950408889634f;
    float m = sk * 1.4426950408889634f, lsum = hh == 0 ? 1.0f : 0.0f;
    const int tlo = max(1, qb - 4), thi = min(64, qb + 4), ntile = 1 + (thi - tlo + 1), nch = (ntile + 1) >> 1;
    LAS bf16_t* Ks = (LAS bf16_t*)(F.lds + SW_K); LAS bf16_t* Vs = (LAS bf16_t*)(F.lds + SW_V);
    u32x4 kx[2][4], vx[2][4];
#define SWA_FETCH(chn, par_) do { _Pragma("unroll") for (int it = 0; it < 4; ++it) { const int e = it * 512 + tid; const int key = e & 31, d8 = (e >> 5) & 15, kv2 = (e >> 9) & 1, sl_ = e >> 10; \
            const int ti_ = (chn) * 2 + sl_; const int tl_ = ti_ == 0 ? 0 : tlo + ti_ - 1; const int kp_ = min(32 * tl_ + key, L - 1); const bf16_t* krow = U + ((size_t)b * L + kp_) * INC; \
            const int kkey_ = (e >> 4) & 31, kd8_ = e & 15; const bf16_t* krow2 = U + ((size_t)b * L + min(32 * tl_ + kkey_, L - 1)) * INC;        \
            kx[par_][it] = *(const u32x4*)(krow2 + O_BK + kv2 * 128 + 8 * kd8_); vx[par_][it] = *(const u32x4*)(krow + O_BV + kv2 * 128 + 8 * d8); } } while (0)
    SWA_FETCH(0, 0);
    if (nch > 1) SWA_FETCH(1, 1);
    for (int c2 = 0; c2 < nch; c2 += 2) {
#pragma unroll
      for (int par = 0; par < 2; ++par) {
        const int ch = c2 + par; if (ch >= nch) break;
        __syncthreads();
#pragma unroll
        for (int it = 0; it < 4; ++it) { const int e = it * 512 + tid; const int key = e & 31, d8 = (e >> 5) & 15, kv2 = (e >> 9) & 1, sl = e >> 10;
            *(LAS u32x4*)(Ks + ((sl * 2 + kv2) * 32 + ((e >> 4) & 31)) * SW_KS + 8 * (e & 15)) = kx[par][it];
            LAS bf16_t* vb = Vs + ((sl * 2 + kv2) * 128 + 8 * d8) * SW_VS + key;
#pragma unroll
            for (int j = 0; j < 4; ++j) { vb[(2 * j) * SW_VS] = (bf16_t)(vx[par][it][j] & 0xffffu); vb[(2 * j + 1) * SW_VS] = (bf16_t)(vx[par][it][j] >> 16); } }
        if (ch + 2 < nch) SWA_FETCH(ch + 2, par);
        __syncthreads();
#pragma unroll 1
        for (int sl = 0; sl < 2; ++sl) {
            const int ti = ch * 2 + sl; if (ti >= ntile) break;
            const int tl = ti == 0 ? 0 : tlo + ti - 1, kp0 = 32 * tl;
            f32x16 S;
#pragma unroll
            for (int i = 0; i < 16; ++i) S[i] = 0.f;
            const LAS bf16_t* kt = Ks + ((sl * 2 + kvh) * 32 + r) * SW_KS + 8 * hh;
#pragma unroll
            for (int ks = 0; ks < 8; ++ks) { const bf16x8 a = *(const LAS bf16x8*)(kt + 16 * ks); S = MFMA32(a, Qf[ks], S); }
            float mx = -1e30f;
            const float fb = (float)(qp - kp0 - 4 * hh);
            if (tl != 0 && abs(qb - tl) <= 3 && tl < 64) {
#pragma unroll
                for (int i = 0; i < 16; ++i) { const float dist = fabsf(fb - (float)((i & 3) + 8 * (i >> 2))); const float sv = S[i] * sc2 - slope2 * dist; S[i] = sv; mx = fmaxf(mx, sv); }
            } else {
#pragma unroll
                for (int i = 0; i < 16; ++i) { const int kp = kp0 + crow16(i, hh); const float dist = fabsf(fb - (float)((i & 3) + 8 * (i >> 2)));
                    const bool ok = (tl == 0) ? (kp < NMETA || dist <= 128.f) : (kp < L && dist <= 128.f);
                    const float sv = ok ? S[i] * sc2 - slope2 * dist : -1e30f; S[i] = sv; mx = fmaxf(mx, sv); }
            }
            mx = fmaxf(mx, xor32(mx));
            float mn = m, alpha = 1.0f;
            if (__builtin_amdgcn_ballot_w64(mx - m > 8.0f) != 0ull) { mn = fmaxf(m, mx); alpha = __builtin_amdgcn_exp2f(m - mn); m = mn; }
            float ps = 0.f;
#pragma unroll
            for (int i = 0; i < 16; ++i) { const float pv = __builtin_amdgcn_exp2f(S[i] - mn); S[i] = pv; ps += pv; }
            lsum = lsum * alpha + ps;
            if (__builtin_amdgcn_ballot_w64(alpha != 1.0f) != 0ull) {
#pragma unroll
                for (int db = 0; db < 4; ++db)
#pragma unroll
                    for (int i = 0; i < 16; ++i) O[db][i] *= alpha; }
            const LAS bf16_t* vt = Vs + ((sl * 2 + kvh) * 128 + r) * SW_VS + 4 * hh;
#pragma unroll
            for (int ks2 = 0; ks2 < 2; ++ks2) {
                u32x4 xp; xp.x = pk2(S[8 * ks2 + 0], S[8 * ks2 + 1]); xp.y = pk2(S[8 * ks2 + 2], S[8 * ks2 + 3]); xp.z = pk2(S[8 * ks2 + 4], S[8 * ks2 + 5]); xp.w = pk2(S[8 * ks2 + 6], S[8 * ks2 + 7]);
                const bf16x8 pb = __builtin_bit_cast(bf16x8, xp);
#pragma unroll
                for (int db = 0; db < 4; ++db) {
                    const s16x4 lo = *(const LAS s16x4*)(vt + (32 * db) * SW_VS + 16 * ks2), hi = *(const LAS s16x4*)(vt + (32 * db) * SW_VS + 16 * ks2 + 8);
                    O[db] = MFMA32(__builtin_shufflevector(lo, hi, 0, 1, 2, 3, 4, 5, 6, 7), pb, O[db]); }
            }
        }
      }
    }
#undef SWA_FETCH
    const float lt = lsum + xor32(lsum), inv = 1.0f / lt;
    float ss = 0.f;
#pragma unroll
    for (int db = 0; db < 4; ++db)
#pragma unroll
        for (int i = 0; i < 16; ++i) { O[db][i] *= inv; ss += O[db][i] * O[db][i]; }
    ss += xor32(ss);
    __syncthreads();
    LAS float* part = (LAS float*)(F.lds + SW_PART); LAS bf16_t* os = (LAS bf16_t*)F.lds;
    if (hh == 0) part[w * 32 + r] = ss;
#pragma unroll
    for (int db = 0; db < 4; ++db)
#pragma unroll
        for (int g = 0; g < 4; ++g) { u32x2 pk; pk.x = pk2(O[db][4 * g], O[db][4 * g + 1]); pk.y = pk2(O[db][4 * g + 2], O[db][4 * g + 3]);
            *(LAS u32x2*)(os + r * SW_OS + w * 128 + 32 * db + 8 * g + 4 * hh) = pk; }
    __syncthreads();
    { const int q = tid >> 4, pc = tid & 15, p = q0 + q;
      if (p < L) { float tot = 0.f;
#pragma unroll
          for (int ww = 0; ww < 8; ++ww) tot += part[ww * 32 + q];
          const float rs = rsqrtf(tot * (1.0f / 1024.0f) + 1e-6f); const LAS float* sg = (const LAS float*)(F.lds + MIXC_SG); bf16_t* yrow = Y + ((size_t)b * L + p) * D + 512;
#pragma unroll
          for (int k = 0; k < 8; ++k) { const int c = 8 * pc + 128 * k; const u32x4 v = *(const LAS u32x4*)(os + q * SW_OS + c);
              const f32x4 g0 = *(const LAS f32x4*)(sg + c), g1 = *(const LAS f32x4*)(sg + c + 4); u32x4 o;
              o.x = pk2(__builtin_bit_cast(float, v.x << 16) * rs * g0[0], __builtin_bit_cast(float, v.x & 0xffff0000u) * rs * g0[1]);
              o.y = pk2(__builtin_bit_cast(float, v.y << 16) * rs * g0[2], __builtin_bit_cast(float, v.y & 0xffff0000u) * rs * g0[3]);
              o.z = pk2(__builtin_bit_cast(float, v.z << 16) * rs * g1[0], __builtin_bit_cast(float, v.z & 0xffff0000u) * rs * g1[1]);
              o.w = pk2(__builtin_bit_cast(float, v.w << 16) * rs * g1[2], __builtin_bit_cast(float, v.w & 0xffff0000u) * rs * g1[3]);
              *(u32x4*)(yrow + c) = o; } } }
}

__device__ __forceinline__ float logsigmoidf_(float x) { return fminf(x, 0.f) - log1pf(expf(-fabsf(x))); }

__device__ __forceinline__ int q_publish(Frame& F, int fetched) {
    LAS int* slot = (LAS int*)(F.lds + LDSCTL_OFF + 512);
    __syncthreads();
    if (F.tid == 0) *slot = fetched;
    __syncthreads();
    return *slot;
}
__device__ __forceinline__ void p_mix1(Frame& F, int l) {
    unsigned char* const wsl = launder_ws(F.ws);
    unsigned* const qw = (unsigned*)(wsl + WS_CTL) + CW_Q + (l * 4 + 0) * 64;
    constexpr int N_SWA = NB * 65, N_GLA = NB * 4 * GNC, N_HP = NB * 33 * 4, N_ALL = N_SWA + N_GLA + N_HP;
    int fetched = 0;
    if (F.tid == 0) fetched = (int)atomicAdd(qw, 1u);
    { const float* sgg = kin(12) + l * 1024; const float* cwg = kin(13) + (size_t)l * 3 * 1536; const float* cbg = kin(14) + l * 1536;
      if (F.tid < 256) *(LAS f32x4*)(F.lds + MIXC_SG + 16 * F.tid) = ((const f32x4*)sgg)[F.tid];
      for (int e = F.tid; e < 1152; e += 512) *(LAS f32x4*)(F.lds + MIXC_CW + 16 * e) = ((const f32x4*)cwg)[e];
      if (F.tid < 384) *(LAS f32x4*)(F.lds + MIXC_CB + 16 * F.tid) = ((const f32x4*)cbg)[F.tid]; }
    int u = q_publish(F, fetched);
    while (u < N_ALL) {
        if (F.tid == 0) fetched = (int)atomicAdd(qw, 1u);
        if (u < N_SWA) swa_item(F, u, l, wsl);
        else if (u < N_SWA + N_GLA) gla_passA_item(F, u - N_SWA, l, wsl);
        else hy_pre_item(F, u - N_SWA - N_GLA, l, wsl);
        u = q_publish(F, fetched);
    }
    __syncthreads();
}

__device__ __forceinline__ void p_mix2(Frame& F, int l) {
    unsigned char* const wsl = launder_ws(F.ws);
    gla_passB(F, wsl);
    hy_conv_phase(F, l, wsl);
}

__device__ __forceinline__ void p_mix3(Frame& F, int l) {
    unsigned char* const wsl = launder_ws(F.ws);
    unsigned* const qw = (unsigned*)(wsl + WS_CTL) + CW_Q + (l * 4 + 2) * 64;
    constexpr int N_GC = NB * 4 * GNC, N_HN = NB * 33, N_ALL = N_GC + N_HN;
    int fetched = 0;
    if (F.tid == 0) fetched = (int)atomicAdd(qw, 1u);
    if (F.tid < 128) *(LAS f32x4*)(F.lds + MIXC_HG + 16 * F.tid) = ((const f32x4*)(kin(22) + l * 512))[F.tid];
    int u = q_publish(F, fetched);
    while (u < N_ALL) {
        if (F.tid == 0) fetched = (int)atomicAdd(qw, 1u);
        if (u < N_HN) hy_norm_item(F, u, l, wsl);
        else gla_passC_item(F, u - N_HN, l, wsl);
        u = q_publish(F, fetched);
    }
    __syncthreads();
}

constexpr int R_RS = 2056;
constexpr int R_AH = 0, R_AL = 8 * R_RS * 2, R_PART = 2 * 8 * R_RS * 2, R_LG = R_PART + 8 * 8 * 32 * 4, R_LCNT = R_LG + 1024, R_REC = R_LCNT + 128;
template <bool DUMMY>
__device__ __forceinline__ void p_ln1_router(Frame& F, int l) {
    unsigned char* const wsl = launder_ws(F.ws); unsigned* const ctl = (unsigned*)(wsl + WS_CTL);
    const bf16_t* MX = (const bf16_t*)(wsl + WS_R1); const bf16_t* hin = (const bf16_t*)(wsl + WS_HB); bf16_t* h = (bf16_t*)(wsl + (DUMMY ? WS_DUM : WS_HB)); unsigned char* hb = wsl + (DUMMY ? WS_DUM + (size_t)T * D * 4 : WS_HB8);
    int* cnt = (int*)(ctl + CW_CNT + l * 512 + (DUMMY ? 256 : 0)); int* list = (int*)(wsl + (DUMMY ? WS_DUM + (size_t)T * D * 6 : WS_LIST));
    int* tok_e = (int*)(wsl + (DUMMY ? WS_DUM + (size_t)T * D * 6 + (size_t)NEXP * T * 4 : WS_TOKE)); int* tok_p = tok_e + (DUMMY ? 2 * T : (WS_TOKP - WS_TOKE) / 4); float* tok_w = (float*)(tok_e + (DUMMY ? 4 * T : (WS_TOKW - WS_TOKE) / 4));
    const LAS float* g = (const LAS float*)(F.lds + 81920); const LAS float* bt = g + D;
    { const float* gg = kin(25) + (size_t)l * D; const float* gb = kin(26) + (size_t)l * D; *(LAS f32x4*)(F.lds + 81920 + 16 * F.tid) = ((const f32x4*)gg)[F.tid]; *(LAS f32x4*)(F.lds + 81920 + 8192 + 16 * F.tid) = ((const f32x4*)gb)[F.tid]; }
    const LAS float* be = (const LAS float*)(F.lds + 81920 + 16384); const LAS float* bg = be + 16;
    if (F.tid < 16) ((LAS float*)(F.lds + 81920 + 16384))[F.tid] = (kin(30) + l * 16)[F.tid]; else if (F.tid < 20) ((LAS float*)(F.lds + 81920 + 16384))[F.tid] = (kin(28) + l * 4)[F.tid - 16];
    const bf16_t* wr = (const bf16_t*)(wsl + WS_WR) + (size_t)l * 256 * 512;
    const int lane = opaque_v(F.lane), w = F.wave, n = lane & 15, kg = lane >> 4;
    LAS bf16_t* AH = (LAS bf16_t*)(F.lds + R_AH); LAS bf16_t* AL = (LAS bf16_t*)(F.lds + R_AL); LAS float* PART = (LAS float*)(F.lds + R_PART); LAS float* LG = (LAS float*)(F.lds + R_LG);
    constexpr int NGRP = T / 8;
    bf16x8 wfr[8][4];
#pragma unroll
    for (int si = 0; si < 8; ++si) { const bf16_t* wp = wr + ((size_t)(8 * w + si) * 4 * 64 + lane) * 8;
#pragma unroll
        for (int q = 0; q < 4; ++q) wfr[si][q] = *(const bf16x8*)(wp + 512 * q); }
    LAS int* lcnt = (LAS int*)(F.lds + R_LCNT); LAS int* rec = (LAS int*)(F.lds + R_REC);
    if (F.tid < 32) lcnt[F.tid] = 0;
    int nloc = 0;
    f32x4 v[8];
    u32x2 hxr[8], mxr[8];
    int gi = F.vcu;
    if (gi < NGRP) {
#pragma unroll
        for (int j = 0; j < 8; ++j) { hxr[j] = ((const u32x2*)(hin + (size_t)(8 * gi + w) * D))[lane + 64 * j]; mxr[j] = ((const u32x2*)(MX + (size_t)(8 * gi + w) * D))[lane + 64 * j]; } }
    __syncthreads();
    for (; gi < NGRP; gi += F.G) {
        const int row = 8 * gi + w;
#pragma unroll
        for (int j = 0; j < 8; ++j) { const u32x2 hx = hxr[j], mx = j < 4 ? mxr[j] : ((const u32x2*)(MX + (size_t)row * D))[lane + 64 * j];
            v[j] = (f32x4){__builtin_bit_cast(float, hx.x << 16), __builtin_bit_cast(float, hx.x & 0xffff0000u), __builtin_bit_cast(float, hx.y << 16), __builtin_bit_cast(float, hx.y & 0xffff0000u)} * ALPHA
                 + (f32x4){__builtin_bit_cast(float, mx.x << 16), __builtin_bit_cast(float, mx.x & 0xffff0000u), __builtin_bit_cast(float, mx.y << 16), __builtin_bit_cast(float, mx.y & 0xffff0000u)}; }
        ln_wave_store<true>(v, g, bt, h + (size_t)row * D, hb + (size_t)row * D, nullptr, lane);
#pragma unroll
        for (int j = 0; j < 8; ++j) { const unsigned h01 = pk2(v[j][0], v[j][1]), h23 = pk2(v[j][2], v[j][3]);
            const unsigned l01 = pk2(v[j][0] - __builtin_bit_cast(float, h01 << 16), v[j][1] - __builtin_bit_cast(float, h01 & 0xffff0000u)), l23 = pk2(v[j][2] - __builtin_bit_cast(float, h23 << 16), v[j][3] - __builtin_bit_cast(float, h23 & 0xffff0000u));
            *(LAS u32x2*)(AH + w * R_RS + (lane + 64 * j) * 4) = (u32x2){h01, h23};
            *(LAS u32x2*)(AL + w * R_RS + (lane + 64 * j) * 4) = (u32x2){l01, l23}; }
        asm volatile("" ::: "memory");
        { const int gn = gi + F.G;
          if (gn < NGRP) {
#pragma unroll
            for (int j = 0; j < 8; ++j) { hxr[j] = ((const u32x2*)(hin + (size_t)(8 * gn + w) * D))[lane + 64 * j]; if (j < 4) mxr[j] = ((const u32x2*)(MX + (size_t)(8 * gn + w) * D))[lane + 64 * j]; } } }
        __syncthreads();
        f32x4 a0 = (f32x4){0.f, 0.f, 0.f, 0.f}, a1 = (f32x4){0.f, 0.f, 0.f, 0.f};
        { const LAS bf16_t* ah = AH + (n & 7) * R_RS + 8 * kg; const LAS bf16_t* al = AL + (n & 7) * R_RS + 8 * kg;
#pragma unroll
          for (int si = 0; si < 8; ++si) { const int st = 8 * w + si;
              const bf16x8 xh = *(const LAS bf16x8*)(ah + 32 * st), xl = *(const LAS bf16x8*)(al + 32 * st);
              const bf16x8 bh0 = wfr[si][0], bl0 = wfr[si][1], bh1 = wfr[si][2], bl1 = wfr[si][3];
              a0 = __builtin_amdgcn_mfma_f32_16x16x32_bf16(xh, bh0, a0, 0, 0, 0); a0 = __builtin_amdgcn_mfma_f32_16x16x32_bf16(xh, bl0, a0, 0, 0, 0); a0 = __builtin_amdgcn_mfma_f32_16x16x32_bf16(xl, bh0, a0, 0, 0, 0);
              a1 = __builtin_amdgcn_mfma_f32_16x16x32_bf16(xh, bh1, a1, 0, 0, 0); a1 = __builtin_amdgcn_mfma_f32_16x16x32_bf16(xh, bl1, a1, 0, 0, 0); a1 = __builtin_amdgcn_mfma_f32_16x16x32_bf16(xl, bh1, a1, 0, 0, 0);
              if (si == 3) __builtin_amdgcn_sched_barrier(0); } }
        if (kg < 2) {
#pragma unroll
            for (int r = 0; r < 4; ++r) { PART[(w * 8 + 4 * kg + r) * 32 + n] = a0[r]; PART[(w * 8 + 4 * kg + r) * 32 + 16 + n] = a1[r]; } }
        __syncthreads();
        if (lane < 32) { float sacc = 0.f;
#pragma unroll
            for (int ww = 0; ww < 8; ++ww) sacc += PART[(ww * 8 + w) * 32 + lane];
            LG[w * 32 + lane] = sacc; }
        LDS_WAIT();
        if (lane == 0) {
            const f32x4 l0 = *(const LAS f32x4*)(LG + w * 32), l1 = *(const LAS f32x4*)(LG + w * 32 + 4), l2 = *(const LAS f32x4*)(LG + w * 32 + 8), l3 = *(const LAS f32x4*)(LG + w * 32 + 12), l4 = *(const LAS f32x4*)(LG + w * 32 + 16);
            float gl[4];
#pragma unroll
            for (int j = 0; j < 4; ++j) gl[j] = l0[j] + bg[j];
            int gsel = 0; float gm = gl[0];
#pragma unroll
            for (int j = 1; j < 4; ++j) if (gl[j] > gm) { gm = gl[j]; gsel = j; }
            float den = 0.f;
#pragma unroll
            for (int j = 0; j < 4; ++j) den += expf(gl[j] - gm);
            const float gtop = 1.0f / den;
            float el[4];
            const float k0 = gsel == 0 ? 1.f : 0.f, k1 = gsel == 1 ? 1.f : 0.f, k2 = gsel == 2 ? 1.f : 0.f, k3 = gsel == 3 ? 1.f : 0.f;
#pragma unroll
            for (int j = 0; j < 4; ++j) el[j] = (k0 * l1[j] + k1 * l2[j]) + (k2 * l3[j] + k3 * l4[j]) + be[gsel * 4 + j];
            int i1 = 0; float m1 = el[0];
#pragma unroll
            for (int j = 1; j < 4; ++j) if (el[j] > m1) { m1 = el[j]; i1 = j; }
            int i2 = -1; float m2 = -3.0e38f;
#pragma unroll
            for (int j = 0; j < 4; ++j) if (j != i1 && el[j] > m2) { m2 = el[j]; i2 = j; }
            const float ex = expf(m2 - m1); const float w1 = gtop / (1.0f + ex), w2 = gtop * ex / (1.0f + ex);
            const int e1 = gsel * 4 + i1, e2 = gsel * 4 + i2;
            const int li1 = __hip_atomic_fetch_add(lcnt + e1, 1, __ATOMIC_RELAXED, __HIP_MEMORY_SCOPE_WORKGROUP), li2 = __hip_atomic_fetch_add(lcnt + e2, 1, __ATOMIC_RELAXED, __HIP_MEMORY_SCOPE_WORKGROUP);
            const int k = nloc * 8 + w; rec[4 * k] = row; rec[4 * k + 1] = e1 | (e2 << 8); rec[4 * k + 2] = li1; rec[4 * k + 3] = li2;
            tok_e[2 * row] = e1; tok_e[2 * row + 1] = e2; tok_w[2 * row] = w1; tok_w[2 * row + 1] = w2;
        }
        ++nloc;
    }
    __syncthreads();
    if (F.tid < 16) { const int c = lcnt[F.tid]; lcnt[16 + F.tid] = c ? atomicAdd(&cnt[16 * F.tid], c) : 0; }
    __syncthreads();
    if (F.tid < nloc * 8) { const int row = rec[4 * F.tid], ee = rec[4 * F.tid + 1], e1 = ee & 255, e2 = ee >> 8;
        const int p1 = lcnt[16 + e1] + rec[4 * F.tid + 2], p2 = lcnt[16 + e2] + rec[4 * F.tid + 3];
        list[(size_t)e1 * T + p1] = row; list[(size_t)e2 * T + p2] = row; tok_p[2 * row] = p1; tok_p[2 * row + 1] = p2; }
    __syncthreads();
}

__device__ __forceinline__ void moe_table(Frame& F, int l) {
    LAS int* tab = (LAS int*)(F.lds + LDSCTL_OFF + 256);
    unsigned* const ctl = (unsigned*)(launder_ws(F.ws) + WS_CTL);
    const int* cnt = (const int*)(ctl + CW_CNT + l * 512);
    __syncthreads();
    if (F.tid < 16) tab[F.tid] = __hip_atomic_load(cnt + 16 * F.tid, __ATOMIC_RELAXED, __HIP_MEMORY_SCOPE_AGENT);
    __syncthreads();
    if (F.tid == 0) { int pp = 0;
        for (int e = 0; e < 16; ++e) { const int c = tab[e]; tab[16 + e] = pp; tab[33 + e] = pp * 256; pp += (c + 255) >> 8; }
        tab[32] = pp; }
    __syncthreads();
}

template <bool DUMMY>
__device__ __forceinline__ void p_ln2(Frame& F, int l) {
    unsigned char* const wsl = launder_ws(F.ws);
    bf16_t* hb = (bf16_t*)(wsl + WS_HB); const unsigned char* O = (const unsigned char*)(wsl + WS_O);
    const int* tok_e = (const int*)(wsl + WS_TOKE); const int* tok_p = (const int*)(wsl + WS_TOKP); const float* tok_w = (const float*)(wsl + WS_TOKW);
    const LAS int* tab = (const LAS int*)(F.lds + LDSCTL_OFF + 256);
    const LAS float* g = (const LAS float*)(F.lds + 65536); const LAS float* bt = g + D;
    { const float* gg = kin(34) + (size_t)l * D; const float* gb = kin(35) + (size_t)l * D; *(LAS f32x4*)(F.lds + 65536 + 16 * F.tid) = ((const f32x4*)gg)[F.tid]; *(LAS f32x4*)(F.lds + 65536 + 8192 + 16 * F.tid) = ((const f32x4*)gb)[F.tid]; }
    __syncthreads();
    const int gw = F.vcu * 8 + F.wave, NGW = F.G * 8, lane = opaque_v(F.lane);
    u32x2 hv[8]; int oa[8], ob[8]; float w0 = 0.f, w1 = 0.f;
    int te0 = 0, te1 = 0, tp0 = 0, tp1 = 0; float tw0 = 0.f, tw1 = 0.f;
    { const int rk = gw + lane * NGW; if (lane < 16 && rk < T) { te0 = tok_e[2 * rk]; te1 = tok_e[2 * rk + 1]; tp0 = tok_p[2 * rk]; tp1 = tok_p[2 * rk + 1]; tw0 = tok_w[2 * rk]; tw1 = tok_w[2 * rk + 1]; } }
    int kk = 0;
#define LN2_ISSUE(rw) do { const int e0_ = __builtin_amdgcn_readlane(te0, kk), e1_ = __builtin_amdgcn_readlane(te1, kk); \
        const size_t r0_ = (size_t)(tab[33 + e0_] + __builtin_amdgcn_readlane(tp0, kk)), r1_ = (size_t)(tab[33 + e1_] + __builtin_amdgcn_readlane(tp1, kk)); \
        w0 = __builtin_bit_cast(float, __builtin_amdgcn_readlane(__builtin_bit_cast(int, tw0), kk)) * (1.0f / 64.0f); w1 = __builtin_bit_cast(float, __builtin_amdgcn_readlane(__builtin_bit_cast(int, tw1), kk)) * (1.0f / 64.0f); ++kk; \
        _Pragma("unroll") for (int j = 0; j < 8; ++j) { const int i4 = lane + 64 * j; hv[j] = ((const u32x2*)(hb + (size_t)(rw) * D))[i4]; oa[j] = ((const int*)(O + r0_ * D))[i4]; ob[j] = ((const int*)(O + r1_ * D))[i4]; } } while (0)
    int row = gw;
    if (row < T) LN2_ISSUE(row);
    for (; row < T; row += NGW) {
        f32x4 v[8];
#pragma unroll
        for (int j = 0; j < 8; ++j) { f32x4 m;
            const f32x2 a01 = __builtin_amdgcn_cvt_pk_f32_fp8(oa[j], false), a23 = __builtin_amdgcn_cvt_pk_f32_fp8(oa[j], true), b01 = __builtin_amdgcn_cvt_pk_f32_fp8(ob[j], false), b23 = __builtin_amdgcn_cvt_pk_f32_fp8(ob[j], true);
            m[0] = w0 * a01[0] + w1 * b01[0]; m[1] = w0 * a01[1] + w1 * b01[1]; m[2] = w0 * a23[0] + w1 * b23[0]; m[3] = w0 * a23[1] + w1 * b23[1];
            v[j] = (f32x4){__builtin_bit_cast(float, hv[j].x << 16), __builtin_bit_cast(float, hv[j].x & 0xffff0000u), __builtin_bit_cast(float, hv[j].y << 16), __builtin_bit_cast(float, hv[j].y & 0xffff0000u)} * ALPHA + m; }
        const int nrow = row + NGW;
        if (nrow < T) LN2_ISSUE(nrow);
        float* orow = nullptr;
        if (l == DEPTH - 1) { const int bb = row / L, pp = row % L; if (pp >= NMETA) orow = kout() + ((size_t)bb * SEQ + (pp - NMETA)) * D; }
        if (DUMMY) ln_wave_store(v, g, bt, (bf16_t*)(wsl + WS_DUM) + (size_t)row * D, nullptr, nullptr, lane);
        else if (l == DEPTH - 1) ln_wave_store<false, true>(v, g, bt, nullptr, nullptr, orow, lane);
        else ln_wave_store(v, g, bt, hb + (size_t)row * D, nullptr, orow, lane);
    }
#undef LN2_ISSUE
}


__device__ __forceinline__ void outproj_tail(Frame& F, int l, unsigned char* wsl) {
    if (F.vcu >= 128) return;
    const bf16_t* Yb = (const bf16_t*)(wsl + WS_Y) + (size_t)16384 * D; const bf16_t* Wt = (const bf16_t*)(wsl + WS_WOUT) + (size_t)l * D * D + (size_t)(16 * F.vcu) * D;
    const int lane = opaque_v(F.lane), w = F.wave, n = lane & 15, kg = lane >> 4;
    f32x4 acc[8];
#pragma unroll
    for (int mb = 0; mb < 8; ++mb) acc[mb] = (f32x4){0.f, 0.f, 0.f, 0.f};
    const bf16_t* ap = Yb + (size_t)n * D + 256 * w + 8 * kg; const bf16_t* bp = Wt + (size_t)n * D + 256 * w + 8 * kg;
#pragma unroll 2
    for (int ks = 0; ks < 8; ++ks) {
        const bf16x8 bfr = *(const bf16x8*)(bp + 32 * ks);
        bf16x8 af[8];
#pragma unroll
        for (int mb = 0; mb < 8; ++mb) af[mb] = *(const bf16x8*)(ap + (size_t)(16 * mb) * D + 32 * ks);
#pragma unroll
        for (int mb = 0; mb < 8; ++mb) acc[mb] = __builtin_amdgcn_mfma_f32_16x16x32_bf16(af[mb], bfr, acc[mb], 0, 0, 0);
    }
    LAS f32x4* red = (LAS f32x4*)F.lds;
    __syncthreads();
#pragma unroll
    for (int mb = 0; mb < 8; ++mb) red[(w * 8 + mb) * 64 + lane] = acc[mb];
    __syncthreads();
    { const int mb = F.tid >> 6;
      f32x4 sacc = red[(0 * 8 + mb) * 64 + lane];
#pragma unroll
      for (int ww = 1; ww < 8; ++ww) sacc += red[(ww * 8 + mb) * 64 + lane];
      const int col = 16 * F.vcu + n; const float bias = (kin(24) + (size_t)l * D)[col];
      bf16_t* MX = (bf16_t*)(wsl + WS_R1);
#pragma unroll
      for (int r = 0; r < 4; ++r) { const size_t o = (size_t)(16384 + 16 * mb + 4 * kg + r) * D + col; MX[o] = (bf16_t)f2bf(sacc[r] + bias); } }
    __syncthreads();
}

#ifndef REP_LN
#define REP_LN 1
#endif
#ifndef REP_PRO
#define REP_PRO 1
#endif
#ifndef REP_MIX
#define REP_MIX 1
#endif
#ifndef REP_GEMM
#define REP_GEMM 1
#endif
#define IN(k) (lo <= (k) && (k) < hi)
#define SEAM(k) do { if (IN(k) && IN((k) + 1)) xcd_barrier(bar); } while (0)
template <int l>
__device__ __forceinline__ void run_layer(Frame& F, const int lo, const int hi, const XcdBarrier& bar) {
        const int P = 1 + l * NPH;
        if (IN(P + 0)) {
            unsigned char* const wsl = launder_ws(F.ws);
            pg::PlainSched S; S.init(MPAD / 256, INCP / 256, F.G, (int)blockIdx.x);
            pg::EpiInProj E{(bf16_t*)(wsl + WS_U), kin(5) + (size_t)l * INC};
            for (int rep = 0; rep < REP_GEMM; ++rep) pg::gemm_phase<false>(F.lds, wsl + WS_HB, (const bf16_t*)(wsl + WS_WIN) + (size_t)l * INCP * D, D, S, E);
        }
        SEAM(P + 0);
        if (IN(P + 1)) for (int rep = 0; rep < REP_MIX; ++rep) p_mix1(F, l);
        SEAM(P + 1);
        if (IN(P + 2)) for (int rep = 0; rep < REP_MIX; ++rep) p_mix2(F, l);
        SEAM(P + 2);
        if (IN(P + 3)) for (int rep = 0; rep < REP_MIX; ++rep) p_mix3(F, l);
        SEAM(P + 3);
        if (IN(P + 4)) {
            unsigned char* const wsl = launder_ws(F.ws);
            pg::PlainSched S; S.init(64, D / 256, F.G, (int)blockIdx.x);
            pg::EpiOutProj E{(bf16_t*)(wsl + WS_R1), kin(24) + (size_t)l * D};
            for (int rep = 0; rep < REP_GEMM; ++rep) pg::gemm_phase<false>(F.lds, wsl + WS_Y, (const bf16_t*)(wsl + WS_WOUT) + (size_t)l * D * D, D, S, E);
            outproj_tail(F, l, wsl);
        }
        SEAM(P + 4);
        if (IN(P + 5)) { if (REP_LN > 1) p_ln1_router<true>(F, l); p_ln1_router<false>(F, l); }
        SEAM(P + 5);
        if (IN(P + 6)) {
            moe_table(F, l);
            unsigned char* const wsl = launder_ws(F.ws);
            pg::MoeSched S; S.tab = (const LAS int*)(F.lds + LDSCTL_OFF + 256); S.list = (const int*)(wsl + WS_LIST); S.nN = 8; S.G = F.G; S.c = F.vcu; S.gather = 1; S.nrowsB = 2048;
            pg::EpiGateUp8 E{(unsigned char*)(wsl + WS_HM)};
            for (int rep = 0; rep < REP_GEMM; ++rep) pg::gemm_phase<true>(F.lds, wsl + WS_HB8, wsl + WS_WGU + (size_t)l * NEXP * 2048 * D, D / 2, S, E);
        }
        SEAM(P + 6);
        if (IN(P + 7)) {
            moe_table(F, l);
            unsigned char* const wsl = launder_ws(F.ws);
            pg::MoeSched S; S.tab = (const LAS int*)(F.lds + LDSCTL_OFF + 256); S.list = nullptr; S.nN = 8; S.G = F.G; S.c = F.vcu; S.gather = 0; S.nrowsB = 2048;
            pg::EpiDown8 E{(unsigned char*)(wsl + WS_O)};
            for (int rep = 0; rep < REP_GEMM; ++rep) pg::gemm_phase<true>(F.lds, wsl + WS_HM, wsl + WS_WD + (size_t)l * NEXP * D * DEXP, DEXP / 2, S, E);
        }
        SEAM(P + 7);
        if (IN(P + 8)) { moe_table(F, l); if (REP_LN > 1) p_ln2<true>(F, l); p_ln2<false>(F, l); }
        SEAM(P + 8);
}

__global__ void __launch_bounds__(512, 2) mk_fwd(Args args) {
    extern __shared__ __attribute__((aligned(16))) unsigned char lds_raw[];
    Frame F;
    F.lds = (LAS unsigned char*)lds_raw;
    F.MISC = (volatile LAS unsigned*)(F.lds + MISC_OFF);
    F.tid = threadIdx.x; F.lane = F.tid & 63; F.wave = __builtin_amdgcn_readfirstlane(F.tid >> 6);
    F.G = gridDim.x; { const int bx = blockIdx.x; F.vcu = (F.G % 8 == 0) ? (bx % 8) * (F.G / 8) + bx / 8 : bx; }
    F.ws = args.ws; F.ctl = (unsigned*)(args.ws + WS_CTL);
    for (int u = F.tid; u < (LDS_BYTES - LDSCTL_OFF) / 4; u += 512) ((LAS unsigned*)(F.lds + LDSCTL_OFF))[u] = 0u;
    __syncthreads();
    const int lo = args.ph_lo, hi = args.ph_hi;
    const bool multi = (hi - lo) > 1;
    XcdBarrier bar; bar.bar = F.ctl + CW_BAR; bar.x = 0; bar.st = nullptr;
    if (multi) bar = xcd_barrier_post(F.ctl + CW_BAR, F.MISC + 8);

    if (IN(0)) { for (int rep = 0; rep < REP_PRO; ++rep) p_prologue(F); }
    SEAM(0);
    run_layer<0>(F, lo, hi, bar); run_layer<1>(F, lo, hi, bar); run_layer<2>(F, lo, hi, bar); run_layer<3>(F, lo, hi, bar);
}

#ifndef MK_CUT
#define MK_CUT 0
#endif
extern "C" void kernel_launch(void* const* d_in, const int* in_sizes, int n_in, void* d_out, int out_size, void* d_ws, size_t ws_size, hipStream_t stream) {
    static bool attr = false;
    if (!attr) { (void)hipFuncSetAttribute((const void*)mk_fwd, hipFuncAttributeMaxDynamicSharedMemorySize, LDS_BYTES); attr = true; }
    (void)hipMemsetAsync(d_ws, 0, CTL_BYTES, stream);
    Args a{};
    for (int i = 0; i < 36; ++i) a.in[i] = (const float*)d_in[i];
    a.out = (float*)d_out; a.ws = (unsigned char*)d_ws;
    const int NP = 1 + DEPTH * NPH;
#if MK_CUT
    for (int p = 0; p < NP; ++p) { a.ph_lo = p; a.ph_hi = p + 1; hipLaunchKernelGGL(mk_fwd, dim3(256), dim3(512), LDS_BYTES, stream, a); }
#else
    a.ph_lo = 0; a.ph_hi = NP; hipLaunchKernelGGL(mk_fwd, dim3(256), dim3(512), LDS_BYTES, stream, a);
#endif
}
```

```cpp
#include <hip/hip_runtime.h>
#include <stdint.h>

#define LAS __attribute__((address_space(3)))
#define GAS __attribute__((address_space(1)))
typedef unsigned short bf16_t;
typedef short bf16x8 __attribute__((ext_vector_type(8)));
typedef float f32x4 __attribute__((ext_vector_type(4)));
typedef float f32x2 __attribute__((ext_vector_type(2)));
typedef unsigned u32x4 __attribute__((ext_vector_type(4)));
typedef unsigned u32x2 __attribute__((ext_vector_type(2)));

constexpr int D = 2048, NB = 8, SEQ = 2048, NMETA = 16, L = SEQ + NMETA, T = NB * L, DEPTH = 4;
constexpr int MPAD = 16640;
constexpr int INC = 4640, INCP = 4864;
constexpr int O_AQ = 0, O_AK = 256, O_AV = 512, O_GF = 1024, O_GB = 1040, O_AR = 1056, O_BQ = 1568, O_BK = 2592, O_BV = 2848, O_CU = 3104;
constexpr int NEXP = 16, DEXP = 1024;
constexpr float ALPHA = 1.681792830507429f;
constexpr int NPH = 9;
constexpr int HMROWS = 2 * T + 4096;

constexpr size_t al256(size_t x) { return (x + 255) & ~(size_t)255; }
constexpr size_t WS_CTL = 0, CTL_BYTES = 1u << 20;
constexpr size_t WS_WIN = WS_CTL + CTL_BYTES;
constexpr size_t WS_WOUT = WS_WIN + (size_t)DEPTH * INCP * D * 2;
constexpr size_t WS_WGU = WS_WOUT + (size_t)DEPTH * D * D * 2;
constexpr size_t WS_WD = WS_WGU + (size_t)DEPTH * NEXP * 2048 * D * 2;
constexpr size_t WS_HB8 = WS_WD + (size_t)DEPTH * NEXP * D * DEXP * 2;
constexpr size_t WS_H = WS_HB8 + (size_t)MPAD * D;
constexpr size_t WS_HB = WS_H + (size_t)T * D * 4;
constexpr size_t WS_Y = WS_HB + (size_t)MPAD * D * 2;
constexpr size_t WS_LIST = WS_Y + (size_t)MPAD * D * 2;
constexpr size_t WS_TOKE = WS_LIST + (size_t)NEXP * T * 4;
constexpr size_t WS_TOKP = WS_TOKE + (size_t)2 * T * 4;
constexpr size_t WS_TOKW = WS_TOKP + (size_t)2 * T * 4;
constexpr size_t WS_HF = WS_TOKW + (size_t)2 * T * 4;
constexpr size_t WS_HBW = WS_HF + (size_t)L * 512 * 4;
constexpr int GLEN = 4736, GCEN = 2336, ZL = 2112;
constexpr int ZROW = 3520, ZOFF = 576;
constexpr size_t WS_FG = al256(WS_HBW + (size_t)L * 512 * 4);
constexpr size_t WS_WR = al256(WS_FG + (size_t)DEPTH * 512 * 2 * GLEN * 2);
constexpr size_t WS_REG = al256(WS_WR + (size_t)DEPTH * 64 * 2 * 2 * 512 * 2);
constexpr size_t WS_U = WS_REG;
constexpr int GNC = 33;
constexpr size_t WS_KVT = al256(WS_U + (size_t)T * INC * 2);
constexpr size_t WS_DEC = WS_KVT + (size_t)64 * GNC * 128 * 64 * 4;
constexpr size_t WS_SPT = WS_DEC + (size_t)64 * GNC * 64 * 4;
constexpr size_t WS_GQK = WS_SPT + (size_t)64 * GNC * 128 * 64 * 2;
constexpr size_t WS_GVT = WS_GQK + (size_t)NB * 4 * GNC * 4 * 64 * 64 * 2;
constexpr size_t WS_SW = WS_GVT + (size_t)NB * 4 * GNC * 128 * 64 * 2;
constexpr size_t WS_X0T = WS_SW + (size_t)T * 1024 * 4;
constexpr size_t WS_ZT = WS_X0T + (size_t)512 * NB * ZL * 2;
constexpr size_t WS_YT = WS_ZT + (size_t)512 * NB * ZL * 2;
constexpr size_t WS_END1 = WS_YT + (size_t)512 * NB * ZL * 2;
constexpr size_t WS_R1 = WS_REG;
constexpr size_t WS_HM = WS_R1 + (size_t)T * D * 4;
constexpr size_t WS_O = WS_HM + (size_t)HMROWS * DEXP * 2;
constexpr size_t WS_END2 = WS_O + (size_t)HMROWS * D * 2;
constexpr size_t WS_DUM = al256(WS_END2);
static_assert(WS_END1 < 2100000000ull && WS_DUM + (size_t)T * D * 6 + (size_t)NEXP * T * 4 + (size_t)T * 32 < 2100000000ull, "d_ws budget");
constexpr int CW_BAR = 4096;
constexpr int CW_Q = 12288;
constexpr int CW_CNT = 16384;

constexpr int RING_BYTES = 131072;
constexpr int LDSCTL_OFF = RING_BYTES;
constexpr int MISC_OFF = LDSCTL_OFF + 1024;
constexpr int LDS_BYTES = 147456;

#define LDS_WAIT() asm volatile("s_waitcnt lgkmcnt(0)" ::: "memory")
#define VM_WAIT() asm volatile("s_waitcnt vmcnt(0)" ::: "memory")
__device__ __forceinline__ unsigned f2bf(float f) { unsigned u = __builtin_bit_cast(unsigned, f); return (u + 0x7fffu + ((u >> 16) & 1u)) >> 16; }
__device__ __forceinline__ unsigned pk2i(float lo, float hi) { return f2bf(lo) | (f2bf(hi) << 16); }
__device__ __forceinline__ unsigned pk2(float lo, float hi) { unsigned r; asm("v_cvt_pk_bf16_f32 %0, %1, %2" : "=v"(r) : "v"(lo), "v"(hi)); return r; }
__device__ __forceinline__ float bf2f(unsigned short b) { return __builtin_bit_cast(float, (unsigned)b << 16); }
template <int N> __device__ __forceinline__ float dpp_row_shr_add(float v) { const int t = __builtin_amdgcn_update_dpp(0, __builtin_bit_cast(int, v), 0x110 + N, 0xf, 0xf, true); return v + __builtin_bit_cast(float, t); }
__device__ __forceinline__ float wave_sum(float v) {
    v = dpp_row_shr_add<1>(v); v = dpp_row_shr_add<2>(v); v = dpp_row_shr_add<4>(v); v = dpp_row_shr_add<8>(v);
    const int vi = __builtin_bit_cast(int, v);
    return (__builtin_bit_cast(float, __builtin_amdgcn_readlane(vi, 15)) + __builtin_bit_cast(float, __builtin_amdgcn_readlane(vi, 31))) + (__builtin_bit_cast(float, __builtin_amdgcn_readlane(vi, 47)) + __builtin_bit_cast(float, __builtin_amdgcn_readlane(vi, 63)));
}
__device__ __forceinline__ float xor32(float v) {
    const int vi = __builtin_bit_cast(int, v);
    auto r = __builtin_amdgcn_permlane32_swap(vi, vi, false, false);
    return __builtin_bit_cast(float, (threadIdx.x & 32) ? r[0] : r[1]);
}
__device__ __forceinline__ float wave_max(float v) {
#pragma unroll
    for (int o = 1; o < 64; o <<= 1) v = fmaxf(v, __shfl_xor(v, o));
    return v;
}

#define XB_TMO      128
#define XB_XCNT(j)  (256  + 64 * (j))
#define XB_XSUB(j)  (1280 + 64 * (j))
#define XB_XGEN(j)  (2304 + 64 * (j))
#define XB_TOP      3328
#define XB_TOPGEN   3392
#define XCD_BAR_WORDS 3456
#define XB_SPIN_CAP (1u << 18)
__device__ __forceinline__ unsigned xb_ld(unsigned* p)              { return __hip_atomic_load(p, __ATOMIC_RELAXED, __HIP_MEMORY_SCOPE_AGENT); }
__device__ __forceinline__ unsigned xb_add(unsigned* p, unsigned v) { return __hip_atomic_fetch_add(p, v, __ATOMIC_RELAXED, __HIP_MEMORY_SCOPE_AGENT); }
__device__ __forceinline__ unsigned xb_xcc_id() { return (unsigned)__builtin_amdgcn_s_getreg((3 << 11) | 20) & 0xFu; }
#define XB_SPIN(cond, bar) do { unsigned _sp = 0; while (cond) { __builtin_amdgcn_s_sleep(1); \
    if ((++_sp & 255u) == 0u) { if (xb_ld(&(bar)[XB_TMO])) break; if (_sp > XB_SPIN_CAP) { atomicAdd(&(bar)[XB_TMO], 1u); break; } } } } while (0)
struct XcdBarrier { unsigned* bar; unsigned x; volatile LAS unsigned* st; };
__device__ __forceinline__ XcdBarrier xcd_barrier_post(unsigned* bar, volatile LAS unsigned* st) {
    XcdBarrier b; b.bar = bar; b.x = xb_xcc_id(); b.st = st;
    if (threadIdx.x == 0) (void)xb_add(&bar[XB_XCNT(b.x)], 1u);
    return b;
}
__device__ __forceinline__ void xcd_barrier_complete(unsigned* bar, unsigned x, unsigned& nloc, unsigned& nx) {
    const unsigned G = gridDim.x * gridDim.y * gridDim.z;
    unsigned sum, cnt, mine, sp = 0u;
    for (;;) {
        sum = 0u; cnt = 0u; mine = 0u;
#pragma unroll
        for (unsigned j = 0; j < 16; ++j) { const unsigned c = xb_ld(&bar[XB_XCNT(j)]); sum += c; cnt += (c > 0u) ? 1u : 0u; mine = (j == x) ? c : mine; }
        if (sum == G) break;
        __builtin_amdgcn_s_sleep(1);
        if ((++sp & 255u) == 0u) { if (xb_ld(&bar[XB_TMO])) break; if (sp > XB_SPIN_CAP) { atomicAdd(&bar[XB_TMO], 1u); break; } }
    }
    nloc = mine > 0u ? mine : 1u; nx = cnt > 0u ? cnt : 1u;
}
__device__ __forceinline__ void xcd_barrier(const XcdBarrier& b) {
    asm volatile("s_waitcnt vmcnt(0)" ::: "memory");
    __syncthreads();
    if (threadIdx.x == 0) {
        unsigned* bar = b.bar;
        __builtin_amdgcn_s_waitcnt(0);
        unsigned nloc = b.st[0], nx = b.st[1];
        if (nloc == 0u) { xcd_barrier_complete(bar, b.x, nloc, nx); b.st[0] = nloc; b.st[1] = nx; }
        const unsigned old = xb_add(&bar[XB_XSUB(b.x)], 1u);
        const unsigned gen = old / nloc;
        if (old + 1u == (gen + 1u) * nloc) {
            __builtin_amdgcn_fence(__ATOMIC_RELEASE, "agent");
            asm volatile("s_waitcnt vmcnt(0)" ::: "memory");
            const unsigned og = xb_add(&bar[XB_TOP], 1u);
            const unsigned tg = og / nx;
            if (og + 1u == (tg + 1u) * nx) xb_add(&bar[XB_TOPGEN], 1u);
            else XB_SPIN(xb_ld(&bar[XB_TOPGEN]) == tg, bar);
            __builtin_amdgcn_fence(__ATOMIC_ACQUIRE, "agent");
            xb_add(&bar[XB_XGEN(b.x)], 1u);
            asm volatile("s_waitcnt vmcnt(0)" ::: "memory");
        } else {
            XB_SPIN(xb_ld(&bar[XB_XGEN(b.x)]) == gen, bar);
            __builtin_amdgcn_fence(__ATOMIC_ACQUIRE, "agent");
            asm volatile("s_waitcnt vmcnt(0)" ::: "memory");
        }
    }
    __syncthreads();
}

namespace pg {
constexpr int BM = 256, BK = 64, HALF = 128, HTB = HALF * BK * 2, STAGE_BYTES = 8 * HTB, NXCD = 8, WGM = 5;
__host__ __device__ __forceinline__ int lds_byte(int r, int c) { const int st = (r >> 4) * 2 + (c >> 5), rr = r & 15, cc = c & 31, ob = rr * 64 + cc * 2; return st * 1024 + (ob ^ (((ob >> 9) & 1) << 5)); }
__host__ __device__ __forceinline__ void stage_rc(int b, int& R, int& C) { const int st = b / 1024, sb = b % 1024, swz = sb ^ (((sb >> 9) & 1) << 5); R = (st >> 1) * 16 + swz / 64; C = (st & 1) * 32 + (swz % 64) / 2; }

__host__ __device__ __forceinline__ int perm32(int rho) { const int n = rho >> 4, i = rho & 15; return 8 * (i >> 2) + 4 * n + (i & 3); }
struct Unit { int e, pm, pn, mvalid, crow0; };

struct PlainSched {
    int nM, nN, nwg, G, c;
    __device__ void init(int nM_, int nN_, int G_, int c_) { nM = nM_; nN = nN_; nwg = nM * nN; G = G_; c = c_; }
    __device__ bool next(int i, Unit& u) const {
        const long Lx = (long)i * G + c; if (Lx >= nwg) return false;
        int wgid = (int)Lx; { const int q = nwg / NXCD, r = nwg % NXCD, xcd = wgid % NXCD, off = wgid / NXCD; wgid = (xcd < r ? xcd * (q + 1) : r * (q + 1) + (xcd - r) * q) + off; }
        const int nig = WGM * nN, gid = wgid / nig, fm = gid * WGM, gsz = (nM - fm) < WGM ? (nM - fm) : WGM;
        u.pm = fm + ((wgid % nig) % gsz); u.pn = (wgid % nig) / gsz; u.e = 0; u.crow0 = u.pm * BM; u.mvalid = min(BM, T - u.pm * BM); return true;
    }
    __device__ __forceinline__ int arow(const Unit& u, int r) const { return min(u.pm * BM + r, T - 1); }
    __device__ __forceinline__ int brow0(const Unit& u) const { return u.pn * BM; }
};
struct MoeSched {
    const LAS int* tab; const int* list; int nN, G, c, gather, nrowsB;
    __device__ bool next(int i, Unit& u) const {
        const int Lx = i * G + c; const int panel = Lx / nN;
        if (panel >= __builtin_amdgcn_readfirstlane(tab[32])) return false;
        int e = 0;
#pragma unroll 1
        for (int j = 1; j < 16; ++j) if (panel >= __builtin_amdgcn_readfirstlane(tab[16 + j])) e = j;
        u.e = e; u.pm = panel - __builtin_amdgcn_readfirstlane(tab[16 + e]); u.pn = Lx % nN; u.crow0 = __builtin_amdgcn_readfirstlane(tab[33 + e]) + u.pm * BM;
        u.mvalid = min(BM, __builtin_amdgcn_readfirstlane(tab[e]) - u.pm * BM); return true;
    }
    __device__ __forceinline__ int arow(const Unit& u, int r) const {
        const int rr = min(r, u.mvalid - 1);
        return gather ? list[(size_t)u.e * T + u.pm * BM + rr] : (u.crow0 + rr);
    }
    __device__ __forceinline__ int brow0(const Unit& u) const { return u.e * nrowsB + u.pn * BM; }
};

typedef int i32x8 __attribute__((ext_vector_type(8)));
typedef int i32x4_ __attribute__((ext_vector_type(4)));
__host__ __device__ __forceinline__ int lds_byte8(int r, int kb) { const int st = (r >> 4) * 2 + (kb >> 1), rr = r & 15; return st * 1024 + rr * 64 + 32 * ((kb & 1) ^ (rr >> 3)); }
template <bool FP8, class Epi, class Sched>
__device__ __forceinline__ void gemm_phase(LAS unsigned char* lds, const void* A, const void* Bt, const int K  , const Sched& S, const Epi& E) {
    const int tid = threadIdx.x, wid = __builtin_amdgcn_readfirstlane(tid >> 6), lane = tid & 63, wr = wid >> 2, wc = wid & 3, fr = lane & 15, fq = lane >> 4;
    const int nt = K / BK;
    unsigned voffB[2];
#pragma unroll
    for (int i = 0; i < 2; ++i) { int R, C; stage_rc(tid * 16 + i * 8192, R, C); const int Rb = Epi::PERM ? ((R & ~31) + perm32(R & 31)) : R; voffB[i] = (unsigned)(Rb * K + C) * 2u; }
    const size_t kstep = (size_t)(BK * 2);
    const size_t hstep = (size_t)HALF * K * 2;
    const unsigned rowb = (unsigned)K * 2u;
    const unsigned ldsw = (unsigned)wid * 1024u;
    const int aoff = FP8 ? lds_byte8(wr * 64 + fr, fq) : lds_byte(wr * 64 + fr, fq * 8), boff = FP8 ? lds_byte8(wc * 32 + fr, fq) : lds_byte(wc * 32 + fr, fq * 8);
#define PG_SA(b, h) (((b) * 2 + (h)) * HTB)
#define PG_SB(b, h) ((4 + (b) * 2 + (h)) * HTB)
#define PG_STAGE_B(bufoff, gbase) do { _Pragma("unroll") for (int _i = 0; _i < 2; ++_i) \
        __builtin_amdgcn_global_load_lds((const unsigned*)((const char*)(gbase) + voffB[_i]), (LAS unsigned*)(lds + (bufoff) + ldsw + _i * 8192), 16, 0, 0); } while (0)
#define PG_STAGE_A(bufoff, gbase, v0, v1) do { \
        __builtin_amdgcn_global_load_lds((const unsigned*)((const char*)(gbase) + (v0)), (LAS unsigned*)(lds + (bufoff) + ldsw), 16, 0, 0); \
        __builtin_amdgcn_global_load_lds((const unsigned*)((const char*)(gbase) + (v1)), (LAS unsigned*)(lds + (bufoff) + ldsw + 8192), 16, 0, 0); } while (0)
#define PG_LDA(dst, b, h) do { _Pragma("unroll") for (int m = 0; m < 4; ++m) _Pragma("unroll") for (int k = 0; k < 2; ++k) dst[m][k] = *(const LAS bf16x8*)(lds + PG_SA(b, h) + aoff + m * 2048 + (FP8 ? k * 16 : k * 1024)); } while (0)
#define PG_LDB(dst, b, h) do { _Pragma("unroll") for (int n = 0; n < 2; ++n) _Pragma("unroll") for (int k = 0; k < 2; ++k) dst[n][k] = *(const LAS bf16x8*)(lds + PG_SB(b, h) + boff + n * 2048 + (FP8 ? k * 16 : k * 1024)); } while (0)
#define PG_MMA(ai, bj, At, Bt_) do { __builtin_amdgcn_s_setprio(1); if constexpr (FP8) { _Pragma("unroll") for (int m = 0; m < 4; ++m) _Pragma("unroll") for (int n = 0; n < 2; ++n) { \
            const i32x8 bq_ = __builtin_shufflevector(__builtin_bit_cast(i32x4_, Bt_[n][0]), __builtin_bit_cast(i32x4_, Bt_[n][1]), 0, 1, 2, 3, 4, 5, 6, 7), aq_ = __builtin_shufflevector(__builtin_bit_cast(i32x4_, At[m][0]), __builtin_bit_cast(i32x4_, At[m][1]), 0, 1, 2, 3, 4, 5, 6, 7); \
            acc[ai][bj][m][n] = __builtin_amdgcn_mfma_scale_f32_16x16x128_f8f6f4(bq_, aq_, acc[ai][bj][m][n], 0, 0, 0, 0x7f7f7f7f, 0, 0x7f7f7f7f); } } \
        else { _Pragma("unroll") for (int m = 0; m < 4; ++m) _Pragma("unroll") for (int n = 0; n < 2; ++n) _Pragma("unroll") for (int k = 0; k < 2; ++k) \
        acc[ai][bj][m][n] = __builtin_amdgcn_mfma_f32_16x16x32_bf16(Bt_[n][k], At[m][k], acc[ai][bj][m][n], 0, 0, 0); } __builtin_amdgcn_s_setprio(0); } while (0)
#define PG_WAIT_V(n) asm volatile("s_waitcnt vmcnt(" #n ")" ::: "memory")
#define PG_WAIT_L(n) asm volatile("s_waitcnt lgkmcnt(" #n ")" ::: "memory")
#define PG_BAR __builtin_amdgcn_s_barrier()
#define PG_SCHED __builtin_amdgcn_sched_barrier(0)
#define PG_SETA(v, u) do { int R0_, C0_, R1_, C1_; stage_rc(tid * 16, R0_, C0_); stage_rc(tid * 16 + 8192, R1_, C1_); \
        v##00 = (unsigned)S.arow(u, R0_) * rowb + (unsigned)C0_ * 2u; v##01 = (unsigned)S.arow(u, R1_) * rowb + (unsigned)C1_ * 2u; \
        v##10 = (unsigned)S.arow(u, HALF + R0_) * rowb + (unsigned)C0_ * 2u; v##11 = (unsigned)S.arow(u, HALF + R1_) * rowb + (unsigned)C1_ * 2u; } while (0)
    Unit cur, nxt; int ui = 0;
    if (!S.next(0, cur)) return;
    f32x4 acc[2][2][4][2];
#pragma unroll
    for (int a = 0; a < 2; ++a)
#pragma unroll
        for (int b = 0; b < 2; ++b)
#pragma unroll
            for (int m = 0; m < 4; ++m)
#pragma unroll
                for (int n = 0; n < 2; ++n) acc[a][b][m][n] = (f32x4){0.f, 0.f, 0.f, 0.f};
    bf16x8 At[4][2], B0[2][2], B1[2][2];
    unsigned vc00, vc01, vc10, vc11;
    PG_SETA(vc, cur);
    const char* Ab = (const char*)A;
    const char* cB = (const char*)Bt + (size_t)S.brow0(cur) * rowb;
    PG_STAGE_B(PG_SB(0, 0), cB); PG_STAGE_B(PG_SB(0, 1), cB + hstep); PG_STAGE_A(PG_SA(0, 0), Ab, vc00, vc01); PG_STAGE_A(PG_SA(0, 1), Ab, vc10, vc11);
    if (wr == 1) PG_BAR;
    PG_WAIT_V(2); PG_BAR;
    PG_STAGE_B(PG_SB(1, 0), cB + kstep); PG_STAGE_A(PG_SA(1, 0), Ab + kstep, vc00, vc01); PG_STAGE_B(PG_SB(1, 1), cB + hstep + kstep);
    PG_WAIT_V(6); PG_BAR;
    for (;;) {
        const bool has_next = S.next(ui + 1, nxt);
        const char* nB = has_next ? (const char*)Bt + (size_t)S.brow0(nxt) * rowb : cB;
        for (int t = 0; t < nt; t += 2) {
            const bool last = (t == nt - 2);
            const char* a1 = Ab + (size_t)(t + 1) * kstep;
            const char* a2 = last ? Ab : Ab + (size_t)(t + 2) * kstep; const char* b2 = last ? nB : cB + (size_t)(t + 2) * kstep;
            const char* a3 = a2 + kstep; const char* b3 = b2 + kstep;
            PG_LDB(B0, 0, 0); PG_LDB(B1, 0, 1); PG_SCHED; PG_LDA(At, 0, 0); PG_STAGE_A(PG_SA(1, 1), a1, vc10, vc11);
            if (last && has_next) { PG_SETA(vc, nxt); }
            PG_WAIT_V(8); PG_WAIT_L(0); PG_BAR; PG_MMA(0, 0, At, B0); PG_MMA(0, 1, At, B1); PG_BAR; PG_SCHED;
            PG_LDA(At, 0, 1); PG_STAGE_B(PG_SB(0, 0), b2); PG_STAGE_B(PG_SB(0, 1), b2 + hstep); PG_STAGE_A(PG_SA(0, 0), a2, vc00, vc01);
            PG_WAIT_V(8); PG_WAIT_L(0); PG_BAR; PG_MMA(1, 0, At, B0); PG_MMA(1, 1, At, B1); PG_BAR; PG_SCHED;
            PG_LDB(B0, 1, 0); PG_LDB(B1, 1, 1); PG_SCHED; PG_LDA(At, 1, 0); PG_STAGE_A(PG_SA(0, 1), a2, vc10, vc11);
            PG_WAIT_V(8); PG_WAIT_L(0); PG_BAR; PG_MMA(0, 0, At, B0); PG_MMA(0, 1, At, B1); PG_BAR; PG_SCHED;
            PG_LDA(At, 1, 1); PG_STAGE_B(PG_SB(1, 0), b3); PG_STAGE_B(PG_SB(1, 1), b3 + hstep); PG_STAGE_A(PG_SA(1, 0), a3, vc00, vc01);
            PG_WAIT_V(8); PG_WAIT_L(0); PG_BAR; PG_MMA(1, 0, At, B0); PG_MMA(1, 1, At, B1); PG_BAR; PG_SCHED;
        }
        if (wr == 0) PG_BAR;
        E(acc, cur, wr, wc, fr, fq);
        if (!has_next) break;
#pragma unroll
        for (int a = 0; a < 2; ++a)
#pragma unroll
            for (int b = 0; b < 2; ++b)
#pragma unroll
                for (int m = 0; m < 4; ++m)
#pragma unroll
                    for (int n = 0; n < 2; ++n) acc[a][b][m][n] = (f32x4){0.f, 0.f, 0.f, 0.f};
        cur = nxt; cB = nB; ++ui;
        if (wr == 1) PG_BAR;
    }
    PG_WAIT_V(0);
    PG_BAR;
#undef PG_SA
#undef PG_SB
#undef PG_STAGE_A
#undef PG_STAGE_B
#undef PG_LDA
#undef PG_LDB
#undef PG_MMA
#undef PG_WAIT_V
#undef PG_WAIT_L
#undef PG_BAR
#undef PG_SCHED
#undef PG_SETA
}

struct EpiInProj {
    static constexpr bool PERM = true;
    bf16_t* U; const float* bias;
    __device__ __forceinline__ void operator()(const f32x4 (&acc)[2][2][4][2], const Unit& u, int wr, int wc, int fr, int fq) const {
        const int col0 = u.pn * BM + wc * 32 + 8 * fq;
        f32x4 bv[2][2]; bool cv[2];
#pragma unroll
        for (int bj = 0; bj < 2; ++bj) { const int c = col0 + bj * HALF; cv[bj] = c < INC;
#pragma unroll
            for (int n = 0; n < 2; ++n) bv[bj][n] = cv[bj] ? *(const f32x4*)(bias + c + 4 * n) : (f32x4){0.f, 0.f, 0.f, 0.f}; }
#pragma unroll
        for (int ai = 0; ai < 2; ++ai)
#pragma unroll
            for (int m = 0; m < 4; ++m) { const int r = ai * HALF + wr * 64 + m * 16 + fr;
                if (r < u.mvalid) { bf16_t* rowp = U + (size_t)(u.crow0 + r) * INC + col0;
#pragma unroll
                    for (int bj = 0; bj < 2; ++bj) if (cv[bj]) { const f32x4 v0 = acc[ai][bj][m][0] + bv[bj][0], v1 = acc[ai][bj][m][1] + bv[bj][1];
                        u32x4 w; w.x = pk2(v0[0], v0[1]); w.y = pk2(v0[2], v0[3]); w.z = pk2(v1[0], v1[1]); w.w = pk2(v1[2], v1[3]); *(u32x4*)(rowp + bj * HALF) = w; } } }
    }
};
struct EpiOutProj {
    static constexpr bool PERM = true;
    bf16_t* MX; const float* bias;
    __device__ __forceinline__ void operator()(const f32x4 (&acc)[2][2][4][2], const Unit& u, int wr, int wc, int fr, int fq) const {
        const int col0 = u.pn * BM + wc * 32 + 8 * fq;
        f32x4 bv[2][2];
#pragma unroll
        for (int bj = 0; bj < 2; ++bj)
#pragma unroll
            for (int n = 0; n < 2; ++n) bv[bj][n] = *(const f32x4*)(bias + col0 + bj * HALF + 4 * n);
#pragma unroll
        for (int ai = 0; ai < 2; ++ai)
#pragma unroll
            for (int m = 0; m < 4; ++m) { const int r = ai * HALF + wr * 64 + m * 16 + fr;
                if (r < u.mvalid) { bf16_t* rowp = MX + (size_t)(u.crow0 + r) * D + col0;
#pragma unroll
                    for (int bj = 0; bj < 2; ++bj) { const f32x4 v0 = acc[ai][bj][m][0] + bv[bj][0], v1 = acc[ai][bj][m][1] + bv[bj][1];
                        u32x4 w; w.x = pk2(v0[0], v0[1]); w.y = pk2(v0[2], v0[3]); w.z = pk2(v1[0], v1[1]); w.w = pk2(v1[2], v1[3]); *(u32x4*)(rowp + bj * HALF) = w; } } }
    }
};
struct EpiGateUp {
    static constexpr bool PERM = false;
    bf16_t* Hm;
    __device__ __forceinline__ void operator()(const f32x4 (&acc)[2][2][4][2], const Unit& u, int wr, int wc, int fr, int fq) const {
        const int col0 = u.pn * 128 + wc * 16 + 4 * fq;
#pragma unroll
        for (int ai = 0; ai < 2; ++ai)
#pragma unroll
            for (int m = 0; m < 4; ++m) { const int r = ai * HALF + wr * 64 + m * 16 + fr;
                if (r < u.mvalid) { bf16_t* rowp = Hm + (size_t)(u.crow0 + r) * DEXP + col0;
#pragma unroll
                    for (int bj = 0; bj < 2; ++bj) { const f32x4 g = acc[ai][bj][m][0], up = acc[ai][bj][m][1]; float o[4];
#pragma unroll
                        for (int j = 0; j < 4; ++j) o[j] = g[j] / (1.0f + __expf(-g[j])) * up[j];
                        u32x2 w; w.x = pk2(o[0], o[1]); w.y = pk2(o[2], o[3]); *(u32x2*)(rowp + bj * 64) = w; } } }
    }
};
struct EpiGateUp8 {
    static constexpr bool PERM = false;
    unsigned char* Hm;
    __device__ __forceinline__ void operator()(const f32x4 (&acc)[2][2][4][2], const Unit& u, int wr, int wc, int fr, int fq) const {
        const int col0 = u.pn * 128 + wc * 32 + 8 * fq;
#pragma unroll
        for (int ai = 0; ai < 2; ++ai)
#pragma unroll
            for (int m = 0; m < 4; ++m) { const int r = ai * HALF + wr * 64 + m * 16 + fr;
                if (r < u.mvalid) { int pk[2];
#pragma unroll
                    for (int bj = 0; bj < 2; ++bj) { const f32x4 g = acc[ai][bj][m][0] * (1.0f / 64.0f), up = acc[ai][bj][m][1] * (16.0f / 64.0f); float o[4];
#pragma unroll
                        for (int j = 0; j < 4; ++j) o[j] = g[j] / (1.0f + __expf(-g[j])) * up[j];
                        int q = __builtin_amdgcn_cvt_pk_fp8_f32(o[0], o[1], 0, false); pk[bj] = __builtin_amdgcn_cvt_pk_fp8_f32(o[2], o[3], q, true); }
                    *(u32x2*)(Hm + (size_t)(u.crow0 + r) * DEXP + col0) = (u32x2){(unsigned)pk[0], (unsigned)pk[1]}; } }
    }
};
struct EpiDown8 {
    static constexpr bool PERM = true;
    unsigned char* O;
    __device__ __forceinline__ void operator()(const f32x4 (&acc)[2][2][4][2], const Unit& u, int wr, int wc, int fr, int fq) const {
        const int col0 = u.pn * BM + wc * 32 + 8 * fq;
#pragma unroll
        for (int ai = 0; ai < 2; ++ai)
#pragma unroll
            for (int m = 0; m < 4; ++m) { const int r = ai * HALF + wr * 64 + m * 16 + fr;
                if (r < u.mvalid) { unsigned char* rowp = O + (size_t)(u.crow0 + r) * D + col0;
#pragma unroll
                    for (int bj = 0; bj < 2; ++bj) { const f32x4 v0 = acc[ai][bj][m][0] * (1.0f / 16.0f), v1 = acc[ai][bj][m][1] * (1.0f / 16.0f);
                        int p0 = __builtin_amdgcn_cvt_pk_fp8_f32(v0[0], v0[1], 0, false); p0 = __builtin_amdgcn_cvt_pk_fp8_f32(v0[2], v0[3], p0, true);
                        int p1 = __builtin_amdgcn_cvt_pk_fp8_f32(v1[0], v1[1], 0, false); p1 = __builtin_amdgcn_cvt_pk_fp8_f32(v1[2], v1[3], p1, true);
                        *(u32x2*)(rowp + bj * HALF) = (u32x2){(unsigned)p0, (unsigned)p1}; } } }
    }
};
struct EpiDown {
    static constexpr bool PERM = false;
    bf16_t* O;
    __device__ __forceinline__ void operator()(const f32x4 (&acc)[2][2][4][2], const Unit& u, int wr, int wc, int fr, int fq) const {
        const int col0 = u.pn * BM + wc * 32 + 4 * fq;
#pragma unroll
        for (int ai = 0; ai < 2; ++ai)
#pragma unroll
            for (int m = 0; m < 4; ++m) { const int r = ai * HALF + wr * 64 + m * 16 + fr;
                if (r < u.mvalid) { bf16_t* rowp = O + (size_t)(u.crow0 + r) * D + col0;
#pragma unroll
                    for (int bj = 0; bj < 2; ++bj)
#pragma unroll
                        for (int n = 0; n < 2; ++n) { const f32x4 v = acc[ai][bj][m][n]; u32x2 w; w.x = pk2i(v[0], v[1]); w.y = pk2i(v[2], v[3]); *(u32x2*)(rowp + bj * HALF + n * 16) = w; } } }
    }
};
}

struct Frame {
    LAS unsigned char* lds; volatile LAS unsigned* MISC; unsigned* ctl; unsigned char* ws;
    int tid, lane, wave, vcu, G;
};
__device__ __forceinline__ int opaque_v(int v) { asm volatile("" : "+v"(v)); return v; }
__device__ __forceinline__ unsigned char* launder_ws(unsigned char* p) { GAS unsigned char* q = (GAS unsigned char*)p; asm volatile("" : "+s"(q)); return (unsigned char*)q; }
struct Args { const float* in[36]; float* out; unsigned char* ws; int ph_lo, ph_hi; };
struct ArgsG { const GAS float* in_[36]; GAS float* out_; GAS unsigned char* ws_; int ph_lo, ph_hi;
 };
#define CAS __attribute__((address_space(4)))
__device__ __forceinline__ const CAS ArgsG* kargp() { const CAS ArgsG* p = (const CAS ArgsG*)__builtin_amdgcn_kernarg_segment_ptr(); asm volatile("" : "+s"(p)); return p; }
__device__ __forceinline__ const float* kin(int k) { return (const float*)kargp()->in_[k]; }
__device__ __forceinline__ float* kout() { return (float*)kargp()->out_; }

__device__ __forceinline__ void transpose64(const float* colp4, int ldw, int K, bf16_t* WT, int k0, int j0, LAS float* scr, int lane) {
    const int kr = lane >> 4, c4 = lane & 15;
    f32x4 t[16];
#pragma unroll
    for (int i = 0; i < 16; ++i) t[i] = colp4 ? *(const f32x4*)(colp4 + (size_t)(k0 + kr + 4 * i) * ldw) : (f32x4){0.f, 0.f, 0.f, 0.f};
    const int ch = lane >> 4, nr = lane & 15;
#pragma unroll
    for (int hf = 0; hf < 2; ++hf) {
#pragma unroll
        for (int i = 0; i < 8; ++i) { LAS float* d = scr + (kr + 4 * i) * 66 + 4 * c4; const f32x4 x = t[hf * 8 + i]; *(LAS f32x2*)d = (f32x2){x[0], x[1]}; *(LAS f32x2*)(d + 2) = (f32x2){x[2], x[3]}; }
        LDS_WAIT();
#pragma unroll
        for (int it = 0; it < 4; ++it) { const int n = nr + 16 * it; const LAS float* sp = scr + (8 * ch) * 66 + n;
            u32x4 o; o.x = pk2(sp[0], sp[66]); o.y = pk2(sp[2 * 66], sp[3 * 66]); o.z = pk2(sp[4 * 66], sp[5 * 66]); o.w = pk2(sp[6 * 66], sp[7 * 66]);
            *(u32x4*)(WT + (size_t)(j0 + n) * K + k0 + 32 * hf + 8 * ch) = o; }
        LDS_WAIT();
    }
}
__device__ __forceinline__ void transpose64_fp8(const float* colp4, int ldw, int K, unsigned char* WT, int k0, int j0, LAS float* scr, int lane) {
    const int kr = lane >> 4, c4 = lane & 15;
    f32x4 t[16];
#pragma unroll
    for (int i = 0; i < 16; ++i) t[i] = *(const f32x4*)(colp4 + (size_t)(k0 + kr + 4 * i) * ldw);
    const int ch = lane >> 5, nr = lane & 31;
#pragma unroll
    for (int hf = 0; hf < 2; ++hf) {
#pragma unroll
        for (int i = 0; i < 8; ++i) { LAS float* d = scr + (kr + 4 * i) * 66 + 4 * c4; const f32x4 x = t[hf * 8 + i]; *(LAS f32x2*)d = (f32x2){x[0], x[1]}; *(LAS f32x2*)(d + 2) = (f32x2){x[2], x[3]}; }
        LDS_WAIT();
#pragma unroll
        for (int it = 0; it < 2; ++it) { const int n = nr + 32 * it; const LAS float* sp = scr + (16 * ch) * 66 + n; int q[4];
#pragma unroll
            for (int g = 0; g < 4; ++g) { int pk = __builtin_amdgcn_cvt_pk_fp8_f32(sp[(4 * g) * 66] * 64.0f, sp[(4 * g + 1) * 66] * 64.0f, 0, false); q[g] = __builtin_amdgcn_cvt_pk_fp8_f32(sp[(4 * g + 2) * 66] * 64.0f, sp[(4 * g + 3) * 66] * 64.0f, pk, true); }
            *(u32x4*)(WT + (size_t)(j0 + n) * K + k0 + 32 * hf + 16 * ch) = (u32x4){(unsigned)q[0], (unsigned)q[1], (unsigned)q[2], (unsigned)q[3]}; }
        LDS_WAIT();
    }
}
__device__ __forceinline__ f32x4 ldg4(const float* p) { return *(const f32x4*)p; }
__device__ __forceinline__ f32x4 ldg4(const LAS float* p) { return *(const LAS f32x4*)p; }
template <bool HB8 = false, bool OUT_ONLY = false, class GP = const float*>
__device__ __forceinline__ void ln_wave_store(f32x4 (&v)[8], GP g, GP b, bf16_t* resrow, unsigned char* f8row, float* orow, int lane) {
    float s = 0.f;
#pragma unroll
    for (int j = 0; j < 8; ++j) s += (v[j][0] + v[j][1]) + (v[j][2] + v[j][3]);
    const float mean = wave_sum(s) * (1.0f / D);
    float q = 0.f;
#pragma unroll
    for (int j = 0; j < 8; ++j) { v[j] = v[j] - mean; q += (v[j][0] * v[j][0] + v[j][1] * v[j][1]) + (v[j][2] * v[j][2] + v[j][3] * v[j][3]); }
    const float rstd = rsqrtf(wave_sum(q) * (1.0f / D) + 1e-5f);
#pragma unroll
    for (int j = 0; j < 8; ++j) {
        const int i4 = lane + 64 * j;
        const f32x4 gv = ldg4(g + 4 * i4), bv = ldg4(b + 4 * i4);
        if (HB8 && (j & 1) == 0) __builtin_amdgcn_sched_barrier(0);
        const f32x4 o = v[j] * rstd * gv + bv;
        v[j] = o;
        if (OUT_ONLY) { if (orow) ((f32x4*)orow)[i4] = o; continue; }
        { u32x2 w; w.x = pk2(o[0], o[1]); w.y = pk2(o[2], o[3]); ((u32x2*)resrow)[i4] = w; }
        if (HB8) { int pk = __builtin_amdgcn_cvt_pk_fp8_f32(o[0], o[1], 0, false); pk = __builtin_amdgcn_cvt_pk_fp8_f32(o[2], o[3], pk, true); ((int*)f8row)[i4] = pk; }
        if (orow) ((f32x4*)orow)[i4] = o;
    }
}

__device__ __forceinline__ void hy_filter_item(Frame& F, int item, unsigned char* wsl);
__device__ __forceinline__ void hy_filter_tails(Frame& F, unsigned char* wsl);
__device__ __forceinline__ void p_prologue(Frame& F) {
    unsigned char* const wsl = launder_ws(F.ws); unsigned* const ctl = (unsigned*)(wsl + WS_CTL);
    LAS float* scr = (LAS float*)(F.lds + F.wave * 16384);
    const int gw = F.vcu * 8 + F.wave, NGW = F.G * 8, lane = F.lane;
    bf16_t* WIN = (bf16_t*)(wsl + WS_WIN); bf16_t* WOUT = (bf16_t*)(wsl + WS_WOUT); bf16_t* WGU = (bf16_t*)(wsl + WS_WGU); bf16_t* WD = (bf16_t*)(wsl + WS_WD);
    constexpr int I_IN = 32 * (INCP / 64), I_OUT = 32 * 32, I_GU = 32 * 32, I_D = 16 * 32;
    constexpr int N_IN = DEPTH * I_IN, N_OUT = DEPTH * I_OUT, N_GU = DEPTH * NEXP * I_GU, N_D = DEPTH * NEXP * I_D, N_TR = N_IN + N_OUT + N_GU + N_D;
    const int c4 = lane & 15, kr4 = lane >> 4;
    struct TrItem { const float* colp; unsigned char* wt; int ldw, K, k0, j0, f8; };
#define TR_DECODE(itv, d) do { int r_ = (itv); \
        if (r_ < N_IN) { const int ll = r_ / I_IN, q = r_ % I_IN, nb = q % (INCP / 64), kb = q / (INCP / 64); const int n = nb * 64 + 4 * c4; \
            d.colp = n < INC ? kin(4) + (size_t)ll * D * INC + n : nullptr; d.ldw = INC; d.K = D; d.wt = (unsigned char*)(WIN + (size_t)ll * INCP * D); d.k0 = kb * 64; d.j0 = nb * 64; d.f8 = 0; } \
        else if (r_ < N_IN + N_OUT) { r_ -= N_IN; const int ll = r_ / I_OUT, q = r_ % I_OUT, nb = q % 32, kb = q / 32; const int n = nb * 64 + 4 * c4; \
            d.colp = kin(23) + (size_t)ll * D * D + n; d.ldw = D; d.K = D; d.wt = (unsigned char*)(WOUT + (size_t)ll * D * D); d.k0 = kb * 64; d.j0 = nb * 64; d.f8 = 0; } \
        else if (r_ < N_IN + N_OUT + N_GU) { r_ -= N_IN + N_OUT; const int le = r_ / I_GU, q = r_ % I_GU, nb = q % 32, kb = q / 32; const int j = nb * 64 + 4 * c4; \
            const int pn = j >> 8, cp = j & 255, bj = cp >> 7, wc = (cp >> 5) & 3, nn = (cp >> 4) & 1, fq = (cp >> 2) & 3; const int hid = pn * 128 + wc * 32 + fq * 8 + bj * 4; \
            d.colp = (nn ? kin(32) : kin(31)) + (size_t)le * D * DEXP + hid; d.ldw = DEXP; d.K = D; d.wt = (unsigned char*)WGU + (size_t)le * 2048 * D; d.k0 = kb * 64; d.j0 = nb * 64; d.f8 = 1; } \
        else { r_ -= N_IN + N_OUT + N_GU; const int le = r_ / I_D, q = r_ % I_D, nb = q % 32, kb = q / 32; const int n = nb * 64 + 4 * c4; \
            d.colp = kin(33) + (size_t)le * DEXP * D + n; d.ldw = D; d.K = DEXP; d.wt = (unsigned char*)WD + (size_t)le * D * DEXP; d.k0 = kb * 64; d.j0 = nb * 64; d.f8 = 1; } } while (0)
#define TR_LOAD(d, t) do { _Pragma("unroll") for (int i = 0; i < 16; ++i) t[i] = d.colp ? *(const f32x4*)(d.colp + (size_t)(d.k0 + kr4 + 4 * i) * d.ldw) : (f32x4){0.f, 0.f, 0.f, 0.f}; } while (0)
    { int it = gw; TrItem dc, dn; f32x4 tc[16], tn[16];
      if (it < N_TR) { TR_DECODE(it, dc); TR_LOAD(dc, tc); }
      for (; it < N_TR; it += NGW) {
          const int itn = it + NGW;
          if (itn < N_TR) { TR_DECODE(itn, dn); TR_LOAD(dn, tn); }
#pragma unroll
          for (int hf = 0; hf < 2; ++hf) {
#pragma unroll
              for (int i = 0; i < 8; ++i) { LAS float* dd = scr + (kr4 + 4 * i) * 66 + 4 * c4; const f32x4 x = tc[hf * 8 + i]; *(LAS f32x2*)dd = (f32x2){x[0], x[1]}; *(LAS f32x2*)(dd + 2) = (f32x2){x[2], x[3]}; }
              LDS_WAIT();
              if (dc.f8) { const int ch = lane >> 5, nr = lane & 31;
#pragma unroll
                  for (int i2 = 0; i2 < 2; ++i2) { const int n = nr + 32 * i2; const LAS float* sp = scr + (16 * ch) * 66 + n; int q[4];
#pragma unroll
                      for (int g = 0; g < 4; ++g) { int pk = __builtin_amdgcn_cvt_pk_fp8_f32(sp[(4 * g) * 66] * 64.0f, sp[(4 * g + 1) * 66] * 64.0f, 0, false); q[g] = __builtin_amdgcn_cvt_pk_fp8_f32(sp[(4 * g + 2) * 66] * 64.0f, sp[(4 * g + 3) * 66] * 64.0f, pk, true); }
                      *(u32x4*)(dc.wt + (size_t)(dc.j0 + n) * dc.K + dc.k0 + 32 * hf + 16 * ch) = (u32x4){(unsigned)q[0], (unsigned)q[1], (unsigned)q[2], (unsigned)q[3]}; }
              } else { const int ch = lane >> 4, nr = lane & 15;
#pragma unroll
                  for (int i2 = 0; i2 < 4; ++i2) { const int n = nr + 16 * i2; const LAS float* sp = scr + (8 * ch) * 66 + n;
                      u32x4 o; o.x = pk2(sp[0], sp[66]); o.y = pk2(sp[2 * 66], sp[3 * 66]); o.z = pk2(sp[4 * 66], sp[5 * 66]); o.w = pk2(sp[6 * 66], sp[7 * 66]);
                      *(u32x4*)((bf16_t*)dc.wt + (size_t)(dc.j0 + n) * dc.K + dc.k0 + 32 * hf + 8 * ch) = o; } }
              LDS_WAIT();
          }
          dc = dn;
#pragma unroll
          for (int i = 0; i < 16; ++i) tc[i] = tn[i];
      } }
#undef TR_DECODE
#undef TR_LOAD
    { bf16_t* WR = (bf16_t*)(wsl + WS_WR);
      for (int idx = blockIdx.x * 512 + F.tid; idx < DEPTH * 64 * 2 * 64; idx += F.G * 512) {
          const int ln = idx & 63, t = (idx >> 6) & 1, sst = (idx >> 7) & 63, ll = idx >> 13, n = ln & 15, kg = ln >> 4, c = 16 * t + n;
          unsigned hi[8], lo[8];
#pragma unroll
          for (int j = 0; j < 8; ++j) { const int k = 32 * sst + 8 * kg + j;
              const float wv = c < 4 ? kin(27)[((size_t)ll * D + k) * 4 + c] : (c < 20 ? kin(29)[((size_t)ll * D + k) * 16 + c - 4] : 0.f);
              hi[j] = f2bf(wv); lo[j] = f2bf(wv - __builtin_bit_cast(float, hi[j] << 16)); }
          bf16_t* o = WR + ((size_t)ll * 256 + (sst * 2 + t) * 2) * 512 + ln * 8;
          *(u32x4*)o = (u32x4){hi[0] | (hi[1] << 16), hi[2] | (hi[3] << 16), hi[4] | (hi[5] << 16), hi[6] | (hi[7] << 16)};
          *(u32x4*)(o + 512) = (u32x4){lo[0] | (lo[1] << 16), lo[2] | (lo[3] << 16), lo[4] | (lo[5] << 16), lo[6] | (lo[7] << 16)}; } }
    hy_filter_tails(F, wsl);
    for (int it = blockIdx.x; it < DEPTH * 66; it += F.G) hy_filter_item(F, it, wsl);
    __syncthreads();
    bf16_t* hb = (bf16_t*)(wsl + WS_HB);
    for (int row = gw; row < T; row += NGW) {
        const int bb = row / L, p = row % L;
        const float* src = p < NMETA ? kin(1) + (size_t)p * D : kin(0) + ((size_t)bb * SEQ + (p - NMETA)) * D;
        f32x4 v[8];
#pragma unroll
        for (int j = 0; j < 8; ++j) v[j] = ((const f32x4*)src)[lane + 64 * j];
        ln_wave_store(v, kin(2), kin(3), hb + (size_t)row * D, nullptr, nullptr, lane);
    }
}


__device__ __forceinline__ void hy_filter_item(Frame& F, int item, unsigned char* wsl) {
    const int half = item & 1, blk = (item >> 1) % 33, l = item / 66, tid = F.tid;
    const float* w1 = kin(15) + (size_t)l * 33 * 64; const float* b1 = kin(16) + l * 64; const float* freq = kin(17) + l * 128;
    const float* w2 = kin(18) + (size_t)l * 64 * 64; const float* b2 = kin(19) + l * 64; const float* w3 = kin(20) + (size_t)l * 64 * 1024;
    LAS float* z = (LAS float*)F.lds;
    LAS float* h1 = z + 64 * 33;
    LAS float* h2 = h1 + 64 * 64;
    LAS bf16_t* ot = (LAS bf16_t*)(h2 + 64 * 64);
    const int d0 = blk * 64;
    __syncthreads();
    for (int e = tid; e < 64 * 33; e += 512) { const int pl = e / 33, k = e % 33, i = d0 + pl; float v;
        if (k == 0) v = (float)i / (float)(L - 1);
        else { const int j = (k - 1) & 15; const double band = 1e-4 + (double)j * ((15.0 - 1e-4) / 15.0); double turns = band * (double)i / (double)L; turns -= (double)(long long)turns;
               const float ang = (float)(turns * 6.283185307179586476925); v = k < 17 ? __cosf(ang) : -__sinf(ang); }
        z[e] = v; }
    __syncthreads();
    { const int j = tid & 63, pg = tid >> 6; const float fq = freq[j], bb = b1[j];
      float a[8];
#pragma unroll
      for (int r = 0; r < 8; ++r) a[r] = bb;
      for (int k = 0; k < 33; ++k) { const float w = w1[k * 64 + j];
#pragma unroll
          for (int r = 0; r < 8; ++r) a[r] += z[(pg * 8 + r) * 33 + k] * w; }
#pragma unroll
      for (int r = 0; r < 8; ++r) h1[(pg * 8 + r) * 64 + j] = __sinf(fq * a[r]); }
    __syncthreads();
    { const int j = tid & 63, pg = tid >> 6; const float fq = freq[64 + j], bb = b2[j];
      float a[8];
#pragma unroll
      for (int r = 0; r < 8; ++r) a[r] = bb;
      for (int k = 0; k < 64; ++k) { const float w = w2[k * 64 + j];
#pragma unroll
          for (int r = 0; r < 8; ++r) a[r] += h1[(pg * 8 + r) * 64 + k] * w; }
#pragma unroll
      for (int r = 0; r < 8; ++r) h2[(pg * 8 + r) * 64 + j] = __sinf(fq * a[r]); }
    __syncthreads();
    { const int c = tid;
      const float mind = logf(1e-2f) / 1.5f, maxd = logf(1e-2f) / 0.3f;
      const float adel = fabsf(mind + (float)c * ((maxd - mind) / 511.0f));
      for (int pq = 0; pq < 64; pq += 8) {
          float a[8];
#pragma unroll
          for (int r = 0; r < 8; ++r) a[r] = 0.f;
          for (int k = 0; k < 64; ++k) { const float w = w3[k * 1024 + half * 512 + c];
#pragma unroll
              for (int r = 0; r < 8; ++r) a[r] += h2[(pq + r) * 64 + k] * w; }
#pragma unroll
          for (int r = 0; r < 8; ++r) { const int i = d0 + pq + r; const float tt = (float)i / (float)(L - 1); ot[c * 66 + pq + r] = (bf16_t)f2bf(a[r] * __expf(-tt * adel)); } } }
    __syncthreads();
    { bf16_t* FG = (bf16_t*)(wsl + WS_FG) + (size_t)l * 512 * 2 * GLEN;
      const int dl = tid & 63, cg = tid >> 6, d = d0 + dl;
      if (d < L && !(half == 1 && d == 0)) {
          const int m = half ? GCEN + d : GCEN - d;
          for (int c = cg; c < 512; c += 8) { const bf16_t v = ot[c * 66 + dl]; bf16_t* row = FG + (size_t)c * 2 * GLEN; row[m] = v; row[GLEN + m - 1] = v; } } }
}
__device__ __forceinline__ void hy_filter_tails(Frame& F, unsigned char* wsl) {
    bf16_t* FG = (bf16_t*)(wsl + WS_FG);
    constexpr int LO0 = GCEN - (L - 1), HI0 = GCEN + (L - 1) + 1;
    constexpr int NT0 = LO0 + (GLEN - HI0), NT1 = (LO0 - 1) + (GLEN - (HI0 - 1));
    for (size_t idx = (size_t)blockIdx.x * 512 + F.tid; idx < (size_t)DEPTH * 512 * (NT0 + NT1); idx += (size_t)F.G * 512) {
        const int rowi = (int)(idx / (NT0 + NT1)); int k = (int)(idx % (NT0 + NT1));
        bf16_t* row = FG + (size_t)rowi * 2 * GLEN;
        if (k < NT0) { const int m = k < LO0 ? k : HI0 + (k - LO0); row[m] = 0; }
        else { k -= NT0; const int m = k < LO0 - 1 ? k : (HI0 - 1) + (k - (LO0 - 1)); row[GLEN + m] = 0; } }
}

constexpr int MIXC_SG = 98304, MIXC_CW = 102400, MIXC_CB = 120832, MIXC_HG = 98304;
__device__ __forceinline__ void hy_pre_item(Frame& F, int item, int l, unsigned char* wsl) {
    const bf16_t* U = (const bf16_t*)(wsl + WS_U);
    bf16_t* X0T = (bf16_t*)(wsl + WS_X0T); bf16_t* ZT = (bf16_t*)(wsl + WS_ZT);
    const LAS float* cw = (const LAS float*)(F.lds + MIXC_CW); const LAS float* cb = (const LAS float*)(F.lds + MIXC_CB);
    const int cc = item & 3, pt = (item >> 2) % 33, b = item / (4 * 33), tid = opaque_v(F.tid);
    const int c8 = tid & 15, pl = tid >> 4, c0 = cc * 128 + 8 * c8;
    LAS bf16_t* zt = (LAS bf16_t*)F.lds; LAS bf16_t* xt = zt + 128 * 72;
    __syncthreads();
    u32x4 raw[2][3][3];
#pragma unroll
    for (int ps = 0; ps < 2; ++ps) { const int p = pt * 64 + pl + 32 * ps; const bool pv = p < L;
#pragma unroll
        for (int g = 0; g < 3; ++g) { const bf16_t* ub = U + ((size_t)b * L + (pv ? p : 0)) * INC + O_CU + g * 512 + c0; const u32x4 z4 = (u32x4){0u, 0u, 0u, 0u};
            raw[ps][g][0] = (pv && p > 0) ? *(const u32x4*)(ub - INC) : z4; raw[ps][g][1] = pv ? *(const u32x4*)ub : z4; raw[ps][g][2] = (p + 1 < L) ? *(const u32x4*)(ub + INC) : z4; } }
#pragma unroll
    for (int ps = 0; ps < 2; ++ps) { const int p = pt * 64 + pl + 32 * ps; const bool pv = p < L;
        float uc[3][8];
#pragma unroll
        for (int g = 0; g < 3; ++g) { const int col = g * 512 + c0;
            const f32x4 wa0 = *(const LAS f32x4*)(cw + col), wa1 = *(const LAS f32x4*)(cw + col + 4), wb0 = *(const LAS f32x4*)(cw + 1536 + col), wb1 = *(const LAS f32x4*)(cw + 1536 + col + 4),
                        wc0 = *(const LAS f32x4*)(cw + 3072 + col), wc1 = *(const LAS f32x4*)(cw + 3072 + col + 4), bb0 = *(const LAS f32x4*)(cb + col), bb1 = *(const LAS f32x4*)(cb + col + 4);
            const u32x4 rm = raw[ps][g][0], r0 = raw[ps][g][1], rp = raw[ps][g][2];
#pragma unroll
            for (int j = 0; j < 4; ++j) {
                const float m0 = __builtin_bit_cast(float, rm[j] << 16), m1 = __builtin_bit_cast(float, rm[j] & 0xffff0000u), x0 = __builtin_bit_cast(float, r0[j] << 16), x1 = __builtin_bit_cast(float, r0[j] & 0xffff0000u),
                            q0 = __builtin_bit_cast(float, rp[j] << 16), q1 = __builtin_bit_cast(float, rp[j] & 0xffff0000u);
                const int e = 2 * j; const float w0a = e < 4 ? wa0[e & 3] : wa1[e & 3], w0b = e < 4 ? wb0[e & 3] : wb1[e & 3], w0c = e < 4 ? wc0[e & 3] : wc1[e & 3], b0_ = e < 4 ? bb0[e & 3] : bb1[e & 3];
                const float w1a = e < 4 ? wa0[(e + 1) & 3] : wa1[(e + 1) & 3], w1b = e < 4 ? wb0[(e + 1) & 3] : wb1[(e + 1) & 3], w1c = e < 4 ? wc0[(e + 1) & 3] : wc1[(e + 1) & 3], b1_ = e < 4 ? bb0[(e + 1) & 3] : bb1[(e + 1) & 3];
                uc[g][e] = pv ? (b0_ + m0 * w0a + x0 * w0b + q0 * w0c) : 0.f; uc[g][e + 1] = pv ? (b1_ + m1 * w1a + x1 * w1b + q1 * w1c) : 0.f; } }
#pragma unroll
        for (int j = 0; j < 8; ++j) { const int col = (pl + 32 * ps + 8 * (c8 & 7)) & 63;
            zt[(8 * c8 + j) * 72 + col] = (bf16_t)f2bf(uc[1][j] * uc[2][j]); xt[(8 * c8 + j) * 72 + col] = (bf16_t)f2bf(uc[0][j]); } }
    __syncthreads();
#pragma unroll
    for (int it = 0; it < 2; ++it) { const int cr = (tid >> 3) + 64 * it, pc = tid & 7;
      const size_t o = ((size_t)(cc * 128 + cr) * NB + b) * ZL + pt * 64 + pc * 8;
      const int pcs = (pc + ((cr >> 3) & 7)) & 7;
      *(u32x4*)(ZT + o) = *(const LAS u32x4*)(zt + cr * 72 + pcs * 8);
      *(u32x4*)(X0T + o) = *(const LAS u32x4*)(xt + cr * 72 + pcs * 8); }
}

__device__ __forceinline__ void hy_conv_phase(Frame& F, int l, unsigned char* wsl) {
    const bf16_t* ZT = (const bf16_t*)(wsl + WS_ZT); const bf16_t* X0T = (const bf16_t*)(wsl + WS_X0T); bf16_t* YT = (bf16_t*)(wsl + WS_YT);
    const bf16_t* FG = (const bf16_t*)(wsl + WS_FG) + (size_t)l * 512 * 2 * GLEN;
    const float* skip = kin(21) + l * 512;
    LAS unsigned char* Zs = F.lds;
    LAS unsigned char* Gs = F.lds + 8 * ZROW * 2;
    const int tid = F.tid, lane = F.lane, wave = F.wave;
    __syncthreads();
    for (int e = tid; e < 8 * ZROW * 2 / 16; e += 512) *(LAS u32x4*)(Zs + e * 16) = (u32x4){0u, 0u, 0u, 0u};
    const int pp = wave & 1, q = wave >> 1;
    const int T0 = 576 * q + 16 * pp, D0 = -(576 * q + 544 + 32 * pp), S0 = T0 + D0;
    const int n = lane & 15, kg = lane >> 4, bb = n & 7, u = n >> 3;
    const unsigned zb = (unsigned)(bb * ZROW * 2 + 2 * (ZOFF + S0 + 32 * u + 8 * kg));
    const int par = n & 1, e0 = GCEN + D0 + 8 * kg - n;
    const unsigned ab = (unsigned)(8 * ZROW * 2 + par * GLEN * 2 + 2 * (e0 - par));
    for (int c = F.vcu; c < 512; c += F.G) {
        __syncthreads();
        for (int e = tid; e < 8 * (ZL / 8); e += 512) { const int b = e / (ZL / 8), pc = e % (ZL / 8);
            *(LAS u32x4*)(Zs + (b * ZROW + ZOFF + pc * 8) * 2) = *(const u32x4*)(ZT + ((size_t)c * NB + b) * ZL + pc * 8); }
        for (int e = tid; e < 2 * GLEN / 8; e += 512) *(LAS u32x4*)(Gs + e * 16) = *(const u32x4*)(FG + (size_t)c * 2 * GLEN + e * 8);
        __syncthreads();
        f32x4 acc[9];
#pragma unroll
        for (int k = 0; k < 9; ++k) acc[k] = (f32x4){0.f, 0.f, 0.f, 0.f};
        bf16x8 ring[18];
#pragma unroll
        for (int s2 = 0; s2 < 17; ++s2) ring[s2] = *(const LAS bf16x8*)(F.lds + zb + 64 * s2);
        u32x4 an;
#pragma unroll
        for (int d = 0; d < 4; ++d) an[d] = *(const LAS unsigned*)(F.lds + ab + 4 * d);
        for (int jo = 0; jo < 5; ++jo) {
            const unsigned zo = zb + (unsigned)jo * 18u * 64u, ao = ab + (unsigned)jo * 18u * 64u;
#pragma unroll
            for (int jj = 0; jj < 18; ++jj) {
                const bf16x8 acur = __builtin_bit_cast(bf16x8, an);
                ring[(jj + 17) % 18] = *(const LAS bf16x8*)(F.lds + zo + 64 * (jj + 17));
#pragma unroll
                for (int d = 0; d < 4; ++d) an[d] = *(const LAS unsigned*)(F.lds + ao + 64 * (jj + 1) + 4 * d);
#pragma unroll
                for (int k = 0; k < 9; ++k) acc[k] = __builtin_amdgcn_mfma_f32_16x16x32_bf16(acur, ring[(jj + 2 * k) % 18], acc[k], 0, 0, 0);
            }
        }
        const float sk = skip[c];
#pragma unroll
        for (int k = 0; k < 9; ++k) { const int t = T0 + 64 * k + 32 * u + 4 * kg;
            if (t < L) { const size_t o = ((size_t)c * NB + bb) * ZL + t;
                const u32x2 xv = *(const u32x2*)(X0T + o); const u32x2 zv = *(const LAS u32x2*)(Zs + (bb * ZROW + ZOFF + t) * 2);
                float y[4];
                y[0] = __builtin_bit_cast(float, xv.x << 16) * (acc[k][0] + sk * __builtin_bit_cast(float, zv.x << 16));
                y[1] = __builtin_bit_cast(float, xv.x & 0xffff0000u) * (acc[k][1] + sk * __builtin_bit_cast(float, zv.x & 0xffff0000u));
                y[2] = __builtin_bit_cast(float, xv.y << 16) * (acc[k][2] + sk * __builtin_bit_cast(float, zv.y << 16));
                y[3] = __builtin_bit_cast(float, xv.y & 0xffff0000u) * (acc[k][3] + sk * __builtin_bit_cast(float, zv.y & 0xffff0000u));
                u32x2 w; w.x = pk2(y[0], y[1]); w.y = pk2(y[2], y[3]); *(u32x2*)(YT + o) = w; } }
    }
    __syncthreads();
}

__device__ __forceinline__ void hy_norm_item(Frame& F, int item, int l, unsigned char* wsl) {
    const bf16_t* YT = (const bf16_t*)(wsl + WS_YT); bf16_t* Y = (bf16_t*)(wsl + WS_Y); const LAS float* hg = (const LAS float*)(F.lds + MIXC_HG);
    const int pt = item % 33, b = item / 33, p0 = pt * 64, tid = opaque_v(F.tid);
    LAS bf16_t* tl = (LAS bf16_t*)F.lds;
    LAS float* part = (LAS float*)(F.lds + 512 * 72 * 2);
    LAS float* rsv = part + 512;
    __syncthreads();
#pragma unroll
    for (int it = 0; it < 8; ++it) { const int c = (tid >> 3) + 64 * it, pc = tid & 7;
        *(LAS u32x4*)(tl + c * 72 + pc * 8) = *(const u32x4*)(YT + ((size_t)c * NB + b) * ZL + p0 + pc * 8); }
    __syncthreads();
    { const int pos = tid & 63, cg = tid >> 6; float sacc = 0.f;
      for (int c = cg * 64; c < cg * 64 + 64; ++c) { const float v = bf2f(tl[c * 72 + pos]); sacc += v * v; }
      part[cg * 64 + pos] = sacc; }
    __syncthreads();
    if (tid < 64) { float sacc = 0.f;
#pragma unroll
        for (int g = 0; g < 8; ++g) sacc += part[g * 64 + tid];
        rsv[tid] = rsqrtf(sacc * (1.0f / 512.0f) + 1e-6f); }
    __syncthreads();
    { const int pos = tid >> 3, pc = tid & 7, p = p0 + pos;
      if (p < L) { const float rs = rsv[pos]; bf16_t* yrow = Y + ((size_t)b * L + p) * D + 1536;
#pragma unroll
          for (int it = 0; it < 8; ++it) { const int c = it * 64 + pc * 8; float v[8];
#pragma unroll
              for (int j = 0; j < 8; ++j) v[j] = bf2f(tl[(c + j) * 72 + pos]) * rs * hg[c + j];
              u32x4 w; w.x = pk2(v[0], v[1]); w.y = pk2(v[2], v[3]); w.z = pk2(v[4], v[5]); w.w = pk2(v[6], v[7]);
              *(u32x4*)(yrow + c) = w; } } }
}


constexpr int GS = 72;
constexpr int G_OP0 = 0, G_OP1 = 9216, G_VT = 18432, G_DEC = 36864, G_PART = 37376, G_W = 38400, G_ST = 49152;
typedef float f32x16 __attribute__((ext_vector_type(16)));
typedef short s16x4 __attribute__((ext_vector_type(4)));
__device__ __forceinline__ float logsigmoid_fast(float x) { return fminf(x, 0.f) - __logf(1.0f + __expf(-fabsf(x))); }
template <int N> __device__ __forceinline__ float row_shr_add(float v) { const int t = __builtin_amdgcn_update_dpp(0, __builtin_bit_cast(int, v), 0x110 + N, 0xf, 0xf, true); return v + __builtin_bit_cast(float, t); }
__device__ __forceinline__ float wave_incl_scan(float v, int lane) {
    v = row_shr_add<1>(v); v = row_shr_add<2>(v); v = row_shr_add<4>(v); v = row_shr_add<8>(v);
    { const int t = __builtin_amdgcn_update_dpp(0, __builtin_bit_cast(int, v), 0x142, 0xa, 0xf, false); v += __builtin_bit_cast(float, t); }
    { const int t = __builtin_amdgcn_update_dpp(0, __builtin_bit_cast(int, v), 0x143, 0xc, 0xf, false); v += __builtin_bit_cast(float, t); }
    return v;
}
__device__ __forceinline__ float lane_bcast63(float v) { return __builtin_bit_cast(float, __builtin_amdgcn_readlane(__builtin_bit_cast(int, v), 63)); }
__device__ __forceinline__ int crow16(int i, int hh) { return (i & 3) + 8 * (i >> 2) + 4 * hh; }
#define MFMA32(a, b, c) __builtin_amdgcn_mfma_f32_32x32x16_bf16((a), (b), (c), 0, 0, 0)
__device__ __forceinline__ void gla_passA_item(Frame& F, int item, int l, unsigned char* wsl) {
    const int n = item % GNC, bh = item / GNC, b = bh >> 2, h = bh & 3, tid = opaque_v(F.tid), w = F.wave, lane = tid & 63;
    LAS float* gw = (LAS float*)(F.lds + G_W);
    const bf16_t* U = (const bf16_t*)(wsl + WS_U);
    const int d0 = 8 * w, p = 64 * n - 48 + lane; const bool valid = p >= 0;
    const bf16_t* urow = U + ((size_t)b * L + (valid ? p : 0)) * INC;
    const u32x4 g0 = *(const u32x4*)(urow + O_GF), g1 = *(const u32x4*)(urow + O_GF + 8), g2 = *(const u32x4*)(urow + O_GB), g3 = *(const u32x4*)(urow + O_GB + 8);
    const u32x4 qraw = *(const u32x4*)(urow + O_AQ + h * 64 + d0), kraw = *(const u32x4*)(urow + O_AK + h * 64 + d0);
    const u32x4 v0 = *(const u32x4*)(urow + O_AV + h * 128 + 16 * w), v1 = *(const u32x4*)(urow + O_AV + h * 128 + 16 * w + 8);
    __syncthreads();
    for (int e = tid; e < 2176; e += 512) { float v;
        if (e < 2048) { const int dirw = e >> 10, rr = (e >> 6) & 15, d = e & 63; v = (dirw ? kin(8) : kin(6))[(size_t)l * 16 * 256 + rr * 256 + h * 64 + d]; }
        else { const int dirw = (e - 2048) >> 6, d = e & 63; v = (dirw ? kin(9) : kin(7))[l * 256 + h * 64 + d]; }
        gw[e] = v; }
    __syncthreads();
    float glf[16], glb[16];
    {
#pragma unroll
      for (int r = 0; r < 4; ++r) { glf[2 * r] = __builtin_bit_cast(float, g0[r] << 16); glf[2 * r + 1] = __builtin_bit_cast(float, g0[r] & 0xffff0000u); glf[8 + 2 * r] = __builtin_bit_cast(float, g1[r] << 16); glf[9 + 2 * r] = __builtin_bit_cast(float, g1[r] & 0xffff0000u);
          glb[2 * r] = __builtin_bit_cast(float, g2[r] << 16); glb[2 * r + 1] = __builtin_bit_cast(float, g2[r] & 0xffff0000u); glb[8 + 2 * r] = __builtin_bit_cast(float, g3[r] << 16); glb[9 + 2 * r] = __builtin_bit_cast(float, g3[r] & 0xffff0000u); } }
    float cF[8], cB[8], tF[8], tB[8];
#pragma unroll
    for (int dirw = 0; dirw < 2; ++dirw) {
        float x[8];
        { const f32x4 b0 = *(const LAS f32x4*)(gw + 2048 + dirw * 64 + d0), b1 = *(const LAS f32x4*)(gw + 2048 + dirw * 64 + d0 + 4);
#pragma unroll
          for (int j = 0; j < 4; ++j) { x[j] = b0[j]; x[4 + j] = b1[j]; } }
#pragma unroll
        for (int r = 0; r < 16; ++r) {
            const f32x4 a0 = *(const LAS f32x4*)(gw + dirw * 1024 + r * 64 + d0), a1 = *(const LAS f32x4*)(gw + dirw * 1024 + r * 64 + d0 + 4);
            const float g = dirw ? glb[r] : glf[r];
#pragma unroll
            for (int j = 0; j < 4; ++j) { x[j] += g * a0[j]; x[4 + j] += g * a1[j]; }
            if ((r & 3) == 3) asm volatile("" : "+v"(x[0]), "+v"(x[1]), "+v"(x[2]), "+v"(x[3]), "+v"(x[4]), "+v"(x[5]), "+v"(x[6]), "+v"(x[7]));
        }
#pragma unroll
        for (int dd = 0; dd < 8; ++dd) {
            const float lg = valid ? logsigmoid_fast(x[dd]) * (1.0f / 16.0f) : 0.f;
            const float ps = wave_incl_scan(lg, lane), tot = lane_bcast63(ps);
            if (dirw == 0) { cF[dd] = ps; tF[dd] = tot; } else { cB[dd] = tot - ps + lg; tB[dd] = tot; }

        }
    }
    LAS bf16_t* op0 = (LAS bf16_t*)(F.lds + G_OP0); LAS bf16_t* op1 = (LAS bf16_t*)(F.lds + G_OP1); LAS float* dec = (LAS float*)(F.lds + G_DEC);
    unsigned pq0[4], pq1[4], pq2[4], pq3[4];
#pragma unroll
    for (int dd = 0; dd < 8; ++dd) {
        const float qv = valid ? ((dd & 1) ? __builtin_bit_cast(float, qraw[dd >> 1] & 0xffff0000u) : __builtin_bit_cast(float, qraw[dd >> 1] << 16)) : 0.f;
        const float kv = valid ? ((dd & 1) ? __builtin_bit_cast(float, kraw[dd >> 1] & 0xffff0000u) : __builtin_bit_cast(float, kraw[dd >> 1] << 16)) : 0.f;
        op0[(d0 + dd) * GS + lane] = (bf16_t)f2bf(kv * __expf(tF[dd] - cF[dd]));
        op1[(d0 + dd) * GS + lane] = (bf16_t)f2bf(kv * __expf(tB[dd] - cB[dd]));
        if (lane == 0) { dec[d0 + dd] = __expf(tF[dd]); dec[64 + d0 + dd] = __expf(tB[dd]); }
        const unsigned a0 = f2bf(qv * 0.125f * __expf(cF[dd])), a1 = f2bf(kv * __expf(-cF[dd])), a2 = f2bf(qv * 0.125f * __expf(cB[dd])), a3 = f2bf(kv * __expf(-cB[dd]));
        if (dd & 1) { pq0[dd >> 1] |= a0 << 16; pq1[dd >> 1] |= a1 << 16; pq2[dd >> 1] |= a2 << 16; pq3[dd >> 1] |= a3 << 16; }
        else { pq0[dd >> 1] = a0; pq1[dd >> 1] = a1; pq2[dd >> 1] = a2; pq3[dd >> 1] = a3; }
    }
    { LAS bf16_t* st = (LAS bf16_t*)(F.lds + G_ST) + lane * GS + d0;
      *(LAS u32x4*)(st) = (u32x4){pq0[0], pq0[1], pq0[2], pq0[3]}; *(LAS u32x4*)(st + 64 * GS) = (u32x4){pq1[0], pq1[1], pq1[2], pq1[3]};
      *(LAS u32x4*)(st + 128 * GS) = (u32x4){pq2[0], pq2[1], pq2[2], pq2[3]}; *(LAS u32x4*)(st + 192 * GS) = (u32x4){pq3[0], pq3[1], pq3[2], pq3[3]}; }
    LAS bf16_t* vt = (LAS bf16_t*)(F.lds + G_VT);
    {
#pragma unroll
      for (int j = 0; j < 4; ++j) { const int dv = 16 * w + 2 * j;
          vt[dv * GS + lane] = valid ? (bf16_t)(v0[j] & 0xffffu) : (bf16_t)0; vt[(dv + 1) * GS + lane] = valid ? (bf16_t)(v0[j] >> 16) : (bf16_t)0;
          vt[(dv + 8) * GS + lane] = valid ? (bf16_t)(v1[j] & 0xffffu) : (bf16_t)0; vt[(dv + 9) * GS + lane] = valid ? (bf16_t)(v1[j] >> 16) : (bf16_t)0; } }
    __syncthreads();
    { bf16_t* gvt = (bf16_t*)(wsl + WS_GVT) + (size_t)item * 8192;
#pragma unroll
      for (int it = 0; it < 2; ++it) { const int e = it * 512 + tid, dv = e >> 3, pc = e & 7; *(u32x4*)(gvt + dv * 64 + pc * 8) = *(const LAS u32x4*)(vt + dv * GS + pc * 8); } }
    { bf16_t* gqk = (bf16_t*)(wsl + WS_GQK) + (size_t)item * 4 * 4096; const LAS bf16_t* st = (const LAS bf16_t*)(F.lds + G_ST);
#pragma unroll
      for (int it = 0; it < 4; ++it) { const int pos = tid >> 3, pc = tid & 7; *(u32x4*)(gqk + it * 4096 + pos * 64 + pc * 8) = *(const LAS u32x4*)(st + (it * 64 + pos) * GS + pc * 8); } }
    const int dir = w >> 2, dvb = w & 3, r = lane & 31, hh = lane >> 5;
    const LAS bf16_t* KL = (const LAS bf16_t*)(F.lds + (dir ? G_OP1 : G_OP0));
    f32x16 acc0, acc1;
#pragma unroll
    for (int i = 0; i < 16; ++i) { acc0[i] = 0.f; acc1[i] = 0.f; }
#pragma unroll
    for (int ks = 0; ks < 4; ++ks) {
        const bf16x8 a = *(const LAS bf16x8*)(vt + (32 * dvb + r) * GS + 16 * ks + 8 * hh);
        const bf16x8 b0 = *(const LAS bf16x8*)(KL + r * GS + 16 * ks + 8 * hh);
        const bf16x8 b1 = *(const LAS bf16x8*)(KL + (32 + r) * GS + 16 * ks + 8 * hh);
        acc0 = MFMA32(a, b0, acc0); acc1 = MFMA32(a, b1, acc1);
    }
    const int chain = (bh << 1) | dir;
    bf16_t* kvt = (bf16_t*)(wsl + WS_KVT) + ((size_t)chain * GNC + n) * 128 * 64;
#pragma unroll
    for (int i = 0; i < 16; ++i) { const int dv = 32 * dvb + crow16(i, hh); kvt[dv * 64 + r] = (bf16_t)f2bf(acc0[i]); kvt[dv * 64 + 32 + r] = (bf16_t)f2bf(acc1[i]); }
    if (tid < 128) { const int d = tid & 63, dd = tid >> 6; ((float*)(wsl + WS_DEC))[((size_t)((bh << 1) | dd) * GNC + n) * 64 + d] = ((const LAS float*)(F.lds + G_DEC))[dd * 64 + d]; }
}
__device__ __forceinline__ void gla_passB(Frame& F, unsigned char* wsl) {
    const bf16_t* KVT = (const bf16_t*)(wsl + WS_KVT); const float* DEC = (const float*)(wsl + WS_DEC); bf16_t* SPT = (bf16_t*)(wsl + WS_SPT);
    const int t0 = blockIdx.x * 512 + F.tid, tstride = F.G * 512;
    for (int t = t0; t < 64 * 4096; t += 2 * tstride) {
        const int tb = t + tstride; const bool hasb = tb < 64 * 4096; const int t2 = hasb ? tb : t;
        const int chA = t >> 12, remA = t & 4095, dvA = remA >> 5, dkA = (remA & 31) * 2, dirA = chA & 1;
        const int chB = t2 >> 12, remB = t2 & 4095, dvB = remB >> 5, dkB = (remB & 31) * 2, dirB = chB & 1;
        float a0 = 0.f, a1 = 0.f, b0 = 0.f, b1 = 0.f;
#pragma unroll 11
        for (int st = 0; st < GNC; ++st) { const int nA = dirA ? GNC - 1 - st : st, nB = dirB ? GNC - 1 - st : st;
            const size_t oA = (((size_t)chA * GNC + nA) * 128 + dvA) * 64 + dkA, oB = (((size_t)chB * GNC + nB) * 128 + dvB) * 64 + dkB;
            *(unsigned*)(SPT + oA) = pk2(a0, a1); if (hasb) *(unsigned*)(SPT + oB) = pk2(b0, b1);
            const unsigned kva_ = *(const unsigned*)(KVT + oA); const f32x2 kvA = (f32x2){__builtin_bit_cast(float, kva_ << 16), __builtin_bit_cast(float, kva_ & 0xffff0000u)}, dcA = *(const f32x2*)(DEC + ((size_t)chA * GNC + nA) * 64 + dkA);
            const unsigned kvb_ = *(const unsigned*)(KVT + oB); const f32x2 kvB = (f32x2){__builtin_bit_cast(float, kvb_ << 16), __builtin_bit_cast(float, kvb_ & 0xffff0000u)}, dcB = *(const f32x2*)(DEC + ((size_t)chB * GNC + nB) * 64 + dkB);
            a0 = dcA[0] * a0 + kvA[0]; a1 = dcA[1] * a1 + kvA[1]; b0 = dcB[0] * b0 + kvB[0]; b1 = dcB[1] * b1 + kvB[1]; }
    }
}
__device__ __forceinline__ void gla_passC_item(Frame& F, int item, int l, unsigned char* wsl) {
    constexpr int C_QD = 0, C_KI = 18432, C_SP = 36864, C_VT = 73728, C_PART = 92160, C_OS = 0, RB = GS * 2, OSS = 132;
    const int n = item % GNC, bh = item / GNC, b = bh >> 2, h = bh & 3;
    const int w = F.wave, tid = opaque_v(F.tid), lane = tid & 63, cb = w >> 2, dvb = w & 3, r = lane & 31, hh = lane >> 5;
    const bf16_t* gqk = (const bf16_t*)(wsl + WS_GQK) + (size_t)item * 4 * 4096;
    const bf16_t* gvt = (const bf16_t*)(wsl + WS_GVT) + (size_t)item * 8192;
    const bf16_t* spt0 = (const bf16_t*)(wsl + WS_SPT) + ((size_t)((bh << 1) | 0) * GNC + n) * 128 * 64;
    const bf16_t* spt1 = (const bf16_t*)(wsl + WS_SPT) + ((size_t)((bh << 1) | 1) * GNC + n) * 128 * 64;
    const bf16_t* U = (const bf16_t*)(wsl + WS_U); bf16_t* Y = (bf16_t*)(wsl + WS_Y);
    u32x4 raw[10], rgr[2];
#pragma unroll
    for (int it = 0; it < 4; ++it) raw[it] = *(const u32x4*)(gqk + it * 4096 + tid * 8);
    raw[4] = *(const u32x4*)(spt0 + tid * 8); raw[5] = *(const u32x4*)(spt0 + 4096 + tid * 8); raw[6] = *(const u32x4*)(spt1 + tid * 8); raw[7] = *(const u32x4*)(spt1 + 4096 + tid * 8);
    raw[8] = *(const u32x4*)(gvt + tid * 8); raw[9] = *(const u32x4*)(gvt + 4096 + tid * 8);
#pragma unroll
    for (int it = 0; it < 2; ++it) { const int e = it * 512 + tid, pos = e >> 4, p = 64 * n - 48 + pos;
        rgr[it] = *(const u32x4*)(U + ((size_t)b * L + max(p, 0)) * INC + O_AR + h * 128 + 8 * (e & 15)); }
    const float gv = (kin(10) + l * 512 + h * 128 + 32 * dvb)[r];
    { const int row = tid >> 3, pc = tid & 7; LAS unsigned char* dst = F.lds + row * RB + pc * 16;
      *(LAS u32x4*)(dst + C_QD) = raw[0]; *(LAS u32x4*)(dst + C_KI) = raw[1]; *(LAS u32x4*)(dst + C_QD + 64 * RB) = raw[2]; *(LAS u32x4*)(dst + C_KI + 64 * RB) = raw[3];
      *(LAS u32x4*)(dst + C_SP) = raw[4]; *(LAS u32x4*)(dst + C_SP + 64 * RB) = raw[5]; *(LAS u32x4*)(dst + C_SP + 128 * RB) = raw[6]; *(LAS u32x4*)(dst + C_SP + 192 * RB) = raw[7];
      *(LAS u32x4*)(dst + C_VT) = raw[8]; *(LAS u32x4*)(dst + C_VT + 64 * RB) = raw[9]; }
    __syncthreads();
    f32x16 o;
#pragma unroll
    for (int i = 0; i < 16; ++i) o[i] = 0.f;
    const LAS unsigned char* fb = F.lds + r * RB + 16 * hh;
    const LAS unsigned char* vb = F.lds + C_VT + (32 * dvb + r) * RB + 8 * hh;
#pragma unroll
    for (int dir = 0; dir < 2; ++dir) {
        bf16x8 qf[4];
#pragma unroll
        for (int ks = 0; ks < 4; ++ks) qf[ks] = *(const LAS bf16x8*)(fb + C_QD + (dir * 64 + 32 * cb) * RB + 32 * ks);
#pragma unroll
        for (int sb = 0; sb < 2; ++sb) {
            f32x16 X;
#pragma unroll
            for (int i = 0; i < 16; ++i) X[i] = 0.f;
#pragma unroll
            for (int ks = 0; ks < 4; ++ks) X = MFMA32(*(const LAS bf16x8*)(fb + C_KI + (dir * 64 + 32 * sb) * RB + 32 * ks), qf[ks], X);
            const int cidx = 32 * cb + r;
#pragma unroll
            for (int i = 0; i < 16; ++i) { const int sidx = 32 * sb + crow16(i, hh); const bool keep = dir ? (sidx > cidx) : (sidx <= cidx); X[i] = keep ? X[i] : 0.f; }
#pragma unroll
            for (int ks2 = 0; ks2 < 2; ++ks2) {
                u32x4 xp; xp.x = pk2(X[8 * ks2 + 0], X[8 * ks2 + 1]); xp.y = pk2(X[8 * ks2 + 2], X[8 * ks2 + 3]); xp.z = pk2(X[8 * ks2 + 4], X[8 * ks2 + 5]); xp.w = pk2(X[8 * ks2 + 6], X[8 * ks2 + 7]);
                const s16x4 vlo = *(const LAS s16x4*)(vb + (32 * sb + 16 * ks2) * 2), vhi = *(const LAS s16x4*)(vb + (32 * sb + 16 * ks2 + 8) * 2);
                o = MFMA32(__builtin_bit_cast(bf16x8, xp), __builtin_shufflevector(vlo, vhi, 0, 1, 2, 3, 4, 5, 6, 7), o);
            }
        }
#pragma unroll
        for (int ks = 0; ks < 4; ++ks) o = MFMA32(qf[ks], *(const LAS bf16x8*)(fb + C_SP + (dir * 128 + 32 * dvb) * RB + 32 * ks), o);
    }
    LAS float* part = (LAS float*)(F.lds + C_PART);
#pragma unroll
    for (int i = 0; i < 16; ++i) { float q = o[i] * o[i];
        q = row_shr_add<1>(q); q = row_shr_add<2>(q); q = row_shr_add<4>(q); q = row_shr_add<8>(q);
        const int qi = __builtin_bit_cast(int, q);
        const float s0 = __builtin_bit_cast(float, __builtin_amdgcn_readlane(qi, 15)) + __builtin_bit_cast(float, __builtin_amdgcn_readlane(qi, 31));
        const float s1 = __builtin_bit_cast(float, __builtin_amdgcn_readlane(qi, 47)) + __builtin_bit_cast(float, __builtin_amdgcn_readlane(qi, 63));
        if (r == 0) part[(cb * 4 + dvb) * 32 + crow16(i, hh)] = hh ? s1 : s0; }
    __syncthreads();
    LAS float* os = (LAS float*)(F.lds + C_OS);
#pragma unroll
    for (int i = 0; i < 16; ++i) { const int rw = crow16(i, hh);
        const float ss = (part[(cb * 4 + 0) * 32 + rw] + part[(cb * 4 + 1) * 32 + rw]) + (part[(cb * 4 + 2) * 32 + rw] + part[(cb * 4 + 3) * 32 + rw]);
        const float rs = rsqrtf(ss * (1.0f / 128.0f) + 1e-6f);
        os[(32 * cb + rw) * OSS + 32 * dvb + r] = o[i] * rs * gv; }
    __syncthreads();
#pragma unroll
    for (int it = 0; it < 2; ++it) { const int e = it * 512 + tid, pos = e >> 4, dv0 = 8 * (e & 15), p = 64 * n - 48 + pos;
        if (p >= 0) { const f32x4 a0 = *(const LAS f32x4*)(os + pos * OSS + dv0), a1 = *(const LAS f32x4*)(os + pos * OSS + dv0 + 4); const u32x4 g = rgr[it]; float y[8];
#pragma unroll
            for (int j = 0; j < 4; ++j) { const float g0 = __builtin_bit_cast(float, g[j] << 16), g1 = __builtin_bit_cast(float, g[j] & 0xffff0000u);
                const float x0 = j < 2 ? a0[2 * j] : a1[2 * j - 4], x1 = j < 2 ? a0[2 * j + 1] : a1[2 * j - 3];
                y[2 * j] = x0 * (g0 / (1.0f + __expf(-g0))); y[2 * j + 1] = x1 * (g1 / (1.0f + __expf(-g1))); }
            u32x4 wv; wv.x = pk2(y[0], y[1]); wv.y = pk2(y[2], y[3]); wv.z = pk2(y[4], y[5]); wv.w = pk2(y[6], y[7]);
            *(u32x4*)(Y + ((size_t)b * L + p) * D + h * 128 + dv0) = wv; } }
}

constexpr int SW_KS = 136, SW_VS = 36;
constexpr int SW_K = 0, SW_V = 2 * 2 * 32 * SW_KS * 2;
constexpr int SW_PART = SW_V + 2 * 2 * 128 * SW_VS * 2;
constexpr int SW_OS = 1032;
__device__ __forceinline__ void swa_item(Frame& F, int item, int l, unsigned char* wsl) {
    const bf16_t* U = (const bf16_t*)(wsl + WS_U); bf16_t* Y = (bf16_t*)(wsl + WS_Y);
    const int qb = item % 65, b = item / 65, q0 = 32 * qb, tid = opaque_v(F.tid), lane = tid & 63, w = F.wave, r = lane & 31, hh = lane >> 5;
    const int head = w, kvh = w >> 2, qp = q0 + r;
    const float slope = exp2f(-(float)(head + 1));
    const float sk = (kin(11) + l * 8)[head];
    bf16x8 Qf[8];
    { const bf16_t* qrow = U + ((size_t)b * L + min(qp, L - 1)) * INC + O_BQ + head * 128;
#pragma unroll
      for (int ks = 0; ks < 8; ++ks) Qf[ks] = *(const bf16x8*)(qrow + 16 * ks + 8 * hh); }
    f32x16 O[4];
#pragma unroll
    for (int db = 0; db < 4; ++db)
#pragma unroll
        for (int i = 0; i < 16; ++i) O[db][i] = 0.f;
    const float sc2 = 0.08838834764831845f * 1.4426950408889634f, slope2 = slope * 1.4426950408889634f;
    float m = sk * 1.4426950408889634f, lsum = hh == 0 ? 1.0f : 0.0f;
    const int tlo = max(1, qb - 4), thi = min(64, qb + 4), ntile = 1 + (thi - tlo + 1), nch = (ntile + 1) >> 1;
    LAS bf16_t* Ks = (LAS bf16_t*)(F.lds + SW_K); LAS bf16_t* Vs = (LAS bf16_t*)(F.lds + SW_V);
    u32x4 kx[2][4], vx[2][4];
#define SWA_FETCH(chn, par_) do { _Pragma("unroll") for (int it = 0; it < 4; ++it) { const int e = it * 512 + tid; const int key = e & 31, d8 = (e >> 5) & 15, kv2 = (e >> 9) & 1, sl_ = e >> 10; \
            const int ti_ = (chn) * 2 + sl_; const int tl_ = ti_ == 0 ? 0 : tlo + ti_ - 1; const int kp_ = min(32 * tl_ + key, L - 1); const bf16_t* krow = U + ((size_t)b * L + kp_) * INC; \
            const int kkey_ = (e >> 4) & 31, kd8_ = e & 15; const bf16_t* krow2 = U + ((size_t)b * L + min(32 * tl_ + kkey_, L - 1)) * INC;        \
            kx[par_][it] = *(const u32x4*)(krow2 + O_BK + kv2 * 128 + 8 * kd8_); vx[par_][it] = *(const u32x4*)(krow + O_BV + kv2 * 128 + 8 * d8); } } while (0)
    SWA_FETCH(0, 0);
    if (nch > 1) SWA_FETCH(1, 1);
    for (int c2 = 0; c2 < nch; c2 += 2) {
#pragma unroll
      for (int par = 0; par < 2; ++par) {
        const int ch = c2 + par; if (ch >= nch) break;
        __syncthreads();
#pragma unroll
        for (int it = 0; it < 4; ++it) { const int e = it * 512 + tid; const int key = e & 31, d8 = (e >> 5) & 15, kv2 = (e >> 9) & 1, sl = e >> 10;
            *(LAS u32x4*)(Ks + ((sl * 2 + kv2) * 32 + ((e >> 4) & 31)) * SW_KS + 8 * (e & 15)) = kx[par][it];
            LAS bf16_t* vb = Vs + ((sl * 2 + kv2) * 128 + 8 * d8) * SW_VS + key;
#pragma unroll
            for (int j = 0; j < 4; ++j) { vb[(2 * j) * SW_VS] = (bf16_t)(vx[par][it][j] & 0xffffu); vb[(2 * j + 1) * SW_VS] = (bf16_t)(vx[par][it][j] >> 16); } }
        if (ch + 2 < nch) SWA_FETCH(ch + 2, par);
        __syncthreads();
#pragma unroll 1
        for (int sl = 0; sl < 2; ++sl) {
            const int ti = ch * 2 + sl; if (ti >= ntile) break;
            const int tl = ti == 0 ? 0 : tlo + ti - 1, kp0 = 32 * tl;
            f32x16 S;
#pragma unroll
            for (int i = 0; i < 16; ++i) S[i] = 0.f;
            const LAS bf16_t* kt = Ks + ((sl * 2 + kvh) * 32 + r) * SW_KS + 8 * hh;
#pragma unroll
            for (int ks = 0; ks < 8; ++ks) { const bf16x8 a = *(const LAS bf16x8*)(kt + 16 * ks); S = MFMA32(a, Qf[ks], S); }
            float mx = -1e30f;
            const float fb = (float)(qp - kp0 - 4 * hh);
            if (tl != 0 && abs(qb - tl) <= 3 && tl < 64) {
#pragma unroll
                for (int i = 0; i < 16; ++i) { const float dist = fabsf(fb - (float)((i & 3) + 8 * (i >> 2))); const float sv = S[i] * sc2 - slope2 * dist; S[i] = sv; mx = fmaxf(mx, sv); }
            } else {
#pragma unroll
                for (int i = 0; i < 16; ++i) { const int kp = kp0 + crow16(i, hh); const float dist = fabsf(fb - (float)((i & 3) + 8 * (i >> 2)));
                    const bool ok = (tl == 0) ? (kp < NMETA || dist <= 128.f) : (kp < L && dist <= 128.f);
                    const float sv = ok ? S[i] * sc2 - slope2 * dist : -1e30f; S[i] = sv; mx = fmaxf(mx, sv); }
            }
            mx = fmaxf(mx, xor32(mx));
            float mn = m, alpha = 1.0f;
            if (__builtin_amdgcn_ballot_w64(mx - m > 8.0f) != 0ull) { mn = fmaxf(m, mx); alpha = __builtin_amdgcn_exp2f(m - mn); m = mn; }
            float ps = 0.f;
#pragma unroll
            for (int i = 0; i < 16; ++i) { const float pv = __builtin_amdgcn_exp2f(S[i] - mn); S[i] = pv; ps += pv; }
            lsum = lsum * alpha + ps;
            if (__builtin_amdgcn_ballot_w64(alpha != 1.0f) != 0ull) {
#pragma unroll
                for (int db = 0; db < 4; ++db)
#pragma unroll
                    for (int i = 0; i < 16; ++i) O[db][i] *= alpha; }
            const LAS bf16_t* vt = Vs + ((sl * 2 + kvh) * 128 + r) * SW_VS + 4 * hh;
#pragma unroll
            for (int ks2 = 0; ks2 < 2; ++ks2) {
                u32x4 xp; xp.x = pk2(S[8 * ks2 + 0], S[8 * ks2 + 1]); xp.y = pk2(S[8 * ks2 + 2], S[8 * ks2 + 3]); xp.z = pk2(S[8 * ks2 + 4], S[8 * ks2 + 5]); xp.w = pk2(S[8 * ks2 + 6], S[8 * ks2 + 7]);
                const bf16x8 pb = __builtin_bit_cast(bf16x8, xp);
#pragma unroll
                for (int db = 0; db < 4; ++db) {
                    const s16x4 lo = *(const LAS s16x4*)(vt + (32 * db) * SW_VS + 16 * ks2), hi = *(const LAS s16x4*)(vt + (32 * db) * SW_VS + 16 * ks2 + 8);
                    O[db] = MFMA32(__builtin_shufflevector(lo, hi, 0, 1, 2, 3, 4, 5, 6, 7), pb, O[db]); }
            }
        }
      }
    }
#undef SWA_FETCH
    const float lt = lsum + xor32(lsum), inv = 1.0f / lt;
    float ss = 0.f;
#pragma unroll
    for (int db = 0; db < 4; ++db)
#pragma unroll
        for (int i = 0; i < 16; ++i) { O[db][i] *= inv; ss += O[db][i] * O[db][i]; }
    ss += xor32(ss);
    __syncthreads();
    LAS float* part = (LAS float*)(F.lds + SW_PART); LAS bf16_t* os = (LAS bf16_t*)F.lds;
    if (hh == 0) part[w * 32 + r] = ss;
#pragma unroll
    for (int db = 0; db < 4; ++db)
#pragma unroll
        for (int g = 0; g < 4; ++g) { u32x2 pk; pk.x = pk2(O[db][4 * g], O[db][4 * g + 1]); pk.y = pk2(O[db][4 * g + 2], O[db][4 * g + 3]);
            *(LAS u32x2*)(os + r * SW_OS + w * 128 + 32 * db + 8 * g + 4 * hh) = pk; }
    __syncthreads();
    { const int q = tid >> 4, pc = tid & 15, p = q0 + q;
      if (p < L) { float tot = 0.f;
#pragma unroll
          for (int ww = 0; ww < 8; ++ww) tot += part[ww * 32 + q];
          const float rs = rsqrtf(tot * (1.0f / 1024.0f) + 1e-6f); const LAS float* sg = (const LAS float*)(F.lds + MIXC_SG); bf16_t* yrow = Y + ((size_t)b * L + p) * D + 512;
#pragma unroll
          for (int k = 0; k < 8; ++k) { const int c = 8 * pc + 128 * k; const u32x4 v = *(const LAS u32x4*)(os + q * SW_OS + c);
              const f32x4 g0 = *(const LAS f32x4*)(sg + c), g1 = *(const LAS f32x4*)(sg + c + 4); u32x4 o;
              o.x = pk2(__builtin_bit_cast(float, v.x << 16) * rs * g0[0], __builtin_bit_cast(float, v.x & 0xffff0000u) * rs * g0[1]);
              o.y = pk2(__builtin_bit_cast(float, v.y << 16) * rs * g0[2], __builtin_bit_cast(float, v.y & 0xffff0000u) * rs * g0[3]);
              o.z = pk2(__builtin_bit_cast(float, v.z << 16) * rs * g1[0], __builtin_bit_cast(float, v.z & 0xffff0000u) * rs * g1[1]);
              o.w = pk2(__builtin_bit_cast(float, v.w << 16) * rs * g1[2], __builtin_bit_cast(float, v.w & 0xffff0000u) * rs * g1[3]);
              *(u32x4*)(yrow + c) = o; } } }
}

__device__ __forceinline__ float logsigmoidf_(float x) { return fminf(x, 0.f) - log1pf(expf(-fabsf(x))); }

__device__ __forceinline__ int q_publish(Frame& F, int fetched) {
    LAS int* slot = (LAS int*)(F.lds + LDSCTL_OFF + 512);
    __syncthreads();
    if (F.tid == 0) *slot = fetched;
    __syncthreads();
    return *slot;
}
__device__ __forceinline__ void p_mix1(Frame& F, int l) {
    unsigned char* const wsl = launder_ws(F.ws);
    unsigned* const qw = (unsigned*)(wsl + WS_CTL) + CW_Q + (l * 4 + 0) * 64;
    constexpr int N_SWA = NB * 65, N_GLA = NB * 4 * GNC, N_HP = NB * 33 * 4, N_ALL = N_SWA + N_GLA + N_HP;
    int fetched = 0;
    if (F.tid == 0) fetched = (int)atomicAdd(qw, 1u);
    { const float* sgg = kin(12) + l * 1024; const float* cwg = kin(13) + (size_t)l * 3 * 1536; const float* cbg = kin(14) + l * 1536;
      if (F.tid < 256) *(LAS f32x4*)(F.lds + MIXC_SG + 16 * F.tid) = ((const f32x4*)sgg)[F.tid];
      for (int e = F.tid; e < 1152; e += 512) *(LAS f32x4*)(F.lds + MIXC_CW + 16 * e) = ((const f32x4*)cwg)[e];
      if (F.tid < 384) *(LAS f32x4*)(F.lds + MIXC_CB + 16 * F.tid) = ((const f32x4*)cbg)[F.tid]; }
    int u = q_publish(F, fetched);
    while (u < N_ALL) {
        if (F.tid == 0) fetched = (int)atomicAdd(qw, 1u);
        if (u < N_SWA) swa_item(F, u, l, wsl);
        else if (u < N_SWA + N_GLA) gla_passA_item(F, u - N_SWA, l, wsl);
        else hy_pre_item(F, u - N_SWA - N_GLA, l, wsl);
        u = q_publish(F, fetched);
    }
    __syncthreads();
}

__device__ __forceinline__ void p_mix2(Frame& F, int l) {
    unsigned char* const wsl = launder_ws(F.ws);
    gla_passB(F, wsl);
    hy_conv_phase(F, l, wsl);
}

__device__ __forceinline__ void p_mix3(Frame& F, int l) {
    unsigned char* const wsl = launder_ws(F.ws);
    unsigned* const qw = (unsigned*)(wsl + WS_CTL) + CW_Q + (l * 4 + 2) * 64;
    constexpr int N_GC = NB * 4 * GNC, N_HN = NB * 33, N_ALL = N_GC + N_HN;
    int fetched = 0;
    if (F.tid == 0) fetched = (int)atomicAdd(qw, 1u);
    if (F.tid < 128) *(LAS f32x4*)(F.lds + MIXC_HG + 16 * F.tid) = ((const f32x4*)(kin(22) + l * 512))[F.tid];
    int u = q_publish(F, fetched);
    while (u < N_ALL) {
        if (F.tid == 0) fetched = (int)atomicAdd(qw, 1u);
        if (u < N_HN) hy_norm_item(F, u, l, wsl);
        else gla_passC_item(F, u - N_HN, l, wsl);
        u = q_publish(F, fetched);
    }
    __syncthreads();
}

constexpr int R_RS = 2056;
constexpr int R_AH = 0, R_AL = 8 * R_RS * 2, R_PART = 2 * 8 * R_RS * 2, R_LG = R_PART + 8 * 8 * 32 * 4, R_LCNT = R_LG + 1024, R_REC = R_LCNT + 128;
template <bool DUMMY>
__device__ __forceinline__ void p_ln1_router(Frame& F, int l) {
    unsigned char* const wsl = launder_ws(F.ws); unsigned* const ctl = (unsigned*)(wsl + WS_CTL);
    const bf16_t* MX = (const bf16_t*)(wsl + WS_R1); const bf16_t* hin = (const bf16_t*)(wsl + WS_HB); bf16_t* h = (bf16_t*)(wsl + (DUMMY ? WS_DUM : WS_HB)); unsigned char* hb = wsl + (DUMMY ? WS_DUM + (size_t)T * D * 4 : WS_HB8);
    int* cnt = (int*)(ctl + CW_CNT + l * 512 + (DUMMY ? 256 : 0)); int* list = (int*)(wsl + (DUMMY ? WS_DUM + (size_t)T * D * 6 : WS_LIST));
    int* tok_e = (int*)(wsl + (DUMMY ? WS_DUM + (size_t)T * D * 6 + (size_t)NEXP * T * 4 : WS_TOKE)); int* tok_p = tok_e + (DUMMY ? 2 * T : (WS_TOKP - WS_TOKE) / 4); float* tok_w = (float*)(tok_e + (DUMMY ? 4 * T : (WS_TOKW - WS_TOKE) / 4));
    const LAS float* g = (const LAS float*)(F.lds + 81920); const LAS float* bt = g + D;
    { const float* gg = kin(25) + (size_t)l * D; const float* gb = kin(26) + (size_t)l * D; *(LAS f32x4*)(F.lds + 81920 + 16 * F.tid) = ((const f32x4*)gg)[F.tid]; *(LAS f32x4*)(F.lds + 81920 + 8192 + 16 * F.tid) = ((const f32x4*)gb)[F.tid]; }
    const LAS float* be = (const LAS float*)(F.lds + 81920 + 16384); const LAS float* bg = be + 16;
    if (F.tid < 16) ((LAS float*)(F.lds + 81920 + 16384))[F.tid] = (kin(30) + l * 16)[F.tid]; else if (F.tid < 20) ((LAS float*)(F.lds + 81920 + 16384))[F.tid] = (kin(28) + l * 4)[F.tid - 16];
    const bf16_t* wr = (const bf16_t*)(wsl + WS_WR) + (size_t)l * 256 * 512;
    const int lane = opaque_v(F.lane), w = F.wave, n = lane & 15, kg = lane >> 4;
    LAS bf16_t* AH = (LAS bf16_t*)(F.lds + R_AH); LAS bf16_t* AL = (LAS bf16_t*)(F.lds + R_AL); LAS float* PART = (LAS float*)(F.lds + R_PART); LAS float* LG = (LAS float*)(F.lds + R_LG);
    constexpr int NGRP = T / 8;
    bf16x8 wfr[8][4];
#pragma unroll
    for (int si = 0; si < 8; ++si) { const bf16_t* wp = wr + ((size_t)(8 * w + si) * 4 * 64 + lane) * 8;
#pragma unroll
        for (int q = 0; q < 4; ++q) wfr[si][q] = *(const bf16x8*)(wp + 512 * q); }
    LAS int* lcnt = (LAS int*)(F.lds + R_LCNT); LAS int* rec = (LAS int*)(F.lds + R_REC);
    if (F.tid < 32) lcnt[F.tid] = 0;
    int nloc = 0;
    f32x4 v[8];
    u32x2 hxr[8], mxr[8];
    int gi = F.vcu;
    if (gi < NGRP) {
#pragma unroll
        for (int j = 0; j < 8; ++j) { hxr[j] = ((const u32x2*)(hin + (size_t)(8 * gi + w) * D))[lane + 64 * j]; mxr[j] = ((const u32x2*)(MX + (size_t)(8 * gi + w) * D))[lane + 64 * j]; } }
    __syncthreads();
    for (; gi < NGRP; gi += F.G) {
        const int row = 8 * gi + w;
#pragma unroll
        for (int j = 0; j < 8; ++j) { const u32x2 hx = hxr[j], mx = j < 4 ? mxr[j] : ((const u32x2*)(MX + (size_t)row * D))[lane + 64 * j];
            v[j] = (f32x4){__builtin_bit_cast(float, hx.x << 16), __builtin_bit_cast(float, hx.x & 0xffff0000u), __builtin_bit_cast(float, hx.y << 16), __builtin_bit_cast(float, hx.y & 0xffff0000u)} * ALPHA
                 + (f32x4){__builtin_bit_cast(float, mx.x << 16), __builtin_bit_cast(float, mx.x & 0xffff0000u), __builtin_bit_cast(float, mx.y << 16), __builtin_bit_cast(float, mx.y & 0xffff0000u)}; }
        ln_wave_store<true>(v, g, bt, h + (size_t)row * D, hb + (size_t)row * D, nullptr, lane);
#pragma unroll
        for (int j = 0; j < 8; ++j) { const unsigned h01 = pk2(v[j][0], v[j][1]), h23 = pk2(v[j][2], v[j][3]);
            const unsigned l01 = pk2(v[j][0] - __builtin_bit_cast(float, h01 << 16), v[j][1] - __builtin_bit_cast(float, h01 & 0xffff0000u)), l23 = pk2(v[j][2] - __builtin_bit_cast(float, h23 << 16), v[j][3] - __builtin_bit_cast(float, h23 & 0xffff0000u));
            *(LAS u32x2*)(AH + w * R_RS + (lane + 64 * j) * 4) = (u32x2){h01, h23};
            *(LAS u32x2*)(AL + w * R_RS + (lane + 64 * j) * 4) = (u32x2){l01, l23}; }
        asm volatile("" ::: "memory");
        { const int gn = gi + F.G;
          if (gn < NGRP) {
#pragma unroll
            for (int j = 0; j < 8; ++j) { hxr[j] = ((const u32x2*)(hin + (size_t)(8 * gn + w) * D))[lane + 64 * j]; if (j < 4) mxr[j] = ((const u32x2*)(MX + (size_t)(8 * gn + w) * D))[lane + 64 * j]; } } }
        __syncthreads();
        f32x4 a0 = (f32x4){0.f, 0.f, 0.f, 0.f}, a1 = (f32x4){0.f, 0.f, 0.f, 0.f};
        { const LAS bf16_t* ah = AH + (n & 7) * R_RS + 8 * kg; const LAS bf16_t* al = AL + (n & 7) * R_RS + 8 * kg;
#pragma unroll
          for (int si = 0; si < 8; ++si) { const int st = 8 * w + si;
              const bf16x8 xh = *(const LAS bf16x8*)(ah + 32 * st), xl = *(const LAS bf16x8*)(al + 32 * st);
              const bf16x8 bh0 = wfr[si][0], bl0 = wfr[si][1], bh1 = wfr[si][2], bl1 = wfr[si][3];
              a0 = __builtin_amdgcn_mfma_f32_16x16x32_bf16(xh, bh0, a0, 0, 0, 0); a0 = __builtin_amdgcn_mfma_f32_16x16x32_bf16(xh, bl0, a0, 0, 0, 0); a0 = __builtin_amdgcn_mfma_f32_16x16x32_bf16(xl, bh0, a0, 0, 0, 0);
              a1 = __builtin_amdgcn_mfma_f32_16x16x32_bf16(xh, bh1, a1, 0, 0, 0); a1 = __builtin_amdgcn_mfma_f32_16x16x32_bf16(xh, bl1, a1, 0, 0, 0); a1 = __builtin_amdgcn_mfma_f32_16x16x32_bf16(xl, bh1, a1, 0, 0, 0);
              if (si == 3) __builtin_amdgcn_sched_barrier(0); } }
        if (kg < 2) {
#pragma unroll
            for (int r = 0; r < 4; ++r) { PART[(w * 8 + 4 * kg + r) * 32 + n] = a0[r]; PART[(w * 8 + 4 * kg + r) * 32 + 16 + n] = a1[r]; } }
        __syncthreads();
        if (lane < 32) { float sacc = 0.f;
#pragma unroll
            for (int ww = 0; ww < 8; ++ww) sacc += PART[(ww * 8 + w) * 32 + lane];
            LG[w * 32 + lane] = sacc; }
        LDS_WAIT();
        if (lane == 0) {
            const f32x4 l0 = *(const LAS f32x4*)(LG + w * 32), l1 = *(const LAS f32x4*)(LG + w * 32 + 4), l2 = *(const LAS f32x4*)(LG + w * 32 + 8), l3 = *(const LAS f32x4*)(LG + w * 32 + 12), l4 = *(const LAS f32x4*)(LG + w * 32 + 16);
            float gl[4];
#pragma unroll
            for (int j = 0; j < 4; ++j) gl[j] = l0[j] + bg[j];
            int gsel = 0; float gm = gl[0];
#pragma unroll
            for (int j = 1; j < 4; ++j) if (gl[j] > gm) { gm = gl[j]; gsel = j; }
            float den = 0.f;
#pragma unroll
            for (int j = 0; j < 4; ++j) den += expf(gl[j] - gm);
            const float gtop = 1.0f / den;
            float el[4];
            const float k0 = gsel == 0 ? 1.f : 0.f, k1 = gsel == 1 ? 1.f : 0.f, k2 = gsel == 2 ? 1.f : 0.f, k3 = gsel == 3 ? 1.f : 0.f;
#pragma unroll
            for (int j = 0; j < 4; ++j) el[j] = (k0 * l1[j] + k1 * l2[j]) + (k2 * l3[j] + k3 * l4[j]) + be[gsel * 4 + j];
            int i1 = 0; float m1 = el[0];
#pragma unroll
            for (int j = 1; j < 4; ++j) if (el[j] > m1) { m1 = el[j]; i1 = j; }
            int i2 = -1; float m2 = -3.0e38f;
#pragma unroll
            for (int j = 0; j < 4; ++j) if (j != i1 && el[j] > m2) { m2 = el[j]; i2 = j; }
            const float ex = expf(m2 - m1); const float w1 = gtop / (1.0f + ex), w2 = gtop * ex / (1.0f + ex);
            const int e1 = gsel * 4 + i1, e2 = gsel * 4 + i2;
            const int li1 = __hip_atomic_fetch_add(lcnt + e1, 1, __ATOMIC_RELAXED, __HIP_MEMORY_SCOPE_WORKGROUP), li2 = __hip_atomic_fetch_add(lcnt + e2, 1, __ATOMIC_RELAXED, __HIP_MEMORY_SCOPE_WORKGROUP);
            const int k = nloc * 8 + w; rec[4 * k] = row; rec[4 * k + 1] = e1 | (e2 << 8); rec[4 * k + 2] = li1; rec[4 * k + 3] = li2;
            tok_e[2 * row] = e1; tok_e[2 * row + 1] = e2; tok_w[2 * row] = w1; tok_w[2 * row + 1] = w2;
        }
        ++nloc;
    }
    __syncthreads();
    if (F.tid < 16) { const int c = lcnt[F.tid]; lcnt[16 + F.tid] = c ? atomicAdd(&cnt[16 * F.tid], c) : 0; }
    __syncthreads();
    if (F.tid < nloc * 8) { const int row = rec[4 * F.tid], ee = rec[4 * F.tid + 1], e1 = ee & 255, e2 = ee >> 8;
        const int p1 = lcnt[16 + e1] + rec[4 * F.tid + 2], p2 = lcnt[16 + e2] + rec[4 * F.tid + 3];
        list[(size_t)e1 * T + p1] = row; list[(size_t)e2 * T + p2] = row; tok_p[2 * row] = p1; tok_p[2 * row + 1] = p2; }
    __syncthreads();
}

__device__ __forceinline__ void moe_table(Frame& F, int l) {
    LAS int* tab = (LAS int*)(F.lds + LDSCTL_OFF + 256);
    unsigned* const ctl = (unsigned*)(launder_ws(F.ws) + WS_CTL);
    const int* cnt = (const int*)(ctl + CW_CNT + l * 512);
    __syncthreads();
    if (F.tid < 16) tab[F.tid] = __hip_atomic_load(cnt + 16 * F.tid, __ATOMIC_RELAXED, __HIP_MEMORY_SCOPE_AGENT);
    __syncthreads();
    if (F.tid == 0) { int pp = 0;
        for (int e = 0; e < 16; ++e) { const int c = tab[e]; tab[16 + e] = pp; tab[33 + e] = pp * 256; pp += (c + 255) >> 8; }
        tab[32] = pp; }
    __syncthreads();
}

template <bool DUMMY>
__device__ __forceinline__ void p_ln2(Frame& F, int l) {
    unsigned char* const wsl = launder_ws(F.ws);
    bf16_t* hb = (bf16_t*)(wsl + WS_HB); const unsigned char* O = (const unsigned char*)(wsl + WS_O);
    const int* tok_e = (const int*)(wsl + WS_TOKE); const int* tok_p = (const int*)(wsl + WS_TOKP); const float* tok_w = (const float*)(wsl + WS_TOKW);
    const LAS int* tab = (const LAS int*)(F.lds + LDSCTL_OFF + 256);
    const LAS float* g = (const LAS float*)(F.lds + 65536); const LAS float* bt = g + D;
    { const float* gg = kin(34) + (size_t)l * D; const float* gb = kin(35) + (size_t)l * D; *(LAS f32x4*)(F.lds + 65536 + 16 * F.tid) = ((const f32x4*)gg)[F.tid]; *(LAS f32x4*)(F.lds + 65536 + 8192 + 16 * F.tid) = ((const f32x4*)gb)[F.tid]; }
    __syncthreads();
    const int gw = F.vcu * 8 + F.wave, NGW = F.G * 8, lane = opaque_v(F.lane);
    u32x2 hv[8]; int oa[8], ob[8]; float w0 = 0.f, w1 = 0.f;
    int te0 = 0, te1 = 0, tp0 = 0, tp1 = 0; float tw0 = 0.f, tw1 = 0.f;
    { const int rk = gw + lane * NGW; if (lane < 16 && rk < T) { te0 = tok_e[2 * rk]; te1 = tok_e[2 * rk + 1]; tp0 = tok_p[2 * rk]; tp1 = tok_p[2 * rk + 1]; tw0 = tok_w[2 * rk]; tw1 = tok_w[2 * rk + 1]; } }
    int kk = 0;
#define LN2_ISSUE(rw) do { const int e0_ = __builtin_amdgcn_readlane(te0, kk), e1_ = __builtin_amdgcn_readlane(te1, kk); \
        const size_t r0_ = (size_t)(tab[33 + e0_] + __builtin_amdgcn_readlane(tp0, kk)), r1_ = (size_t)(tab[33 + e1_] + __builtin_amdgcn_readlane(tp1, kk)); \
        w0 = __builtin_bit_cast(float, __builtin_amdgcn_readlane(__builtin_bit_cast(int, tw0), kk)) * (1.0f / 64.0f); w1 = __builtin_bit_cast(float, __builtin_amdgcn_readlane(__builtin_bit_cast(int, tw1), kk)) * (1.0f / 64.0f); ++kk; \
        _Pragma("unroll") for (int j = 0; j < 8; ++j) { const int i4 = lane + 64 * j; hv[j] = ((const u32x2*)(hb + (size_t)(rw) * D))[i4]; oa[j] = ((const int*)(O + r0_ * D))[i4]; ob[j] = ((const int*)(O + r1_ * D))[i4]; } } while (0)
    int row = gw;
    if (row < T) LN2_ISSUE(row);
    for (; row < T; row += NGW) {
        f32x4 v[8];
#pragma unroll
        for (int j = 0; j < 8; ++j) { f32x4 m;
            const f32x2 a01 = __builtin_amdgcn_cvt_pk_f32_fp8(oa[j], false), a23 = __builtin_amdgcn_cvt_pk_f32_fp8(oa[j], true), b01 = __builtin_amdgcn_cvt_pk_f32_fp8(ob[j], false), b23 = __builtin_amdgcn_cvt_pk_f32_fp8(ob[j], true);
            m[0] = w0 * a01[0] + w1 * b01[0]; m[1] = w0 * a01[1] + w1 * b01[1]; m[2] = w0 * a23[0] + w1 * b23[0]; m[3] = w0 * a23[1] + w1 * b23[1];
            v[j] = (f32x4){__builtin_bit_cast(float, hv[j].x << 16), __builtin_bit_cast(float, hv[j].x & 0xffff0000u), __builtin_bit_cast(float, hv[j].y << 16), __builtin_bit_cast(float, hv[j].y & 0xffff0000u)} * ALPHA + m; }
        const int nrow = row + NGW;
        if (nrow < T) LN2_ISSUE(nrow);
        float* orow = nullptr;
        if (l == DEPTH - 1) { const int bb = row / L, pp = row % L; if (pp >= NMETA) orow = kout() + ((size_t)bb * SEQ + (pp - NMETA)) * D; }
        if (DUMMY) ln_wave_store(v, g, bt, (bf16_t*)(wsl + WS_DUM) + (size_t)row * D, nullptr, nullptr, lane);
        else if (l == DEPTH - 1) ln_wave_store<false, true>(v, g, bt, nullptr, nullptr, orow, lane);
        else ln_wave_store(v, g, bt, hb + (size_t)row * D, nullptr, orow, lane);
    }
#undef LN2_ISSUE
}


__device__ __forceinline__ void outproj_tail(Frame& F, int l, unsigned char* wsl) {
    if (F.vcu >= 256) return;
    const int colblk = F.vcu & 127, rh = F.vcu >> 7;
    const bf16_t* Yb = (const bf16_t*)(wsl + WS_Y) + (size_t)(16384 + 64 * rh) * D; const bf16_t* Wt = (const bf16_t*)(wsl + WS_WOUT) + (size_t)l * D * D + (size_t)(16 * colblk) * D;
    const int lane = opaque_v(F.lane), w = F.wave, n = lane & 15, kg = lane >> 4;
    f32x4 acc[4];
#pragma unroll
    for (int mb = 0; mb < 4; ++mb) acc[mb] = (f32x4){0.f, 0.f, 0.f, 0.f};
    const bf16_t* ap = Yb + (size_t)n * D + 256 * w + 8 * kg; const bf16_t* bp = Wt + (size_t)n * D + 256 * w + 8 * kg;
#pragma unroll 4
    for (int ks = 0; ks < 8; ++ks) {
        const bf16x8 bfr = *(const bf16x8*)(bp + 32 * ks);
        bf16x8 af[4];
#pragma unroll
        for (int mb = 0; mb < 4; ++mb) af[mb] = *(const bf16x8*)(ap + (size_t)(16 * mb) * D + 32 * ks);
#pragma unroll
        for (int mb = 0; mb < 4; ++mb) acc[mb] = __builtin_amdgcn_mfma_f32_16x16x32_bf16(af[mb], bfr, acc[mb], 0, 0, 0);
    }
    LAS f32x4* red = (LAS f32x4*)F.lds;
    __syncthreads();
#pragma unroll
    for (int mb = 0; mb < 4; ++mb) red[(w * 4 + mb) * 64 + lane] = acc[mb];
    __syncthreads();
    if (F.tid < 256) { const int mb = F.tid >> 6;
      f32x4 sacc = red[(0 * 4 + mb) * 64 + lane];
#pragma unroll
      for (int ww = 1; ww < 8; ++ww) sacc += red[(ww * 4 + mb) * 64 + lane];
      const int col = 16 * colblk + n; const float bias = (kin(24) + (size_t)l * D)[col];
      bf16_t* MX = (bf16_t*)(wsl + WS_R1);
#pragma unroll
      for (int r = 0; r < 4; ++r) { const size_t o = (size_t)(16384 + 64 * rh + 16 * mb + 4 * kg + r) * D + col; MX[o] = (bf16_t)f2bf(sacc[r] + bias); } }
    __syncthreads();
}

#ifndef REP_LN
#define REP_LN 1
#endif
#ifndef REP_PRO
#define REP_PRO 1
#endif
#ifndef REP_MIX
#define REP_MIX 1
#endif
#ifndef REP_GEMM
#define REP_GEMM 1
#endif
#define IN(k) (lo <= (k) && (k) < hi)
#define SEAM(k) do { if (IN(k) && IN((k) + 1)) xcd_barrier(bar); } while (0)
template <int l>
__device__ __forceinline__ void run_layer(Frame& F, const int lo, const int hi, const XcdBarrier& bar) {
        const int P = 1 + l * NPH;
        if (IN(P + 0)) {
            unsigned char* const wsl = launder_ws(F.ws);
            pg::PlainSched S; S.init(MPAD / 256, INCP / 256, F.G, (int)blockIdx.x);
            pg::EpiInProj E{(bf16_t*)(wsl + WS_U), kin(5) + (size_t)l * INC};
            for (int rep = 0; rep < REP_GEMM; ++rep) pg::gemm_phase<false>(F.lds, wsl + WS_HB, (const bf16_t*)(wsl + WS_WIN) + (size_t)l * INCP * D, D, S, E);
        }
        SEAM(P + 0);
        if (IN(P + 1)) for (int rep = 0; rep < REP_MIX; ++rep) p_mix1(F, l);
        SEAM(P + 1);
        if (IN(P + 2)) for (int rep = 0; rep < REP_MIX; ++rep) p_mix2(F, l);
        SEAM(P + 2);
        if (IN(P + 3)) for (int rep = 0; rep < REP_MIX; ++rep) p_mix3(F, l);
        SEAM(P + 3);
        if (IN(P + 4)) {
            unsigned char* const wsl = launder_ws(F.ws);
            pg::PlainSched S; S.init(64, D / 256, F.G, (int)blockIdx.x);
            pg::EpiOutProj E{(bf16_t*)(wsl + WS_R1), kin(24) + (size_t)l * D};
            for (int rep = 0; rep < REP_GEMM; ++rep) pg::gemm_phase<false>(F.lds, wsl + WS_Y, (const bf16_t*)(wsl + WS_WOUT) + (size_t)l * D * D, D, S, E);
            outproj_tail(F, l, wsl);
        }
        SEAM(P + 4);
        if (IN(P + 5)) { if (REP_LN > 1) p_ln1_router<true>(F, l); p_ln1_router<false>(F, l); }
        SEAM(P + 5);
        if (IN(P + 6)) {
            moe_table(F, l);
            unsigned char* const wsl = launder_ws(F.ws);
            pg::MoeSched S; S.tab = (const LAS int*)(F.lds + LDSCTL_OFF + 256); S.list = (const int*)(wsl + WS_LIST); S.nN = 8; S.G = F.G; S.c = F.vcu; S.gather = 1; S.nrowsB = 2048;
            pg::EpiGateUp8 E{(unsigned char*)(wsl + WS_HM)};
            for (int rep = 0; rep < REP_GEMM; ++rep) pg::gemm_phase<true>(F.lds, wsl + WS_HB8, wsl + WS_WGU + (size_t)l * NEXP * 2048 * D, D / 2, S, E);
        }
        SEAM(P + 6);
        if (IN(P + 7)) {
            moe_table(F, l);
            unsigned char* const wsl = launder_ws(F.ws);
            pg::MoeSched S; S.tab = (const LAS int*)(F.lds + LDSCTL_OFF + 256); S.list = nullptr; S.nN = 8; S.G = F.G; S.c = F.vcu; S.gather = 0; S.nrowsB = 2048;
            pg::EpiDown8 E{(unsigned char*)(wsl + WS_O)};
            for (int rep = 0; rep < REP_GEMM; ++rep) pg::gemm_phase<true>(F.lds, wsl + WS_HM, wsl + WS_WD + (size_t)l * NEXP * D * DEXP, DEXP / 2, S, E);
        }
        SEAM(P + 7);
        if (IN(P + 8)) { moe_table(F, l); if (REP_LN > 1) p_ln2<true>(F, l); p_ln2<false>(F, l); }
        SEAM(P + 8);
}

__global__ void __launch_bounds__(512, 2) mk_fwd(Args args) {
    extern __shared__ __attribute__((aligned(16))) unsigned char lds_raw[];
    Frame F;
    F.lds = (LAS unsigned char*)lds_raw;
    F.MISC = (volatile LAS unsigned*)(F.lds + MISC_OFF);
    F.tid = threadIdx.x; F.lane = F.tid & 63; F.wave = __builtin_amdgcn_readfirstlane(F.tid >> 6);
    F.G = gridDim.x; { const int bx = blockIdx.x; F.vcu = (F.G % 8 == 0) ? (bx % 8) * (F.G / 8) + bx / 8 : bx; }
    F.ws = args.ws; F.ctl = (unsigned*)(args.ws + WS_CTL);
    for (int u = F.tid; u < (LDS_BYTES - LDSCTL_OFF) / 4; u += 512) ((LAS unsigned*)(F.lds + LDSCTL_OFF))[u] = 0u;
    __syncthreads();
    const int lo = args.ph_lo, hi = args.ph_hi;
    const bool multi = (hi - lo) > 1;
    XcdBarrier bar; bar.bar = F.ctl + CW_BAR; bar.x = 0; bar.st = nullptr;
    if (multi) bar = xcd_barrier_post(F.ctl + CW_BAR, F.MISC + 8);

    if (IN(0)) { for (int rep = 0; rep < REP_PRO; ++rep) p_prologue(F); }
    SEAM(0);
    run_layer<0>(F, lo, hi, bar); run_layer<1>(F, lo, hi, bar); run_layer<2>(F, lo, hi, bar); run_layer<3>(F, lo, hi, bar);
}

#ifndef MK_CUT
#define MK_CUT 0
#endif
extern "C" void kernel_launch(void* const* d_in, const int* in_sizes, int n_in, void* d_out, int out_size, void* d_ws, size_t ws_size, hipStream_t stream) {
    static bool attr = false;
    if (!attr) { (void)hipFuncSetAttribute((const void*)mk_fwd, hipFuncAttributeMaxDynamicSharedMemorySize, LDS_BYTES); attr = true; }
    (void)hipMemsetAsync(d_ws, 0, CTL_BYTES, stream);
    Args a{};
    for (int i = 0; i < 36; ++i) a.in[i] = (const float*)d_in[i];
    a.out = (float*)d_out; a.ws = (unsigned char*)d_ws;
    const int NP = 1 + DEPTH * NPH;
#if MK_CUT
    for (int p = 0; p < NP; ++p) { a.ph_lo = p; a.ph_hi = p + 1; hipLaunchKernelGGL(mk_fwd, dim3(256), dim3(512), LDS_BYTES, stream, a); }
#else
    a.ph_lo = 0; a.ph_hi = NP; hipLaunchKernelGGL(mk_fwd, dim3(256), dim3(512), LDS_BYTES, stream, a);
#endif
}
```
